# Optimizing an MI355X kernel written in HIP

```python
import math
import jax, jax.numpy as jnp
from jax import lax
import numpy as np

D_MODEL = 1024
BATCH = 4
SEQ = 8192
DEPTH = 1

D_MIX = D_MODEL
RET_WIDTH = D_MIX // 2
RET_HEADS = 4
RET_HEAD_DIM = RET_WIDTH // RET_HEADS
RET_CHUNK = 128
ROPE_BASE = 10000.0
SSM_WIDTH = D_MIX - RET_WIDTH
SSM_GROUP = 16
SSM_GROUPS = SSM_WIDTH // SSM_GROUP
SSM_STATE = 64
DT_MIN = 1e-3
DT_MAX = 1e-1
D_FF = 4 * D_MODEL
NORM_EPS = 1e-6
IN_COLS = 4 * RET_WIDTH + SSM_WIDTH

kernel_name = "hymba_retnet_s5_sandwich_block"


def rmsnorm(x, g):
    xf = x.astype(jnp.float32)
    y = xf * lax.rsqrt(jnp.mean(xf * xf, axis=-1, keepdims=True) + NORM_EPS) * g.astype(jnp.float32)
    return y.astype(x.dtype)


def rope(x):
    L, d = x.shape[1], x.shape[-1]
    half = d // 2
    inv_freq = ROPE_BASE ** (-jnp.arange(half, dtype=jnp.float32) / half)
    ang = jnp.arange(L, dtype=jnp.float32)[:, None] * inv_freq[None, :]
    cos = jnp.cos(ang)[None, :, None, :]
    sin = jnp.sin(ang)[None, :, None, :]
    x1, x2 = x[..., :half], x[..., half:]
    return jnp.concatenate([x1 * cos - x2 * sin, x1 * sin + x2 * cos], axis=-1)


def retention_chunkwise(q, k, v):
    B, L, H, d = q.shape
    C = RET_CHUNK
    nc = L // C
    log_gamma = jnp.log(1.0 - jnp.exp(jnp.linspace(math.log(1.0 / 32), math.log(1.0 / 512), H))).astype(jnp.float32)
    q = q.reshape(B, nc, C, H, d)
    k = k.reshape(B, nc, C, H, d)
    v = v.reshape(B, nc, C, H, d)
    idx = jnp.arange(C, dtype=jnp.float32)
    diff = idx[:, None] - idx[None, :]
    decay = jnp.where(diff[None] >= 0, jnp.exp(jnp.maximum(diff, 0.0)[None] * log_gamma[:, None, None]), 0.0)
    s = jnp.einsum('bnihk,bnjhk->bnhij', q, k) * decay[None, None]
    inner = jnp.einsum('bnhij,bnjhd->bnihd', s, v)
    zeta = jnp.exp((C - 1 - idx)[None, :] * log_gamma[:, None])
    S = jnp.einsum('bnjhk,bnjhd,hj->bnhkd', k, v, zeta)
    g_chunk = jnp.exp(C * log_gamma)[None, :, None, None]

    def step(R, S_i):
        return g_chunk * R + S_i, R

    R0 = jnp.zeros((B, H, d, d), jnp.float32)
    _, R_prev = lax.scan(step, R0, jnp.moveaxis(S, 1, 0))
    R_prev = jnp.moveaxis(R_prev, 0, 1)
    xi = jnp.exp((idx + 1.0)[None, :] * log_gamma[:, None])
    cross = jnp.einsum('bnihk,bnhkd,hi->bnihd', q, R_prev, xi)
    return (inner + cross).reshape(B, L, H, d)


def head_groupnorm(y, g):
    mu = jnp.mean(y, axis=-1, keepdims=True)
    var = jnp.mean(jnp.square(y - mu), axis=-1, keepdims=True)
    yn = (y - mu) * lax.rsqrt(var + NORM_EPS)
    return yn * g.astype(jnp.float32).reshape(RET_HEADS, RET_HEAD_DIM)


def s5_scan(u, lam_re, lam_im, log_dt, b_re, b_im, c_re, c_im, d_skip):
    B, L, _ = u.shape
    uf = u.astype(jnp.float32).reshape(B, L, SSM_GROUPS, SSM_GROUP)
    lam = lax.complex(jnp.minimum(lam_re.astype(jnp.float32), -1e-4), lam_im.astype(jnp.float32))
    dt = jnp.exp(log_dt.astype(jnp.float32))[:, None]
    lam_bar = jnp.exp(lam * dt)
    b_c = lax.complex(b_re.astype(jnp.float32), b_im.astype(jnp.float32))
    b_bar = ((lam_bar - 1.0) / lam)[:, :, None] * b_c
    bu = jnp.einsum('blgc,gpc->blgp', uf.astype(jnp.complex64), b_bar)
    a = jnp.broadcast_to(lam_bar, bu.shape)

    def combine(e1, e2):
        a1, x1 = e1
        a2, x2 = e2
        return a2 * a1, a2 * x1 + x2

    _, states = lax.associative_scan(combine, (a, bu), axis=1)
    c_c = lax.complex(c_re.astype(jnp.float32), c_im.astype(jnp.float32))
    y = jnp.real(jnp.einsum('blgp,gcp->blgc', states, c_c))
    y = y + d_skip.astype(jnp.float32).reshape(SSM_GROUPS, SSM_GROUP) * uf
    return y.reshape(B, L, SSM_WIDTH)


def setup_inputs(seed: int = 0) -> dict:
    key = jax.random.key(seed)
    ks = jax.random.split(key, 20)
    f32 = jnp.float32
    nrm = lambda k, shape, scale: (jax.random.normal(k, shape, f32) * scale)
    gain = lambda k, shape: 1.0 + 0.02 * jax.random.normal(k, shape, f32)
    x = jax.random.normal(ks[0], (BATCH, SEQ, D_MODEL), f32)
    lam_im_base = math.pi * jnp.arange(SSM_STATE, dtype=f32)
    return {
        "x": x,
        "norm_mix_pre": gain(ks[1], (DEPTH, D_MODEL)),
        "norm_mix_post": gain(ks[2], (DEPTH, D_MODEL)),
        "w_in": nrm(ks[3], (DEPTH, D_MODEL, IN_COLS), D_MODEL ** -0.5),
        "ret_gn_gain": gain(ks[4], (DEPTH, RET_WIDTH)),
        "ssm_lambda_re": -0.5 + 0.01 * jax.random.normal(ks[5], (DEPTH, SSM_GROUPS, SSM_STATE), f32),
        "ssm_lambda_im": lam_im_base + 0.01 * jax.random.normal(ks[6], (DEPTH, SSM_GROUPS, SSM_STATE), f32),
        "ssm_log_dt": jax.random.uniform(ks[7], (DEPTH, SSM_GROUPS), f32, math.log(DT_MIN), math.log(DT_MAX)),
        "ssm_b_re": nrm(ks[8], (DEPTH, SSM_GROUPS, SSM_STATE, SSM_GROUP), (2 * SSM_GROUP) ** -0.5),
        "ssm_b_im": nrm(ks[9], (DEPTH, SSM_GROUPS, SSM_STATE, SSM_GROUP), (2 * SSM_GROUP) ** -0.5),
        "ssm_c_re": nrm(ks[10], (DEPTH, SSM_GROUPS, SSM_GROUP, SSM_STATE), (2 * SSM_STATE) ** -0.5),
        "ssm_c_im": nrm(ks[11], (DEPTH, SSM_GROUPS, SSM_GROUP, SSM_STATE), (2 * SSM_STATE) ** -0.5),
        "ssm_d": nrm(ks[12], (DEPTH, SSM_WIDTH), 1.0),
        "w_glu": nrm(ks[13], (DEPTH, SSM_WIDTH, 2 * SSM_WIDTH), SSM_WIDTH ** -0.5),
        "w_out": nrm(ks[14], (DEPTH, D_MIX, D_MODEL), D_MIX ** -0.5),
        "norm_mlp_pre": gain(ks[15], (DEPTH, D_MODEL)),
        "norm_mlp_post": gain(ks[16], (DEPTH, D_MODEL)),
        "w_ff1": nrm(ks[17], (DEPTH, D_MODEL, D_FF), D_MODEL ** -0.5),
        "w_ff2": nrm(ks[18], (DEPTH, D_FF, D_MODEL), D_FF ** -0.5),
    }


def reference(x, norm_mix_pre, norm_mix_post, w_in, ret_gn_gain, ssm_lambda_re, ssm_lambda_im,
              ssm_log_dt, ssm_b_re, ssm_b_im, ssm_c_re, ssm_c_im, ssm_d, w_glu, w_out,
              norm_mlp_pre, norm_mlp_post, w_ff1, w_ff2):
    B, L, _ = x.shape
    for i in range(DEPTH):
        h = rmsnorm(x, norm_mix_pre[i])
        proj = h @ w_in[i]
        q, k, v, gate, u = jnp.split(proj, [RET_WIDTH, 2 * RET_WIDTH, 3 * RET_WIDTH, 4 * RET_WIDTH], axis=-1)
        heads = lambda t: t.astype(jnp.float32).reshape(B, L, RET_HEADS, RET_HEAD_DIM)
        qh = rope(heads(q))
        kh = rope(heads(k)) * (RET_HEAD_DIM ** -0.5)
        vh = heads(v)
        y_ret = head_groupnorm(retention_chunkwise(qh, kh, vh), ret_gn_gain[i]).reshape(B, L, RET_WIDTH)
        y_ret = (jax.nn.silu(gate.astype(jnp.float32)) * y_ret).astype(x.dtype)

        y_ssm = jax.nn.gelu(s5_scan(u, ssm_lambda_re[i], ssm_lambda_im[i], ssm_log_dt[i], ssm_b_re[i],
                                    ssm_b_im[i], ssm_c_re[i], ssm_c_im[i], ssm_d[i])).astype(x.dtype)
        glu_a, glu_b = jnp.split(y_ssm @ w_glu[i], 2, axis=-1)
        y_ssm = glu_a * jax.nn.sigmoid(glu_b)

        mix = jnp.concatenate([y_ret, y_ssm], axis=-1) @ w_out[i]
        x = x + rmsnorm(mix, norm_mix_post[i])

        h = rmsnorm(x, norm_mlp_pre[i])
        m = jnp.square(jax.nn.relu(h @ w_ff1[i])) @ w_ff2[i]
        x = x + rmsnorm(m, norm_mlp_post[i])
    return x
```

```cpp
#include <hip/hip_runtime.h>
#include <hip/hip_cooperative_groups.h>
#include <cstdio>
namespace cg = cooperative_groups;

#ifndef N_LAUNCH_PER_PHASE
#define N_LAUNCH_PER_PHASE 1
#endif

#define LAS __attribute__((address_space(3)))
typedef unsigned short bf16_t;
typedef short bf16x8 __attribute__((ext_vector_type(8)));
typedef float f32x4 __attribute__((ext_vector_type(4)));
typedef float f32x2 __attribute__((ext_vector_type(2)));
typedef unsigned u32x4 __attribute__((ext_vector_type(4)));
typedef unsigned u32x2 __attribute__((ext_vector_type(2)));

constexpr int T = 32768, SEQ = 8192, DM = 1024, NIN = 2560, DFF = 4096;
constexpr float EPS = 1e-6f;
constexpr int NPHASE = 11;

constexpr size_t MiB = 1u << 20;
constexpr size_t WS_WIN = 1 * MiB, WS_WGLU = 6 * MiB, WS_WOUT = 7 * MiB, WS_WFF1 = 9 * MiB, WS_WFF2 = 17 * MiB;
constexpr size_t WS_ROPE = 25 * MiB, WS_TW = 29 * MiB, WS_W1S = 49 * MiB, WS_SS = 53 * MiB, WS_SS2 = 55 * MiB, WS_HINC = 57 * MiB;
constexpr size_t WS_XN = 80 * MiB;
constexpr size_t WS_QB = 144 * MiB, WS_KB = 176 * MiB, WS_VB = 208 * MiB, WS_GB = 240 * MiB, WS_AU = 272 * MiB;
constexpr size_t WS_SST = 312 * MiB, WS_RTB = 376 * MiB, WS_YSSM = 408 * MiB, WS_YMIX = 440 * MiB;
constexpr size_t WS_MIXB = 144 * MiB, WS_HID = 144 * MiB, WS_MB = 400 * MiB;

constexpr int LDS_BYTES = 147456;
constexpr int TS = 272;
constexpr int TILE_B = 128 * TS;

__device__ __forceinline__ unsigned cvt_pk_bf16(float lo, float hi) { unsigned r; asm volatile("v_cvt_pk_bf16_f32 %0, %1, %2" : "=v"(r) : "v"(lo), "v"(hi)); return r; }
__device__ __forceinline__ float bf_lo(unsigned w) { return __uint_as_float(w << 16); }
__device__ __forceinline__ float bf_hi(unsigned w) { return __uint_as_float(w & 0xffff0000u); }
__device__ __forceinline__ bf16_t f2bf(float f) { return (bf16_t)(cvt_pk_bf16(f, 0.f) & 0xffffu); }
__device__ __forceinline__ float wave_sum(float v) {
#pragma unroll
    for (int o = 1; o < 64; o <<= 1) v += __shfl_xor(v, o);
    return v;
}
#define LDS_WAIT() asm volatile("s_waitcnt lgkmcnt(0)" ::: "memory")

namespace pg8 {
constexpr int BM = 256, BK = 64, HALF = 128, HTB = HALF * BK * 2, STAGE_BYTES = 8 * HTB, NXCD = 8, WGM = 8;
__device__ __forceinline__ int lds_byte(int r, int c) { const int st = (r >> 4) * 2 + (c >> 5), rr = r & 15, cc = c & 31, ob = rr * 64 + cc * 2; return st * 1024 + (ob ^ (((ob >> 9) & 1) << 5)); }
__device__ __forceinline__ void stage_rc(int b, int& R, int& C) { const int st = b / 1024, sb = b % 1024, swz = sb ^ (((sb >> 9) & 1) << 5); R = (st >> 1) * 16 + swz / 64; C = (st & 1) * 32 + (swz % 64) / 2; }
__device__ __forceinline__ int perm32(int rho) { const int n = rho >> 4, i = rho & 15; return 8 * (i >> 2) + 4 * n + (i & 3); }

struct Unit { int pm, pn, pb; };
struct Gemm { const bf16_t* A; const bf16_t* Bt; int lda, ldb, K; size_t bsA, bsB; };

struct StaticOrder {
    int nM, nN, nwg, G, c;
    __device__ void init(int M, int N, int G_, int c_) { nM = M / BM; nN = N / BM; nwg = nM * nN; G = G_; c = c_; }
    __device__ bool next(int i, Unit& u) const {
        const long L = (long)i * G + c; if (L >= nwg) return false;
        int wgid = (int)L; { const int q = nwg / NXCD, r = nwg % NXCD, xcd = wgid % NXCD, off = wgid / NXCD; wgid = (xcd < r ? xcd * (q + 1) : r * (q + 1) + (xcd - r) * q) + off; }
        const int nig = WGM * nN, gid = wgid / nig, fm = gid * WGM, gsz = (nM - fm) < WGM ? (nM - fm) : WGM;
        u.pm = fm + ((wgid % nig) % gsz); u.pn = (wgid % nig) / gsz; u.pb = 0; return true;
    }
};
struct BatchOrder {
    int G, c;
    __device__ bool next(int i, Unit& u) const {
        const int L = i * G + c; if (L >= 256) return false;
        u.pb = L >> 3; const int r = L & 7; u.pm = r & 3; u.pn = r >> 2; return true;
    }
};

template <class Epi, class Sched>
__device__ __forceinline__ void gemm_phase(LAS unsigned char* lds, const Gemm g, const Sched& S, const Epi& E) {
    const int tid = threadIdx.x, wid = __builtin_amdgcn_readfirstlane(tid >> 6), lane = tid & 63, wr = wid >> 2, wc = wid & 3, fr = lane & 15, fq = lane >> 4;
    const int K = g.K, nt = K / BK;
    unsigned voffA[2], voffB[2];
#pragma unroll
    for (int i = 0; i < 2; ++i) { int R, C; stage_rc(tid * 16 + i * 8192, R, C); const int Rb = Epi::PERM ? ((R & ~31) + perm32(R & 31)) : R;
        voffA[i] = (unsigned)(R * g.lda + C) * 2u; voffB[i] = (unsigned)(Rb * g.ldb + C) * 2u; }
    const size_t kstep = (size_t)(BK * 2);
    const size_t hstepA = (size_t)HALF * g.lda * 2, hstepB = (size_t)HALF * g.ldb * 2;
    const size_t tstepA = 2 * hstepA, tstepB = 2 * hstepB;
    const unsigned ldsw = (unsigned)wid * 1024u;
    const int aoff = lds_byte(wr * 64 + fr, fq * 8), boff = lds_byte(wc * 32 + fr, fq * 8);
#define PG8_SA(b, h) (((b) * 2 + (h)) * HTB)
#define PG8_SB(b, h) ((4 + (b) * 2 + (h)) * HTB)
#define PG8_STAGE(bufoff, gbase, voff) do { _Pragma("unroll") for (int _i = 0; _i < 2; ++_i) \
        __builtin_amdgcn_global_load_lds((const unsigned*)((const char*)(gbase) + (voff)[_i]), (LAS unsigned*)(lds + (bufoff) + ldsw + _i * 8192), 16, 0, 0); } while (0)
#define PG8_LDA(dst, b, h) do { _Pragma("unroll") for (int m = 0; m < 4; ++m) _Pragma("unroll") for (int k = 0; k < 2; ++k) dst[m][k] = *(const LAS bf16x8*)(lds + PG8_SA(b, h) + aoff + m * 2048 + k * 1024); } while (0)
#define PG8_LDB(dst, b, h) do { _Pragma("unroll") for (int n = 0; n < 2; ++n) _Pragma("unroll") for (int k = 0; k < 2; ++k) dst[n][k] = *(const LAS bf16x8*)(lds + PG8_SB(b, h) + boff + n * 2048 + k * 1024); } while (0)
#define PG8_MMA(ai, bj, At, Bt) do { __builtin_amdgcn_s_setprio(1); _Pragma("unroll") for (int m = 0; m < 4; ++m) _Pragma("unroll") for (int n = 0; n < 2; ++n) _Pragma("unroll") for (int k = 0; k < 2; ++k) \
        acc[ai][bj][m][n] = __builtin_amdgcn_mfma_f32_16x16x32_bf16(Bt[n][k], At[m][k], acc[ai][bj][m][n], 0, 0, 0); __builtin_amdgcn_s_setprio(0); } while (0)
#define PG8_WAIT_V(n) asm volatile("s_waitcnt vmcnt(" #n ")" ::: "memory")
#define PG8_WAIT_L(n) asm volatile("s_waitcnt lgkmcnt(" #n ")" ::: "memory")
#define PG8_BAR __builtin_amdgcn_s_barrier()
#define PG8_SCHED __builtin_amdgcn_sched_barrier(0)
    Unit cur, nxt; int ui = 0;
    if (!S.next(0, cur)) return;
    f32x4 acc[2][2][4][2];
#pragma unroll
    for (int a = 0; a < 2; ++a)
#pragma unroll
        for (int b = 0; b < 2; ++b)
#pragma unroll
            for (int m = 0; m < 4; ++m)
#pragma unroll
                for (int n = 0; n < 2; ++n) acc[a][b][m][n] = (f32x4){0.f, 0.f, 0.f, 0.f};
    bf16x8 At[4][2], B0[2][2], B1[2][2];
    const char* cA = (const char*)g.A + (size_t)cur.pb * g.bsA * 2 + (size_t)cur.pm * tstepA;
    const char* cB = (const char*)g.Bt + (size_t)cur.pb * g.bsB * 2 + (size_t)cur.pn * tstepB;
    PG8_STAGE(PG8_SB(0, 0), cB, voffB); PG8_STAGE(PG8_SA(0, 0), cA, voffA); PG8_STAGE(PG8_SB(0, 1), cB + hstepB, voffB); PG8_STAGE(PG8_SA(0, 1), cA + hstepA, voffA);
    if (wr == 1) PG8_BAR;
    PG8_WAIT_V(4); PG8_BAR;
    PG8_STAGE(PG8_SB(1, 0), cB + kstep, voffB); PG8_STAGE(PG8_SA(1, 0), cA + kstep, voffA); PG8_STAGE(PG8_SB(1, 1), cB + hstepB + kstep, voffB);
    PG8_WAIT_V(6); PG8_BAR;
    for (;;) {
        const bool has_next = S.next(ui + 1, nxt);
        const char* nA = has_next ? (const char*)g.A + (size_t)nxt.pb * g.bsA * 2 + (size_t)nxt.pm * tstepA : cA;
        const char* nB = has_next ? (const char*)g.Bt + (size_t)nxt.pb * g.bsB * 2 + (size_t)nxt.pn * tstepB : cB;
        for (int t = 0; t < nt; t += 2) {
            const bool last = (t == nt - 2);
            const char* a1 = cA + (size_t)(t + 1) * kstep;
            const char* a2 = last ? nA : cA + (size_t)(t + 2) * kstep; const char* b2 = last ? nB : cB + (size_t)(t + 2) * kstep;
            const char* a3 = a2 + kstep; const char* b3 = b2 + kstep;
            PG8_LDB(B0, 0, 0); PG8_SCHED; PG8_LDA(At, 0, 0); PG8_STAGE(PG8_SA(1, 1), a1 + hstepA, voffA);
            PG8_WAIT_L(8); PG8_BAR; PG8_WAIT_L(0); PG8_MMA(0, 0, At, B0); PG8_BAR; PG8_SCHED;
            PG8_LDB(B1, 0, 1); PG8_STAGE(PG8_SB(0, 0), b2, voffB);
            PG8_BAR; PG8_WAIT_L(0); PG8_MMA(0, 1, At, B1); PG8_BAR;
            PG8_LDA(At, 0, 1); PG8_STAGE(PG8_SA(0, 0), a2, voffA);
            PG8_BAR; PG8_WAIT_L(0); PG8_MMA(1, 0, At, B0); PG8_BAR; PG8_SCHED;
            PG8_STAGE(PG8_SB(0, 1), b2 + hstepB, voffB);
            PG8_WAIT_V(6); PG8_BAR; PG8_MMA(1, 1, At, B1); PG8_BAR;
            PG8_LDB(B0, 1, 0); PG8_SCHED; PG8_LDA(At, 1, 0); PG8_STAGE(PG8_SA(0, 1), a2 + hstepA, voffA);
            PG8_WAIT_L(8); PG8_BAR; PG8_WAIT_L(0); PG8_MMA(0, 0, At, B0); PG8_BAR; PG8_SCHED;
            PG8_LDB(B1, 1, 1); PG8_STAGE(PG8_SB(1, 0), b3, voffB);
            PG8_BAR; PG8_WAIT_L(0); PG8_MMA(0, 1, At, B1); PG8_BAR;
            PG8_LDA(At, 1, 1); PG8_STAGE(PG8_SA(1, 0), a3, voffA);
            PG8_BAR; PG8_WAIT_L(0); PG8_MMA(1, 0, At, B0); PG8_BAR; PG8_SCHED;
            PG8_STAGE(PG8_SB(1, 1), b3 + hstepB, voffB);
            PG8_WAIT_V(6); PG8_BAR; PG8_MMA(1, 1, At, B1); PG8_BAR;
        }
        E(acc, cur, wr, wc, fr, fq);
        if (!has_next) break;
#pragma unroll
        for (int a = 0; a < 2; ++a)
#pragma unroll
            for (int b = 0; b < 2; ++b)
#pragma unroll
                for (int m = 0; m < 4; ++m)
#pragma unroll
                    for (int n = 0; n < 2; ++n) acc[a][b][m][n] = (f32x4){0.f, 0.f, 0.f, 0.f};
        cur = nxt; cA = nA; cB = nB; ++ui;
    }
    PG8_WAIT_V(0);
    if (wr == 0) PG8_BAR;
    PG8_BAR;
#undef PG8_SA
#undef PG8_SB
#undef PG8_STAGE
#undef PG8_LDA
#undef PG8_LDB
#undef PG8_MMA
#undef PG8_WAIT_V
#undef PG8_WAIT_L
#undef PG8_BAR
#undef PG8_SCHED
}

__device__ __forceinline__ u32x4 pack8(const f32x4 v0, const f32x4 v1) {
    u32x4 w; w.x = cvt_pk_bf16(v0[0], v0[1]); w.y = cvt_pk_bf16(v0[2], v0[3]); w.z = cvt_pk_bf16(v1[0], v1[1]); w.w = cvt_pk_bf16(v1[2], v1[3]); return w;
}
__device__ __forceinline__ f32x4 rope4(const f32x4 v, const f32x4 cs) {
    f32x4 r; r[0] = v[0] * cs[0] - v[1] * cs[1]; r[1] = v[0] * cs[1] + v[1] * cs[0]; r[2] = v[2] * cs[2] - v[3] * cs[3]; r[3] = v[2] * cs[3] + v[3] * cs[2]; return r;
}
struct EpiInProj {
    static constexpr bool PERM = true;
    bf16_t *Q, *Kb, *V, *Gt, *AU; const float* rope;
    __device__ __forceinline__ void operator()(const f32x4 (&acc)[2][2][4][2], const Unit& u, int wr, int wc, int fr, int fq) const {
        const int sect = u.pn >> 1;
        const int row0 = u.pm * BM + wr * 64 + fr;
        const int colt = (u.pn & 1) * 256 + wc * 32 + 8 * fq;
        if (sect <= 1) {
            bf16_t* O = sect ? Kb : Q;
#pragma unroll
            for (int ai = 0; ai < 2; ++ai)
#pragma unroll
                for (int m = 0; m < 4; ++m) {
                    const int row = row0 + ai * HALF + m * 16, pos = row & (SEQ - 1);
                    const float* rp = rope + ((size_t)pos * 64 + 16 * wc + 4 * fq) * 2;
                    const f32x4 cs0 = *(const f32x4*)rp, cs1 = *(const f32x4*)(rp + 4);
#pragma unroll
                    for (int bj = 0; bj < 2; ++bj) {
                        const f32x4 v0 = rope4(acc[ai][bj][m][0], cs0), v1 = rope4(acc[ai][bj][m][1], cs1);
                        *(u32x4*)(O + (size_t)row * 512 + colt + bj * HALF) = pack8(v0, v1);
                    }
                }
        } else if (sect <= 3) {
            bf16_t* O = (sect == 2) ? V : Gt;
#pragma unroll
            for (int ai = 0; ai < 2; ++ai)
#pragma unroll
                for (int m = 0; m < 4; ++m) {
                    const int row = row0 + ai * HALF + m * 16;
#pragma unroll
                    for (int bj = 0; bj < 2; ++bj) *(u32x4*)(O + (size_t)row * 512 + colt + bj * HALF) = pack8(acc[ai][bj][m][0], acc[ai][bj][m][1]);
                }
        } else {
#pragma unroll
            for (int ai = 0; ai < 2; ++ai)
#pragma unroll
                for (int m = 0; m < 4; ++m) {
                    const int row = row0 + ai * HALF + m * 16, cr = row >> 5, s = row & 31;
#pragma unroll
                    for (int bj = 0; bj < 2; ++bj) {
                        const int cu = colt + bj * HALF, g = cu >> 4, c0 = cu & 15;
                        *(u32x4*)(AU + ((size_t)(g * 1024 + cr) * 640 + s * 16 + c0)) = pack8(acc[ai][bj][m][0], acc[ai][bj][m][1]);
                    }
                }
        }
    }
};
struct EpiGlu {
    static constexpr bool PERM = true;
    bf16_t* Y;
    __device__ __forceinline__ void operator()(const f32x4 (&acc)[2][2][4][2], const Unit& u, int wr, int wc, int fr, int fq) const {
        const int row0 = u.pm * BM + wr * 64 + fr, col = 512 + u.pn * 128 + wc * 32 + 8 * fq;
#pragma unroll
        for (int ai = 0; ai < 2; ++ai)
#pragma unroll
            for (int m = 0; m < 4; ++m) {
                const int row = row0 + ai * HALF + m * 16;
                f32x4 y0, y1;
#pragma unroll
                for (int j = 0; j < 4; ++j) {
                    y0[j] = acc[ai][0][m][0][j] / (1.0f + __expf(-acc[ai][1][m][0][j]));
                    y1[j] = acc[ai][0][m][1][j] / (1.0f + __expf(-acc[ai][1][m][1][j]));
                }
                *(u32x4*)(Y + (size_t)row * 1024 + col) = pack8(y0, y1);
            }
    }
};
struct EpiSS {
    static constexpr bool PERM = true;
    bf16_t* O; float* SS;
    __device__ __forceinline__ void operator()(const f32x4 (&acc)[2][2][4][2], const Unit& u, int wr, int wc, int fr, int fq) const {
        const int row0 = u.pm * BM + wr * 64 + fr, col = u.pn * BM + wc * 32 + 8 * fq;
#pragma unroll
        for (int ai = 0; ai < 2; ++ai)
#pragma unroll
            for (int m = 0; m < 4; ++m) {
                const int row = row0 + ai * HALF + m * 16; float q = 0.f;
#pragma unroll
                for (int bj = 0; bj < 2; ++bj) {
                    const f32x4 v0 = acc[ai][bj][m][0], v1 = acc[ai][bj][m][1];
                    q += (v0[0] * v0[0] + v0[1] * v0[1]) + (v0[2] * v0[2] + v0[3] * v0[3]) + (v1[0] * v1[0] + v1[1] * v1[1]) + (v1[2] * v1[2] + v1[3] * v1[3]);
                    *(u32x4*)(O + (size_t)row * 1024 + col + bj * HALF) = pack8(v0, v1);
                }
                q += __shfl_xor(q, 16); q += __shfl_xor(q, 32);
                if (fq == 0) SS[(size_t)row * 16 + u.pn * 4 + wc] = q;
            }
    }
};
struct EpiRelu2 {
    static constexpr bool PERM = true;
    bf16_t* O;
    __device__ __forceinline__ void operator()(const f32x4 (&acc)[2][2][4][2], const Unit& u, int wr, int wc, int fr, int fq) const {
        const int row0 = u.pm * BM + wr * 64 + fr, col = u.pn * BM + wc * 32 + 8 * fq;
#pragma unroll
        for (int ai = 0; ai < 2; ++ai)
#pragma unroll
            for (int m = 0; m < 4; ++m) {
                const int row = row0 + ai * HALF + m * 16;
#pragma unroll
                for (int bj = 0; bj < 2; ++bj) {
                    f32x4 v0 = acc[ai][bj][m][0], v1 = acc[ai][bj][m][1];
#pragma unroll
                    for (int j = 0; j < 4; ++j) { const float a = fmaxf(v0[j], 0.f), b = fmaxf(v1[j], 0.f); v0[j] = a * a; v1[j] = b * b; }
                    *(u32x4*)(O + (size_t)row * DFF + col + bj * HALF) = pack8(v0, v1);
                }
            }
    }
};
struct EpiSsm {
    static constexpr bool PERM = true;
    const bf16_t* AU; const float* dskip; bf16_t* Y;
    __device__ __forceinline__ void operator()(const f32x4 (&acc)[2][2][4][2], const Unit& u, int wr, int wc, int fr, int fq) const {
        const int g = u.pb;
        const int row0 = u.pm * BM + wr * 64 + fr, colt = u.pn * BM + wc * 32 + 8 * fq;
        const int c0 = 8 * (fq & 1);
        const f32x4 d0 = *(const f32x4*)(dskip + g * 16 + c0), d1 = *(const f32x4*)(dskip + g * 16 + c0 + 4);
#pragma unroll
        for (int ai = 0; ai < 2; ++ai)
#pragma unroll
            for (int m = 0; m < 4; ++m) {
                const int cr = row0 + ai * HALF + m * 16;
#pragma unroll
                for (int bj = 0; bj < 2; ++bj) {
                    const int col = colt + bj * HALF, s = col >> 4;
                    const u32x4 uw = *(const u32x4*)(AU + ((size_t)(g * 1024 + cr) * 640 + col));
                    f32x4 v0 = acc[ai][bj][m][0], v1 = acc[ai][bj][m][1];
                    v0[0] += d0[0] * bf_lo(uw.x); v0[1] += d0[1] * bf_hi(uw.x); v0[2] += d0[2] * bf_lo(uw.y); v0[3] += d0[3] * bf_hi(uw.y);
                    v1[0] += d1[0] * bf_lo(uw.z); v1[1] += d1[1] * bf_hi(uw.z); v1[2] += d1[2] * bf_lo(uw.w); v1[3] += d1[3] * bf_hi(uw.w);
#pragma unroll
                    for (int j = 0; j < 4; ++j) {
                        const float a = v0[j], za = 1.5957691216f * (a + 0.044715f * a * a * a); v0[j] = a / (1.0f + __expf(-za));
                        const float b = v1[j], zb = 1.5957691216f * (b + 0.044715f * b * b * b); v1[j] = b / (1.0f + __expf(-zb));
                    }
                    const size_t tok = (size_t)cr * 32 + s;
                    *(u32x4*)(Y + tok * 512 + g * 16 + c0) = pack8(v0, v1);
                }
            }
    }
};
}

__device__ __forceinline__ bf16x8 frag_nat(const LAS unsigned char* tile, int idx0, int k0, int fr, int fq) {
    return *(const LAS bf16x8*)(tile + (idx0 + fr) * TS + (k0 + 8 * fq) * 2);
}
__device__ __forceinline__ bf16x8 frag_tr(unsigned tile_addr, int k0, int idx0, int lane) {
    const int g = lane >> 4, q = (lane & 15) >> 2, p = lane & 3;
    const unsigned addr = tile_addr + (unsigned)((k0 + 8 * g + q) * TS + (idx0 + 4 * p) * 2);
    u32x2 lo, hi;
    asm volatile("ds_read_b64_tr_b16 %0, %2\n\tds_read_b64_tr_b16 %1, %2 offset:1088\n\ts_waitcnt lgkmcnt(0)" : "=&v"(lo), "=&v"(hi) : "v"(addr) : "memory");
    u32x4 r; r.x = lo.x; r.y = lo.y; r.z = hi.x; r.w = hi.y;
    return __builtin_bit_cast(bf16x8, r);
}
__device__ __forceinline__ void frags_tr8(bf16x8 (&b)[8], unsigned tile_addr, int k0, int lane) {
    const int g = lane >> 4, q = (lane & 15) >> 2, p = lane & 3;
    const unsigned addr = tile_addr + (unsigned)((k0 + 8 * g + q) * TS + (4 * p) * 2);
    u32x2 r0, r1, r2, r3, r4, r5, r6, r7, r8, r9, r10, r11, r12, r13, r14, r15;
    asm volatile(
        "ds_read_b64_tr_b16 %0, %16\n\t"
        "ds_read_b64_tr_b16 %1, %16 offset:1088\n\t"
        "ds_read_b64_tr_b16 %2, %16 offset:32\n\t"
        "ds_read_b64_tr_b16 %3, %16 offset:1120\n\t"
        "ds_read_b64_tr_b16 %4, %16 offset:64\n\t"
        "ds_read_b64_tr_b16 %5, %16 offset:1152\n\t"
        "ds_read_b64_tr_b16 %6, %16 offset:96\n\t"
        "ds_read_b64_tr_b16 %7, %16 offset:1184\n\t"
        "ds_read_b64_tr_b16 %8, %16 offset:128\n\t"
        "ds_read_b64_tr_b16 %9, %16 offset:1216\n\t"
        "ds_read_b64_tr_b16 %10, %16 offset:160\n\t"
        "ds_read_b64_tr_b16 %11, %16 offset:1248\n\t"
        "ds_read_b64_tr_b16 %12, %16 offset:192\n\t"
        "ds_read_b64_tr_b16 %13, %16 offset:1280\n\t"
        "ds_read_b64_tr_b16 %14, %16 offset:224\n\t"
        "ds_read_b64_tr_b16 %15, %16 offset:1312\n\t"
        "s_waitcnt lgkmcnt(0)"
        : "=&v"(r0), "=&v"(r1), "=&v"(r2), "=&v"(r3), "=&v"(r4), "=&v"(r5), "=&v"(r6), "=&v"(r7),
          "=&v"(r8), "=&v"(r9), "=&v"(r10), "=&v"(r11), "=&v"(r12), "=&v"(r13), "=&v"(r14), "=&v"(r15)
        : "v"(addr) : "memory");
    u32x4 w;
    w.x = r0.x; w.y = r0.y; w.z = r1.x; w.w = r1.y; b[0] = __builtin_bit_cast(bf16x8, w);
    w.x = r2.x; w.y = r2.y; w.z = r3.x; w.w = r3.y; b[1] = __builtin_bit_cast(bf16x8, w);
    w.x = r4.x; w.y = r4.y; w.z = r5.x; w.w = r5.y; b[2] = __builtin_bit_cast(bf16x8, w);
    w.x = r6.x; w.y = r6.y; w.z = r7.x; w.w = r7.y; b[3] = __builtin_bit_cast(bf16x8, w);
    w.x = r8.x; w.y = r8.y; w.z = r9.x; w.w = r9.y; b[4] = __builtin_bit_cast(bf16x8, w);
    w.x = r10.x; w.y = r10.y; w.z = r11.x; w.w = r11.y; b[5] = __builtin_bit_cast(bf16x8, w);
    w.x = r12.x; w.y = r12.y; w.z = r13.x; w.w = r13.y; b[6] = __builtin_bit_cast(bf16x8, w);
    w.x = r14.x; w.y = r14.y; w.z = r15.x; w.w = r15.y; b[7] = __builtin_bit_cast(bf16x8, w);
}
template <bool ATR, bool BTR>
__device__ __forceinline__ void mma128(f32x4 (&acc)[8], const LAS unsigned char* lds, unsigned lds_addr, int offA, int offB, int m0, int lane) {
    const int fr = lane & 15, fq = lane >> 4;
#pragma unroll
    for (int ks = 0; ks < 4; ++ks) {
        bf16x8 af, bfr[8];
        if (ATR) af = frag_tr(lds_addr + offA, 32 * ks, m0, lane); else af = frag_nat(lds + offA, m0, 32 * ks, fr, fq);
        if (BTR) frags_tr8(bfr, lds_addr + offB, 32 * ks, lane);
        else {
#pragma unroll
            for (int n = 0; n < 8; ++n) bfr[n] = frag_nat(lds + offB, 16 * n, 32 * ks, fr, fq);
        }
#pragma unroll
        for (int n = 0; n < 8; ++n) acc[n] = __builtin_amdgcn_mfma_f32_16x16x32_bf16(bfr[n], af, acc[n], 0, 0, 0);
    }
}
__device__ __forceinline__ void tile_load(LAS unsigned char* dst, const bf16_t* src, int ld, int tid) {
    u32x4 v[4];
#pragma unroll
    for (int i = 0; i < 4; ++i) { const int q = tid + 512 * i, row = q >> 4, pc = q & 15; v[i] = *(const u32x4*)(src + (size_t)row * ld + pc * 8); }
#pragma unroll
    for (int i = 0; i < 4; ++i) { const int q = tid + 512 * i, row = q >> 4, pc = q & 15; *(LAS u32x4*)(dst + row * TS + pc * 16) = v[i]; }
}
__device__ __forceinline__ void tile_load_zeta(LAS unsigned char* dst, const bf16_t* src, int ld, int tid, float l2g) {
    u32x4 v[4];
#pragma unroll
    for (int i = 0; i < 4; ++i) { const int q = tid + 512 * i, row = q >> 4, pc = q & 15; v[i] = *(const u32x4*)(src + (size_t)row * ld + pc * 8); }
#pragma unroll
    for (int i = 0; i < 4; ++i) {
        const int q = tid + 512 * i, row = q >> 4, pc = q & 15; const float z = exp2f((float)(127 - row) * l2g);
        u32x4 w;
        w.x = cvt_pk_bf16(bf_lo(v[i].x) * z, bf_hi(v[i].x) * z); w.y = cvt_pk_bf16(bf_lo(v[i].y) * z, bf_hi(v[i].y) * z);
        w.z = cvt_pk_bf16(bf_lo(v[i].z) * z, bf_hi(v[i].z) * z); w.w = cvt_pk_bf16(bf_lo(v[i].w) * z, bf_hi(v[i].w) * z);
        *(LAS u32x4*)(dst + row * TS + pc * 16) = w;
    }
}
__device__ __forceinline__ float ret_log2_gamma(int h) { const float g = 1.0f - exp2f(-5.0f - (4.0f / 3.0f) * (float)h); return log2f(g); }

__device__ __forceinline__ int dest_row(int mode, int n) {
    if (mode == 1) { if (n < 1024) { const int sect = n >> 9, w = n & 511, h = w >> 7, j = w & 127; return (sect << 9) + (h << 7) + ((j & 63) << 1) + (j >> 6); } return n; }
    if (mode == 2) { const int bj = n >> 9, rem = n & 511, pn = rem >> 7, j = rem & 127; return (pn << 8) + (bj << 7) + j; }
    return n;
}
__device__ __forceinline__ void p0_transpose_item(const float* W, int K, int N, bf16_t* WT, const float* gain, int mode, LAS float* scr, int item, int lane) {
    const int nblk = N / 32, kb = item / nblk, nb = item % nblk, k0 = 64 * kb, n0 = 32 * nb;
    const float cs = (mode == 1 && n0 >= 512 && n0 < 1024) ? 0.08838834764831845f : 1.0f;
#pragma unroll 8
    for (int i = 0; i < 32; ++i) { const int kk = 2 * i + (lane >> 5); const float g = gain ? gain[k0 + kk] * cs : cs; scr[kk * 33 + (lane & 31)] = W[(size_t)(k0 + kk) * N + n0 + (lane & 31)] * g; }
    LDS_WAIT();
    const int c = lane & 7;
#pragma unroll
    for (int j = 0; j < 4; ++j) { const int n = (lane >> 3) + 8 * j; const LAS float* s = scr + (8 * c) * 33 + n;
        u32x4 o; o.x = cvt_pk_bf16(s[0 * 33], s[1 * 33]); o.y = cvt_pk_bf16(s[2 * 33], s[3 * 33]); o.z = cvt_pk_bf16(s[4 * 33], s[5 * 33]); o.w = cvt_pk_bf16(s[6 * 33], s[7 * 33]);
        *(u32x4*)(WT + (size_t)dest_row(mode, n0 + n) * K + k0 + 8 * c) = o; }
    LDS_WAIT();
}
__device__ __forceinline__ void s5_pow(float lre, float lim, float dt, float j, float& pr, float& pi) {
    const float mag = expf(j * (dt * lre)); float s, c; sincosf(j * (dt * lim), &s, &c); pr = mag * c; pi = mag * s;
}
__device__ __forceinline__ void s5_coef(float lre, float lim, float dt, float& cr, float& ci) {
    float br, bi; s5_pow(lre, lim, dt, 1.0f, br, bi); br -= 1.0f;
    const float den = lre * lre + lim * lim; cr = (br * lre + bi * lim) / den; ci = (bi * lre - br * lim) / den;
}

struct Args { const float* in[19]; float* out; unsigned char* ws; int ph_lo, ph_hi; };

__global__ void __launch_bounds__(512, 2) fwd_kernel(Args a) {
    extern __shared__ __attribute__((aligned(16))) unsigned char lds_raw[];
    LAS unsigned char* lds = (LAS unsigned char*)lds_raw;
    const unsigned lds_addr = (unsigned)(size_t)lds_raw;
    cg::grid_group grid = cg::this_grid();
    const int tid = threadIdx.x, lane = tid & 63, wave = __builtin_amdgcn_readfirstlane(tid >> 6);
    const int G = gridDim.x, bx = blockIdx.x;
    const int lo = a.ph_lo, hi = a.ph_hi;
    unsigned char* ws = a.ws;
#define IN(k) (lo <= (k) && (k) < hi)
#define SEAM(k) do { if (lo <= (k) && (k) + 1 < hi) grid.sync(); } while (0)

    const float* x = a.in[0];
    const float* g_mix_pre = a.in[1]; const float* g_mix_post = a.in[2]; const float* w_in = a.in[3]; const float* gn_gain = a.in[4];
    const float* lam_re = a.in[5]; const float* lam_im = a.in[6]; const float* log_dt = a.in[7];
    const float* b_re = a.in[8]; const float* b_im = a.in[9]; const float* c_re = a.in[10]; const float* c_im = a.in[11]; const float* d_skip = a.in[12];
    const float* w_glu = a.in[13]; const float* w_out = a.in[14]; const float* g_mlp_pre = a.in[15]; const float* g_mlp_post = a.in[16];
    const float* w_ff1 = a.in[17]; const float* w_ff2 = a.in[18];
    float* out = a.out;

    bf16_t* WIN = (bf16_t*)(ws + WS_WIN); bf16_t* WGLU = (bf16_t*)(ws + WS_WGLU); bf16_t* WOUT = (bf16_t*)(ws + WS_WOUT);
    bf16_t* WFF1 = (bf16_t*)(ws + WS_WFF1); bf16_t* WFF2 = (bf16_t*)(ws + WS_WFF2);
    float* ROPE = (float*)(ws + WS_ROPE); bf16_t* TW = (bf16_t*)(ws + WS_TW); bf16_t* W1S = (bf16_t*)(ws + WS_W1S);
    float* SS = (float*)(ws + WS_SS); float* SS2 = (float*)(ws + WS_SS2); float* HINC = (float*)(ws + WS_HINC);
    bf16_t* XN = (bf16_t*)(ws + WS_XN);
    bf16_t* QB = (bf16_t*)(ws + WS_QB); bf16_t* KB = (bf16_t*)(ws + WS_KB); bf16_t* VB = (bf16_t*)(ws + WS_VB); bf16_t* GB = (bf16_t*)(ws + WS_GB);
    bf16_t* AU = (bf16_t*)(ws + WS_AU); float* SST = (float*)(ws + WS_SST); bf16_t* RTB = (bf16_t*)(ws + WS_RTB);
    bf16_t* YSSM = (bf16_t*)(ws + WS_YSSM); bf16_t* YMIX = (bf16_t*)(ws + WS_YMIX);
    bf16_t* MIXB = (bf16_t*)(ws + WS_MIXB); bf16_t* HID = (bf16_t*)(ws + WS_HID); bf16_t* MB = (bf16_t*)(ws + WS_MB);

    if (IN(0)) {
        const int gw = bx * 8 + wave, NGW = G * 8;
        {
            LAS float* scr = (LAS float*)(lds + wave * 16384);
            constexpr int I_IN = (DM / 64) * (NIN / 32), I_GLU = (512 / 64) * (1024 / 32), I_OUT = (DM / 64) * (DM / 32), I_F1 = (DM / 64) * (DFF / 32), I_F2 = (DFF / 64) * (DM / 32);
            constexpr int NITEMS = I_IN + I_GLU + I_OUT + I_F1 + I_F2;
            for (int it = gw; it < NITEMS; it += NGW) {
                int r = it;
                if (r < I_IN) { p0_transpose_item(w_in, DM, NIN, WIN, g_mix_pre, 1, scr, r, lane); continue; } r -= I_IN;
                if (r < I_GLU) { p0_transpose_item(w_glu, 512, 1024, WGLU, nullptr, 2, scr, r, lane); continue; } r -= I_GLU;
                if (r < I_OUT) { p0_transpose_item(w_out, DM, DM, WOUT, nullptr, 0, scr, r, lane); continue; } r -= I_OUT;
                if (r < I_F1) { p0_transpose_item(w_ff1, DM, DFF, WFF1, g_mlp_pre, 0, scr, r, lane); continue; } r -= I_F1;
                p0_transpose_item(w_ff2, DFF, DM, WFF2, nullptr, 0, scr, r, lane);
            }
        }
        for (int m = gw; m < T; m += NGW) {
            const f32x4* xr = (const f32x4*)(x + (size_t)m * DM) + lane;
            f32x4 v[4]; float s = 0.f;
#pragma unroll
            for (int j = 0; j < 4; ++j) { v[j] = xr[64 * j]; s += (v[j][0] * v[j][0] + v[j][1] * v[j][1]) + (v[j][2] * v[j][2] + v[j][3] * v[j][3]); }
            const float rstd = 1.0f / sqrtf(wave_sum(s) * (1.0f / DM) + EPS);
            u32x2* o8 = (u32x2*)(XN + (size_t)m * DM) + lane;
#pragma unroll
            for (int j = 0; j < 4; ++j) { u32x2 w; w.x = cvt_pk_bf16(v[j][0] * rstd, v[j][1] * rstd); w.y = cvt_pk_bf16(v[j][2] * rstd, v[j][3] * rstd); o8[64 * j] = w; }
        }
        for (int i = bx * 512 + tid; i < SEQ * 64; i += G * 512) {
            const int pos = i >> 6, j = i & 63;
            const float inv = (float)pow(10000.0, -(double)j / 64.0);
            const float ang = (float)pos * inv; float s, c; sincosf(ang, &s, &c);
            *(f32x2*)(ROPE + (size_t)i * 2) = (f32x2){c, s};
        }
        for (int i = bx * 512 + tid; i < 32 * 32 * 64; i += G * 512) {
            {
                const int q = i & 63, t = (i >> 6) & 31, g = i >> 11;
                const float lre = fminf(lam_re[g * 64 + q], -1e-4f), lim = lam_im[g * 64 + q], dt = expf(log_dt[g]);
                float pr, pi; s5_pow(lre, lim, dt, (float)(t + 1), pr, pi);
#pragma unroll 4
                for (int c = 0; c < 16; ++c) {
                    const float cr = c_re[(g * 16 + c) * 64 + q], ci = c_im[(g * 16 + c) * 64 + q];
                    const float zr = cr * pr - ci * pi, zi = cr * pi + ci * pr;
                    bf16_t* row = TW + (size_t)(g * 512 + t * 16 + c) * 640 + 512;
                    row[q] = f2bf(zr); row[64 + q] = f2bf(-zi);
                }
            }
            {
                const int s = i & 31, p = (i >> 5) & 63, g = i >> 11;
                const float lre = fminf(lam_re[g * 64 + p], -1e-4f), lim = lam_im[g * 64 + p], dt = expf(log_dt[g]);
                float pr, pi, cr, ci; s5_pow(lre, lim, dt, (float)(31 - s), pr, pi); s5_coef(lre, lim, dt, cr, ci);
                const float wr_ = pr * cr - pi * ci, wi_ = pr * ci + pi * cr;
                float zr[16], zi[16];
#pragma unroll
                for (int c = 0; c < 16; ++c) { const float br = b_re[(g * 64 + p) * 16 + c], bi = b_im[(g * 64 + p) * 16 + c]; zr[c] = wr_ * br - wi_ * bi; zi[c] = wr_ * bi + wi_ * br; }
                u32x4* o0 = (u32x4*)(W1S + (size_t)(g * 128 + p) * 512 + s * 16);
                u32x4* o1 = (u32x4*)(W1S + (size_t)(g * 128 + 64 + p) * 512 + s * 16);
                u32x4 w;
                w.x = cvt_pk_bf16(zr[0], zr[1]); w.y = cvt_pk_bf16(zr[2], zr[3]); w.z = cvt_pk_bf16(zr[4], zr[5]); w.w = cvt_pk_bf16(zr[6], zr[7]); o0[0] = w;
                w.x = cvt_pk_bf16(zr[8], zr[9]); w.y = cvt_pk_bf16(zr[10], zr[11]); w.z = cvt_pk_bf16(zr[12], zr[13]); w.w = cvt_pk_bf16(zr[14], zr[15]); o0[1] = w;
                w.x = cvt_pk_bf16(zi[0], zi[1]); w.y = cvt_pk_bf16(zi[2], zi[3]); w.z = cvt_pk_bf16(zi[4], zi[5]); w.w = cvt_pk_bf16(zi[6], zi[7]); o1[0] = w;
                w.x = cvt_pk_bf16(zi[8], zi[9]); w.y = cvt_pk_bf16(zi[10], zi[11]); w.z = cvt_pk_bf16(zi[12], zi[13]); w.w = cvt_pk_bf16(zi[14], zi[15]); o1[1] = w;
            }
        }
        __syncthreads();
        {
            LAS float* cp = (LAS float*)(lds + 8 * 16384) + (tid >> 8) * 128;
            const int half = tid >> 8, t256 = tid & 255;
            for (int it = bx; it < 1024; it += G) {
                const int g = it >> 5, jj = 2 * (it & 31) + half - 31;
                if (t256 < 64 && jj >= 0 && jj <= 31) {
                    const int p = t256;
                    const float lre = fminf(lam_re[g * 64 + p], -1e-4f), lim = lam_im[g * 64 + p], dt = expf(log_dt[g]);
                    float pr, pi, cr, ci; s5_pow(lre, lim, dt, (float)jj, pr, pi); s5_coef(lre, lim, dt, cr, ci);
                    cp[p] = pr * cr - pi * ci; cp[64 + p] = pr * ci + pi * cr;
                }
                __syncthreads();
                if (jj <= 31) {
                    const int c = t256 >> 4, c2 = t256 & 15; float val = 0.f;
                    if (jj >= 0) {
                        for (int p = 0; p < 64; ++p) {
                            const float xr_ = cp[p], xi_ = cp[64 + p];
                            const float br = b_re[(g * 64 + p) * 16 + c2], bi = b_im[(g * 64 + p) * 16 + c2];
                            const float zr = xr_ * br - xi_ * bi, zi = xr_ * bi + xi_ * br;
                            val += c_re[(g * 16 + c) * 64 + p] * zr - c_im[(g * 16 + c) * 64 + p] * zi;
                        }
                    }
                    const bf16_t bv = f2bf(val);
                    const int tlo = jj >= 0 ? jj : 0, thi = jj >= 0 ? 31 : 31 + jj;
                    for (int t = tlo; t <= thi; ++t) TW[(size_t)(g * 512 + t * 16 + c) * 640 + (t - jj) * 16 + c2] = bv;
                }
                __syncthreads();
            }
        }
    }
    SEAM(0);

    if (IN(1)) {
        pg8::Gemm g{XN, WIN, DM, DM, DM, 0, 0}; pg8::StaticOrder S; S.init(T, NIN, G, bx);
        pg8::EpiInProj E{QB, KB, VB, GB, AU, ROPE};
        pg8::gemm_phase(lds, g, S, E);
    }
    SEAM(1);

    if (IN(2)) {
        const int fr = lane & 15, fq = lane >> 4;
        for (int it = bx; it < 256; it += G) {
            const int g = it >> 3, rt = it & 7;
            f32x4 acc[8];
#pragma unroll
            for (int n = 0; n < 8; ++n) acc[n] = (f32x4){0.f, 0.f, 0.f, 0.f};
            for (int kt = 0; kt < 4; ++kt) {
                tile_load(lds, AU + (size_t)(g * 1024 + rt * 128) * 640 + kt * 128, 640, tid);
                tile_load(lds + TILE_B, W1S + (size_t)(g * 128) * 512 + kt * 128, 512, tid);
                __syncthreads();
                mma128<false, false>(acc, lds, lds_addr, 0, TILE_B, 16 * wave, lane);
                __syncthreads();
            }
            float* o = HINC + ((size_t)(g * 1024 + rt * 128 + 16 * wave + fr)) * 128 + 4 * fq;
#pragma unroll
            for (int n = 0; n < 8; ++n) *(f32x4*)(o + 16 * n) = acc[n];
        }
        for (int it = bx; it < 1024; it += G) {
            const int n = it & 63, h = (it >> 6) & 3, b = it >> 8;
            const float l2g = ret_log2_gamma(h);
            const size_t tok0 = (size_t)b * SEQ + n * 128;
            tile_load(lds, KB + tok0 * 512 + h * 128, 512, tid);
            tile_load_zeta(lds + TILE_B, VB + tok0 * 512 + h * 128, 512, tid, l2g);
            __syncthreads();
            f32x4 acc[8];
#pragma unroll
            for (int nb = 0; nb < 8; ++nb) acc[nb] = (f32x4){0.f, 0.f, 0.f, 0.f};
            mma128<true, true>(acc, lds, lds_addr, TILE_B, 0, 16 * wave, lane);
            float* o = SST + (size_t)it * 16384 + (16 * wave + fr) * 128 + 4 * fq;
#pragma unroll
            for (int nb = 0; nb < 8; ++nb) *(f32x4*)(o + 16 * nb) = acc[nb];
            __syncthreads();
        }
    }
    SEAM(2);

    if (IN(3)) {
        for (int idx = bx * 512 + tid; idx < 16 * 8192; idx += G * 512) {
            const int bh = idx >> 13, e2 = idx & 8191, h = bh & 3;
            const float gch = exp2f(128.0f * ret_log2_gamma(h));
            const float* sp = SST + (size_t)bh * 64 * 16384 + 2 * e2;
            unsigned* rp = (unsigned*)(RTB + (size_t)bh * 64 * 16384 + 2 * e2);
            float r0 = 0.f, r1 = 0.f;
            for (int n0 = 0; n0 < 64; n0 += 8) {
                f32x2 s[8];
#pragma unroll
                for (int j = 0; j < 8; ++j) s[j] = *(const f32x2*)(sp + (size_t)(n0 + j) * 16384);
#pragma unroll
                for (int j = 0; j < 8; ++j) { rp[(size_t)(n0 + j) * 8192] = cvt_pk_bf16(r0, r1); r0 = gch * r0 + s[j][0]; r1 = gch * r1 + s[j][1]; }
            }
        }
        {
            LAS float* X = (LAS float*)lds;
            for (int it = bx; it < 128; it += G) {
                const int b = it >> 5, g = it & 31, p = tid & 63, seg = tid >> 6;
                const float lre = fminf(lam_re[g * 64 + p], -1e-4f), lim = lam_im[g * 64 + p], dt = expf(log_dt[g]);
                float ar, ai, Ar, Ai; s5_pow(lre, lim, dt, 32.0f, ar, ai); s5_pow(lre, lim, dt, 1024.0f, Ar, Ai);
                const float* hp = HINC + ((size_t)(g * 1024 + b * 256 + seg * 32)) * 128 + p;
                float xr = 0.f, xi = 0.f;
                for (int i = 0; i < 32; ++i) { const float hr = hp[(size_t)i * 128], hi_ = hp[(size_t)i * 128 + 64]; const float nr = ar * xr - ai * xi + hr, ni = ar * xi + ai * xr + hi_; xr = nr; xi = ni; }
                X[(seg * 64 + p) * 2] = xr; X[(seg * 64 + p) * 2 + 1] = xi;
                __syncthreads();
                float cr = 0.f, ci = 0.f;
                for (int s = 0; s < seg; ++s) { const float tr = X[(s * 64 + p) * 2], ti = X[(s * 64 + p) * 2 + 1]; const float nr = Ar * cr - Ai * ci + tr, ni = Ar * ci + Ai * cr + ti; cr = nr; ci = ni; }
                bf16_t* op = AU + ((size_t)(g * 1024 + b * 256 + seg * 32)) * 640 + 512 + p;
                xr = cr; xi = ci;
                for (int i = 0; i < 32; ++i) {
                    op[(size_t)i * 640] = f2bf(xr); op[(size_t)i * 640 + 64] = f2bf(xi);
                    const float hr = hp[(size_t)i * 128], hi_ = hp[(size_t)i * 128 + 64]; const float nr = ar * xr - ai * xi + hr, ni = ar * xi + ai * xr + hi_; xr = nr; xi = ni;
                }
                __syncthreads();
            }
        }
    }
    SEAM(3);

    if (IN(4)) {
        {
            pg8::Gemm g{AU, TW, 640, 640, 640, (size_t)1024 * 640, (size_t)512 * 640}; pg8::BatchOrder S{G, bx};
            pg8::EpiSsm E{AU, d_skip, YSSM};
            pg8::gemm_phase(lds, g, S, E);
        }
        const int fr = lane & 15, fq = lane >> 4;
        constexpr int OQ = 0, OK_ = TILE_B, OV = 2 * TILE_B, OR = 3 * TILE_B;
        for (int it = bx; it < 1024; it += G) {
            const int n = it & 63, h = (it >> 6) & 3, b = it >> 8;
            const float l2g = ret_log2_gamma(h);
            const size_t tok0 = (size_t)b * SEQ + n * 128;
            tile_load(lds + OQ, QB + tok0 * 512 + h * 128, 512, tid);
            tile_load(lds + OK_, KB + tok0 * 512 + h * 128, 512, tid);
            tile_load(lds + OV, VB + tok0 * 512 + h * 128, 512, tid);
            tile_load(lds + OR, RTB + (size_t)it * 16384, 128, tid);
            __syncthreads();
            const int i = 16 * wave + fr;
            f32x4 sc[8];
#pragma unroll
            for (int nb = 0; nb < 8; ++nb) sc[nb] = (f32x4){0.f, 0.f, 0.f, 0.f};
            mma128<false, false>(sc, lds, lds_addr, OQ, OK_, 16 * wave, lane);
            __syncthreads();
#pragma unroll
            for (int nb = 0; nb < 8; ++nb) {
                f32x4 pv;
#pragma unroll
                for (int e = 0; e < 4; ++e) { const int j = 16 * nb + 4 * fq + e; pv[e] = (i >= j) ? sc[nb][e] * exp2f((float)(i - j) * l2g) : 0.f; }
                u32x2 w; w.x = cvt_pk_bf16(pv[0], pv[1]); w.y = cvt_pk_bf16(pv[2], pv[3]);
                *(LAS u32x2*)(lds + OK_ + i * TS + (16 * nb + 4 * fq) * 2) = w;
            }
            LDS_WAIT();
            __syncthreads();
            f32x4 a1[8], a2[8];
#pragma unroll
            for (int nb = 0; nb < 8; ++nb) { a1[nb] = (f32x4){0.f, 0.f, 0.f, 0.f}; a2[nb] = (f32x4){0.f, 0.f, 0.f, 0.f}; }
            mma128<false, true>(a1, lds, lds_addr, OK_, OV, 16 * wave, lane);
            mma128<false, false>(a2, lds, lds_addr, OQ, OR, 16 * wave, lane);
            const float xi = exp2f((float)(i + 1) * l2g);
            float s1 = 0.f, s2 = 0.f;
#pragma unroll
            for (int nb = 0; nb < 8; ++nb)
#pragma unroll
                for (int e = 0; e < 4; ++e) { const float o = a1[nb][e] + xi * a2[nb][e]; a1[nb][e] = o; s1 += o; s2 += o * o; }
            s1 += __shfl_xor(s1, 16); s1 += __shfl_xor(s1, 32); s2 += __shfl_xor(s2, 16); s2 += __shfl_xor(s2, 32);
            const float mu = s1 * (1.0f / 128.0f), var = fmaxf(s2 * (1.0f / 128.0f) - mu * mu, 0.f), rs = 1.0f / sqrtf(var + EPS);
            const size_t tok = tok0 + i;
#pragma unroll
            for (int nb = 0; nb < 8; ++nb) {
                const int d = 16 * nb + 4 * fq;
                const u32x2 gw = *(const u32x2*)(GB + tok * 512 + h * 128 + d);
                const f32x4 gg = *(const f32x4*)(gn_gain + h * 128 + d);
                const float g0 = bf_lo(gw.x), g1 = bf_hi(gw.x), g2 = bf_lo(gw.y), g3 = bf_hi(gw.y);
                const float y0 = (a1[nb][0] - mu) * rs * gg[0] * (g0 / (1.0f + __expf(-g0)));
                const float y1 = (a1[nb][1] - mu) * rs * gg[1] * (g1 / (1.0f + __expf(-g1)));
                const float y2 = (a1[nb][2] - mu) * rs * gg[2] * (g2 / (1.0f + __expf(-g2)));
                const float y3 = (a1[nb][3] - mu) * rs * gg[3] * (g3 / (1.0f + __expf(-g3)));
                u32x2 w; w.x = cvt_pk_bf16(y0, y1); w.y = cvt_pk_bf16(y2, y3);
                *(u32x2*)(YMIX + tok * 1024 + h * 128 + d) = w;
            }
            __syncthreads();
        }
    }
    SEAM(4);

    if (IN(5)) {
        pg8::Gemm g{YSSM, WGLU, 512, 512, 512, 0, 0}; pg8::StaticOrder S; S.init(T, 1024, G, bx);
        pg8::EpiGlu E{YMIX};
        pg8::gemm_phase(lds, g, S, E);
    }
    SEAM(5);

    if (IN(6)) {
        pg8::Gemm g{YMIX, WOUT, DM, DM, DM, 0, 0}; pg8::StaticOrder S; S.init(T, DM, G, bx);
        pg8::EpiSS E{MIXB, SS};
        pg8::gemm_phase(lds, g, S, E);
    }
    SEAM(6);

    if (IN(7)) {
        const int gw = bx * 8 + wave, NGW = G * 8;
        for (int m = gw; m < T; m += NGW) {
            const f32x4* sp = (const f32x4*)(SS + (size_t)m * 16);
            const f32x4 p0 = sp[0], p1 = sp[1], p2 = sp[2], p3 = sp[3];
            const float ssum = ((p0[0] + p0[1]) + (p0[2] + p0[3])) + ((p1[0] + p1[1]) + (p1[2] + p1[3])) + ((p2[0] + p2[1]) + (p2[2] + p2[3])) + ((p3[0] + p3[1]) + (p3[2] + p3[3]));
            const float rstd = 1.0f / sqrtf(ssum * (1.0f / DM) + EPS);
            const f32x4* xr = (const f32x4*)(x + (size_t)m * DM) + lane;
            const u32x2* mr = (const u32x2*)(MIXB + (size_t)m * DM) + lane;
            const f32x4* gr = (const f32x4*)g_mix_post + lane;
            f32x4* orow = (f32x4*)(out + (size_t)m * DM) + lane;
            f32x4 v[4]; float s = 0.f;
#pragma unroll
            for (int j = 0; j < 4; ++j) {
                const f32x4 xv = xr[64 * j], gv = gr[64 * j]; const u32x2 mw = mr[64 * j];
                v[j][0] = xv[0] + bf_lo(mw.x) * rstd * gv[0]; v[j][1] = xv[1] + bf_hi(mw.x) * rstd * gv[1];
                v[j][2] = xv[2] + bf_lo(mw.y) * rstd * gv[2]; v[j][3] = xv[3] + bf_hi(mw.y) * rstd * gv[3];
                s += (v[j][0] * v[j][0] + v[j][1] * v[j][1]) + (v[j][2] * v[j][2] + v[j][3] * v[j][3]);
                orow[64 * j] = v[j];
            }
            const float rstd1 = 1.0f / sqrtf(wave_sum(s) * (1.0f / DM) + EPS);
            u32x2* o8 = (u32x2*)(XN + (size_t)m * DM) + lane;
#pragma unroll
            for (int j = 0; j < 4; ++j) { u32x2 w; w.x = cvt_pk_bf16(v[j][0] * rstd1, v[j][1] * rstd1); w.y = cvt_pk_bf16(v[j][2] * rstd1, v[j][3] * rstd1); o8[64 * j] = w; }
        }
    }
    SEAM(7);

    if (IN(8)) {
        pg8::Gemm g{XN, WFF1, DM, DM, DM, 0, 0}; pg8::StaticOrder S; S.init(T, DFF, G, bx);
        pg8::EpiRelu2 E{HID};
        pg8::gemm_phase(lds, g, S, E);
    }
    SEAM(8);

    if (IN(9)) {
        pg8::Gemm g{HID, WFF2, DFF, DFF, DFF, 0, 0}; pg8::StaticOrder S; S.init(T, DM, G, bx);
        pg8::EpiSS E{MB, SS2};
        pg8::gemm_phase(lds, g, S, E);
    }
    SEAM(9);

    if (IN(10)) {
        const int gw = bx * 8 + wave, NGW = G * 8;
        for (int m = gw; m < T; m += NGW) {
            const f32x4* sp = (const f32x4*)(SS2 + (size_t)m * 16);
            const f32x4 p0 = sp[0], p1 = sp[1], p2 = sp[2], p3 = sp[3];
            const float ssum = ((p0[0] + p0[1]) + (p0[2] + p0[3])) + ((p1[0] + p1[1]) + (p1[2] + p1[3])) + ((p2[0] + p2[1]) + (p2[2] + p2[3])) + ((p3[0] + p3[1]) + (p3[2] + p3[3]));
            const float rstd = 1.0f / sqrtf(ssum * (1.0f / DM) + EPS);
            const u32x2* mr = (const u32x2*)(MB + (size_t)m * DM) + lane;
            const f32x4* gr = (const f32x4*)g_mlp_post + lane;
            f32x4* orow = (f32x4*)(out + (size_t)m * DM) + lane;
#pragma unroll
            for (int j = 0; j < 4; ++j) {
                f32x4 xv = orow[64 * j]; const f32x4 gv = gr[64 * j]; const u32x2 mw = mr[64 * j];
                xv[0] += bf_lo(mw.x) * rstd * gv[0]; xv[1] += bf_hi(mw.x) * rstd * gv[1];
                xv[2] += bf_lo(mw.y) * rstd * gv[2]; xv[3] += bf_hi(mw.y) * rstd * gv[3];
                orow[64 * j] = xv;
            }
        }
    }
#undef IN
#undef SEAM
}

extern "C" void kernel_launch(void* const* d_in, const int* in_sizes, int n_in, void* d_out, int out_size, void* d_ws, size_t ws_size, hipStream_t stream) {
    static int grid = 0;
    if (grid == 0) {
        int dev = 0, cus = 0, per_cu = 0;
        hipGetDevice(&dev);
        hipDeviceGetAttribute(&cus, hipDeviceAttributeMultiprocessorCount, dev);
        hipFuncSetAttribute((const void*)fwd_kernel, hipFuncAttributeMaxDynamicSharedMemorySize, LDS_BYTES);
        if (hipOccupancyMaxActiveBlocksPerMultiprocessor(&per_cu, (const void*)fwd_kernel, 512, LDS_BYTES) != hipSuccess || per_cu < 1) per_cu = 1;
        (void)hipGetLastError();
        grid = cus * per_cu;
        if (grid <= 0) grid = 256;
    }
    Args a{};
    for (int i = 0; i < 19; ++i) a.in[i] = (const float*)d_in[i];
    a.out = (float*)d_out; a.ws = (unsigned char*)d_ws;
#if N_LAUNCH_PER_PHASE
    for (int ph = 0; ph < NPHASE; ++ph) {
        a.ph_lo = ph; a.ph_hi = ph + 1;
        void* args[] = {&a};
        hipError_t e = hipLaunchCooperativeKernel((const void*)fwd_kernel, dim3(grid), dim3(512), args, LDS_BYTES, stream);
        if (e != hipSuccess) { fprintf(stderr, "cooperative launch (phase %d) failed: %s (grid %d)\n", ph, hipGetErrorString(e), grid); break; }
    }
#else
    a.ph_lo = 0; a.ph_hi = NPHASE;
    void* args[] = {&a};
    hipError_t e = hipLaunchCooperativeKernel((const void*)fwd_kernel, dim3(grid), dim3(512), args, LDS_BYTES, stream);
    if (e != hipSuccess) fprintf(stderr, "cooperative launch failed: %s (grid %d)\n", hipGetErrorString(e), grid);
#endif
}
```

```cpp
#include <hip/hip_runtime.h>
#include <hip/hip_cooperative_groups.h>
#include <cstdio>
namespace cg = cooperative_groups;

#ifndef N_LAUNCH_PER_PHASE
#define N_LAUNCH_PER_PHASE 0
#endif

#define LAS __attribute__((address_space(3)))
typedef unsigned short bf16_t;
typedef short bf16x8 __attribute__((ext_vector_type(8)));
typedef float f32x4 __attribute__((ext_vector_type(4)));
typedef float f32x2 __attribute__((ext_vector_type(2)));
typedef unsigned u32x4 __attribute__((ext_vector_type(4)));
typedef unsigned u32x2 __attribute__((ext_vector_type(2)));

constexpr int T = 32768, SEQ = 8192, DM = 1024, NIN = 2560, DFF = 4096;
constexpr float EPS = 1e-6f;
constexpr int NPHASE = 11;

constexpr size_t MiB = 1u << 20;
constexpr size_t WS_WIN = 1 * MiB, WS_WGLU = 6 * MiB, WS_WOUT = 7 * MiB, WS_WFF1 = 9 * MiB, WS_WFF2 = 17 * MiB;
constexpr size_t WS_ROPE = 25 * MiB, WS_TW = 29 * MiB, WS_W1S = 49 * MiB, WS_SS = 53 * MiB, WS_SS2 = 55 * MiB, WS_HINC = 57 * MiB;
constexpr size_t WS_XN = 80 * MiB;
constexpr size_t WS_QB = 144 * MiB, WS_KB = 176 * MiB, WS_VB = 208 * MiB, WS_GB = 240 * MiB, WS_AU = 272 * MiB;
constexpr size_t WS_SST = 312 * MiB, WS_RTB = 376 * MiB, WS_YSSM = 408 * MiB, WS_YMIX = 440 * MiB;
constexpr size_t WS_MIXB = 144 * MiB, WS_HID = 144 * MiB, WS_MB = 400 * MiB;

constexpr int LDS_BYTES = 147456;
constexpr int TS = 272;
constexpr int TILE_B = 128 * TS;

__device__ __forceinline__ unsigned cvt_pk_bf16(float lo, float hi) { unsigned r; asm volatile("v_cvt_pk_bf16_f32 %0, %1, %2" : "=v"(r) : "v"(lo), "v"(hi)); return r; }
__device__ __forceinline__ float bf_lo(unsigned w) { return __uint_as_float(w << 16); }
__device__ __forceinline__ float bf_hi(unsigned w) { return __uint_as_float(w & 0xffff0000u); }
__device__ __forceinline__ bf16_t f2bf(float f) { return (bf16_t)(cvt_pk_bf16(f, 0.f) & 0xffffu); }
__device__ __forceinline__ float wave_sum(float v) {
#pragma unroll
    for (int o = 1; o < 64; o <<= 1) v += __shfl_xor(v, o);
    return v;
}
#define LDS_WAIT() asm volatile("s_waitcnt lgkmcnt(0)" ::: "memory")

namespace pg8 {
constexpr int BM = 256, BK = 64, HALF = 128, HTB = HALF * BK * 2, STAGE_BYTES = 8 * HTB, NXCD = 8, WGM = 8;
__device__ __forceinline__ int lds_byte(int r, int c) { const int st = (r >> 4) * 2 + (c >> 5), rr = r & 15, cc = c & 31, ob = rr * 64 + cc * 2; return st * 1024 + (ob ^ (((ob >> 9) & 1) << 5)); }
__device__ __forceinline__ void stage_rc(int b, int& R, int& C) { const int st = b / 1024, sb = b % 1024, swz = sb ^ (((sb >> 9) & 1) << 5); R = (st >> 1) * 16 + swz / 64; C = (st & 1) * 32 + (swz % 64) / 2; }
__device__ __forceinline__ int perm32(int rho) { const int n = rho >> 4, i = rho & 15; return 8 * (i >> 2) + 4 * n + (i & 3); }

struct Unit { int pm, pn, pb; };
struct Gemm { const bf16_t* A; const bf16_t* Bt; int lda, ldb, K; size_t bsA, bsB; };

struct StaticOrder {
    int nM, nN, nwg, G, c;
    __device__ void init(int M, int N, int G_, int c_) { nM = M / BM; nN = N / BM; nwg = nM * nN; G = G_; c = c_; }
    __device__ bool next(int i, Unit& u) const {
        const long L = (long)i * G + c; if (L >= nwg) return false;
        int wgid = (int)L; { const int q = nwg / NXCD, r = nwg % NXCD, xcd = wgid % NXCD, off = wgid / NXCD; wgid = (xcd < r ? xcd * (q + 1) : r * (q + 1) + (xcd - r) * q) + off; }
        const int nig = WGM * nN, gid = wgid / nig, fm = gid * WGM, gsz = (nM - fm) < WGM ? (nM - fm) : WGM;
        u.pm = fm + ((wgid % nig) % gsz); u.pn = (wgid % nig) / gsz; u.pb = 0; return true;
    }
};
struct BatchOrder {
    int G, c;
    __device__ bool next(int i, Unit& u) const {
        const int L = i * G + c; if (L >= 256) return false;
        u.pb = L >> 3; const int r = L & 7; u.pm = r & 3; u.pn = r >> 2; return true;
    }
};

template <class Epi, class Sched>
__device__ __forceinline__ void gemm_phase(LAS unsigned char* lds, const Gemm g, const Sched& S, const Epi& E) {
    const int tid = threadIdx.x, wid = __builtin_amdgcn_readfirstlane(tid >> 6), lane = tid & 63, wr = wid >> 2, wc = wid & 3, fr = lane & 15, fq = lane >> 4;
    const int K = g.K, nt = K / BK;
    unsigned voffA[2], voffB[2];
#pragma unroll
    for (int i = 0; i < 2; ++i) { int R, C; stage_rc(tid * 16 + i * 8192, R, C); const int Rb = Epi::PERM ? ((R & ~31) + perm32(R & 31)) : R;
        voffA[i] = (unsigned)(R * g.lda + C) * 2u; voffB[i] = (unsigned)(Rb * g.ldb + C) * 2u; }
    const size_t kstep = (size_t)(BK * 2);
    const size_t hstepA = (size_t)HALF * g.lda * 2, hstepB = (size_t)HALF * g.ldb * 2;
    const size_t tstepA = 2 * hstepA, tstepB = 2 * hstepB;
    const unsigned ldsw = (unsigned)wid * 1024u;
    const int aoff = lds_byte(wr * 64 + fr, fq * 8), boff = lds_byte(wc * 32 + fr, fq * 8);
#define PG8_SA(b, h) (((b) * 2 + (h)) * HTB)
#define PG8_SB(b, h) ((4 + (b) * 2 + (h)) * HTB)
#define PG8_STAGE(bufoff, gbase, voff) do { _Pragma("unroll") for (int _i = 0; _i < 2; ++_i) \
        __builtin_amdgcn_global_load_lds((const unsigned*)((const char*)(gbase) + (voff)[_i]), (LAS unsigned*)(lds + (bufoff) + ldsw + _i * 8192), 16, 0, 0); } while (0)
#define PG8_LDA(dst, b, h) do { _Pragma("unroll") for (int m = 0; m < 4; ++m) _Pragma("unroll") for (int k = 0; k < 2; ++k) dst[m][k] = *(const LAS bf16x8*)(lds + PG8_SA(b, h) + aoff + m * 2048 + k * 1024); } while (0)
#define PG8_LDB(dst, b, h) do { _Pragma("unroll") for (int n = 0; n < 2; ++n) _Pragma("unroll") for (int k = 0; k < 2; ++k) dst[n][k] = *(const LAS bf16x8*)(lds + PG8_SB(b, h) + boff + n * 2048 + k * 1024); } while (0)
#define PG8_MMA(ai, bj, At, Bt) do { __builtin_amdgcn_s_setprio(1); _Pragma("unroll") for (int m = 0; m < 4; ++m) _Pragma("unroll") for (int n = 0; n < 2; ++n) _Pragma("unroll") for (int k = 0; k < 2; ++k) \
        acc[ai][bj][m][n] = __builtin_amdgcn_mfma_f32_16x16x32_bf16(Bt[n][k], At[m][k], acc[ai][bj][m][n], 0, 0, 0); __builtin_amdgcn_s_setprio(0); } while (0)
#define PG8_WAIT_V(n) asm volatile("s_waitcnt vmcnt(" #n ")" ::: "memory")
#define PG8_WAIT_L(n) asm volatile("s_waitcnt lgkmcnt(" #n ")" ::: "memory")
#define PG8_BAR __builtin_amdgcn_s_barrier()
#define PG8_SCHED __builtin_amdgcn_sched_barrier(0)
    Unit cur, nxt; int ui = 0;
    if (!S.next(0, cur)) return;
    f32x4 acc[2][2][4][2];
#pragma unroll
    for (int a = 0; a < 2; ++a)
#pragma unroll
        for (int b = 0; b < 2; ++b)
#pragma unroll
            for (int m = 0; m < 4; ++m)
#pragma unroll
                for (int n = 0; n < 2; ++n) acc[a][b][m][n] = (f32x4){0.f, 0.f, 0.f, 0.f};
    bf16x8 At[4][2], B0[2][2], B1[2][2];
    const char* cA = (const char*)g.A + (size_t)cur.pb * g.bsA * 2 + (size_t)cur.pm * tstepA;
    const char* cB = (const char*)g.Bt + (size_t)cur.pb * g.bsB * 2 + (size_t)cur.pn * tstepB;
    PG8_STAGE(PG8_SB(0, 0), cB, voffB); PG8_STAGE(PG8_SA(0, 0), cA, voffA); PG8_STAGE(PG8_SB(0, 1), cB + hstepB, voffB); PG8_STAGE(PG8_SA(0, 1), cA + hstepA, voffA);
    if (wr == 1) PG8_BAR;
    PG8_WAIT_V(4); PG8_BAR;
    PG8_STAGE(PG8_SB(1, 0), cB + kstep, voffB); PG8_STAGE(PG8_SA(1, 0), cA + kstep, voffA); PG8_STAGE(PG8_SB(1, 1), cB + hstepB + kstep, voffB);
    PG8_WAIT_V(6); PG8_BAR;
    for (;;) {
        const bool has_next = S.next(ui + 1, nxt);
        const char* nA = has_next ? (const char*)g.A + (size_t)nxt.pb * g.bsA * 2 + (size_t)nxt.pm * tstepA : cA;
        const char* nB = has_next ? (const char*)g.Bt + (size_t)nxt.pb * g.bsB * 2 + (size_t)nxt.pn * tstepB : cB;
        for (int t = 0; t < nt; t += 2) {
            const bool last = (t == nt - 2);
            const char* a1 = cA + (size_t)(t + 1) * kstep;
            const char* a2 = last ? nA : cA + (size_t)(t + 2) * kstep; const char* b2 = last ? nB : cB + (size_t)(t + 2) * kstep;
            const char* a3 = a2 + kstep; const char* b3 = b2 + kstep;
            PG8_LDB(B0, 0, 0); PG8_SCHED; PG8_LDA(At, 0, 0); PG8_STAGE(PG8_SA(1, 1), a1 + hstepA, voffA);
            PG8_WAIT_L(8); PG8_BAR; PG8_WAIT_L(0); PG8_MMA(0, 0, At, B0); PG8_BAR; PG8_SCHED;
            PG8_LDB(B1, 0, 1); PG8_STAGE(PG8_SB(0, 0), b2, voffB);
            PG8_BAR; PG8_WAIT_L(0); PG8_MMA(0, 1, At, B1); PG8_BAR;
            PG8_LDA(At, 0, 1); PG8_STAGE(PG8_SA(0, 0), a2, voffA);
            PG8_BAR; PG8_WAIT_L(0); PG8_MMA(1, 0, At, B0); PG8_BAR; PG8_SCHED;
            PG8_STAGE(PG8_SB(0, 1), b2 + hstepB, voffB);
            PG8_WAIT_V(6); PG8_BAR; PG8_MMA(1, 1, At, B1); PG8_BAR;
            PG8_LDB(B0, 1, 0); PG8_SCHED; PG8_LDA(At, 1, 0); PG8_STAGE(PG8_SA(0, 1), a2 + hstepA, voffA);
            PG8_WAIT_L(8); PG8_BAR; PG8_WAIT_L(0); PG8_MMA(0, 0, At, B0); PG8_BAR; PG8_SCHED;
            PG8_LDB(B1, 1, 1); PG8_STAGE(PG8_SB(1, 0), b3, voffB);
            PG8_BAR; PG8_WAIT_L(0); PG8_MMA(0, 1, At, B1); PG8_BAR;
            PG8_LDA(At, 1, 1); PG8_STAGE(PG8_SA(1, 0), a3, voffA);
            PG8_BAR; PG8_WAIT_L(0); PG8_MMA(1, 0, At, B0); PG8_BAR; PG8_SCHED;
            PG8_STAGE(PG8_SB(1, 1), b3 + hstepB, voffB);
            PG8_WAIT_V(6); PG8_BAR; PG8_MMA(1, 1, At, B1); PG8_BAR;
        }
        E(acc, cur, wr, wc, fr, fq);
        if (!has_next) break;
#pragma unroll
        for (int a = 0; a < 2; ++a)
#pragma unroll
            for (int b = 0; b < 2; ++b)
#pragma unroll
                for (int m = 0; m < 4; ++m)
#pragma unroll
                    for (int n = 0; n < 2; ++n) acc[a][b][m][n] = (f32x4){0.f, 0.f, 0.f, 0.f};
        cur = nxt; cA = nA; cB = nB; ++ui;
    }
    PG8_WAIT_V(0);
    if (wr == 0) PG8_BAR;
    PG8_BAR;
#undef PG8_SA
#undef PG8_SB
#undef PG8_STAGE
#undef PG8_LDA
#undef PG8_LDB
#undef PG8_MMA
#undef PG8_WAIT_V
#undef PG8_WAIT_L
#undef PG8_BAR
#undef PG8_SCHED
}

__device__ __forceinline__ u32x4 pack8(const f32x4 v0, const f32x4 v1) {
    u32x4 w; w.x = cvt_pk_bf16(v0[0], v0[1]); w.y = cvt_pk_bf16(v0[2], v0[3]); w.z = cvt_pk_bf16(v1[0], v1[1]); w.w = cvt_pk_bf16(v1[2], v1[3]); return w;
}
__device__ __forceinline__ f32x4 rope4(const f32x4 v, const f32x4 cs) {
    f32x4 r; r[0] = v[0] * cs[0] - v[1] * cs[1]; r[1] = v[0] * cs[1] + v[1] * cs[0]; r[2] = v[2] * cs[2] - v[3] * cs[3]; r[3] = v[2] * cs[3] + v[3] * cs[2]; return r;
}
struct EpiInProj {
    static constexpr bool PERM = true;
    bf16_t *Q, *Kb, *V, *Gt, *AU; const float* rope;
    __device__ __forceinline__ void operator()(const f32x4 (&acc)[2][2][4][2], const Unit& u, int wr, int wc, int fr, int fq) const {
        const int sect = u.pn >> 1;
        const int row0 = u.pm * BM + wr * 64 + fr;
        const int colt = (u.pn & 1) * 256 + wc * 32 + 8 * fq;
        if (sect <= 1) {
            bf16_t* O = sect ? Kb : Q;
#pragma unroll
            for (int ai = 0; ai < 2; ++ai)
#pragma unroll
                for (int m = 0; m < 4; ++m) {
                    const int row = row0 + ai * HALF + m * 16, pos = row & (SEQ - 1);
                    const float* rp = rope + ((size_t)pos * 64 + 16 * wc + 4 * fq) * 2;
                    const f32x4 cs0 = *(const f32x4*)rp, cs1 = *(const f32x4*)(rp + 4);
#pragma unroll
                    for (int bj = 0; bj < 2; ++bj) {
                        const f32x4 v0 = rope4(acc[ai][bj][m][0], cs0), v1 = rope4(acc[ai][bj][m][1], cs1);
                        *(u32x4*)(O + (size_t)row * 512 + colt + bj * HALF) = pack8(v0, v1);
                    }
                }
        } else if (sect <= 3) {
            bf16_t* O = (sect == 2) ? V : Gt;
#pragma unroll
            for (int ai = 0; ai < 2; ++ai)
#pragma unroll
                for (int m = 0; m < 4; ++m) {
                    const int row = row0 + ai * HALF + m * 16;
#pragma unroll
                    for (int bj = 0; bj < 2; ++bj) *(u32x4*)(O + (size_t)row * 512 + colt + bj * HALF) = pack8(acc[ai][bj][m][0], acc[ai][bj][m][1]);
                }
        } else {
#pragma unroll
            for (int ai = 0; ai < 2; ++ai)
#pragma unroll
                for (int m = 0; m < 4; ++m) {
                    const int row = row0 + ai * HALF + m * 16, cr = row >> 5, s = row & 31;
#pragma unroll
                    for (int bj = 0; bj < 2; ++bj) {
                        const int cu = colt + bj * HALF, g = cu >> 4, c0 = cu & 15;
                        *(u32x4*)(AU + ((size_t)(g * 1024 + cr) * 640 + s * 16 + c0)) = pack8(acc[ai][bj][m][0], acc[ai][bj][m][1]);
                    }
                }
        }
    }
};
struct EpiGlu {
    static constexpr bool PERM = true;
    bf16_t* Y;
    __device__ __forceinline__ void operator()(const f32x4 (&acc)[2][2][4][2], const Unit& u, int wr, int wc, int fr, int fq) const {
        const int row0 = u.pm * BM + wr * 64 + fr, col = 512 + u.pn * 128 + wc * 32 + 8 * fq;
#pragma unroll
        for (int ai = 0; ai < 2; ++ai)
#pragma unroll
            for (int m = 0; m < 4; ++m) {
                const int row = row0 + ai * HALF + m * 16;
                f32x4 y0, y1;
#pragma unroll
                for (int j = 0; j < 4; ++j) {
                    y0[j] = acc[ai][0][m][0][j] / (1.0f + __expf(-acc[ai][1][m][0][j]));
                    y1[j] = acc[ai][0][m][1][j] / (1.0f + __expf(-acc[ai][1][m][1][j]));
                }
                *(u32x4*)(Y + (size_t)row * 1024 + col) = pack8(y0, y1);
            }
    }
};
struct EpiSS {
    static constexpr bool PERM = true;
    bf16_t* O; float* SS;
    __device__ __forceinline__ void operator()(const f32x4 (&acc)[2][2][4][2], const Unit& u, int wr, int wc, int fr, int fq) const {
        const int row0 = u.pm * BM + wr * 64 + fr, col = u.pn * BM + wc * 32 + 8 * fq;
#pragma unroll
        for (int ai = 0; ai < 2; ++ai)
#pragma unroll
            for (int m = 0; m < 4; ++m) {
                const int row = row0 + ai * HALF + m * 16; float q = 0.f;
#pragma unroll
                for (int bj = 0; bj < 2; ++bj) {
                    const f32x4 v0 = acc[ai][bj][m][0], v1 = acc[ai][bj][m][1];
                    q += (v0[0] * v0[0] + v0[1] * v0[1]) + (v0[2] * v0[2] + v0[3] * v0[3]) + (v1[0] * v1[0] + v1[1] * v1[1]) + (v1[2] * v1[2] + v1[3] * v1[3]);
                    *(u32x4*)(O + (size_t)row * 1024 + col + bj * HALF) = pack8(v0, v1);
                }
                q += __shfl_xor(q, 16); q += __shfl_xor(q, 32);
                if (fq == 0) SS[(size_t)row * 16 + u.pn * 4 + wc] = q;
            }
    }
};
struct EpiRelu2 {
    static constexpr bool PERM = true;
    bf16_t* O;
    __device__ __forceinline__ void operator()(const f32x4 (&acc)[2][2][4][2], const Unit& u, int wr, int wc, int fr, int fq) const {
        const int row0 = u.pm * BM + wr * 64 + fr, col = u.pn * BM + wc * 32 + 8 * fq;
#pragma unroll
        for (int ai = 0; ai < 2; ++ai)
#pragma unroll
            for (int m = 0; m < 4; ++m) {
                const int row = row0 + ai * HALF + m * 16;
#pragma unroll
                for (int bj = 0; bj < 2; ++bj) {
                    f32x4 v0 = acc[ai][bj][m][0], v1 = acc[ai][bj][m][1];
#pragma unroll
                    for (int j = 0; j < 4; ++j) { const float a = fmaxf(v0[j], 0.f), b = fmaxf(v1[j], 0.f); v0[j] = a * a; v1[j] = b * b; }
                    *(u32x4*)(O + (size_t)row * DFF + col + bj * HALF) = pack8(v0, v1);
                }
            }
    }
};
struct EpiSsm {
    static constexpr bool PERM = true;
    const bf16_t* AU; const float* dskip; bf16_t* Y;
    __device__ __forceinline__ void operator()(const f32x4 (&acc)[2][2][4][2], const Unit& u, int wr, int wc, int fr, int fq) const {
        const int g = u.pb;
        const int row0 = u.pm * BM + wr * 64 + fr, colt = u.pn * BM + wc * 32 + 8 * fq;
        const int c0 = 8 * (fq & 1);
        const f32x4 d0 = *(const f32x4*)(dskip + g * 16 + c0), d1 = *(const f32x4*)(dskip + g * 16 + c0 + 4);
#pragma unroll
        for (int ai = 0; ai < 2; ++ai)
#pragma unroll
            for (int m = 0; m < 4; ++m) {
                const int cr = row0 + ai * HALF + m * 16;
#pragma unroll
                for (int bj = 0; bj < 2; ++bj) {
                    const int col = colt + bj * HALF, s = col >> 4;
                    const u32x4 uw = *(const u32x4*)(AU + ((size_t)(g * 1024 + cr) * 640 + col));
                    f32x4 v0 = acc[ai][bj][m][0], v1 = acc[ai][bj][m][1];
                    v0[0] += d0[0] * bf_lo(uw.x); v0[1] += d0[1] * bf_hi(uw.x); v0[2] += d0[2] * bf_lo(uw.y); v0[3] += d0[3] * bf_hi(uw.y);
                    v1[0] += d1[0] * bf_lo(uw.z); v1[1] += d1[1] * bf_hi(uw.z); v1[2] += d1[2] * bf_lo(uw.w); v1[3] += d1[3] * bf_hi(uw.w);
#pragma unroll
                    for (int j = 0; j < 4; ++j) {
                        const float a = v0[j], za = 1.5957691216f * (a + 0.044715f * a * a * a); v0[j] = a / (1.0f + __expf(-za));
                        const float b = v1[j], zb = 1.5957691216f * (b + 0.044715f * b * b * b); v1[j] = b / (1.0f + __expf(-zb));
                    }
                    const size_t tok = (size_t)cr * 32 + s;
                    *(u32x4*)(Y + tok * 512 + g * 16 + c0) = pack8(v0, v1);
                }
            }
    }
};
}

__device__ __forceinline__ bf16x8 frag_nat(const LAS unsigned char* tile, int idx0, int k0, int fr, int fq) {
    return *(const LAS bf16x8*)(tile + (idx0 + fr) * TS + (k0 + 8 * fq) * 2);
}
__device__ __forceinline__ bf16x8 frag_tr(unsigned tile_addr, int k0, int idx0, int lane) {
    const int g = lane >> 4, q = (lane & 15) >> 2, p = lane & 3;
    const unsigned addr = tile_addr + (unsigned)((k0 + 8 * g + q) * TS + (idx0 + 4 * p) * 2);
    u32x2 lo, hi;
    asm volatile("ds_read_b64_tr_b16 %0, %2\n\tds_read_b64_tr_b16 %1, %2 offset:1088\n\ts_waitcnt lgkmcnt(0)" : "=&v"(lo), "=&v"(hi) : "v"(addr) : "memory");
    u32x4 r; r.x = lo.x; r.y = lo.y; r.z = hi.x; r.w = hi.y;
    return __builtin_bit_cast(bf16x8, r);
}
__device__ __forceinline__ void frags_tr8(bf16x8 (&b)[8], unsigned tile_addr, int k0, int lane) {
    const int g = lane >> 4, q = (lane & 15) >> 2, p = lane & 3;
    const unsigned addr = tile_addr + (unsigned)((k0 + 8 * g + q) * TS + (4 * p) * 2);
    u32x2 r0, r1, r2, r3, r4, r5, r6, r7, r8, r9, r10, r11, r12, r13, r14, r15;
    asm volatile(
        "ds_read_b64_tr_b16 %0, %16\n\t"
        "ds_read_b64_tr_b16 %1, %16 offset:1088\n\t"
        "ds_read_b64_tr_b16 %2, %16 offset:32\n\t"
        "ds_read_b64_tr_b16 %3, %16 offset:1120\n\t"
        "ds_read_b64_tr_b16 %4, %16 offset:64\n\t"
        "ds_read_b64_tr_b16 %5, %16 offset:1152\n\t"
        "ds_read_b64_tr_b16 %6, %16 offset:96\n\t"
        "ds_read_b64_tr_b16 %7, %16 offset:1184\n\t"
        "ds_read_b64_tr_b16 %8, %16 offset:128\n\t"
        "ds_read_b64_tr_b16 %9, %16 offset:1216\n\t"
        "ds_read_b64_tr_b16 %10, %16 offset:160\n\t"
        "ds_read_b64_tr_b16 %11, %16 offset:1248\n\t"
        "ds_read_b64_tr_b16 %12, %16 offset:192\n\t"
        "ds_read_b64_tr_b16 %13, %16 offset:1280\n\t"
        "ds_read_b64_tr_b16 %14, %16 offset:224\n\t"
        "ds_read_b64_tr_b16 %15, %16 offset:1312\n\t"
        "s_waitcnt lgkmcnt(0)"
        : "=&v"(r0), "=&v"(r1), "=&v"(r2), "=&v"(r3), "=&v"(r4), "=&v"(r5), "=&v"(r6), "=&v"(r7),
          "=&v"(r8), "=&v"(r9), "=&v"(r10), "=&v"(r11), "=&v"(r12), "=&v"(r13), "=&v"(r14), "=&v"(r15)
        : "v"(addr) : "memory");
    u32x4 w;
    w.x = r0.x; w.y = r0.y; w.z = r1.x; w.w = r1.y; b[0] = __builtin_bit_cast(bf16x8, w);
    w.x = r2.x; w.y = r2.y; w.z = r3.x; w.w = r3.y; b[1] = __builtin_bit_cast(bf16x8, w);
    w.x = r4.x; w.y = r4.y; w.z = r5.x; w.w = r5.y; b[2] = __builtin_bit_cast(bf16x8, w);
    w.x = r6.x; w.y = r6.y; w.z = r7.x; w.w = r7.y; b[3] = __builtin_bit_cast(bf16x8, w);
    w.x = r8.x; w.y = r8.y; w.z = r9.x; w.w = r9.y; b[4] = __builtin_bit_cast(bf16x8, w);
    w.x = r10.x; w.y = r10.y; w.z = r11.x; w.w = r11.y; b[5] = __builtin_bit_cast(bf16x8, w);
    w.x = r12.x; w.y = r12.y; w.z = r13.x; w.w = r13.y; b[6] = __builtin_bit_cast(bf16x8, w);
    w.x = r14.x; w.y = r14.y; w.z = r15.x; w.w = r15.y; b[7] = __builtin_bit_cast(bf16x8, w);
}
template <bool ATR, bool BTR>
__device__ __forceinline__ void mma128(f32x4 (&acc)[8], const LAS unsigned char* lds, unsigned lds_addr, int offA, int offB, int m0, int lane) {
    const int fr = lane & 15, fq = lane >> 4;
#pragma unroll
    for (int ks = 0; ks < 4; ++ks) {
        bf16x8 af, bfr[8];
        if (ATR) af = frag_tr(lds_addr + offA, 32 * ks, m0, lane); else af = frag_nat(lds + offA, m0, 32 * ks, fr, fq);
        if (BTR) frags_tr8(bfr, lds_addr + offB, 32 * ks, lane);
        else {
#pragma unroll
            for (int n = 0; n < 8; ++n) bfr[n] = frag_nat(lds + offB, 16 * n, 32 * ks, fr, fq);
        }
#pragma unroll
        for (int n = 0; n < 8; ++n) acc[n] = __builtin_amdgcn_mfma_f32_16x16x32_bf16(bfr[n], af, acc[n], 0, 0, 0);
    }
}
__device__ __forceinline__ void tile_load(LAS unsigned char* dst, const bf16_t* src, int ld, int tid) {
    u32x4 v[4];
#pragma unroll
    for (int i = 0; i < 4; ++i) { const int q = tid + 512 * i, row = q >> 4, pc = q & 15; v[i] = *(const u32x4*)(src + (size_t)row * ld + pc * 8); }
#pragma unroll
    for (int i = 0; i < 4; ++i) { const int q = tid + 512 * i, row = q >> 4, pc = q & 15; *(LAS u32x4*)(dst + row * TS + pc * 16) = v[i]; }
}
__device__ __forceinline__ void tile_load_zeta(LAS unsigned char* dst, const bf16_t* src, int ld, int tid, float l2g) {
    u32x4 v[4];
#pragma unroll
    for (int i = 0; i < 4; ++i) { const int q = tid + 512 * i, row = q >> 4, pc = q & 15; v[i] = *(const u32x4*)(src + (size_t)row * ld + pc * 8); }
#pragma unroll
    for (int i = 0; i < 4; ++i) {
        const int q = tid + 512 * i, row = q >> 4, pc = q & 15; const float z = exp2f((float)(127 - row) * l2g);
        u32x4 w;
        w.x = cvt_pk_bf16(bf_lo(v[i].x) * z, bf_hi(v[i].x) * z); w.y = cvt_pk_bf16(bf_lo(v[i].y) * z, bf_hi(v[i].y) * z);
        w.z = cvt_pk_bf16(bf_lo(v[i].z) * z, bf_hi(v[i].z) * z); w.w = cvt_pk_bf16(bf_lo(v[i].w) * z, bf_hi(v[i].w) * z);
        *(LAS u32x4*)(dst + row * TS + pc * 16) = w;
    }
}
__device__ __forceinline__ float ret_log2_gamma(int h) { const float g = 1.0f - exp2f(-5.0f - (4.0f / 3.0f) * (float)h); return log2f(g); }

__device__ __forceinline__ int dest_row(int mode, int n) {
    if (mode == 1) { if (n < 1024) { const int sect = n >> 9, w = n & 511, h = w >> 7, j = w & 127; return (sect << 9) + (h << 7) + ((j & 63) << 1) + (j >> 6); } return n; }
    if (mode == 2) { const int bj = n >> 9, rem = n & 511, pn = rem >> 7, j = rem & 127; return (pn << 8) + (bj << 7) + j; }
    return n;
}
__device__ __forceinline__ void p0_transpose_item(const float* W, int K, int N, bf16_t* WT, const float* gain, int mode, LAS float* scr, int item, int lane) {
    const int nblk = N / 32, kb = item / nblk, nb = item % nblk, k0 = 64 * kb, n0 = 32 * nb;
    const float cs = (mode == 1 && n0 >= 512 && n0 < 1024) ? 0.08838834764831845f : 1.0f;
#pragma unroll 8
    for (int i = 0; i < 32; ++i) { const int kk = 2 * i + (lane >> 5); const float g = gain ? gain[k0 + kk] * cs : cs; scr[kk * 33 + (lane & 31)] = W[(size_t)(k0 + kk) * N + n0 + (lane & 31)] * g; }
    LDS_WAIT();
    const int c = lane & 7;
#pragma unroll
    for (int j = 0; j < 4; ++j) { const int n = (lane >> 3) + 8 * j; const LAS float* s = scr + (8 * c) * 33 + n;
        u32x4 o; o.x = cvt_pk_bf16(s[0 * 33], s[1 * 33]); o.y = cvt_pk_bf16(s[2 * 33], s[3 * 33]); o.z = cvt_pk_bf16(s[4 * 33], s[5 * 33]); o.w = cvt_pk_bf16(s[6 * 33], s[7 * 33]);
        *(u32x4*)(WT + (size_t)dest_row(mode, n0 + n) * K + k0 + 8 * c) = o; }
    LDS_WAIT();
}
__device__ __forceinline__ void s5_pow(float lre, float lim, float dt, float j, float& pr, float& pi) {
    const float mag = expf(j * (dt * lre)); float s, c; sincosf(j * (dt * lim), &s, &c); pr = mag * c; pi = mag * s;
}
__device__ __forceinline__ void s5_coef(float lre, float lim, float dt, float& cr, float& ci) {
    float br, bi; s5_pow(lre, lim, dt, 1.0f, br, bi); br -= 1.0f;
    const float den = lre * lre + lim * lim; cr = (br * lre + bi * lim) / den; ci = (bi * lre - br * lim) / den;
}

struct Args { const float* in[19]; float* out; unsigned char* ws; int ph_lo, ph_hi; };

__global__ void __launch_bounds__(512, 2) fwd_kernel(Args a) {
    extern __shared__ __attribute__((aligned(16))) unsigned char lds_raw[];
    LAS unsigned char* lds = (LAS unsigned char*)lds_raw;
    const unsigned lds_addr = (unsigned)(size_t)lds_raw;
    cg::grid_group grid = cg::this_grid();
    const int tid = threadIdx.x, lane = tid & 63, wave = __builtin_amdgcn_readfirstlane(tid >> 6);
    const int G = gridDim.x, bx = blockIdx.x;
    const int lo = a.ph_lo, hi = a.ph_hi;
    unsigned char* ws = a.ws;
#define IN(k) (lo <= (k) && (k) < hi)
#define SEAM(k) do { if (lo <= (k) && (k) + 1 < hi) grid.sync(); } while (0)

    const float* x = a.in[0];
    const float* g_mix_pre = a.in[1]; const float* g_mix_post = a.in[2]; const float* w_in = a.in[3]; const float* gn_gain = a.in[4];
    const float* lam_re = a.in[5]; const float* lam_im = a.in[6]; const float* log_dt = a.in[7];
    const float* b_re = a.in[8]; const float* b_im = a.in[9]; const float* c_re = a.in[10]; const float* c_im = a.in[11]; const float* d_skip = a.in[12];
    const float* w_glu = a.in[13]; const float* w_out = a.in[14]; const float* g_mlp_pre = a.in[15]; const float* g_mlp_post = a.in[16];
    const float* w_ff1 = a.in[17]; const float* w_ff2 = a.in[18];
    float* out = a.out;

    bf16_t* WIN = (bf16_t*)(ws + WS_WIN); bf16_t* WGLU = (bf16_t*)(ws + WS_WGLU); bf16_t* WOUT = (bf16_t*)(ws + WS_WOUT);
    bf16_t* WFF1 = (bf16_t*)(ws + WS_WFF1); bf16_t* WFF2 = (bf16_t*)(ws + WS_WFF2);
    float* ROPE = (float*)(ws + WS_ROPE); bf16_t* TW = (bf16_t*)(ws + WS_TW); bf16_t* W1S = (bf16_t*)(ws + WS_W1S);
    float* SS = (float*)(ws + WS_SS); float* SS2 = (float*)(ws + WS_SS2); float* HINC = (float*)(ws + WS_HINC);
    bf16_t* XN = (bf16_t*)(ws + WS_XN);
    bf16_t* QB = (bf16_t*)(ws + WS_QB); bf16_t* KB = (bf16_t*)(ws + WS_KB); bf16_t* VB = (bf16_t*)(ws + WS_VB); bf16_t* GB = (bf16_t*)(ws + WS_GB);
    bf16_t* AU = (bf16_t*)(ws + WS_AU); float* SST = (float*)(ws + WS_SST); bf16_t* RTB = (bf16_t*)(ws + WS_RTB);
    bf16_t* YSSM = (bf16_t*)(ws + WS_YSSM); bf16_t* YMIX = (bf16_t*)(ws + WS_YMIX);
    bf16_t* MIXB = (bf16_t*)(ws + WS_MIXB); bf16_t* HID = (bf16_t*)(ws + WS_HID); bf16_t* MB = (bf16_t*)(ws + WS_MB);

    if (IN(0)) {
        const int gw = bx * 8 + wave, NGW = G * 8;
        {
            LAS float* scr = (LAS float*)(lds + wave * 16384);
            constexpr int I_IN = (DM / 64) * (NIN / 32), I_GLU = (512 / 64) * (1024 / 32), I_OUT = (DM / 64) * (DM / 32), I_F1 = (DM / 64) * (DFF / 32), I_F2 = (DFF / 64) * (DM / 32);
            constexpr int NITEMS = I_IN + I_GLU + I_OUT + I_F1 + I_F2;
            for (int it = gw; it < NITEMS; it += NGW) {
                int r = it;
                if (r < I_IN) { p0_transpose_item(w_in, DM, NIN, WIN, g_mix_pre, 1, scr, r, lane); continue; } r -= I_IN;
                if (r < I_GLU) { p0_transpose_item(w_glu, 512, 1024, WGLU, nullptr, 2, scr, r, lane); continue; } r -= I_GLU;
                if (r < I_OUT) { p0_transpose_item(w_out, DM, DM, WOUT, nullptr, 0, scr, r, lane); continue; } r -= I_OUT;
                if (r < I_F1) { p0_transpose_item(w_ff1, DM, DFF, WFF1, g_mlp_pre, 0, scr, r, lane); continue; } r -= I_F1;
                p0_transpose_item(w_ff2, DFF, DM, WFF2, nullptr, 0, scr, r, lane);
            }
        }
        for (int m = gw; m < T; m += NGW) {
            const f32x4* xr = (const f32x4*)(x + (size_t)m * DM) + lane;
            f32x4 v[4]; float s = 0.f;
#pragma unroll
            for (int j = 0; j < 4; ++j) { v[j] = xr[64 * j]; s += (v[j][0] * v[j][0] + v[j][1] * v[j][1]) + (v[j][2] * v[j][2] + v[j][3] * v[j][3]); }
            const float rstd = 1.0f / sqrtf(wave_sum(s) * (1.0f / DM) + EPS);
            u32x2* o8 = (u32x2*)(XN + (size_t)m * DM) + lane;
#pragma unroll
            for (int j = 0; j < 4; ++j) { u32x2 w; w.x = cvt_pk_bf16(v[j][0] * rstd, v[j][1] * rstd); w.y = cvt_pk_bf16(v[j][2] * rstd, v[j][3] * rstd); o8[64 * j] = w; }
        }
        for (int i = bx * 512 + tid; i < SEQ * 64; i += G * 512) {
            const int pos = i >> 6, j = i & 63;
            const float inv = (float)pow(10000.0, -(double)j / 64.0);
            const float ang = (float)pos * inv; float s, c; sincosf(ang, &s, &c);
            *(f32x2*)(ROPE + (size_t)i * 2) = (f32x2){c, s};
        }
        for (int i = bx * 512 + tid; i < 32 * 32 * 64; i += G * 512) {
            {
                const int q = i & 63, t = (i >> 6) & 31, g = i >> 11;
                const float lre = fminf(lam_re[g * 64 + q], -1e-4f), lim = lam_im[g * 64 + q], dt = expf(log_dt[g]);
                float pr, pi; s5_pow(lre, lim, dt, (float)(t + 1), pr, pi);
#pragma unroll 4
                for (int c = 0; c < 16; ++c) {
                    const float cr = c_re[(g * 16 + c) * 64 + q], ci = c_im[(g * 16 + c) * 64 + q];
                    const float zr = cr * pr - ci * pi, zi = cr * pi + ci * pr;
                    bf16_t* row = TW + (size_t)(g * 512 + t * 16 + c) * 640 + 512;
                    row[q] = f2bf(zr); row[64 + q] = f2bf(-zi);
                }
            }
            {
                const int s = i & 31, p = (i >> 5) & 63, g = i >> 11;
                const float lre = fminf(lam_re[g * 64 + p], -1e-4f), lim = lam_im[g * 64 + p], dt = expf(log_dt[g]);
                float pr, pi, cr, ci; s5_pow(lre, lim, dt, (float)(31 - s), pr, pi); s5_coef(lre, lim, dt, cr, ci);
                const float wr_ = pr * cr - pi * ci, wi_ = pr * ci + pi * cr;
                float zr[16], zi[16];
#pragma unroll
                for (int c = 0; c < 16; ++c) { const float br = b_re[(g * 64 + p) * 16 + c], bi = b_im[(g * 64 + p) * 16 + c]; zr[c] = wr_ * br - wi_ * bi; zi[c] = wr_ * bi + wi_ * br; }
                u32x4* o0 = (u32x4*)(W1S + (size_t)(g * 128 + p) * 512 + s * 16);
                u32x4* o1 = (u32x4*)(W1S + (size_t)(g * 128 + 64 + p) * 512 + s * 16);
                u32x4 w;
                w.x = cvt_pk_bf16(zr[0], zr[1]); w.y = cvt_pk_bf16(zr[2], zr[3]); w.z = cvt_pk_bf16(zr[4], zr[5]); w.w = cvt_pk_bf16(zr[6], zr[7]); o0[0] = w;
                w.x = cvt_pk_bf16(zr[8], zr[9]); w.y = cvt_pk_bf16(zr[10], zr[11]); w.z = cvt_pk_bf16(zr[12], zr[13]); w.w = cvt_pk_bf16(zr[14], zr[15]); o0[1] = w;
                w.x = cvt_pk_bf16(zi[0], zi[1]); w.y = cvt_pk_bf16(zi[2], zi[3]); w.z = cvt_pk_bf16(zi[4], zi[5]); w.w = cvt_pk_bf16(zi[6], zi[7]); o1[0] = w;
                w.x = cvt_pk_bf16(zi[8], zi[9]); w.y = cvt_pk_bf16(zi[10], zi[11]); w.z = cvt_pk_bf16(zi[12], zi[13]); w.w = cvt_pk_bf16(zi[14], zi[15]); o1[1] = w;
            }
        }
        __syncthreads();
        {
            LAS float* cp = (LAS float*)(lds + 8 * 16384) + (tid >> 8) * 128;
            const int half = tid >> 8, t256 = tid & 255;
            for (int it = bx; it < 1024; it += G) {
                const int g = it >> 5, jj = 2 * (it & 31) + half - 31;
                if (t256 < 64 && jj >= 0 && jj <= 31) {
                    const int p = t256;
                    const float lre = fminf(lam_re[g * 64 + p], -1e-4f), lim = lam_im[g * 64 + p], dt = expf(log_dt[g]);
                    float pr, pi, cr, ci; s5_pow(lre, lim, dt, (float)jj, pr, pi); s5_coef(lre, lim, dt, cr, ci);
                    cp[p] = pr * cr - pi * ci; cp[64 + p] = pr * ci + pi * cr;
                }
                __syncthreads();
                if (jj <= 31) {
                    const int c = t256 >> 4, c2 = t256 & 15; float val = 0.f;
                    if (jj >= 0) {
                        for (int p = 0; p < 64; ++p) {
                            const float xr_ = cp[p], xi_ = cp[64 + p];
                            const float br = b_re[(g * 64 + p) * 16 + c2], bi = b_im[(g * 64 + p) * 16 + c2];
                            const float zr = xr_ * br - xi_ * bi, zi = xr_ * bi + xi_ * br;
                            val += c_re[(g * 16 + c) * 64 + p] * zr - c_im[(g * 16 + c) * 64 + p] * zi;
                        }
                    }
                    const bf16_t bv = f2bf(val);
                    const int tlo = jj >= 0 ? jj : 0, thi = jj >= 0 ? 31 : 31 + jj;
                    for (int t = tlo; t <= thi; ++t) TW[(size_t)(g * 512 + t * 16 + c) * 640 + (t - jj) * 16 + c2] = bv;
                }
                __syncthreads();
            }
        }
    }
    SEAM(0);

    if (IN(1)) {
        pg8::Gemm g{XN, WIN, DM, DM, DM, 0, 0}; pg8::StaticOrder S; S.init(T, NIN, G, bx);
        pg8::EpiInProj E{QB, KB, VB, GB, AU, ROPE};
        pg8::gemm_phase(lds, g, S, E);
    }
    SEAM(1);

    if (IN(2)) {
        const int fr = lane & 15, fq = lane >> 4;
        for (int it = bx; it < 256; it += G) {
            const int g = it >> 3, rt = it & 7;
            f32x4 acc[8];
#pragma unroll
            for (int n = 0; n < 8; ++n) acc[n] = (f32x4){0.f, 0.f, 0.f, 0.f};
            for (int kt = 0; kt < 4; ++kt) {
                tile_load(lds, AU + (size_t)(g * 1024 + rt * 128) * 640 + kt * 128, 640, tid);
                tile_load(lds + TILE_B, W1S + (size_t)(g * 128) * 512 + kt * 128, 512, tid);
                __syncthreads();
                mma128<false, false>(acc, lds, lds_addr, 0, TILE_B, 16 * wave, lane);
                __syncthreads();
            }
            float* o = HINC + ((size_t)(g * 1024 + rt * 128 + 16 * wave + fr)) * 128 + 4 * fq;
#pragma unroll
            for (int n = 0; n < 8; ++n) *(f32x4*)(o + 16 * n) = acc[n];
        }
        for (int it = bx; it < 1024; it += G) {
            const int n = it & 63, h = (it >> 6) & 3, b = it >> 8;
            const float l2g = ret_log2_gamma(h);
            const size_t tok0 = (size_t)b * SEQ + n * 128;
            tile_load(lds, KB + tok0 * 512 + h * 128, 512, tid);
            tile_load_zeta(lds + TILE_B, VB + tok0 * 512 + h * 128, 512, tid, l2g);
            __syncthreads();
            f32x4 acc[8];
#pragma unroll
            for (int nb = 0; nb < 8; ++nb) acc[nb] = (f32x4){0.f, 0.f, 0.f, 0.f};
            mma128<true, true>(acc, lds, lds_addr, TILE_B, 0, 16 * wave, lane);
            float* o = SST + (size_t)it * 16384 + (16 * wave + fr) * 128 + 4 * fq;
#pragma unroll
            for (int nb = 0; nb < 8; ++nb) *(f32x4*)(o + 16 * nb) = acc[nb];
            __syncthreads();
        }
    }
    SEAM(2);

    if (IN(3)) {
        for (int idx = bx * 512 + tid; idx < 16 * 8192; idx += G * 512) {
            const int bh = idx >> 13, e2 = idx & 8191, h = bh & 3;
            const float gch = exp2f(128.0f * ret_log2_gamma(h));
            const float* sp = SST + (size_t)bh * 64 * 16384 + 2 * e2;
            unsigned* rp = (unsigned*)(RTB + (size_t)bh * 64 * 16384 + 2 * e2);
            float r0 = 0.f, r1 = 0.f;
            for (int n0 = 0; n0 < 64; n0 += 8) {
                f32x2 s[8];
#pragma unroll
                for (int j = 0; j < 8; ++j) s[j] = *(const f32x2*)(sp + (size_t)(n0 + j) * 16384);
#pragma unroll
                for (int j = 0; j < 8; ++j) { rp[(size_t)(n0 + j) * 8192] = cvt_pk_bf16(r0, r1); r0 = gch * r0 + s[j][0]; r1 = gch * r1 + s[j][1]; }
            }
        }
        {
            LAS float* X = (LAS float*)lds;
            for (int it = bx; it < 128; it += G) {
                const int b = it >> 5, g = it & 31, p = tid & 63, seg = tid >> 6;
                const float lre = fminf(lam_re[g * 64 + p], -1e-4f), lim = lam_im[g * 64 + p], dt = expf(log_dt[g]);
                float ar, ai, Ar, Ai; s5_pow(lre, lim, dt, 32.0f, ar, ai); s5_pow(lre, lim, dt, 1024.0f, Ar, Ai);
                const float* hp = HINC + ((size_t)(g * 1024 + b * 256 + seg * 32)) * 128 + p;
                float xr = 0.f, xi = 0.f;
                for (int i = 0; i < 32; ++i) { const float hr = hp[(size_t)i * 128], hi_ = hp[(size_t)i * 128 + 64]; const float nr = ar * xr - ai * xi + hr, ni = ar * xi + ai * xr + hi_; xr = nr; xi = ni; }
                X[(seg * 64 + p) * 2] = xr; X[(seg * 64 + p) * 2 + 1] = xi;
                __syncthreads();
                float cr = 0.f, ci = 0.f;
                for (int s = 0; s < seg; ++s) { const float tr = X[(s * 64 + p) * 2], ti = X[(s * 64 + p) * 2 + 1]; const float nr = Ar * cr - Ai * ci + tr, ni = Ar * ci + Ai * cr + ti; cr = nr; ci = ni; }
                bf16_t* op = AU + ((size_t)(g * 1024 + b * 256 + seg * 32)) * 640 + 512 + p;
                xr = cr; xi = ci;
                for (int i = 0; i < 32; ++i) {
                    op[(size_t)i * 640] = f2bf(xr); op[(size_t)i * 640 + 64] = f2bf(xi);
                    const float hr = hp[(size_t)i * 128], hi_ = hp[(size_t)i * 128 + 64]; const float nr = ar * xr - ai * xi + hr, ni = ar * xi + ai * xr + hi_; xr = nr; xi = ni;
                }
                __syncthreads();
            }
        }
    }
    SEAM(3);

    if (IN(4)) {
        {
            pg8::Gemm g{AU, TW, 640, 640, 640, (size_t)1024 * 640, (size_t)512 * 640}; pg8::BatchOrder S{G, bx};
            pg8::EpiSsm E{AU, d_skip, YSSM};
            pg8::gemm_phase(lds, g, S, E);
        }
        const int fr = lane & 15, fq = lane >> 4;
        constexpr int OQ = 0, OK_ = TILE_B, OV = 2 * TILE_B, OR = 3 * TILE_B;
        for (int it = bx; it < 1024; it += G) {
            const int n = it & 63, h = (it >> 6) & 3, b = it >> 8;
            const float l2g = ret_log2_gamma(h);
            const size_t tok0 = (size_t)b * SEQ + n * 128;
            tile_load(lds + OQ, QB + tok0 * 512 + h * 128, 512, tid);
            tile_load(lds + OK_, KB + tok0 * 512 + h * 128, 512, tid);
            tile_load(lds + OV, VB + tok0 * 512 + h * 128, 512, tid);
            tile_load(lds + OR, RTB + (size_t)it * 16384, 128, tid);
            __syncthreads();
            const int i = 16 * wave + fr;
            f32x4 sc[8];
#pragma unroll
            for (int nb = 0; nb < 8; ++nb) sc[nb] = (f32x4){0.f, 0.f, 0.f, 0.f};
            mma128<false, false>(sc, lds, lds_addr, OQ, OK_, 16 * wave, lane);
            __syncthreads();
#pragma unroll
            for (int nb = 0; nb < 8; ++nb) {
                f32x4 pv;
#pragma unroll
                for (int e = 0; e < 4; ++e) { const int j = 16 * nb + 4 * fq + e; pv[e] = (i >= j) ? sc[nb][e] * exp2f((float)(i - j) * l2g) : 0.f; }
                u32x2 w; w.x = cvt_pk_bf16(pv[0], pv[1]); w.y = cvt_pk_bf16(pv[2], pv[3]);
                *(LAS u32x2*)(lds + OK_ + i * TS + (16 * nb + 4 * fq) * 2) = w;
            }
            LDS_WAIT();
            __syncthreads();
            f32x4 a1[8], a2[8];
#pragma unroll
            for (int nb = 0; nb < 8; ++nb) { a1[nb] = (f32x4){0.f, 0.f, 0.f, 0.f}; a2[nb] = (f32x4){0.f, 0.f, 0.f, 0.f}; }
            mma128<false, true>(a1, lds, lds_addr, OK_, OV, 16 * wave, lane);
            mma128<false, false>(a2, lds, lds_addr, OQ, OR, 16 * wave, lane);
            const float xi = exp2f((float)(i + 1) * l2g);
            float s1 = 0.f, s2 = 0.f;
#pragma unroll
            for (int nb = 0; nb < 8; ++nb)
#pragma unroll
                for (int e = 0; e < 4; ++e) { const float o = a1[nb][e] + xi * a2[nb][e]; a1[nb][e] = o; s1 += o; s2 += o * o; }
            s1 += __shfl_xor(s1, 16); s1 += __shfl_xor(s1, 32); s2 += __shfl_xor(s2, 16); s2 += __shfl_xor(s2, 32);
            const float mu = s1 * (1.0f / 128.0f), var = fmaxf(s2 * (1.0f / 128.0f) - mu * mu, 0.f), rs = 1.0f / sqrtf(var + EPS);
            const size_t tok = tok0 + i;
#pragma unroll
            for (int nb = 0; nb < 8; ++nb) {
                const int d = 16 * nb + 4 * fq;
                const u32x2 gw = *(const u32x2*)(GB + tok * 512 + h * 128 + d);
                const f32x4 gg = *(const f32x4*)(gn_gain + h * 128 + d);
                const float g0 = bf_lo(gw.x), g1 = bf_hi(gw.x), g2 = bf_lo(gw.y), g3 = bf_hi(gw.y);
                const float y0 = (a1[nb][0] - mu) * rs * gg[0] * (g0 / (1.0f + __expf(-g0)));
                const float y1 = (a1[nb][1] - mu) * rs * gg[1] * (g1 / (1.0f + __expf(-g1)));
                const float y2 = (a1[nb][2] - mu) * rs * gg[2] * (g2 / (1.0f + __expf(-g2)));
                const float y3 = (a1[nb][3] - mu) * rs * gg[3] * (g3 / (1.0f + __expf(-g3)));
                u32x2 w; w.x = cvt_pk_bf16(y0, y1); w.y = cvt_pk_bf16(y2, y3);
                *(u32x2*)(YMIX + tok * 1024 + h * 128 + d) = w;
            }
            __syncthreads();
        }
    }
    SEAM(4);

    if (IN(5)) {
        pg8::Gemm g{YSSM, WGLU, 512, 512, 512, 0, 0}; pg8::StaticOrder S; S.init(T, 1024, G, bx);
        pg8::EpiGlu E{YMIX};
        pg8::gemm_phase(lds, g, S, E);
    }
    SEAM(5);

    if (IN(6)) {
        pg8::Gemm g{YMIX, WOUT, DM, DM, DM, 0, 0}; pg8::StaticOrder S; S.init(T, DM, G, bx);
        pg8::EpiSS E{MIXB, SS};
        pg8::gemm_phase(lds, g, S, E);
    }
    SEAM(6);

    if (IN(7)) {
        const int gw = bx * 8 + wave, NGW = G * 8;
        for (int m = gw; m < T; m += NGW) {
            const f32x4* sp = (const f32x4*)(SS + (size_t)m * 16);
            const f32x4 p0 = sp[0], p1 = sp[1], p2 = sp[2], p3 = sp[3];
            const float ssum = ((p0[0] + p0[1]) + (p0[2] + p0[3])) + ((p1[0] + p1[1]) + (p1[2] + p1[3])) + ((p2[0] + p2[1]) + (p2[2] + p2[3])) + ((p3[0] + p3[1]) + (p3[2] + p3[3]));
            const float rstd = 1.0f / sqrtf(ssum * (1.0f / DM) + EPS);
            const f32x4* xr = (const f32x4*)(x + (size_t)m * DM) + lane;
            const u32x2* mr = (const u32x2*)(MIXB + (size_t)m * DM) + lane;
            const f32x4* gr = (const f32x4*)g_mix_post + lane;
            f32x4* orow = (f32x4*)(out + (size_t)m * DM) + lane;
            f32x4 v[4]; float s = 0.f;
#pragma unroll
            for (int j = 0; j < 4; ++j) {
                const f32x4 xv = xr[64 * j], gv = gr[64 * j]; const u32x2 mw = mr[64 * j];
                v[j][0] = xv[0] + bf_lo(mw.x) * rstd * gv[0]; v[j][1] = xv[1] + bf_hi(mw.x) * rstd * gv[1];
                v[j][2] = xv[2] + bf_lo(mw.y) * rstd * gv[2]; v[j][3] = xv[3] + bf_hi(mw.y) * rstd * gv[3];
                s += (v[j][0] * v[j][0] + v[j][1] * v[j][1]) + (v[j][2] * v[j][2] + v[j][3] * v[j][3]);
                orow[64 * j] = v[j];
            }
            const float rstd1 = 1.0f / sqrtf(wave_sum(s) * (1.0f / DM) + EPS);
            u32x2* o8 = (u32x2*)(XN + (size_t)m * DM) + lane;
#pragma unroll
            for (int j = 0; j < 4; ++j) { u32x2 w; w.x = cvt_pk_bf16(v[j][0] * rstd1, v[j][1] * rstd1); w.y = cvt_pk_bf16(v[j][2] * rstd1, v[j][3] * rstd1); o8[64 * j] = w; }
        }
    }
    SEAM(7);

    if (IN(8)) {
        pg8::Gemm g{XN, WFF1, DM, DM, DM, 0, 0}; pg8::StaticOrder S; S.init(T, DFF, G, bx);
        pg8::EpiRelu2 E{HID};
        pg8::gemm_phase(lds, g, S, E);
    }
    SEAM(8);

    if (IN(9)) {
        pg8::Gemm g{HID, WFF2, DFF, DFF, DFF, 0, 0}; pg8::StaticOrder S; S.init(T, DM, G, bx);
        pg8::EpiSS E{MB, SS2};
        pg8::gemm_phase(lds, g, S, E);
    }
    SEAM(9);

    if (IN(10)) {
        const int gw = bx * 8 + wave, NGW = G * 8;
        for (int m = gw; m < T; m += NGW) {
            const f32x4* sp = (const f32x4*)(SS2 + (size_t)m * 16);
            const f32x4 p0 = sp[0], p1 = sp[1], p2 = sp[2], p3 = sp[3];
            const float ssum = ((p0[0] + p0[1]) + (p0[2] + p0[3])) + ((p1[0] + p1[1]) + (p1[2] + p1[3])) + ((p2[0] + p2[1]) + (p2[2] + p2[3])) + ((p3[0] + p3[1]) + (p3[2] + p3[3]));
            const float rstd = 1.0f / sqrtf(ssum * (1.0f / DM) + EPS);
            const u32x2* mr = (const u32x2*)(MB + (size_t)m * DM) + lane;
            const f32x4* gr = (const f32x4*)g_mlp_post + lane;
            f32x4* orow = (f32x4*)(out + (size_t)m * DM) + lane;
#pragma unroll
            for (int j = 0; j < 4; ++j) {
                f32x4 xv = orow[64 * j]; const f32x4 gv = gr[64 * j]; const u32x2 mw = mr[64 * j];
                xv[0] += bf_lo(mw.x) * rstd * gv[0]; xv[1] += bf_hi(mw.x) * rstd * gv[1];
                xv[2] += bf_lo(mw.y) * rstd * gv[2]; xv[3] += bf_hi(mw.y) * rstd * gv[3];
                orow[64 * j] = xv;
            }
        }
    }
#undef IN
#undef SEAM
}

extern "C" void kernel_launch(void* const* d_in, const int* in_sizes, int n_in, void* d_out, int out_size, void* d_ws, size_t ws_size, hipStream_t stream) {
    static int grid = 0;
    if (grid == 0) {
        int dev = 0, cus = 0, per_cu = 0;
        hipGetDevice(&dev);
        hipDeviceGetAttribute(&cus, hipDeviceAttributeMultiprocessorCount, dev);
        hipFuncSetAttribute((const void*)fwd_kernel, hipFuncAttributeMaxDynamicSharedMemorySize, LDS_BYTES);
        if (hipOccupancyMaxActiveBlocksPerMultiprocessor(&per_cu, (const void*)fwd_kernel, 512, LDS_BYTES) != hipSuccess || per_cu < 1) per_cu = 1;
        (void)hipGetLastError();
        grid = cus * per_cu;
        if (grid <= 0) grid = 256;
    }
    Args a{};
    for (int i = 0; i < 19; ++i) a.in[i] = (const float*)d_in[i];
    a.out = (float*)d_out; a.ws = (unsigned char*)d_ws;
#if N_LAUNCH_PER_PHASE
    for (int ph = 0; ph < NPHASE; ++ph) {
        a.ph_lo = ph; a.ph_hi = ph + 1;
        void* args[] = {&a};
        hipError_t e = hipLaunchCooperativeKernel((const void*)fwd_kernel, dim3(grid), dim3(512), args, LDS_BYTES, stream);
        if (e != hipSuccess) { fprintf(stderr, "cooperative launch (phase %d) failed: %s (grid %d)\n", ph, hipGetErrorString(e), grid); break; }
    }
#else
    a.ph_lo = 0; a.ph_hi = NPHASE;
    void* args[] = {&a};
    hipError_t e = hipLaunchCooperativeKernel((const void*)fwd_kernel, dim3(grid), dim3(512), args, LDS_BYTES, stream);
    if (e != hipSuccess) fprintf(stderr, "cooperative launch failed: %s (grid %d)\n", hipGetErrorString(e), grid);
#endif
}
```

```cpp
#include <hip/hip_runtime.h>
#include <hip/hip_cooperative_groups.h>
#include <cstdio>
namespace cg = cooperative_groups;

#ifndef N_LAUNCH_PER_PHASE
#define N_LAUNCH_PER_PHASE 0
#endif

#ifndef PROBE_DUP
#define PROBE_DUP 0
#endif
#define REPS(k) (1 + ((PROBE_DUP >> (k)) & 1))
#define LAS __attribute__((address_space(3)))
typedef unsigned short bf16_t;
typedef short bf16x8 __attribute__((ext_vector_type(8)));
typedef float f32x4 __attribute__((ext_vector_type(4)));
typedef float f32x2 __attribute__((ext_vector_type(2)));
typedef unsigned u32x4 __attribute__((ext_vector_type(4)));
typedef unsigned u32x2 __attribute__((ext_vector_type(2)));

constexpr int T = 32768, SEQ = 8192, DM = 1024, NIN = 2560, DFF = 4096;
constexpr float EPS = 1e-6f;
constexpr int NPHASE = 11;

constexpr size_t MiB = 1u << 20;
constexpr size_t WS_WIN = 1 * MiB, WS_WGLU = 6 * MiB, WS_WOUT = 7 * MiB, WS_WFF1 = 9 * MiB, WS_WFF2 = 17 * MiB;
constexpr size_t WS_ROPE = 25 * MiB, WS_TW = 29 * MiB, WS_W1S = 49 * MiB, WS_SS = 53 * MiB, WS_SS2 = 55 * MiB, WS_HINC = 57 * MiB;
constexpr size_t WS_XN = 80 * MiB;
constexpr size_t WS_QB = 144 * MiB, WS_KB = 176 * MiB, WS_VB = 208 * MiB, WS_GB = 240 * MiB, WS_AU = 272 * MiB;
constexpr size_t WS_SST = 312 * MiB, WS_RTB = 376 * MiB, WS_YSSM = 408 * MiB, WS_YMIX = 440 * MiB;
constexpr size_t WS_MIXB = 144 * MiB, WS_HID = 144 * MiB, WS_MB = 400 * MiB;

constexpr int LDS_BYTES = 147456;
constexpr int TS = 272;
constexpr int TILE_B = 128 * TS;

__device__ __forceinline__ unsigned cvt_pk_bf16(float lo, float hi) { unsigned r; asm volatile("v_cvt_pk_bf16_f32 %0, %1, %2" : "=v"(r) : "v"(lo), "v"(hi)); return r; }
__device__ __forceinline__ float bf_lo(unsigned w) { return __uint_as_float(w << 16); }
__device__ __forceinline__ float bf_hi(unsigned w) { return __uint_as_float(w & 0xffff0000u); }
__device__ __forceinline__ bf16_t f2bf(float f) { return (bf16_t)(cvt_pk_bf16(f, 0.f) & 0xffffu); }
__device__ __forceinline__ float wave_sum(float v) {
#pragma unroll
    for (int o = 1; o < 64; o <<= 1) v += __shfl_xor(v, o);
    return v;
}
#define LDS_WAIT() asm volatile("s_waitcnt lgkmcnt(0)" ::: "memory")

namespace pg8 {
constexpr int BM = 256, BK = 64, HALF = 128, HTB = HALF * BK * 2, STAGE_BYTES = 8 * HTB, NXCD = 8, WGM = 8;
__device__ __forceinline__ int lds_byte(int r, int c) { const int st = (r >> 4) * 2 + (c >> 5), rr = r & 15, cc = c & 31, ob = rr * 64 + cc * 2; return st * 1024 + (ob ^ (((ob >> 9) & 1) << 5)); }
__device__ __forceinline__ void stage_rc(int b, int& R, int& C) { const int st = b / 1024, sb = b % 1024, swz = sb ^ (((sb >> 9) & 1) << 5); R = (st >> 1) * 16 + swz / 64; C = (st & 1) * 32 + (swz % 64) / 2; }
__device__ __forceinline__ int perm32(int rho) { const int n = rho >> 4, i = rho & 15; return 8 * (i >> 2) + 4 * n + (i & 3); }

struct Unit { int pm, pn, pb; };
struct Gemm { const bf16_t* A; const bf16_t* Bt; int lda, ldb, K; size_t bsA, bsB; };

struct StaticOrder {
    int nM, nN, nwg, G, c;
    __device__ void init(int M, int N, int G_, int c_) { nM = M / BM; nN = N / BM; nwg = nM * nN; G = G_; c = c_; }
    __device__ bool next(int i, Unit& u) const {
        const long L = (long)i * G + c; if (L >= nwg) return false;
        int wgid = (int)L; { const int q = nwg / NXCD, r = nwg % NXCD, xcd = wgid % NXCD, off = wgid / NXCD; wgid = (xcd < r ? xcd * (q + 1) : r * (q + 1) + (xcd - r) * q) + off; }
        const int nig = WGM * nN, gid = wgid / nig, fm = gid * WGM, gsz = (nM - fm) < WGM ? (nM - fm) : WGM;
        u.pm = fm + ((wgid % nig) % gsz); u.pn = (wgid % nig) / gsz; u.pb = 0; return true;
    }
};
struct BatchOrder {
    int G, c;
    __device__ bool next(int i, Unit& u) const {
        const int L = i * G + c; if (L >= 256) return false;
        u.pb = L >> 3; const int r = L & 7; u.pm = r & 3; u.pn = r >> 2; return true;
    }
};

template <class Epi, class Sched>
__device__ __forceinline__ void gemm_phase(LAS unsigned char* lds, const Gemm g, const Sched& S, const Epi& E) {
    const int tid = threadIdx.x, wid = __builtin_amdgcn_readfirstlane(tid >> 6), lane = tid & 63, wr = wid >> 2, wc = wid & 3, fr = lane & 15, fq = lane >> 4;
    const int K = g.K, nt = K / BK;
    unsigned voffA[2], voffB[2];
#pragma unroll
    for (int i = 0; i < 2; ++i) { int R, C; stage_rc(tid * 16 + i * 8192, R, C); const int Rb = Epi::PERM ? ((R & ~31) + perm32(R & 31)) : R;
        voffA[i] = (unsigned)(R * g.lda + C) * 2u; voffB[i] = (unsigned)(Rb * g.ldb + C) * 2u; }
    const size_t kstep = (size_t)(BK * 2);
    const size_t hstepA = (size_t)HALF * g.lda * 2, hstepB = (size_t)HALF * g.ldb * 2;
    const size_t tstepA = 2 * hstepA, tstepB = 2 * hstepB;
    const unsigned ldsw = (unsigned)wid * 1024u;
    const int aoff = lds_byte(wr * 64 + fr, fq * 8), boff = lds_byte(wc * 32 + fr, fq * 8);
#define PG8_SA(b, h) (((b) * 2 + (h)) * HTB)
#define PG8_SB(b, h) ((4 + (b) * 2 + (h)) * HTB)
#define PG8_STAGE(bufoff, gbase, voff) do { _Pragma("unroll") for (int _i = 0; _i < 2; ++_i) \
        __builtin_amdgcn_global_load_lds((const unsigned*)((const char*)(gbase) + (voff)[_i]), (LAS unsigned*)(lds + (bufoff) + ldsw + _i * 8192), 16, 0, 0); } while (0)
#define PG8_LDA(dst, b, h) do { _Pragma("unroll") for (int m = 0; m < 4; ++m) _Pragma("unroll") for (int k = 0; k < 2; ++k) dst[m][k] = *(const LAS bf16x8*)(lds + PG8_SA(b, h) + aoff + m * 2048 + k * 1024); } while (0)
#define PG8_LDB(dst, b, h) do { _Pragma("unroll") for (int n = 0; n < 2; ++n) _Pragma("unroll") for (int k = 0; k < 2; ++k) dst[n][k] = *(const LAS bf16x8*)(lds + PG8_SB(b, h) + boff + n * 2048 + k * 1024); } while (0)
#define PG8_MMA(ai, bj, At, Bt) do { __builtin_amdgcn_s_setprio(1); _Pragma("unroll") for (int m = 0; m < 4; ++m) _Pragma("unroll") for (int n = 0; n < 2; ++n) _Pragma("unroll") for (int k = 0; k < 2; ++k) \
        acc[ai][bj][m][n] = __builtin_amdgcn_mfma_f32_16x16x32_bf16(Bt[n][k], At[m][k], acc[ai][bj][m][n], 0, 0, 0); __builtin_amdgcn_s_setprio(0); } while (0)
#define PG8_WAIT_V(n) asm volatile("s_waitcnt vmcnt(" #n ")" ::: "memory")
#define PG8_WAIT_L(n) asm volatile("s_waitcnt lgkmcnt(" #n ")" ::: "memory")
#define PG8_BAR __builtin_amdgcn_s_barrier()
#define PG8_SCHED __builtin_amdgcn_sched_barrier(0)
    Unit cur, nxt; int ui = 0;
    if (!S.next(0, cur)) return;
    f32x4 acc[2][2][4][2];
#pragma unroll
    for (int a = 0; a < 2; ++a)
#pragma unroll
        for (int b = 0; b < 2; ++b)
#pragma unroll
            for (int m = 0; m < 4; ++m)
#pragma unroll
                for (int n = 0; n < 2; ++n) acc[a][b][m][n] = (f32x4){0.f, 0.f, 0.f, 0.f};
    bf16x8 At[4][2], B0[2][2], B1[2][2];
    const char* cA = (const char*)g.A + (size_t)cur.pb * g.bsA * 2 + (size_t)cur.pm * tstepA;
    const char* cB = (const char*)g.Bt + (size_t)cur.pb * g.bsB * 2 + (size_t)cur.pn * tstepB;
    PG8_STAGE(PG8_SB(0, 0), cB, voffB); PG8_STAGE(PG8_SA(0, 0), cA, voffA); PG8_STAGE(PG8_SB(0, 1), cB + hstepB, voffB); PG8_STAGE(PG8_SA(0, 1), cA + hstepA, voffA);
    if (wr == 1) PG8_BAR;
    PG8_WAIT_V(4); PG8_BAR;
    PG8_STAGE(PG8_SB(1, 0), cB + kstep, voffB); PG8_STAGE(PG8_SA(1, 0), cA + kstep, voffA); PG8_STAGE(PG8_SB(1, 1), cB + hstepB + kstep, voffB);
    PG8_WAIT_V(6); PG8_BAR;
    for (;;) {
        const bool has_next = S.next(ui + 1, nxt);
        const char* nA = has_next ? (const char*)g.A + (size_t)nxt.pb * g.bsA * 2 + (size_t)nxt.pm * tstepA : cA;
        const char* nB = has_next ? (const char*)g.Bt + (size_t)nxt.pb * g.bsB * 2 + (size_t)nxt.pn * tstepB : cB;
        for (int t = 0; t < nt; t += 2) {
            const bool last = (t == nt - 2);
            const char* a1 = cA + (size_t)(t + 1) * kstep;
            const char* a2 = last ? nA : cA + (size_t)(t + 2) * kstep; const char* b2 = last ? nB : cB + (size_t)(t + 2) * kstep;
            const char* a3 = a2 + kstep; const char* b3 = b2 + kstep;
            PG8_LDB(B0, 0, 0); PG8_SCHED; PG8_LDA(At, 0, 0); PG8_STAGE(PG8_SA(1, 1), a1 + hstepA, voffA);
            PG8_WAIT_L(8); PG8_BAR; PG8_WAIT_L(0); PG8_MMA(0, 0, At, B0); PG8_BAR; PG8_SCHED;
            PG8_LDB(B1, 0, 1); PG8_STAGE(PG8_SB(0, 0), b2, voffB);
            PG8_BAR; PG8_WAIT_L(0); PG8_MMA(0, 1, At, B1); PG8_BAR;
            PG8_LDA(At, 0, 1); PG8_STAGE(PG8_SA(0, 0), a2, voffA);
            PG8_BAR; PG8_WAIT_L(0); PG8_MMA(1, 0, At, B0); PG8_BAR; PG8_SCHED;
            PG8_STAGE(PG8_SB(0, 1), b2 + hstepB, voffB);
            PG8_WAIT_V(6); PG8_BAR; PG8_MMA(1, 1, At, B1); PG8_BAR;
            PG8_LDB(B0, 1, 0); PG8_SCHED; PG8_LDA(At, 1, 0); PG8_STAGE(PG8_SA(0, 1), a2 + hstepA, voffA);
            PG8_WAIT_L(8); PG8_BAR; PG8_WAIT_L(0); PG8_MMA(0, 0, At, B0); PG8_BAR; PG8_SCHED;
            PG8_LDB(B1, 1, 1); PG8_STAGE(PG8_SB(1, 0), b3, voffB);
            PG8_BAR; PG8_WAIT_L(0); PG8_MMA(0, 1, At, B1); PG8_BAR;
            PG8_LDA(At, 1, 1); PG8_STAGE(PG8_SA(1, 0), a3, voffA);
            PG8_BAR; PG8_WAIT_L(0); PG8_MMA(1, 0, At, B0); PG8_BAR; PG8_SCHED;
            PG8_STAGE(PG8_SB(1, 1), b3 + hstepB, voffB);
            PG8_WAIT_V(6); PG8_BAR; PG8_MMA(1, 1, At, B1); PG8_BAR;
        }
        E(acc, cur, wr, wc, fr, fq);
        if (!has_next) break;
#pragma unroll
        for (int a = 0; a < 2; ++a)
#pragma unroll
            for (int b = 0; b < 2; ++b)
#pragma unroll
                for (int m = 0; m < 4; ++m)
#pragma unroll
                    for (int n = 0; n < 2; ++n) acc[a][b][m][n] = (f32x4){0.f, 0.f, 0.f, 0.f};
        cur = nxt; cA = nA; cB = nB; ++ui;
    }
    PG8_WAIT_V(0);
    if (wr == 0) PG8_BAR;
    PG8_BAR;
#undef PG8_SA
#undef PG8_SB
#undef PG8_STAGE
#undef PG8_LDA
#undef PG8_LDB
#undef PG8_MMA
#undef PG8_WAIT_V
#undef PG8_WAIT_L
#undef PG8_BAR
#undef PG8_SCHED
}

__device__ __forceinline__ u32x4 pack8(const f32x4 v0, const f32x4 v1) {
    u32x4 w; w.x = cvt_pk_bf16(v0[0], v0[1]); w.y = cvt_pk_bf16(v0[2], v0[3]); w.z = cvt_pk_bf16(v1[0], v1[1]); w.w = cvt_pk_bf16(v1[2], v1[3]); return w;
}
__device__ __forceinline__ f32x4 rope4(const f32x4 v, const f32x4 cs) {
    f32x4 r; r[0] = v[0] * cs[0] - v[1] * cs[1]; r[1] = v[0] * cs[1] + v[1] * cs[0]; r[2] = v[2] * cs[2] - v[3] * cs[3]; r[3] = v[2] * cs[3] + v[3] * cs[2]; return r;
}
struct EpiInProj {
    static constexpr bool PERM = true;
    bf16_t *Q, *Kb, *V, *Gt, *AU; const float* rope;
    __device__ __forceinline__ void operator()(const f32x4 (&acc)[2][2][4][2], const Unit& u, int wr, int wc, int fr, int fq) const {
        const int sect = u.pn >> 1;
        const int row0 = u.pm * BM + wr * 64 + fr;
        const int colt = (u.pn & 1) * 256 + wc * 32 + 8 * fq;
        if (sect <= 1) {
            bf16_t* O = sect ? Kb : Q;
#pragma unroll
            for (int ai = 0; ai < 2; ++ai)
#pragma unroll
                for (int m = 0; m < 4; ++m) {
                    const int row = row0 + ai * HALF + m * 16, pos = row & (SEQ - 1);
                    const float* rp = rope + ((size_t)pos * 64 + 16 * wc + 4 * fq) * 2;
                    const f32x4 cs0 = *(const f32x4*)rp, cs1 = *(const f32x4*)(rp + 4);
#pragma unroll
                    for (int bj = 0; bj < 2; ++bj) {
                        const f32x4 v0 = rope4(acc[ai][bj][m][0], cs0), v1 = rope4(acc[ai][bj][m][1], cs1);
                        *(u32x4*)(O + (size_t)row * 512 + colt + bj * HALF) = pack8(v0, v1);
                    }
                }
        } else if (sect <= 3) {
            bf16_t* O = (sect == 2) ? V : Gt;
#pragma unroll
            for (int ai = 0; ai < 2; ++ai)
#pragma unroll
                for (int m = 0; m < 4; ++m) {
                    const int row = row0 + ai * HALF + m * 16;
#pragma unroll
                    for (int bj = 0; bj < 2; ++bj) *(u32x4*)(O + (size_t)row * 512 + colt + bj * HALF) = pack8(acc[ai][bj][m][0], acc[ai][bj][m][1]);
                }
        } else {
#pragma unroll
            for (int ai = 0; ai < 2; ++ai)
#pragma unroll
                for (int m = 0; m < 4; ++m) {
                    const int row = row0 + ai * HALF + m * 16, cr = row >> 5, s = row & 31;
#pragma unroll
                    for (int bj = 0; bj < 2; ++bj) {
                        const int cu = colt + bj * HALF, g = cu >> 4, c0 = cu & 15;
                        *(u32x4*)(AU + ((size_t)(g * 1024 + cr) * 640 + s * 16 + c0)) = pack8(acc[ai][bj][m][0], acc[ai][bj][m][1]);
                    }
                }
        }
    }
};
struct EpiGlu {
    static constexpr bool PERM = true;
    bf16_t* Y;
    __device__ __forceinline__ void operator()(const f32x4 (&acc)[2][2][4][2], const Unit& u, int wr, int wc, int fr, int fq) const {
        const int row0 = u.pm * BM + wr * 64 + fr, col = 512 + u.pn * 128 + wc * 32 + 8 * fq;
#pragma unroll
        for (int ai = 0; ai < 2; ++ai)
#pragma unroll
            for (int m = 0; m < 4; ++m) {
                const int row = row0 + ai * HALF + m * 16;
                f32x4 y0, y1;
#pragma unroll
                for (int j = 0; j < 4; ++j) {
                    y0[j] = acc[ai][0][m][0][j] / (1.0f + __expf(-acc[ai][1][m][0][j]));
                    y1[j] = acc[ai][0][m][1][j] / (1.0f + __expf(-acc[ai][1][m][1][j]));
                }
                *(u32x4*)(Y + (size_t)row * 1024 + col) = pack8(y0, y1);
            }
    }
};
struct EpiSS {
    static constexpr bool PERM = true;
    bf16_t* O; float* SS;
    __device__ __forceinline__ void operator()(const f32x4 (&acc)[2][2][4][2], const Unit& u, int wr, int wc, int fr, int fq) const {
        const int row0 = u.pm * BM + wr * 64 + fr, col = u.pn * BM + wc * 32 + 8 * fq;
#pragma unroll
        for (int ai = 0; ai < 2; ++ai)
#pragma unroll
            for (int m = 0; m < 4; ++m) {
                const int row = row0 + ai * HALF + m * 16; float q = 0.f;
#pragma unroll
                for (int bj = 0; bj < 2; ++bj) {
                    const f32x4 v0 = acc[ai][bj][m][0], v1 = acc[ai][bj][m][1];
                    q += (v0[0] * v0[0] + v0[1] * v0[1]) + (v0[2] * v0[2] + v0[3] * v0[3]) + (v1[0] * v1[0] + v1[1] * v1[1]) + (v1[2] * v1[2] + v1[3] * v1[3]);
                    *(u32x4*)(O + (size_t)row * 1024 + col + bj * HALF) = pack8(v0, v1);
                }
                q += __shfl_xor(q, 16); q += __shfl_xor(q, 32);
                if (fq == 0) SS[(size_t)row * 16 + u.pn * 4 + wc] = q;
            }
    }
};
struct EpiRelu2 {
    static constexpr bool PERM = true;
    bf16_t* O;
    __device__ __forceinline__ void operator()(const f32x4 (&acc)[2][2][4][2], const Unit& u, int wr, int wc, int fr, int fq) const {
        const int row0 = u.pm * BM + wr * 64 + fr, col = u.pn * BM + wc * 32 + 8 * fq;
#pragma unroll
        for (int ai = 0; ai < 2; ++ai)
#pragma unroll
            for (int m = 0; m < 4; ++m) {
                const int row = row0 + ai * HALF + m * 16;
#pragma unroll
                for (int bj = 0; bj < 2; ++bj) {
                    f32x4 v0 = acc[ai][bj][m][0], v1 = acc[ai][bj][m][1];
#pragma unroll
                    for (int j = 0; j < 4; ++j) { const float a = fmaxf(v0[j], 0.f), b = fmaxf(v1[j], 0.f); v0[j] = a * a; v1[j] = b * b; }
                    *(u32x4*)(O + (size_t)row * DFF + col + bj * HALF) = pack8(v0, v1);
                }
            }
    }
};
struct EpiSsm {
    static constexpr bool PERM = true;
    const bf16_t* AU; const float* dskip; bf16_t* Y;
    __device__ __forceinline__ void operator()(const f32x4 (&acc)[2][2][4][2], const Unit& u, int wr, int wc, int fr, int fq) const {
        const int g = u.pb;
        const int row0 = u.pm * BM + wr * 64 + fr, colt = u.pn * BM + wc * 32 + 8 * fq;
        const int c0 = 8 * (fq & 1);
        const f32x4 d0 = *(const f32x4*)(dskip + g * 16 + c0), d1 = *(const f32x4*)(dskip + g * 16 + c0 + 4);
#pragma unroll
        for (int ai = 0; ai < 2; ++ai)
#pragma unroll
            for (int m = 0; m < 4; ++m) {
                const int cr = row0 + ai * HALF + m * 16;
#pragma unroll
                for (int bj = 0; bj < 2; ++bj) {
                    const int col = colt + bj * HALF, s = col >> 4;
                    const u32x4 uw = *(const u32x4*)(AU + ((size_t)(g * 1024 + cr) * 640 + col));
                    f32x4 v0 = acc[ai][bj][m][0], v1 = acc[ai][bj][m][1];
                    v0[0] += d0[0] * bf_lo(uw.x); v0[1] += d0[1] * bf_hi(uw.x); v0[2] += d0[2] * bf_lo(uw.y); v0[3] += d0[3] * bf_hi(uw.y);
                    v1[0] += d1[0] * bf_lo(uw.z); v1[1] += d1[1] * bf_hi(uw.z); v1[2] += d1[2] * bf_lo(uw.w); v1[3] += d1[3] * bf_hi(uw.w);
#pragma unroll
                    for (int j = 0; j < 4; ++j) {
                        const float a = v0[j], za = 1.5957691216f * (a + 0.044715f * a * a * a); v0[j] = a / (1.0f + __expf(-za));
                        const float b = v1[j], zb = 1.5957691216f * (b + 0.044715f * b * b * b); v1[j] = b / (1.0f + __expf(-zb));
                    }
                    const size_t tok = (size_t)cr * 32 + s;
                    *(u32x4*)(Y + tok * 512 + g * 16 + c0) = pack8(v0, v1);
                }
            }
    }
};
}

__device__ __forceinline__ bf16x8 frag_nat(const LAS unsigned char* tile, int idx0, int k0, int fr, int fq) {
    return *(const LAS bf16x8*)(tile + (idx0 + fr) * TS + (k0 + 8 * fq) * 2);
}
__device__ __forceinline__ bf16x8 frag_tr(unsigned tile_addr, int k0, int idx0, int lane) {
    const int g = lane >> 4, q = (lane & 15) >> 2, p = lane & 3;
    const unsigned addr = tile_addr + (unsigned)((k0 + 8 * g + q) * TS + (idx0 + 4 * p) * 2);
    u32x2 lo, hi;
    asm volatile("ds_read_b64_tr_b16 %0, %2\n\tds_read_b64_tr_b16 %1, %2 offset:1088\n\ts_waitcnt lgkmcnt(0)" : "=&v"(lo), "=&v"(hi) : "v"(addr) : "memory");
    u32x4 r; r.x = lo.x; r.y = lo.y; r.z = hi.x; r.w = hi.y;
    return __builtin_bit_cast(bf16x8, r);
}
__device__ __forceinline__ void frags_tr8(bf16x8 (&b)[8], unsigned tile_addr, int k0, int lane) {
    const int g = lane >> 4, q = (lane & 15) >> 2, p = lane & 3;
    const unsigned addr = tile_addr + (unsigned)((k0 + 8 * g + q) * TS + (4 * p) * 2);
    u32x2 r0, r1, r2, r3, r4, r5, r6, r7, r8, r9, r10, r11, r12, r13, r14, r15;
    asm volatile(
        "ds_read_b64_tr_b16 %0, %16\n\t"
        "ds_read_b64_tr_b16 %1, %16 offset:1088\n\t"
        "ds_read_b64_tr_b16 %2, %16 offset:32\n\t"
        "ds_read_b64_tr_b16 %3, %16 offset:1120\n\t"
        "ds_read_b64_tr_b16 %4, %16 offset:64\n\t"
        "ds_read_b64_tr_b16 %5, %16 offset:1152\n\t"
        "ds_read_b64_tr_b16 %6, %16 offset:96\n\t"
        "ds_read_b64_tr_b16 %7, %16 offset:1184\n\t"
        "ds_read_b64_tr_b16 %8, %16 offset:128\n\t"
        "ds_read_b64_tr_b16 %9, %16 offset:1216\n\t"
        "ds_read_b64_tr_b16 %10, %16 offset:160\n\t"
        "ds_read_b64_tr_b16 %11, %16 offset:1248\n\t"
        "ds_read_b64_tr_b16 %12, %16 offset:192\n\t"
        "ds_read_b64_tr_b16 %13, %16 offset:1280\n\t"
        "ds_read_b64_tr_b16 %14, %16 offset:224\n\t"
        "ds_read_b64_tr_b16 %15, %16 offset:1312\n\t"
        "s_waitcnt lgkmcnt(0)"
        : "=&v"(r0), "=&v"(r1), "=&v"(r2), "=&v"(r3), "=&v"(r4), "=&v"(r5), "=&v"(r6), "=&v"(r7),
          "=&v"(r8), "=&v"(r9), "=&v"(r10), "=&v"(r11), "=&v"(r12), "=&v"(r13), "=&v"(r14), "=&v"(r15)
        : "v"(addr) : "memory");
    u32x4 w;
    w.x = r0.x; w.y = r0.y; w.z = r1.x; w.w = r1.y; b[0] = __builtin_bit_cast(bf16x8, w);
    w.x = r2.x; w.y = r2.y; w.z = r3.x; w.w = r3.y; b[1] = __builtin_bit_cast(bf16x8, w);
    w.x = r4.x; w.y = r4.y; w.z = r5.x; w.w = r5.y; b[2] = __builtin_bit_cast(bf16x8, w);
    w.x = r6.x; w.y = r6.y; w.z = r7.x; w.w = r7.y; b[3] = __builtin_bit_cast(bf16x8, w);
    w.x = r8.x; w.y = r8.y; w.z = r9.x; w.w = r9.y; b[4] = __builtin_bit_cast(bf16x8, w);
    w.x = r10.x; w.y = r10.y; w.z = r11.x; w.w = r11.y; b[5] = __builtin_bit_cast(bf16x8, w);
    w.x = r12.x; w.y = r12.y; w.z = r13.x; w.w = r13.y; b[6] = __builtin_bit_cast(bf16x8, w);
    w.x = r14.x; w.y = r14.y; w.z = r15.x; w.w = r15.y; b[7] = __builtin_bit_cast(bf16x8, w);
}
template <bool ATR, bool BTR>
__device__ __forceinline__ void mma128(f32x4 (&acc)[8], const LAS unsigned char* lds, unsigned lds_addr, int offA, int offB, int m0, int lane) {
    const int fr = lane & 15, fq = lane >> 4;
#pragma unroll
    for (int ks = 0; ks < 4; ++ks) {
        bf16x8 af, bfr[8];
        if (ATR) af = frag_tr(lds_addr + offA, 32 * ks, m0, lane); else af = frag_nat(lds + offA, m0, 32 * ks, fr, fq);
        if (BTR) frags_tr8(bfr, lds_addr + offB, 32 * ks, lane);
        else {
#pragma unroll
            for (int n = 0; n < 8; ++n) bfr[n] = frag_nat(lds + offB, 16 * n, 32 * ks, fr, fq);
        }
#pragma unroll
        for (int n = 0; n < 8; ++n) acc[n] = __builtin_amdgcn_mfma_f32_16x16x32_bf16(bfr[n], af, acc[n], 0, 0, 0);
    }
}
__device__ __forceinline__ void tile_load(LAS unsigned char* dst, const bf16_t* src, int ld, int tid) {
    u32x4 v[4];
#pragma unroll
    for (int i = 0; i < 4; ++i) { const int q = tid + 512 * i, row = q >> 4, pc = q & 15; v[i] = *(const u32x4*)(src + (size_t)row * ld + pc * 8); }
#pragma unroll
    for (int i = 0; i < 4; ++i) { const int q = tid + 512 * i, row = q >> 4, pc = q & 15; *(LAS u32x4*)(dst + row * TS + pc * 16) = v[i]; }
}
__device__ __forceinline__ void tile_load_zeta(LAS unsigned char* dst, const bf16_t* src, int ld, int tid, float l2g) {
    u32x4 v[4];
#pragma unroll
    for (int i = 0; i < 4; ++i) { const int q = tid + 512 * i, row = q >> 4, pc = q & 15; v[i] = *(const u32x4*)(src + (size_t)row * ld + pc * 8); }
#pragma unroll
    for (int i = 0; i < 4; ++i) {
        const int q = tid + 512 * i, row = q >> 4, pc = q & 15; const float z = exp2f((float)(127 - row) * l2g);
        u32x4 w;
        w.x = cvt_pk_bf16(bf_lo(v[i].x) * z, bf_hi(v[i].x) * z); w.y = cvt_pk_bf16(bf_lo(v[i].y) * z, bf_hi(v[i].y) * z);
        w.z = cvt_pk_bf16(bf_lo(v[i].z) * z, bf_hi(v[i].z) * z); w.w = cvt_pk_bf16(bf_lo(v[i].w) * z, bf_hi(v[i].w) * z);
        *(LAS u32x4*)(dst + row * TS + pc * 16) = w;
    }
}
__device__ __forceinline__ float ret_log2_gamma(int h) { const float g = 1.0f - exp2f(-5.0f - (4.0f / 3.0f) * (float)h); return log2f(g); }

__device__ __forceinline__ int dest_row(int mode, int n) {
    if (mode == 1) { if (n < 1024) { const int sect = n >> 9, w = n & 511, h = w >> 7, j = w & 127; return (sect << 9) + (h << 7) + ((j & 63) << 1) + (j >> 6); } return n; }
    if (mode == 2) { const int bj = n >> 9, rem = n & 511, pn = rem >> 7, j = rem & 127; return (pn << 8) + (bj << 7) + j; }
    return n;
}
__device__ __forceinline__ void p0_transpose_item(const float* W, int K, int N, bf16_t* WT, const float* gain, int mode, LAS float* scr, int item, int lane) {
    const int nblk = N / 32, kb = item / nblk, nb = item % nblk, k0 = 64 * kb, n0 = 32 * nb;
    const float cs = (mode == 1 && n0 >= 512 && n0 < 1024) ? 0.08838834764831845f : 1.0f;
#pragma unroll 8
    for (int i = 0; i < 32; ++i) { const int kk = 2 * i + (lane >> 5); const float g = gain ? gain[k0 + kk] * cs : cs; scr[kk * 33 + (lane & 31)] = W[(size_t)(k0 + kk) * N + n0 + (lane & 31)] * g; }
    LDS_WAIT();
    const int c = lane & 7;
#pragma unroll
    for (int j = 0; j < 4; ++j) { const int n = (lane >> 3) + 8 * j; const LAS float* s = scr + (8 * c) * 33 + n;
        u32x4 o; o.x = cvt_pk_bf16(s[0 * 33], s[1 * 33]); o.y = cvt_pk_bf16(s[2 * 33], s[3 * 33]); o.z = cvt_pk_bf16(s[4 * 33], s[5 * 33]); o.w = cvt_pk_bf16(s[6 * 33], s[7 * 33]);
        *(u32x4*)(WT + (size_t)dest_row(mode, n0 + n) * K + k0 + 8 * c) = o; }
    LDS_WAIT();
}
__device__ __forceinline__ void s5_pow(float lre, float lim, float dt, float j, float& pr, float& pi) {
    const float mag = expf(j * (dt * lre)); float s, c; sincosf(j * (dt * lim), &s, &c); pr = mag * c; pi = mag * s;
}
__device__ __forceinline__ void s5_coef(float lre, float lim, float dt, float& cr, float& ci) {
    float br, bi; s5_pow(lre, lim, dt, 1.0f, br, bi); br -= 1.0f;
    const float den = lre * lre + lim * lim; cr = (br * lre + bi * lim) / den; ci = (bi * lre - br * lim) / den;
}

#define XB_TMO      128
#define XB_XCNT(j)  (256  + 64 * (j))
#define XB_XSUB(j)  (1280 + 64 * (j))
#define XB_XGEN(j)  (2304 + 64 * (j))
#define XB_TOP      3328
#define XB_TOPGEN   3392
#define XCD_BAR_WORDS 3456
#define XB_SPIN_CAP (1u << 18)
__device__ __forceinline__ unsigned xb_ld(unsigned* p)              { return __hip_atomic_load(p, __ATOMIC_RELAXED, __HIP_MEMORY_SCOPE_AGENT); }
__device__ __forceinline__ unsigned xb_add(unsigned* p, unsigned v) { return __hip_atomic_fetch_add(p, v, __ATOMIC_RELAXED, __HIP_MEMORY_SCOPE_AGENT); }
__device__ __forceinline__ unsigned xb_xcc_id() { return (unsigned)__builtin_amdgcn_s_getreg((3 << 11) | 20) & 0xFu; }
#define XB_SPIN(cond, bar) do { unsigned _sp = 0; while (cond) { __builtin_amdgcn_s_sleep(1); \
    if ((++_sp & 255u) == 0u) { if (xb_ld(&(bar)[XB_TMO])) break; if (_sp > XB_SPIN_CAP) { atomicAdd(&(bar)[XB_TMO], 1u); break; } } } } while (0)
struct XcdBarrier { unsigned* bar; unsigned x; volatile LAS unsigned* st; };
__device__ __forceinline__ XcdBarrier xcd_barrier_post(unsigned* bar, volatile LAS unsigned* st) {
    XcdBarrier b; b.bar = bar; b.x = xb_xcc_id(); b.st = st;
    if (threadIdx.x == 0) (void)xb_add(&bar[XB_XCNT(b.x)], 1u);
    return b;
}
__device__ __forceinline__ void xcd_barrier_complete(unsigned* bar, unsigned x, unsigned& nloc, unsigned& nx) {
    const unsigned G = gridDim.x * gridDim.y * gridDim.z;
    unsigned sum, cnt, mine, sp = 0u;
    for (;;) {
        sum = 0u; cnt = 0u; mine = 0u;
#pragma unroll
        for (unsigned j = 0; j < 16; ++j) { const unsigned c = xb_ld(&bar[XB_XCNT(j)]); sum += c; cnt += (c > 0u) ? 1u : 0u; mine = (j == x) ? c : mine; }
        if (sum == G) break;
        __builtin_amdgcn_s_sleep(1);
        if ((++sp & 255u) == 0u) { if (xb_ld(&bar[XB_TMO])) break; if (sp > XB_SPIN_CAP) { atomicAdd(&bar[XB_TMO], 1u); break; } }
    }
    nloc = mine > 0u ? mine : 1u; nx = cnt > 0u ? cnt : 1u;
}
__device__ __forceinline__ void xcd_barrier(const XcdBarrier& b) {
    asm volatile("s_waitcnt vmcnt(0)" ::: "memory");
    __syncthreads();
    if (threadIdx.x == 0) {
        unsigned* bar = b.bar;
        __builtin_amdgcn_s_waitcnt(0);
        unsigned nloc = b.st[0], nx = b.st[1];
        if (nloc == 0u) { xcd_barrier_complete(bar, b.x, nloc, nx); b.st[0] = nloc; b.st[1] = nx; }
        const unsigned old = xb_add(&bar[XB_XSUB(b.x)], 1u);
        const unsigned gen = old / nloc;
        if (old + 1u == (gen + 1u) * nloc) {
            __builtin_amdgcn_fence(__ATOMIC_RELEASE, "agent");
            asm volatile("s_waitcnt vmcnt(0)" ::: "memory");
            const unsigned og = xb_add(&bar[XB_TOP], 1u);
            const unsigned tg = og / nx;
            if (og + 1u == (tg + 1u) * nx) xb_add(&bar[XB_TOPGEN], 1u);
            else XB_SPIN(xb_ld(&bar[XB_TOPGEN]) == tg, bar);
            __builtin_amdgcn_fence(__ATOMIC_ACQUIRE, "agent");
            xb_add(&bar[XB_XGEN(b.x)], 1u);
            asm volatile("s_waitcnt vmcnt(0)" ::: "memory");
        } else {
            XB_SPIN(xb_ld(&bar[XB_XGEN(b.x)]) == gen, bar);
            __builtin_amdgcn_fence(__ATOMIC_ACQUIRE, "agent");
            asm volatile("s_waitcnt vmcnt(0)" ::: "memory");
        }
    }
    __syncthreads();
}

struct Args { const float* in[19]; float* out; unsigned char* ws; int ph_lo, ph_hi; };

__global__ void __launch_bounds__(512, 2) fwd_kernel(Args a) {
    extern __shared__ __attribute__((aligned(16))) unsigned char lds_raw[];
    LAS unsigned char* lds = (LAS unsigned char*)lds_raw;
    const unsigned lds_addr = (unsigned)(size_t)lds_raw;
    cg::grid_group grid = cg::this_grid();
    const int tid = threadIdx.x, lane = tid & 63, wave = __builtin_amdgcn_readfirstlane(tid >> 6);
    const int G = gridDim.x, bx = blockIdx.x;
    const int lo = a.ph_lo, hi = a.ph_hi;
    unsigned char* ws = a.ws;
#define IN(k) (lo <= (k) && (k) < hi)
#define SEAM(k) do { if (lo <= (k) && (k) + 1 < hi) xcd_barrier(xbar); } while (0)
    volatile LAS unsigned* misc = (volatile LAS unsigned*)(lds + (LDS_BYTES - 64));
    if (tid < 16) misc[tid] = 0u;
    __syncthreads();
    const XcdBarrier xbar = xcd_barrier_post((unsigned*)ws, misc);
    if (lo < 0) grid.sync();

    const float* x = a.in[0];
    const float* g_mix_pre = a.in[1]; const float* g_mix_post = a.in[2]; const float* w_in = a.in[3]; const float* gn_gain = a.in[4];
    const float* lam_re = a.in[5]; const float* lam_im = a.in[6]; const float* log_dt = a.in[7];
    const float* b_re = a.in[8]; const float* b_im = a.in[9]; const float* c_re = a.in[10]; const float* c_im = a.in[11]; const float* d_skip = a.in[12];
    const float* w_glu = a.in[13]; const float* w_out = a.in[14]; const float* g_mlp_pre = a.in[15]; const float* g_mlp_post = a.in[16];
    const float* w_ff1 = a.in[17]; const float* w_ff2 = a.in[18];
    float* out = a.out;

    bf16_t* WIN = (bf16_t*)(ws + WS_WIN); bf16_t* WGLU = (bf16_t*)(ws + WS_WGLU); bf16_t* WOUT = (bf16_t*)(ws + WS_WOUT);
    bf16_t* WFF1 = (bf16_t*)(ws + WS_WFF1); bf16_t* WFF2 = (bf16_t*)(ws + WS_WFF2);
    float* ROPE = (float*)(ws + WS_ROPE); bf16_t* TW = (bf16_t*)(ws + WS_TW); bf16_t* W1S = (bf16_t*)(ws + WS_W1S);
    float* SS = (float*)(ws + WS_SS); float* SS2 = (float*)(ws + WS_SS2); float* HINC = (float*)(ws + WS_HINC);
    bf16_t* XN = (bf16_t*)(ws + WS_XN);
    bf16_t* QB = (bf16_t*)(ws + WS_QB); bf16_t* KB = (bf16_t*)(ws + WS_KB); bf16_t* VB = (bf16_t*)(ws + WS_VB); bf16_t* GB = (bf16_t*)(ws + WS_GB);
    bf16_t* AU = (bf16_t*)(ws + WS_AU); float* SST = (float*)(ws + WS_SST); bf16_t* RTB = (bf16_t*)(ws + WS_RTB);
    bf16_t* YSSM = (bf16_t*)(ws + WS_YSSM); bf16_t* YMIX = (bf16_t*)(ws + WS_YMIX);
    bf16_t* MIXB = (bf16_t*)(ws + WS_MIXB); bf16_t* HID = (bf16_t*)(ws + WS_HID); bf16_t* MB = (bf16_t*)(ws + WS_MB);

    if (IN(0)) for (int rep = 0; rep < REPS(0); ++rep) {
        const int gw = bx * 8 + wave, NGW = G * 8;
        {
            LAS float* scr = (LAS float*)(lds + wave * 16384);
            constexpr int I_IN = (DM / 64) * (NIN / 32), I_GLU = (512 / 64) * (1024 / 32), I_OUT = (DM / 64) * (DM / 32), I_F1 = (DM / 64) * (DFF / 32), I_F2 = (DFF / 64) * (DM / 32);
            constexpr int NITEMS = I_IN + I_GLU + I_OUT + I_F1 + I_F2;
            for (int it = gw; it < NITEMS; it += NGW) {
                int r = it;
                if (r < I_IN) { p0_transpose_item(w_in, DM, NIN, WIN, g_mix_pre, 1, scr, r, lane); continue; } r -= I_IN;
                if (r < I_GLU) { p0_transpose_item(w_glu, 512, 1024, WGLU, nullptr, 2, scr, r, lane); continue; } r -= I_GLU;
                if (r < I_OUT) { p0_transpose_item(w_out, DM, DM, WOUT, nullptr, 0, scr, r, lane); continue; } r -= I_OUT;
                if (r < I_F1) { p0_transpose_item(w_ff1, DM, DFF, WFF1, g_mlp_pre, 0, scr, r, lane); continue; } r -= I_F1;
                p0_transpose_item(w_ff2, DFF, DM, WFF2, nullptr, 0, scr, r, lane);
            }
        }
        for (int m = gw; m < T; m += NGW) {
            const f32x4* xr = (const f32x4*)(x + (size_t)m * DM) + lane;
            f32x4 v[4]; float s = 0.f;
#pragma unroll
            for (int j = 0; j < 4; ++j) { v[j] = xr[64 * j]; s += (v[j][0] * v[j][0] + v[j][1] * v[j][1]) + (v[j][2] * v[j][2] + v[j][3] * v[j][3]); }
            const float rstd = 1.0f / sqrtf(wave_sum(s) * (1.0f / DM) + EPS);
            u32x2* o8 = (u32x2*)(XN + (size_t)m * DM) + lane;
#pragma unroll
            for (int j = 0; j < 4; ++j) { u32x2 w; w.x = cvt_pk_bf16(v[j][0] * rstd, v[j][1] * rstd); w.y = cvt_pk_bf16(v[j][2] * rstd, v[j][3] * rstd); o8[64 * j] = w; }
        }
        for (int i = bx * 512 + tid; i < SEQ * 64; i += G * 512) {
            const int pos = i >> 6, j = i & 63;
            const float inv = (float)pow(10000.0, -(double)j / 64.0);
            const float ang = (float)pos * inv; float s, c; sincosf(ang, &s, &c);
            *(f32x2*)(ROPE + (size_t)i * 2) = (f32x2){c, s};
        }
        for (int i = bx * 512 + tid; i < 32 * 32 * 64; i += G * 512) {
            {
                const int q = i & 63, t = (i >> 6) & 31, g = i >> 11;
                const float lre = fminf(lam_re[g * 64 + q], -1e-4f), lim = lam_im[g * 64 + q], dt = expf(log_dt[g]);
                float pr, pi; s5_pow(lre, lim, dt, (float)(t + 1), pr, pi);
#pragma unroll 4
                for (int c = 0; c < 16; ++c) {
                    const float cr = c_re[(g * 16 + c) * 64 + q], ci = c_im[(g * 16 + c) * 64 + q];
                    const float zr = cr * pr - ci * pi, zi = cr * pi + ci * pr;
                    bf16_t* row = TW + (size_t)(g * 512 + t * 16 + c) * 640 + 512;
                    row[q] = f2bf(zr); row[64 + q] = f2bf(-zi);
                }
            }
            {
                const int s = i & 31, p = (i >> 5) & 63, g = i >> 11;
                const float lre = fminf(lam_re[g * 64 + p], -1e-4f), lim = lam_im[g * 64 + p], dt = expf(log_dt[g]);
                float pr, pi, cr, ci; s5_pow(lre, lim, dt, (float)(31 - s), pr, pi); s5_coef(lre, lim, dt, cr, ci);
                const float wr_ = pr * cr - pi * ci, wi_ = pr * ci + pi * cr;
                float zr[16], zi[16];
#pragma unroll
                for (int c = 0; c < 16; ++c) { const float br = b_re[(g * 64 + p) * 16 + c], bi = b_im[(g * 64 + p) * 16 + c]; zr[c] = wr_ * br - wi_ * bi; zi[c] = wr_ * bi + wi_ * br; }
                u32x4* o0 = (u32x4*)(W1S + (size_t)(g * 128 + p) * 512 + s * 16);
                u32x4* o1 = (u32x4*)(W1S + (size_t)(g * 128 + 64 + p) * 512 + s * 16);
                u32x4 w;
                w.x = cvt_pk_bf16(zr[0], zr[1]); w.y = cvt_pk_bf16(zr[2], zr[3]); w.z = cvt_pk_bf16(zr[4], zr[5]); w.w = cvt_pk_bf16(zr[6], zr[7]); o0[0] = w;
                w.x = cvt_pk_bf16(zr[8], zr[9]); w.y = cvt_pk_bf16(zr[10], zr[11]); w.z = cvt_pk_bf16(zr[12], zr[13]); w.w = cvt_pk_bf16(zr[14], zr[15]); o0[1] = w;
                w.x = cvt_pk_bf16(zi[0], zi[1]); w.y = cvt_pk_bf16(zi[2], zi[3]); w.z = cvt_pk_bf16(zi[4], zi[5]); w.w = cvt_pk_bf16(zi[6], zi[7]); o1[0] = w;
                w.x = cvt_pk_bf16(zi[8], zi[9]); w.y = cvt_pk_bf16(zi[10], zi[11]); w.z = cvt_pk_bf16(zi[12], zi[13]); w.w = cvt_pk_bf16(zi[14], zi[15]); o1[1] = w;
            }
        }
        __syncthreads();
        {
            LAS float* cp = (LAS float*)(lds + 8 * 16384) + (tid >> 8) * 128;
            const int half = tid >> 8, t256 = tid & 255;
            for (int it = bx; it < 1024; it += G) {
                const int g = it >> 5, jj = 2 * (it & 31) + half - 31;
                if (t256 < 64 && jj >= 0 && jj <= 31) {
                    const int p = t256;
                    const float lre = fminf(lam_re[g * 64 + p], -1e-4f), lim = lam_im[g * 64 + p], dt = expf(log_dt[g]);
                    float pr, pi, cr, ci; s5_pow(lre, lim, dt, (float)jj, pr, pi); s5_coef(lre, lim, dt, cr, ci);
                    cp[p] = pr * cr - pi * ci; cp[64 + p] = pr * ci + pi * cr;
                }
                __syncthreads();
                if (jj <= 31) {
                    const int c = t256 >> 4, c2 = t256 & 15; float val = 0.f;
                    if (jj >= 0) {
                        for (int p = 0; p < 64; ++p) {
                            const float xr_ = cp[p], xi_ = cp[64 + p];
                            const float br = b_re[(g * 64 + p) * 16 + c2], bi = b_im[(g * 64 + p) * 16 + c2];
                            const float zr = xr_ * br - xi_ * bi, zi = xr_ * bi + xi_ * br;
                            val += c_re[(g * 16 + c) * 64 + p] * zr - c_im[(g * 16 + c) * 64 + p] * zi;
                        }
                    }
                    const bf16_t bv = f2bf(val);
                    const int tlo = jj >= 0 ? jj : 0, thi = jj >= 0 ? 31 : 31 + jj;
                    for (int t = tlo; t <= thi; ++t) TW[(size_t)(g * 512 + t * 16 + c) * 640 + (t - jj) * 16 + c2] = bv;
                }
                __syncthreads();
            }
        }
    }
    SEAM(0);

    if (IN(1)) for (int rep = 0; rep < REPS(1); ++rep) {
        pg8::Gemm g{XN, WIN, DM, DM, DM, 0, 0}; pg8::StaticOrder S; S.init(T, NIN, G, bx);
        pg8::EpiInProj E{QB, KB, VB, GB, AU, ROPE};
        pg8::gemm_phase(lds, g, S, E);
    }
    SEAM(1);

    if (IN(2)) for (int rep = 0; rep < REPS(2); ++rep) {
        const int fr = lane & 15, fq = lane >> 4;
        for (int it = bx; it < 256; it += G) {
            const int g = it >> 3, rt = it & 7;
            f32x4 acc[8];
#pragma unroll
            for (int n = 0; n < 8; ++n) acc[n] = (f32x4){0.f, 0.f, 0.f, 0.f};
            for (int kt = 0; kt < 4; ++kt) {
                tile_load(lds, AU + (size_t)(g * 1024 + rt * 128) * 640 + kt * 128, 640, tid);
                tile_load(lds + TILE_B, W1S + (size_t)(g * 128) * 512 + kt * 128, 512, tid);
                __syncthreads();
                mma128<false, false>(acc, lds, lds_addr, 0, TILE_B, 16 * wave, lane);
                __syncthreads();
            }
            float* o = HINC + ((size_t)(g * 1024 + rt * 128 + 16 * wave + fr)) * 128 + 4 * fq;
#pragma unroll
            for (int n = 0; n < 8; ++n) *(f32x4*)(o + 16 * n) = acc[n];
        }
        for (int it = bx; it < 1024; it += G) {
            const int n = it & 63, h = (it >> 6) & 3, b = it >> 8;
            const float l2g = ret_log2_gamma(h);
            const size_t tok0 = (size_t)b * SEQ + n * 128;
            tile_load(lds, KB + tok0 * 512 + h * 128, 512, tid);
            tile_load_zeta(lds + TILE_B, VB + tok0 * 512 + h * 128, 512, tid, l2g);
            __syncthreads();
            f32x4 acc[8];
#pragma unroll
            for (int nb = 0; nb < 8; ++nb) acc[nb] = (f32x4){0.f, 0.f, 0.f, 0.f};
            mma128<true, true>(acc, lds, lds_addr, TILE_B, 0, 16 * wave, lane);
            float* o = SST + (size_t)it * 16384 + (16 * wave + fr) * 128 + 4 * fq;
#pragma unroll
            for (int nb = 0; nb < 8; ++nb) *(f32x4*)(o + 16 * nb) = acc[nb];
            __syncthreads();
        }
    }
    SEAM(2);

    if (IN(3)) for (int rep = 0; rep < REPS(3); ++rep) {
        for (int idx = bx * 512 + tid; idx < 16 * 8192; idx += G * 512) {
            const int bh = idx >> 13, e2 = idx & 8191, h = bh & 3;
            const float gch = exp2f(128.0f * ret_log2_gamma(h));
            const float* sp = SST + (size_t)bh * 64 * 16384 + 2 * e2;
            unsigned* rp = (unsigned*)(RTB + (size_t)bh * 64 * 16384 + 2 * e2);
            float r0 = 0.f, r1 = 0.f;
            for (int n0 = 0; n0 < 64; n0 += 8) {
                f32x2 s[8];
#pragma unroll
                for (int j = 0; j < 8; ++j) s[j] = *(const f32x2*)(sp + (size_t)(n0 + j) * 16384);
#pragma unroll
                for (int j = 0; j < 8; ++j) { rp[(size_t)(n0 + j) * 8192] = cvt_pk_bf16(r0, r1); r0 = gch * r0 + s[j][0]; r1 = gch * r1 + s[j][1]; }
            }
        }
        {
            LAS float* X = (LAS float*)lds;
            for (int it = bx; it < 128; it += G) {
                const int b = it >> 5, g = it & 31, p = tid & 63, seg = tid >> 6;
                const float lre = fminf(lam_re[g * 64 + p], -1e-4f), lim = lam_im[g * 64 + p], dt = expf(log_dt[g]);
                float ar, ai, Ar, Ai; s5_pow(lre, lim, dt, 32.0f, ar, ai); s5_pow(lre, lim, dt, 1024.0f, Ar, Ai);
                const float* hp = HINC + ((size_t)(g * 1024 + b * 256 + seg * 32)) * 128 + p;
                float xr = 0.f, xi = 0.f;
                for (int i = 0; i < 32; ++i) { const float hr = hp[(size_t)i * 128], hi_ = hp[(size_t)i * 128 + 64]; const float nr = ar * xr - ai * xi + hr, ni = ar * xi + ai * xr + hi_; xr = nr; xi = ni; }
                X[(seg * 64 + p) * 2] = xr; X[(seg * 64 + p) * 2 + 1] = xi;
                __syncthreads();
                float cr = 0.f, ci = 0.f;
                for (int s = 0; s < seg; ++s) { const float tr = X[(s * 64 + p) * 2], ti = X[(s * 64 + p) * 2 + 1]; const float nr = Ar * cr - Ai * ci + tr, ni = Ar * ci + Ai * cr + ti; cr = nr; ci = ni; }
                bf16_t* op = AU + ((size_t)(g * 1024 + b * 256 + seg * 32)) * 640 + 512 + p;
                xr = cr; xi = ci;
                for (int i = 0; i < 32; ++i) {
                    op[(size_t)i * 640] = f2bf(xr); op[(size_t)i * 640 + 64] = f2bf(xi);
                    const float hr = hp[(size_t)i * 128], hi_ = hp[(size_t)i * 128 + 64]; const float nr = ar * xr - ai * xi + hr, ni = ar * xi + ai * xr + hi_; xr = nr; xi = ni;
                }
                __syncthreads();
            }
        }
    }
    SEAM(3);

    if (IN(4)) for (int rep = 0; rep < REPS(4); ++rep) {
        {
            pg8::Gemm g{AU, TW, 640, 640, 640, (size_t)1024 * 640, (size_t)512 * 640}; pg8::BatchOrder S{G, bx};
            pg8::EpiSsm E{AU, d_skip, YSSM};
            pg8::gemm_phase(lds, g, S, E);
        }
        const int fr = lane & 15, fq = lane >> 4;
        constexpr int OQ = 0, OK_ = TILE_B, OV = 2 * TILE_B, OR = 3 * TILE_B;
        for (int it = bx; it < 1024; it += G) {
            const int n = it & 63, h = (it >> 6) & 3, b = it >> 8;
            const float l2g = ret_log2_gamma(h);
            const size_t tok0 = (size_t)b * SEQ + n * 128;
            tile_load(lds + OQ, QB + tok0 * 512 + h * 128, 512, tid);
            tile_load(lds + OK_, KB + tok0 * 512 + h * 128, 512, tid);
            tile_load(lds + OV, VB + tok0 * 512 + h * 128, 512, tid);
            tile_load(lds + OR, RTB + (size_t)it * 16384, 128, tid);
            __syncthreads();
            const int i = 16 * wave + fr;
            f32x4 sc[8];
#pragma unroll
            for (int nb = 0; nb < 8; ++nb) sc[nb] = (f32x4){0.f, 0.f, 0.f, 0.f};
            mma128<false, false>(sc, lds, lds_addr, OQ, OK_, 16 * wave, lane);
            __syncthreads();
#pragma unroll
            for (int nb = 0; nb < 8; ++nb) {
                f32x4 pv;
#pragma unroll
                for (int e = 0; e < 4; ++e) { const int j = 16 * nb + 4 * fq + e; pv[e] = (i >= j) ? sc[nb][e] * exp2f((float)(i - j) * l2g) : 0.f; }
                u32x2 w; w.x = cvt_pk_bf16(pv[0], pv[1]); w.y = cvt_pk_bf16(pv[2], pv[3]);
                *(LAS u32x2*)(lds + OK_ + i * TS + (16 * nb + 4 * fq) * 2) = w;
            }
            LDS_WAIT();
            __syncthreads();
            f32x4 a1[8], a2[8];
#pragma unroll
            for (int nb = 0; nb < 8; ++nb) { a1[nb] = (f32x4){0.f, 0.f, 0.f, 0.f}; a2[nb] = (f32x4){0.f, 0.f, 0.f, 0.f}; }
            mma128<false, true>(a1, lds, lds_addr, OK_, OV, 16 * wave, lane);
            mma128<false, false>(a2, lds, lds_addr, OQ, OR, 16 * wave, lane);
            const float xi = exp2f((float)(i + 1) * l2g);
            float s1 = 0.f, s2 = 0.f;
#pragma unroll
            for (int nb = 0; nb < 8; ++nb)
#pragma unroll
                for (int e = 0; e < 4; ++e) { const float o = a1[nb][e] + xi * a2[nb][e]; a1[nb][e] = o; s1 += o; s2 += o * o; }
            s1 += __shfl_xor(s1, 16); s1 += __shfl_xor(s1, 32); s2 += __shfl_xor(s2, 16); s2 += __shfl_xor(s2, 32);
            const float mu = s1 * (1.0f / 128.0f), var = fmaxf(s2 * (1.0f / 128.0f) - mu * mu, 0.f), rs = 1.0f / sqrtf(var + EPS);
            const size_t tok = tok0 + i;
#pragma unroll
            for (int nb = 0; nb < 8; ++nb) {
                const int d = 16 * nb + 4 * fq;
                const u32x2 gw = *(const u32x2*)(GB + tok * 512 + h * 128 + d);
                const f32x4 gg = *(const f32x4*)(gn_gain + h * 128 + d);
                const float g0 = bf_lo(gw.x), g1 = bf_hi(gw.x), g2 = bf_lo(gw.y), g3 = bf_hi(gw.y);
                const float y0 = (a1[nb][0] - mu) * rs * gg[0] * (g0 / (1.0f + __expf(-g0)));
                const float y1 = (a1[nb][1] - mu) * rs * gg[1] * (g1 / (1.0f + __expf(-g1)));
                const float y2 = (a1[nb][2] - mu) * rs * gg[2] * (g2 / (1.0f + __expf(-g2)));
                const float y3 = (a1[nb][3] - mu) * rs * gg[3] * (g3 / (1.0f + __expf(-g3)));
                u32x2 w; w.x = cvt_pk_bf16(y0, y1); w.y = cvt_pk_bf16(y2, y3);
                *(u32x2*)(YMIX + tok * 1024 + h * 128 + d) = w;
            }
            __syncthreads();
        }
    }
    SEAM(4);

    if (IN(5)) for (int rep = 0; rep < REPS(5); ++rep) {
        pg8::Gemm g{YSSM, WGLU, 512, 512, 512, 0, 0}; pg8::StaticOrder S; S.init(T, 1024, G, bx);
        pg8::EpiGlu E{YMIX};
        pg8::gemm_phase(lds, g, S, E);
    }
    SEAM(5);

    if (IN(6)) for (int rep = 0; rep < REPS(6); ++rep) {
        pg8::Gemm g{YMIX, WOUT, DM, DM, DM, 0, 0}; pg8::StaticOrder S; S.init(T, DM, G, bx);
        pg8::EpiSS E{MIXB, SS};
        pg8::gemm_phase(lds, g, S, E);
    }
    SEAM(6);

    if (IN(7)) for (int rep = 0; rep < REPS(7); ++rep) {
        const int gw = bx * 8 + wave, NGW = G * 8;
        for (int m = gw; m < T; m += NGW) {
            const f32x4* sp = (const f32x4*)(SS + (size_t)m * 16);
            const f32x4 p0 = sp[0], p1 = sp[1], p2 = sp[2], p3 = sp[3];
            const float ssum = ((p0[0] + p0[1]) + (p0[2] + p0[3])) + ((p1[0] + p1[1]) + (p1[2] + p1[3])) + ((p2[0] + p2[1]) + (p2[2] + p2[3])) + ((p3[0] + p3[1]) + (p3[2] + p3[3]));
            const float rstd = 1.0f / sqrtf(ssum * (1.0f / DM) + EPS);
            const f32x4* xr = (const f32x4*)(x + (size_t)m * DM) + lane;
            const u32x2* mr = (const u32x2*)(MIXB + (size_t)m * DM) + lane;
            const f32x4* gr = (const f32x4*)g_mix_post + lane;
            f32x4* orow = (f32x4*)(out + (size_t)m * DM) + lane;
            f32x4 v[4]; float s = 0.f;
#pragma unroll
            for (int j = 0; j < 4; ++j) {
                const f32x4 xv = xr[64 * j], gv = gr[64 * j]; const u32x2 mw = mr[64 * j];
                v[j][0] = xv[0] + bf_lo(mw.x) * rstd * gv[0]; v[j][1] = xv[1] + bf_hi(mw.x) * rstd * gv[1];
                v[j][2] = xv[2] + bf_lo(mw.y) * rstd * gv[2]; v[j][3] = xv[3] + bf_hi(mw.y) * rstd * gv[3];
                s += (v[j][0] * v[j][0] + v[j][1] * v[j][1]) + (v[j][2] * v[j][2] + v[j][3] * v[j][3]);
                orow[64 * j] = v[j];
            }
            const float rstd1 = 1.0f / sqrtf(wave_sum(s) * (1.0f / DM) + EPS);
            u32x2* o8 = (u32x2*)(XN + (size_t)m * DM) + lane;
#pragma unroll
            for (int j = 0; j < 4; ++j) { u32x2 w; w.x = cvt_pk_bf16(v[j][0] * rstd1, v[j][1] * rstd1); w.y = cvt_pk_bf16(v[j][2] * rstd1, v[j][3] * rstd1); o8[64 * j] = w; }
        }
    }
    SEAM(7);

    if (IN(8)) for (int rep = 0; rep < REPS(8); ++rep) {
        pg8::Gemm g{XN, WFF1, DM, DM, DM, 0, 0}; pg8::StaticOrder S; S.init(T, DFF, G, bx);
        pg8::EpiRelu2 E{HID};
        pg8::gemm_phase(lds, g, S, E);
    }
    SEAM(8);

    if (IN(9)) for (int rep = 0; rep < REPS(9); ++rep) {
        pg8::Gemm g{HID, WFF2, DFF, DFF, DFF, 0, 0}; pg8::StaticOrder S; S.init(T, DM, G, bx);
        pg8::EpiSS E{MB, SS2};
        pg8::gemm_phase(lds, g, S, E);
    }
    SEAM(9);

    if (IN(10)) {
        const int gw = bx * 8 + wave, NGW = G * 8;
        for (int m = gw; m < T; m += NGW) {
            const f32x4* sp = (const f32x4*)(SS2 + (size_t)m * 16);
            const f32x4 p0 = sp[0], p1 = sp[1], p2 = sp[2], p3 = sp[3];
            const float ssum = ((p0[0] + p0[1]) + (p0[2] + p0[3])) + ((p1[0] + p1[1]) + (p1[2] + p1[3])) + ((p2[0] + p2[1]) + (p2[2] + p2[3])) + ((p3[0] + p3[1]) + (p3[2] + p3[3]));
            const float rstd = 1.0f / sqrtf(ssum * (1.0f / DM) + EPS);
            const u32x2* mr = (const u32x2*)(MB + (size_t)m * DM) + lane;
            const f32x4* gr = (const f32x4*)g_mlp_post + lane;
            f32x4* orow = (f32x4*)(out + (size_t)m * DM) + lane;
#pragma unroll
            for (int j = 0; j < 4; ++j) {
                f32x4 xv = orow[64 * j]; const f32x4 gv = gr[64 * j]; const u32x2 mw = mr[64 * j];
                xv[0] += bf_lo(mw.x) * rstd * gv[0]; xv[1] += bf_hi(mw.x) * rstd * gv[1];
                xv[2] += bf_lo(mw.y) * rstd * gv[2]; xv[3] += bf_hi(mw.y) * rstd * gv[3];
                orow[64 * j] = xv;
            }
        }
    }
#undef IN
#undef SEAM
}

extern "C" void kernel_launch(void* const* d_in, const int* in_sizes, int n_in, void* d_out, int out_size, void* d_ws, size_t ws_size, hipStream_t stream) {
    static int grid = 0;
    if (grid == 0) {
        int dev = 0, cus = 0, per_cu = 0;
        hipGetDevice(&dev);
        hipDeviceGetAttribute(&cus, hipDeviceAttributeMultiprocessorCount, dev);
        hipFuncSetAttribute((const void*)fwd_kernel, hipFuncAttributeMaxDynamicSharedMemorySize, LDS_BYTES);
        if (hipOccupancyMaxActiveBlocksPerMultiprocessor(&per_cu, (const void*)fwd_kernel, 512, LDS_BYTES) != hipSuccess || per_cu < 1) per_cu = 1;
        (void)hipGetLastError();
        grid = cus * per_cu;
        if (grid <= 0) grid = 256;
    }
    Args a{};
    for (int i = 0; i < 19; ++i) a.in[i] = (const float*)d_in[i];
    a.out = (float*)d_out; a.ws = (unsigned char*)d_ws;
#if N_LAUNCH_PER_PHASE
    for (int ph = 0; ph < NPHASE; ++ph) {
        a.ph_lo = ph; a.ph_hi = ph + 1;
        void* args[] = {&a};
        hipError_t e = hipLaunchCooperativeKernel((const void*)fwd_kernel, dim3(grid), dim3(512), args, LDS_BYTES, stream);
        if (e != hipSuccess) { fprintf(stderr, "cooperative launch (phase %d) failed: %s (grid %d)\n", ph, hipGetErrorString(e), grid); break; }
    }
#else
    a.ph_lo = 0; a.ph_hi = NPHASE;
    (void)hipMemsetAsync(d_ws, 0, 16384, stream);
    void* args[] = {&a};
    hipError_t e = hipLaunchCooperativeKernel((const void*)fwd_kernel, dim3(grid), dim3(512), args, LDS_BYTES, stream);
    if (e != hipSuccess) fprintf(stderr, "cooperative launch failed: %s (grid %d)\n", hipGetErrorString(e), grid);
#ifdef PROBE_EXTRA_PHASE
    {
        Args b = a; b.ph_lo = PROBE_EXTRA_PHASE; b.ph_hi = PROBE_EXTRA_PHASE + 1;
        void* args2[] = {&b};
        (void)hipLaunchCooperativeKernel((const void*)fwd_kernel, dim3(grid), dim3(512), args2, LDS_BYTES, stream);
    }
#endif
#endif
}
```

```cpp
#include <hip/hip_runtime.h>
#include <hip/hip_cooperative_groups.h>
#include <cstdio>
namespace cg = cooperative_groups;

#ifndef N_LAUNCH_PER_PHASE
#define N_LAUNCH_PER_PHASE 0
#endif

#ifndef PROBE_P4_PART
#define PROBE_P4_PART 0
#endif
#ifndef PROBE_DUP
#define PROBE_DUP 0
#endif
#define REPS(k) (1 + ((PROBE_DUP >> (k)) & 1))
#define LAS __attribute__((address_space(3)))
typedef unsigned short bf16_t;
typedef short bf16x8 __attribute__((ext_vector_type(8)));
typedef float f32x4 __attribute__((ext_vector_type(4)));
typedef float f32x2 __attribute__((ext_vector_type(2)));
typedef unsigned u32x4 __attribute__((ext_vector_type(4)));
typedef unsigned u32x2 __attribute__((ext_vector_type(2)));

constexpr int T = 32768, SEQ = 8192, DM = 1024, NIN = 2560, DFF = 4096;
constexpr float EPS = 1e-6f;
constexpr int NPHASE = 11;

constexpr size_t MiB = 1u << 20;
constexpr size_t WS_WIN = 1 * MiB, WS_WGLU = 6 * MiB, WS_WOUT = 7 * MiB, WS_WFF1 = 9 * MiB, WS_WFF2 = 17 * MiB;
constexpr size_t WS_ROPE = 25 * MiB, WS_TW = 29 * MiB, WS_W1S = 49 * MiB, WS_SS = 53 * MiB, WS_SS2 = 55 * MiB, WS_HINC = 57 * MiB;
constexpr size_t WS_XN = 80 * MiB;
constexpr size_t WS_QB = 144 * MiB, WS_KB = 176 * MiB, WS_VB = 208 * MiB, WS_GB = 240 * MiB, WS_AU = 272 * MiB;
constexpr size_t WS_SST = 312 * MiB, WS_RTB = 376 * MiB, WS_YSSM = 408 * MiB;
constexpr size_t WS_YMIX = 312 * MiB;
constexpr size_t WS_HID = 144 * MiB;
constexpr size_t WS_MIXB = 400 * MiB;
constexpr size_t WS_MB = 80 * MiB;

constexpr int LDS_BYTES = 147456;
constexpr int TS = 272;
constexpr int TILE_B = 128 * TS;

__device__ __forceinline__ unsigned cvt_pk_bf16(float lo, float hi) { unsigned r; asm volatile("v_cvt_pk_bf16_f32 %0, %1, %2" : "=v"(r) : "v"(lo), "v"(hi)); return r; }
__device__ __forceinline__ float bf_lo(unsigned w) { return __uint_as_float(w << 16); }
__device__ __forceinline__ float bf_hi(unsigned w) { return __uint_as_float(w & 0xffff0000u); }
__device__ __forceinline__ bf16_t f2bf(float f) { return (bf16_t)(cvt_pk_bf16(f, 0.f) & 0xffffu); }
__device__ __forceinline__ float wave_sum(float v) {
#pragma unroll
    for (int o = 1; o < 64; o <<= 1) v += __shfl_xor(v, o);
    return v;
}
#define LDS_WAIT() asm volatile("s_waitcnt lgkmcnt(0)" ::: "memory")

namespace pg8 {
constexpr int BM = 256, BK = 64, HALF = 128, HTB = HALF * BK * 2, STAGE_BYTES = 8 * HTB, NXCD = 8, WGM = 8;
__device__ __forceinline__ int lds_byte(int r, int c) { const int st = (r >> 4) * 2 + (c >> 5), rr = r & 15, cc = c & 31, ob = rr * 64 + cc * 2; return st * 1024 + (ob ^ (((ob >> 9) & 1) << 5)); }
__device__ __forceinline__ void stage_rc(int b, int& R, int& C) { const int st = b / 1024, sb = b % 1024, swz = sb ^ (((sb >> 9) & 1) << 5); R = (st >> 1) * 16 + swz / 64; C = (st & 1) * 32 + (swz % 64) / 2; }
__device__ __forceinline__ int perm32(int rho) { const int n = rho >> 4, i = rho & 15; return 8 * (i >> 2) + 4 * n + (i & 3); }

struct Unit { int pm, pn, pb; };
struct Gemm { const bf16_t* A; const bf16_t* Bt; int lda, ldb, K; size_t bsA, bsB; };

struct StaticOrder {
    int nM, nN, nwg, G, c;
    __device__ void init(int M, int N, int G_, int c_) { nM = M / BM; nN = N / BM; nwg = nM * nN; G = G_; c = c_; }
    __device__ bool next(int i, Unit& u) const {
        const long L = (long)i * G + c; if (L >= nwg) return false;
        int wgid = (int)L; { const int q = nwg / NXCD, r = nwg % NXCD, xcd = wgid % NXCD, off = wgid / NXCD; wgid = (xcd < r ? xcd * (q + 1) : r * (q + 1) + (xcd - r) * q) + off; }
        const int nig = WGM * nN, gid = wgid / nig, fm = gid * WGM, gsz = (nM - fm) < WGM ? (nM - fm) : WGM;
        u.pm = fm + ((wgid % nig) % gsz); u.pn = (wgid % nig) / gsz; u.pb = 0; return true;
    }
};
struct BatchOrder {
    int G, c;
    __device__ bool next(int i, Unit& u) const {
        const int L = i * G + c; if (L >= 256) return false;
        const int xcd = L & 7, slot = L >> 3;
        u.pb = xcd * 4 + (slot >> 3); const int r = slot & 7; u.pm = r & 3; u.pn = r >> 2; return true;
    }
};

template <class Epi, class Sched>
__device__ __forceinline__ void gemm_phase(LAS unsigned char* lds, const Gemm g, const Sched& S, const Epi& E) {
    const int tid = threadIdx.x, wid = __builtin_amdgcn_readfirstlane(tid >> 6), lane = tid & 63, wr = wid >> 2, wc = wid & 3, fr = lane & 15, fq = lane >> 4;
    const int K = g.K, nt = K / BK;
    unsigned voffA[2], voffB[2];
#pragma unroll
    for (int i = 0; i < 2; ++i) { int R, C; stage_rc(tid * 16 + i * 8192, R, C); const int Rb = Epi::PERM ? ((R & ~31) + perm32(R & 31)) : R;
        voffA[i] = (unsigned)(R * g.lda + C) * 2u; voffB[i] = (unsigned)(Rb * g.ldb + C) * 2u; }
    const size_t kstep = (size_t)(BK * 2);
    const size_t hstepA = (size_t)HALF * g.lda * 2, hstepB = (size_t)HALF * g.ldb * 2;
    const size_t tstepA = 2 * hstepA, tstepB = 2 * hstepB;
    const unsigned ldsw = (unsigned)wid * 1024u;
    const int aoff = lds_byte(wr * 64 + fr, fq * 8), boff = lds_byte(wc * 32 + fr, fq * 8);
#define PG8_SA(b, h) (((b) * 2 + (h)) * HTB)
#define PG8_SB(b, h) ((4 + (b) * 2 + (h)) * HTB)
#define PG8_STAGE(bufoff, gbase, voff) do { _Pragma("unroll") for (int _i = 0; _i < 2; ++_i) \
        __builtin_amdgcn_global_load_lds((const unsigned*)((const char*)(gbase) + (voff)[_i]), (LAS unsigned*)(lds + (bufoff) + ldsw + _i * 8192), 16, 0, 0); } while (0)
#define PG8_LDA(dst, b, h) do { _Pragma("unroll") for (int m = 0; m < 4; ++m) _Pragma("unroll") for (int k = 0; k < 2; ++k) dst[m][k] = *(const LAS bf16x8*)(lds + PG8_SA(b, h) + aoff + m * 2048 + k * 1024); } while (0)
#define PG8_LDB(dst, b, h) do { _Pragma("unroll") for (int n = 0; n < 2; ++n) _Pragma("unroll") for (int k = 0; k < 2; ++k) dst[n][k] = *(const LAS bf16x8*)(lds + PG8_SB(b, h) + boff + n * 2048 + k * 1024); } while (0)
#define PG8_MMA(ai, bj, At, Bt) do { __builtin_amdgcn_s_setprio(1); _Pragma("unroll") for (int m = 0; m < 4; ++m) _Pragma("unroll") for (int n = 0; n < 2; ++n) _Pragma("unroll") for (int k = 0; k < 2; ++k) \
        acc[ai][bj][m][n] = __builtin_amdgcn_mfma_f32_16x16x32_bf16(Bt[n][k], At[m][k], acc[ai][bj][m][n], 0, 0, 0); __builtin_amdgcn_s_setprio(0); } while (0)
#define PG8_WAIT_V(n) asm volatile("s_waitcnt vmcnt(" #n ")" ::: "memory")
#define PG8_WAIT_L(n) asm volatile("s_waitcnt lgkmcnt(" #n ")" ::: "memory")
#define PG8_BAR __builtin_amdgcn_s_barrier()
#define PG8_SCHED __builtin_amdgcn_sched_barrier(0)
    Unit cur, nxt; int ui = 0;
    if (!S.next(0, cur)) return;
    f32x4 acc[2][2][4][2];
#pragma unroll
    for (int a = 0; a < 2; ++a)
#pragma unroll
        for (int b = 0; b < 2; ++b)
#pragma unroll
            for (int m = 0; m < 4; ++m)
#pragma unroll
                for (int n = 0; n < 2; ++n) acc[a][b][m][n] = (f32x4){0.f, 0.f, 0.f, 0.f};
    bf16x8 At[4][2], B0[2][2], B1[2][2];
    const char* cA = (const char*)g.A + (size_t)cur.pb * g.bsA * 2 + (size_t)cur.pm * tstepA;
    const char* cB = (const char*)g.Bt + (size_t)cur.pb * g.bsB * 2 + (size_t)cur.pn * tstepB;
    PG8_STAGE(PG8_SB(0, 0), cB, voffB); PG8_STAGE(PG8_SA(0, 0), cA, voffA); PG8_STAGE(PG8_SB(0, 1), cB + hstepB, voffB); PG8_STAGE(PG8_SA(0, 1), cA + hstepA, voffA);
    if (wr == 1) PG8_BAR;
    PG8_WAIT_V(4); PG8_BAR;
    PG8_STAGE(PG8_SB(1, 0), cB + kstep, voffB); PG8_STAGE(PG8_SA(1, 0), cA + kstep, voffA); PG8_STAGE(PG8_SB(1, 1), cB + hstepB + kstep, voffB);
    PG8_WAIT_V(6); PG8_BAR;
    for (;;) {
        const bool has_next = S.next(ui + 1, nxt);
        const char* nA = has_next ? (const char*)g.A + (size_t)nxt.pb * g.bsA * 2 + (size_t)nxt.pm * tstepA : cA;
        const char* nB = has_next ? (const char*)g.Bt + (size_t)nxt.pb * g.bsB * 2 + (size_t)nxt.pn * tstepB : cB;
        for (int t = 0; t < nt; t += 2) {
            const bool last = (t == nt - 2);
            const char* a1 = cA + (size_t)(t + 1) * kstep;
            const char* a2 = last ? nA : cA + (size_t)(t + 2) * kstep; const char* b2 = last ? nB : cB + (size_t)(t + 2) * kstep;
            const char* a3 = a2 + kstep; const char* b3 = b2 + kstep;
            PG8_LDB(B0, 0, 0); PG8_SCHED; PG8_LDA(At, 0, 0); PG8_STAGE(PG8_SA(1, 1), a1 + hstepA, voffA);
            PG8_WAIT_L(8); PG8_BAR; PG8_WAIT_L(0); PG8_MMA(0, 0, At, B0); PG8_BAR; PG8_SCHED;
            PG8_LDB(B1, 0, 1); PG8_STAGE(PG8_SB(0, 0), b2, voffB);
            PG8_BAR; PG8_WAIT_L(0); PG8_MMA(0, 1, At, B1); PG8_BAR;
            PG8_LDA(At, 0, 1); PG8_STAGE(PG8_SA(0, 0), a2, voffA);
            PG8_BAR; PG8_WAIT_L(0); PG8_MMA(1, 0, At, B0); PG8_BAR; PG8_SCHED;
            PG8_STAGE(PG8_SB(0, 1), b2 + hstepB, voffB);
            PG8_WAIT_V(6); PG8_BAR; PG8_MMA(1, 1, At, B1); PG8_BAR;
            PG8_LDB(B0, 1, 0); PG8_SCHED; PG8_LDA(At, 1, 0); PG8_STAGE(PG8_SA(0, 1), a2 + hstepA, voffA);
            PG8_WAIT_L(8); PG8_BAR; PG8_WAIT_L(0); PG8_MMA(0, 0, At, B0); PG8_BAR; PG8_SCHED;
            PG8_LDB(B1, 1, 1); PG8_STAGE(PG8_SB(1, 0), b3, voffB);
            PG8_BAR; PG8_WAIT_L(0); PG8_MMA(0, 1, At, B1); PG8_BAR;
            PG8_LDA(At, 1, 1); PG8_STAGE(PG8_SA(1, 0), a3, voffA);
            PG8_BAR; PG8_WAIT_L(0); PG8_MMA(1, 0, At, B0); PG8_BAR; PG8_SCHED;
            PG8_STAGE(PG8_SB(1, 1), b3 + hstepB, voffB);
            PG8_WAIT_V(6); PG8_BAR; PG8_MMA(1, 1, At, B1); PG8_BAR;
        }
        E(acc, cur, wr, wc, fr, fq);
        if (!has_next) break;
#pragma unroll
        for (int a = 0; a < 2; ++a)
#pragma unroll
            for (int b = 0; b < 2; ++b)
#pragma unroll
                for (int m = 0; m < 4; ++m)
#pragma unroll
                    for (int n = 0; n < 2; ++n) acc[a][b][m][n] = (f32x4){0.f, 0.f, 0.f, 0.f};
        cur = nxt; cA = nA; cB = nB; ++ui;
    }
    PG8_WAIT_V(0);
    if (wr == 0) PG8_BAR;
    PG8_BAR;
#undef PG8_SA
#undef PG8_SB
#undef PG8_STAGE
#undef PG8_LDA
#undef PG8_LDB
#undef PG8_MMA
#undef PG8_WAIT_V
#undef PG8_WAIT_L
#undef PG8_BAR
#undef PG8_SCHED
}

__device__ __forceinline__ u32x4 pack8(const f32x4 v0, const f32x4 v1) {
    u32x4 w; w.x = cvt_pk_bf16(v0[0], v0[1]); w.y = cvt_pk_bf16(v0[2], v0[3]); w.z = cvt_pk_bf16(v1[0], v1[1]); w.w = cvt_pk_bf16(v1[2], v1[3]); return w;
}
__device__ __forceinline__ f32x4 rope4(const f32x4 v, const f32x4 cs) {
    f32x4 r; r[0] = v[0] * cs[0] - v[1] * cs[1]; r[1] = v[0] * cs[1] + v[1] * cs[0]; r[2] = v[2] * cs[2] - v[3] * cs[3]; r[3] = v[2] * cs[3] + v[3] * cs[2]; return r;
}
struct EpiInProj {
    static constexpr bool PERM = true;
    bf16_t *Q, *Kb, *V, *Gt, *AU; const float* rope;
    __device__ __forceinline__ void operator()(const f32x4 (&acc)[2][2][4][2], const Unit& u, int wr, int wc, int fr, int fq) const {
        const int sect = u.pn >> 1;
        const int row0 = u.pm * BM + wr * 64 + fr;
        const int colt = (u.pn & 1) * 256 + wc * 32 + 8 * fq;
        if (sect <= 1) {
            bf16_t* O = sect ? Kb : Q;
#pragma unroll
            for (int ai = 0; ai < 2; ++ai)
#pragma unroll
                for (int m = 0; m < 4; ++m) {
                    const int row = row0 + ai * HALF + m * 16, pos = row & (SEQ - 1);
                    const float* rp = rope + ((size_t)pos * 64 + 16 * wc + 4 * fq) * 2;
                    const f32x4 cs0 = *(const f32x4*)rp, cs1 = *(const f32x4*)(rp + 4);
#pragma unroll
                    for (int bj = 0; bj < 2; ++bj) {
                        const f32x4 v0 = rope4(acc[ai][bj][m][0], cs0), v1 = rope4(acc[ai][bj][m][1], cs1);
                        *(u32x4*)(O + (size_t)row * 512 + colt + bj * HALF) = pack8(v0, v1);
                    }
                }
        } else if (sect <= 3) {
            bf16_t* O = (sect == 2) ? V : Gt;
#pragma unroll
            for (int ai = 0; ai < 2; ++ai)
#pragma unroll
                for (int m = 0; m < 4; ++m) {
                    const int row = row0 + ai * HALF + m * 16;
#pragma unroll
                    for (int bj = 0; bj < 2; ++bj) *(u32x4*)(O + (size_t)row * 512 + colt + bj * HALF) = pack8(acc[ai][bj][m][0], acc[ai][bj][m][1]);
                }
        } else {
#pragma unroll
            for (int ai = 0; ai < 2; ++ai)
#pragma unroll
                for (int m = 0; m < 4; ++m) {
                    const int row = row0 + ai * HALF + m * 16, cr = row >> 5, s = row & 31;
#pragma unroll
                    for (int bj = 0; bj < 2; ++bj) {
                        const int cu = colt + bj * HALF, g = cu >> 4, c0 = cu & 15;
                        *(u32x4*)(AU + ((size_t)(g * 1024 + cr) * 640 + s * 16 + c0)) = pack8(acc[ai][bj][m][0], acc[ai][bj][m][1]);
                    }
                }
        }
    }
};
struct EpiGlu {
    static constexpr bool PERM = true;
    bf16_t* Y;
    __device__ __forceinline__ void operator()(const f32x4 (&acc)[2][2][4][2], const Unit& u, int wr, int wc, int fr, int fq) const {
        const int row0 = u.pm * BM + wr * 64 + fr, col = 512 + u.pn * 128 + wc * 32 + 8 * fq;
#pragma unroll
        for (int ai = 0; ai < 2; ++ai)
#pragma unroll
            for (int m = 0; m < 4; ++m) {
                const int row = row0 + ai * HALF + m * 16;
                f32x4 y0, y1;
#pragma unroll
                for (int j = 0; j < 4; ++j) {
                    y0[j] = acc[ai][0][m][0][j] / (1.0f + __expf(-acc[ai][1][m][0][j]));
                    y1[j] = acc[ai][0][m][1][j] / (1.0f + __expf(-acc[ai][1][m][1][j]));
                }
                *(u32x4*)(Y + (size_t)row * 1024 + col) = pack8(y0, y1);
            }
    }
};
struct EpiSS {
    static constexpr bool PERM = true;
    bf16_t* O; float* SS;
    __device__ __forceinline__ void operator()(const f32x4 (&acc)[2][2][4][2], const Unit& u, int wr, int wc, int fr, int fq) const {
        const int row0 = u.pm * BM + wr * 64 + fr, col = u.pn * BM + wc * 32 + 8 * fq;
#pragma unroll
        for (int ai = 0; ai < 2; ++ai)
#pragma unroll
            for (int m = 0; m < 4; ++m) {
                const int row = row0 + ai * HALF + m * 16; float q = 0.f;
#pragma unroll
                for (int bj = 0; bj < 2; ++bj) {
                    const f32x4 v0 = acc[ai][bj][m][0], v1 = acc[ai][bj][m][1];
                    q += (v0[0] * v0[0] + v0[1] * v0[1]) + (v0[2] * v0[2] + v0[3] * v0[3]) + (v1[0] * v1[0] + v1[1] * v1[1]) + (v1[2] * v1[2] + v1[3] * v1[3]);
                    *(u32x4*)(O + (size_t)row * 1024 + col + bj * HALF) = pack8(v0, v1);
                }
                q += __shfl_xor(q, 16); q += __shfl_xor(q, 32);
                if (fq == 0) SS[(size_t)row * 16 + u.pn * 4 + wc] = q;
            }
    }
};
struct EpiRelu2 {
    static constexpr bool PERM = true;
    bf16_t* O;
    __device__ __forceinline__ void operator()(const f32x4 (&acc)[2][2][4][2], const Unit& u, int wr, int wc, int fr, int fq) const {
        const int row0 = u.pm * BM + wr * 64 + fr, col = u.pn * BM + wc * 32 + 8 * fq;
#pragma unroll
        for (int ai = 0; ai < 2; ++ai)
#pragma unroll
            for (int m = 0; m < 4; ++m) {
                const int row = row0 + ai * HALF + m * 16;
#pragma unroll
                for (int bj = 0; bj < 2; ++bj) {
                    f32x4 v0 = acc[ai][bj][m][0], v1 = acc[ai][bj][m][1];
#pragma unroll
                    for (int j = 0; j < 4; ++j) { const float a = fmaxf(v0[j], 0.f), b = fmaxf(v1[j], 0.f); v0[j] = a * a; v1[j] = b * b; }
                    *(u32x4*)(O + (size_t)row * DFF + col + bj * HALF) = pack8(v0, v1);
                }
            }
    }
};
struct EpiSsm {
    static constexpr bool PERM = true;
    const bf16_t* AU; const float* dskip; bf16_t* Y;
    __device__ __forceinline__ void operator()(const f32x4 (&acc)[2][2][4][2], const Unit& u, int wr, int wc, int fr, int fq) const {
        const int g = u.pb;
        const int row0 = u.pm * BM + wr * 64 + fr, colt = u.pn * BM + wc * 32 + 8 * fq;
        const int c0 = 8 * (fq & 1);
        const f32x4 d0 = *(const f32x4*)(dskip + g * 16 + c0), d1 = *(const f32x4*)(dskip + g * 16 + c0 + 4);
#pragma unroll
        for (int ai = 0; ai < 2; ++ai)
#pragma unroll
            for (int m = 0; m < 4; ++m) {
                const int cr = row0 + ai * HALF + m * 16;
#pragma unroll
                for (int bj = 0; bj < 2; ++bj) {
                    const int col = colt + bj * HALF, s = col >> 4;
                    const u32x4 uw = *(const u32x4*)(AU + ((size_t)(g * 1024 + cr) * 640 + col));
                    f32x4 v0 = acc[ai][bj][m][0], v1 = acc[ai][bj][m][1];
                    v0[0] += d0[0] * bf_lo(uw.x); v0[1] += d0[1] * bf_hi(uw.x); v0[2] += d0[2] * bf_lo(uw.y); v0[3] += d0[3] * bf_hi(uw.y);
                    v1[0] += d1[0] * bf_lo(uw.z); v1[1] += d1[1] * bf_hi(uw.z); v1[2] += d1[2] * bf_lo(uw.w); v1[3] += d1[3] * bf_hi(uw.w);
#pragma unroll
                    for (int j = 0; j < 4; ++j) {
                        const float a = v0[j], za = 1.5957691216f * (a + 0.044715f * a * a * a); v0[j] = a / (1.0f + __expf(-za));
                        const float b = v1[j], zb = 1.5957691216f * (b + 0.044715f * b * b * b); v1[j] = b / (1.0f + __expf(-zb));
                    }
                    const size_t tok = (size_t)cr * 32 + s;
                    *(u32x4*)(Y + tok * 512 + g * 16 + c0) = pack8(v0, v1);
                }
            }
    }
};
}

__device__ __forceinline__ bf16x8 frag_nat(const LAS unsigned char* tile, int idx0, int k0, int fr, int fq) {
    return *(const LAS bf16x8*)(tile + (idx0 + fr) * TS + (k0 + 8 * fq) * 2);
}
__device__ __forceinline__ bf16x8 frag_tr(unsigned tile_addr, int k0, int idx0, int lane) {
    const int g = lane >> 4, q = (lane & 15) >> 2, p = lane & 3;
    const unsigned addr = tile_addr + (unsigned)((k0 + 8 * g + q) * TS + (idx0 + 4 * p) * 2);
    u32x2 lo, hi;
    asm volatile("ds_read_b64_tr_b16 %0, %2\n\tds_read_b64_tr_b16 %1, %2 offset:1088\n\ts_waitcnt lgkmcnt(0)" : "=&v"(lo), "=&v"(hi) : "v"(addr) : "memory");
    u32x4 r; r.x = lo.x; r.y = lo.y; r.z = hi.x; r.w = hi.y;
    return __builtin_bit_cast(bf16x8, r);
}
__device__ __forceinline__ void frags_tr8(bf16x8 (&b)[8], unsigned tile_addr, int k0, int lane) {
    const int g = lane >> 4, q = (lane & 15) >> 2, p = lane & 3;
    const unsigned addr = tile_addr + (unsigned)((k0 + 8 * g + q) * TS + (4 * p) * 2);
    u32x2 r0, r1, r2, r3, r4, r5, r6, r7, r8, r9, r10, r11, r12, r13, r14, r15;
    asm volatile(
        "ds_read_b64_tr_b16 %0, %16\n\t"
        "ds_read_b64_tr_b16 %1, %16 offset:1088\n\t"
        "ds_read_b64_tr_b16 %2, %16 offset:32\n\t"
        "ds_read_b64_tr_b16 %3, %16 offset:1120\n\t"
        "ds_read_b64_tr_b16 %4, %16 offset:64\n\t"
        "ds_read_b64_tr_b16 %5, %16 offset:1152\n\t"
        "ds_read_b64_tr_b16 %6, %16 offset:96\n\t"
        "ds_read_b64_tr_b16 %7, %16 offset:1184\n\t"
        "ds_read_b64_tr_b16 %8, %16 offset:128\n\t"
        "ds_read_b64_tr_b16 %9, %16 offset:1216\n\t"
        "ds_read_b64_tr_b16 %10, %16 offset:160\n\t"
        "ds_read_b64_tr_b16 %11, %16 offset:1248\n\t"
        "ds_read_b64_tr_b16 %12, %16 offset:192\n\t"
        "ds_read_b64_tr_b16 %13, %16 offset:1280\n\t"
        "ds_read_b64_tr_b16 %14, %16 offset:224\n\t"
        "ds_read_b64_tr_b16 %15, %16 offset:1312\n\t"
        "s_waitcnt lgkmcnt(0)"
        : "=&v"(r0), "=&v"(r1), "=&v"(r2), "=&v"(r3), "=&v"(r4), "=&v"(r5), "=&v"(r6), "=&v"(r7),
          "=&v"(r8), "=&v"(r9), "=&v"(r10), "=&v"(r11), "=&v"(r12), "=&v"(r13), "=&v"(r14), "=&v"(r15)
        : "v"(addr) : "memory");
    u32x4 w;
    w.x = r0.x; w.y = r0.y; w.z = r1.x; w.w = r1.y; b[0] = __builtin_bit_cast(bf16x8, w);
    w.x = r2.x; w.y = r2.y; w.z = r3.x; w.w = r3.y; b[1] = __builtin_bit_cast(bf16x8, w);
    w.x = r4.x; w.y = r4.y; w.z = r5.x; w.w = r5.y; b[2] = __builtin_bit_cast(bf16x8, w);
    w.x = r6.x; w.y = r6.y; w.z = r7.x; w.w = r7.y; b[3] = __builtin_bit_cast(bf16x8, w);
    w.x = r8.x; w.y = r8.y; w.z = r9.x; w.w = r9.y; b[4] = __builtin_bit_cast(bf16x8, w);
    w.x = r10.x; w.y = r10.y; w.z = r11.x; w.w = r11.y; b[5] = __builtin_bit_cast(bf16x8, w);
    w.x = r12.x; w.y = r12.y; w.z = r13.x; w.w = r13.y; b[6] = __builtin_bit_cast(bf16x8, w);
    w.x = r14.x; w.y = r14.y; w.z = r15.x; w.w = r15.y; b[7] = __builtin_bit_cast(bf16x8, w);
}
template <bool ATR, bool BTR>
__device__ __forceinline__ void mma128(f32x4 (&acc)[8], const LAS unsigned char* lds, unsigned lds_addr, int offA, int offB, int m0, int lane) {
    const int fr = lane & 15, fq = lane >> 4;
#pragma unroll
    for (int ks = 0; ks < 4; ++ks) {
        bf16x8 af, bfr[8];
        if (ATR) af = frag_tr(lds_addr + offA, 32 * ks, m0, lane); else af = frag_nat(lds + offA, m0, 32 * ks, fr, fq);
        if (BTR) frags_tr8(bfr, lds_addr + offB, 32 * ks, lane);
        else {
#pragma unroll
            for (int n = 0; n < 8; ++n) bfr[n] = frag_nat(lds + offB, 16 * n, 32 * ks, fr, fq);
        }
#pragma unroll
        for (int n = 0; n < 8; ++n) acc[n] = __builtin_amdgcn_mfma_f32_16x16x32_bf16(bfr[n], af, acc[n], 0, 0, 0);
    }
}
__device__ __forceinline__ void tile_load(LAS unsigned char* dst, const bf16_t* src, int ld, int tid) {
    u32x4 v[4];
#pragma unroll
    for (int i = 0; i < 4; ++i) { const int q = tid + 512 * i, row = q >> 4, pc = q & 15; v[i] = *(const u32x4*)(src + (size_t)row * ld + pc * 8); }
#pragma unroll
    for (int i = 0; i < 4; ++i) { const int q = tid + 512 * i, row = q >> 4, pc = q & 15; *(LAS u32x4*)(dst + row * TS + pc * 16) = v[i]; }
}
__device__ __forceinline__ void tile_load_zeta(LAS unsigned char* dst, const bf16_t* src, int ld, int tid, float l2g) {
    u32x4 v[4];
#pragma unroll
    for (int i = 0; i < 4; ++i) { const int q = tid + 512 * i, row = q >> 4, pc = q & 15; v[i] = *(const u32x4*)(src + (size_t)row * ld + pc * 8); }
#pragma unroll
    for (int i = 0; i < 4; ++i) {
        const int q = tid + 512 * i, row = q >> 4, pc = q & 15; const float z = exp2f((float)(127 - row) * l2g);
        u32x4 w;
        w.x = cvt_pk_bf16(bf_lo(v[i].x) * z, bf_hi(v[i].x) * z); w.y = cvt_pk_bf16(bf_lo(v[i].y) * z, bf_hi(v[i].y) * z);
        w.z = cvt_pk_bf16(bf_lo(v[i].z) * z, bf_hi(v[i].z) * z); w.w = cvt_pk_bf16(bf_lo(v[i].w) * z, bf_hi(v[i].w) * z);
        *(LAS u32x4*)(dst + row * TS + pc * 16) = w;
    }
}
__device__ __forceinline__ void tile_issue(u32x4 (&v)[4], const bf16_t* src, int ld, int tid) {
#pragma unroll
    for (int i = 0; i < 4; ++i) { const int q = tid + 512 * i, row = q >> 4, pc = q & 15; v[i] = *(const u32x4*)(src + (size_t)row * ld + pc * 8); }
}
__device__ __forceinline__ void tile_commit(LAS unsigned char* dst, const u32x4 (&v)[4], int tid) {
#pragma unroll
    for (int i = 0; i < 4; ++i) { const int q = tid + 512 * i, row = q >> 4, pc = q & 15; *(LAS u32x4*)(dst + row * TS + pc * 16) = v[i]; }
}
__device__ __forceinline__ void tile_commit_zeta(LAS unsigned char* dst, const u32x4 (&v)[4], int tid, float l2g) {
#pragma unroll
    for (int i = 0; i < 4; ++i) {
        const int q = tid + 512 * i, row = q >> 4, pc = q & 15; const float z = exp2f((float)(127 - row) * l2g);
        u32x4 w;
        w.x = cvt_pk_bf16(bf_lo(v[i].x) * z, bf_hi(v[i].x) * z); w.y = cvt_pk_bf16(bf_lo(v[i].y) * z, bf_hi(v[i].y) * z);
        w.z = cvt_pk_bf16(bf_lo(v[i].z) * z, bf_hi(v[i].z) * z); w.w = cvt_pk_bf16(bf_lo(v[i].w) * z, bf_hi(v[i].w) * z);
        *(LAS u32x4*)(dst + row * TS + pc * 16) = w;
    }
}
__device__ __forceinline__ float ret_log2_gamma(int h) { const float g = 1.0f - exp2f(-5.0f - (4.0f / 3.0f) * (float)h); return log2f(g); }

__device__ __forceinline__ int dest_row(int mode, int n) {
    if (mode == 1) { if (n < 1024) { const int sect = n >> 9, w = n & 511, h = w >> 7, j = w & 127; return (sect << 9) + (h << 7) + ((j & 63) << 1) + (j >> 6); } return n; }
    if (mode == 2) { const int bj = n >> 9, rem = n & 511, pn = rem >> 7, j = rem & 127; return (pn << 8) + (bj << 7) + j; }
    return n;
}
__device__ __forceinline__ void p0_transpose_item(const float* W, int K, int N, bf16_t* WT, const float* gain, int mode, LAS float* scr, int item, int lane) {
    const int nblk = N / 32, kb = item / nblk, nb = item % nblk, k0 = 64 * kb, n0 = 32 * nb;
    const float cs = (mode == 1 && n0 >= 512 && n0 < 1024) ? 0.08838834764831845f : 1.0f;
#pragma unroll 8
    for (int i = 0; i < 32; ++i) { const int kk = 2 * i + (lane >> 5); const float g = gain ? gain[k0 + kk] * cs : cs; scr[kk * 33 + (lane & 31)] = W[(size_t)(k0 + kk) * N + n0 + (lane & 31)] * g; }
    LDS_WAIT();
    const int c = lane & 7;
#pragma unroll
    for (int j = 0; j < 4; ++j) { const int n = (lane >> 3) + 8 * j; const LAS float* s = scr + (8 * c) * 33 + n;
        u32x4 o; o.x = cvt_pk_bf16(s[0 * 33], s[1 * 33]); o.y = cvt_pk_bf16(s[2 * 33], s[3 * 33]); o.z = cvt_pk_bf16(s[4 * 33], s[5 * 33]); o.w = cvt_pk_bf16(s[6 * 33], s[7 * 33]);
        *(u32x4*)(WT + (size_t)dest_row(mode, n0 + n) * K + k0 + 8 * c) = o; }
    LDS_WAIT();
}
__device__ __forceinline__ void s5_pow(float lre, float lim, float dt, float j, float& pr, float& pi) {
    const float mag = expf(j * (dt * lre)); float s, c; sincosf(j * (dt * lim), &s, &c); pr = mag * c; pi = mag * s;
}
__device__ __forceinline__ void s5_coef(float lre, float lim, float dt, float& cr, float& ci) {
    float br, bi; s5_pow(lre, lim, dt, 1.0f, br, bi); br -= 1.0f;
    const float den = lre * lre + lim * lim; cr = (br * lre + bi * lim) / den; ci = (bi * lre - br * lim) / den;
}

#define XB_TMO      128
#define XB_XCNT(j)  (256  + 64 * (j))
#define XB_XSUB(j)  (1280 + 64 * (j))
#define XB_XGEN(j)  (2304 + 64 * (j))
#define XB_TOP      3328
#define XB_TOPGEN   3392
#define XCD_BAR_WORDS 3456
#define XB_SPIN_CAP (1u << 18)
__device__ __forceinline__ unsigned xb_ld(unsigned* p)              { return __hip_atomic_load(p, __ATOMIC_RELAXED, __HIP_MEMORY_SCOPE_AGENT); }
__device__ __forceinline__ unsigned xb_add(unsigned* p, unsigned v) { return __hip_atomic_fetch_add(p, v, __ATOMIC_RELAXED, __HIP_MEMORY_SCOPE_AGENT); }
__device__ __forceinline__ unsigned xb_xcc_id() { return (unsigned)__builtin_amdgcn_s_getreg((3 << 11) | 20) & 0xFu; }
#define XB_SPIN(cond, bar) do { unsigned _sp = 0; while (cond) { __builtin_amdgcn_s_sleep(1); \
    if ((++_sp & 255u) == 0u) { if (xb_ld(&(bar)[XB_TMO])) break; if (_sp > XB_SPIN_CAP) { atomicAdd(&(bar)[XB_TMO], 1u); break; } } } } while (0)
struct XcdBarrier { unsigned* bar; unsigned x; volatile LAS unsigned* st; };
__device__ __forceinline__ XcdBarrier xcd_barrier_post(unsigned* bar, volatile LAS unsigned* st) {
    XcdBarrier b; b.bar = bar; b.x = xb_xcc_id(); b.st = st;
    if (threadIdx.x == 0) (void)xb_add(&bar[XB_XCNT(b.x)], 1u);
    return b;
}
__device__ __forceinline__ void xcd_barrier_complete(unsigned* bar, unsigned x, unsigned& nloc, unsigned& nx) {
    const unsigned G = gridDim.x * gridDim.y * gridDim.z;
    unsigned sum, cnt, mine, sp = 0u;
    for (;;) {
        sum = 0u; cnt = 0u; mine = 0u;
#pragma unroll
        for (unsigned j = 0; j < 16; ++j) { const unsigned c = xb_ld(&bar[XB_XCNT(j)]); sum += c; cnt += (c > 0u) ? 1u : 0u; mine = (j == x) ? c : mine; }
        if (sum == G) break;
        __builtin_amdgcn_s_sleep(1);
        if ((++sp & 255u) == 0u) { if (xb_ld(&bar[XB_TMO])) break; if (sp > XB_SPIN_CAP) { atomicAdd(&bar[XB_TMO], 1u); break; } }
    }
    nloc = mine > 0u ? mine : 1u; nx = cnt > 0u ? cnt : 1u;
}
__device__ __forceinline__ void xcd_barrier(const XcdBarrier& b) {
    asm volatile("s_waitcnt vmcnt(0)" ::: "memory");
    __syncthreads();
    if (threadIdx.x == 0) {
        unsigned* bar = b.bar;
        __builtin_amdgcn_s_waitcnt(0);
        unsigned nloc = b.st[0], nx = b.st[1];
        if (nloc == 0u) { xcd_barrier_complete(bar, b.x, nloc, nx); b.st[0] = nloc; b.st[1] = nx; }
        const unsigned old = xb_add(&bar[XB_XSUB(b.x)], 1u);
        const unsigned gen = old / nloc;
        if (old + 1u == (gen + 1u) * nloc) {
            __builtin_amdgcn_fence(__ATOMIC_RELEASE, "agent");
            asm volatile("s_waitcnt vmcnt(0)" ::: "memory");
            const unsigned og = xb_add(&bar[XB_TOP], 1u);
            const unsigned tg = og / nx;
            if (og + 1u == (tg + 1u) * nx) xb_add(&bar[XB_TOPGEN], 1u);
            else XB_SPIN(xb_ld(&bar[XB_TOPGEN]) == tg, bar);
            __builtin_amdgcn_fence(__ATOMIC_ACQUIRE, "agent");
            xb_add(&bar[XB_XGEN(b.x)], 1u);
            asm volatile("s_waitcnt vmcnt(0)" ::: "memory");
        } else {
            XB_SPIN(xb_ld(&bar[XB_XGEN(b.x)]) == gen, bar);
            __builtin_amdgcn_fence(__ATOMIC_ACQUIRE, "agent");
            asm volatile("s_waitcnt vmcnt(0)" ::: "memory");
        }
    }
    __syncthreads();
}

struct Args { const float* in[19]; float* out; unsigned char* ws; int ph_lo, ph_hi; };

__global__ void __launch_bounds__(512, 2) fwd_kernel(Args a) {
    extern __shared__ __attribute__((aligned(16))) unsigned char lds_raw[];
    LAS unsigned char* lds = (LAS unsigned char*)lds_raw;
    const unsigned lds_addr = (unsigned)(size_t)lds_raw;
    cg::grid_group grid = cg::this_grid();
    const int tid = threadIdx.x, lane = tid & 63, wave = __builtin_amdgcn_readfirstlane(tid >> 6);
    const int G = gridDim.x, bx = blockIdx.x;
    const int lo = a.ph_lo, hi = a.ph_hi;
    unsigned char* ws = a.ws;
#define IN(k) (lo <= (k) && (k) < hi)
#define SEAM(k) do { if (lo <= (k) && (k) + 1 < hi) xcd_barrier(xbar); } while (0)
    volatile LAS unsigned* misc = (volatile LAS unsigned*)(lds + (LDS_BYTES - 64));
    if (tid < 16) misc[tid] = 0u;
    __syncthreads();
    const XcdBarrier xbar = xcd_barrier_post((unsigned*)ws, misc);
    if (lo < 0) grid.sync();

    const float* x = a.in[0];
    const float* g_mix_pre = a.in[1]; const float* g_mix_post = a.in[2]; const float* w_in = a.in[3]; const float* gn_gain = a.in[4];
    const float* lam_re = a.in[5]; const float* lam_im = a.in[6]; const float* log_dt = a.in[7];
    const float* b_re = a.in[8]; const float* b_im = a.in[9]; const float* c_re = a.in[10]; const float* c_im = a.in[11]; const float* d_skip = a.in[12];
    const float* w_glu = a.in[13]; const float* w_out = a.in[14]; const float* g_mlp_pre = a.in[15]; const float* g_mlp_post = a.in[16];
    const float* w_ff1 = a.in[17]; const float* w_ff2 = a.in[18];
    float* out = a.out;

    bf16_t* WIN = (bf16_t*)(ws + WS_WIN); bf16_t* WGLU = (bf16_t*)(ws + WS_WGLU); bf16_t* WOUT = (bf16_t*)(ws + WS_WOUT);
    bf16_t* WFF1 = (bf16_t*)(ws + WS_WFF1); bf16_t* WFF2 = (bf16_t*)(ws + WS_WFF2);
    float* ROPE = (float*)(ws + WS_ROPE); bf16_t* TW = (bf16_t*)(ws + WS_TW); bf16_t* W1S = (bf16_t*)(ws + WS_W1S);
    float* SS = (float*)(ws + WS_SS); float* SS2 = (float*)(ws + WS_SS2); float* HINC = (float*)(ws + WS_HINC);
    bf16_t* XN = (bf16_t*)(ws + WS_XN);
    bf16_t* QB = (bf16_t*)(ws + WS_QB); bf16_t* KB = (bf16_t*)(ws + WS_KB); bf16_t* VB = (bf16_t*)(ws + WS_VB); bf16_t* GB = (bf16_t*)(ws + WS_GB);
    bf16_t* AU = (bf16_t*)(ws + WS_AU); float* SST = (float*)(ws + WS_SST); bf16_t* RTB = (bf16_t*)(ws + WS_RTB);
    bf16_t* YSSM = (bf16_t*)(ws + WS_YSSM); bf16_t* YMIX = (bf16_t*)(ws + WS_YMIX);
    bf16_t* MIXB = (bf16_t*)(ws + WS_MIXB); bf16_t* HID = (bf16_t*)(ws + WS_HID); bf16_t* MB = (bf16_t*)(ws + WS_MB);

    if (IN(0)) for (int rep = 0; rep < REPS(0); ++rep) {
        const int gw = bx * 8 + wave, NGW = G * 8;
        {
            LAS float* scr = (LAS float*)(lds + wave * 16384);
            constexpr int I_IN = (DM / 64) * (NIN / 32), I_GLU = (512 / 64) * (1024 / 32), I_OUT = (DM / 64) * (DM / 32), I_F1 = (DM / 64) * (DFF / 32), I_F2 = (DFF / 64) * (DM / 32);
            constexpr int NITEMS = I_IN + I_GLU + I_OUT + I_F1 + I_F2;
            for (int it = gw; it < NITEMS; it += NGW) {
                int r = it;
                if (r < I_IN) { p0_transpose_item(w_in, DM, NIN, WIN, g_mix_pre, 1, scr, r, lane); continue; } r -= I_IN;
                if (r < I_GLU) { p0_transpose_item(w_glu, 512, 1024, WGLU, nullptr, 2, scr, r, lane); continue; } r -= I_GLU;
                if (r < I_OUT) { p0_transpose_item(w_out, DM, DM, WOUT, nullptr, 0, scr, r, lane); continue; } r -= I_OUT;
                if (r < I_F1) { p0_transpose_item(w_ff1, DM, DFF, WFF1, g_mlp_pre, 0, scr, r, lane); continue; } r -= I_F1;
                p0_transpose_item(w_ff2, DFF, DM, WFF2, nullptr, 0, scr, r, lane);
            }
        }
        for (int m = gw; m < T; m += NGW) {
            const f32x4* xr = (const f32x4*)(x + (size_t)m * DM) + lane;
            f32x4 v[4]; float s = 0.f;
#pragma unroll
            for (int j = 0; j < 4; ++j) { v[j] = xr[64 * j]; s += (v[j][0] * v[j][0] + v[j][1] * v[j][1]) + (v[j][2] * v[j][2] + v[j][3] * v[j][3]); }
            const float rstd = 1.0f / sqrtf(wave_sum(s) * (1.0f / DM) + EPS);
            u32x2* o8 = (u32x2*)(XN + (size_t)m * DM) + lane;
#pragma unroll
            for (int j = 0; j < 4; ++j) { u32x2 w; w.x = cvt_pk_bf16(v[j][0] * rstd, v[j][1] * rstd); w.y = cvt_pk_bf16(v[j][2] * rstd, v[j][3] * rstd); o8[64 * j] = w; }
        }
        const float rope_inv = (float)pow(10000.0, -(double)(tid & 63) / 64.0);
        for (int i = bx * 512 + tid; i < SEQ * 64; i += G * 512) {
            const int pos = i >> 6;
            const float inv = rope_inv;
            const float ang = (float)pos * inv; float s, c; sincosf(ang, &s, &c);
            *(f32x2*)(ROPE + (size_t)i * 2) = (f32x2){c, s};
        }
        for (int i = bx * 512 + tid; i < 32 * 32 * 64; i += G * 512) {
            {
                const int q = i & 63, t = (i >> 6) & 31, g = i >> 11;
                const float lre = fminf(lam_re[g * 64 + q], -1e-4f), lim = lam_im[g * 64 + q], dt = expf(log_dt[g]);
                float pr, pi; s5_pow(lre, lim, dt, (float)(t + 1), pr, pi);
#pragma unroll 4
                for (int c = 0; c < 16; ++c) {
                    const float cr = c_re[(g * 16 + c) * 64 + q], ci = c_im[(g * 16 + c) * 64 + q];
                    const float zr = cr * pr - ci * pi, zi = cr * pi + ci * pr;
                    bf16_t* row = TW + (size_t)(g * 512 + t * 16 + c) * 640 + 512;
                    row[q] = f2bf(zr); row[64 + q] = f2bf(-zi);
                }
            }
            {
                const int s = i & 31, p = (i >> 5) & 63, g = i >> 11;
                const float lre = fminf(lam_re[g * 64 + p], -1e-4f), lim = lam_im[g * 64 + p], dt = expf(log_dt[g]);
                float pr, pi, cr, ci; s5_pow(lre, lim, dt, (float)(31 - s), pr, pi); s5_coef(lre, lim, dt, cr, ci);
                const float wr_ = pr * cr - pi * ci, wi_ = pr * ci + pi * cr;
                float zr[16], zi[16];
#pragma unroll
                for (int c = 0; c < 16; ++c) { const float br = b_re[(g * 64 + p) * 16 + c], bi = b_im[(g * 64 + p) * 16 + c]; zr[c] = wr_ * br - wi_ * bi; zi[c] = wr_ * bi + wi_ * br; }
                u32x4* o0 = (u32x4*)(W1S + (size_t)(g * 128 + p) * 512 + s * 16);
                u32x4* o1 = (u32x4*)(W1S + (size_t)(g * 128 + 64 + p) * 512 + s * 16);
                u32x4 w;
                w.x = cvt_pk_bf16(zr[0], zr[1]); w.y = cvt_pk_bf16(zr[2], zr[3]); w.z = cvt_pk_bf16(zr[4], zr[5]); w.w = cvt_pk_bf16(zr[6], zr[7]); o0[0] = w;
                w.x = cvt_pk_bf16(zr[8], zr[9]); w.y = cvt_pk_bf16(zr[10], zr[11]); w.z = cvt_pk_bf16(zr[12], zr[13]); w.w = cvt_pk_bf16(zr[14], zr[15]); o0[1] = w;
                w.x = cvt_pk_bf16(zi[0], zi[1]); w.y = cvt_pk_bf16(zi[2], zi[3]); w.z = cvt_pk_bf16(zi[4], zi[5]); w.w = cvt_pk_bf16(zi[6], zi[7]); o1[0] = w;
                w.x = cvt_pk_bf16(zi[8], zi[9]); w.y = cvt_pk_bf16(zi[10], zi[11]); w.z = cvt_pk_bf16(zi[12], zi[13]); w.w = cvt_pk_bf16(zi[14], zi[15]); o1[1] = w;
            }
        }
        for (int i = bx * 512 + tid; i < 16384 * 64; i += G * 512) {
            const int piece = i & 63, row = i >> 6, t = (row >> 4) & 31;
            if (piece >= 2 * (t + 1)) *(u32x4*)(TW + (size_t)row * 640 + piece * 8) = (u32x4){0u, 0u, 0u, 0u};
        }
        __syncthreads();
        {
            LAS float* Bre = (LAS float*)lds; LAS float* Bim = Bre + 1024; LAS float* Cre = Bre + 2048; LAS float* Cim = Bre + 3072;
            LAS float* cpr = Bre + 4096; LAS float* cpi = cpr + 256;
            for (int it = bx; it < 256; it += G) {
                const int g = it >> 3, jq = it & 7;
                {
                    const int q0 = tid, q1 = tid + 512;
                    const float* s0 = (q0 < 256 ? b_re : b_im) + g * 1024 + (q0 & 255) * 4;
                    const float* s1 = (q1 < 768 ? c_re : c_im) + g * 1024 + (q1 & 255) * 4;
                    *(LAS f32x4*)(Bre + q0 * 4) = *(const f32x4*)s0;
                    *(LAS f32x4*)(Bre + q1 * 4) = *(const f32x4*)s1;
                }
                if (tid < 256) {
                    const int p = tid & 63, jl = tid >> 6;
                    const float lre = fminf(lam_re[g * 64 + p], -1e-4f), lim = lam_im[g * 64 + p], dt = expf(log_dt[g]);
                    float pr, pi, cr, ci; s5_pow(lre, lim, dt, (float)(4 * jq + jl), pr, pi); s5_coef(lre, lim, dt, cr, ci);
                    cpr[jl * 64 + p] = pr * cr - pi * ci; cpi[jl * 64 + p] = pr * ci + pi * cr;
                }
                __syncthreads();
                {
                    const int cc = tid & 255, c = cc >> 4, c2 = cc & 15, jh = tid >> 8;
                    float v0 = 0.f, v1 = 0.f;
#pragma unroll 8
                    for (int p = 0; p < 64; ++p) {
                        const float cr = Cre[c * 64 + p], ci = Cim[c * 64 + p], br = Bre[p * 16 + c2], bi = Bim[p * 16 + c2];
                        const float mr = cr * br - ci * bi, mi = cr * bi + ci * br;
                        v0 += mr * cpr[(2 * jh) * 64 + p] - mi * cpi[(2 * jh) * 64 + p];
                        v1 += mr * cpr[(2 * jh + 1) * 64 + p] - mi * cpi[(2 * jh + 1) * 64 + p];
                    }
                    const int jj0 = 4 * jq + 2 * jh;
                    const bf16_t w0 = f2bf(v0), w1 = f2bf(v1);
                    for (int t = jj0; t < 32; ++t) TW[(size_t)(g * 512 + t * 16 + c) * 640 + (t - jj0) * 16 + c2] = w0;
                    for (int t = jj0 + 1; t < 32; ++t) TW[(size_t)(g * 512 + t * 16 + c) * 640 + (t - jj0 - 1) * 16 + c2] = w1;
                }
                __syncthreads();
            }
        }
    }
    SEAM(0);

    if (IN(1)) for (int rep = 0; rep < REPS(1); ++rep) {
        pg8::Gemm g{XN, WIN, DM, DM, DM, 0, 0}; pg8::StaticOrder S; S.init(T, NIN, G, bx);
        pg8::EpiInProj E{QB, KB, VB, GB, AU, ROPE};
        pg8::gemm_phase(lds, g, S, E);
    }
    SEAM(1);

    if (IN(2)) for (int rep = 0; rep < REPS(2); ++rep) {
        const int fr = lane & 15, fq = lane >> 4;
        for (int it = bx; it < 256; it += G) {
            const int g = it >> 3, rt = it & 7;
            const bf16_t* pA = AU + (size_t)(g * 1024 + rt * 128) * 640; const bf16_t* pB = W1S + (size_t)(g * 128) * 512;
            f32x4 acc[8];
#pragma unroll
            for (int n = 0; n < 8; ++n) acc[n] = (f32x4){0.f, 0.f, 0.f, 0.f};
            u32x4 ra[4], rb[4];
            tile_issue(ra, pA, 640, tid); tile_issue(rb, pB, 512, tid);
            for (int kt = 0; kt < 4; ++kt) {
                tile_commit(lds, ra, tid); tile_commit(lds + TILE_B, rb, tid);
                __syncthreads();
                if (kt < 3) { tile_issue(ra, pA + (kt + 1) * 128, 640, tid); tile_issue(rb, pB + (kt + 1) * 128, 512, tid); }
                mma128<false, false>(acc, lds, lds_addr, 0, TILE_B, 16 * wave, lane);
                __syncthreads();
            }
            float* o = HINC + ((size_t)(g * 1024 + rt * 128 + 16 * wave + fr)) * 128 + 4 * fq;
#pragma unroll
            for (int n = 0; n < 8; ++n) *(f32x4*)(o + 16 * n) = acc[n];
        }
        {
            u32x4 rk[4], rv[4];
            int it = bx;
#define R1_ISSUE(IT) do { const int n_ = (IT) & 63, h_ = ((IT) >> 6) & 3, b_ = (IT) >> 8; const size_t t0_ = (size_t)b_ * SEQ + n_ * 128; \
                tile_issue(rk, KB + t0_ * 512 + h_ * 128, 512, tid); tile_issue(rv, VB + t0_ * 512 + h_ * 128, 512, tid); } while (0)
            if (it < 1024) R1_ISSUE(it);
            for (; it < 1024; it += G) {
                const int h = (it >> 6) & 3;
                const float l2g = ret_log2_gamma(h);
                tile_commit(lds, rk, tid); tile_commit_zeta(lds + TILE_B, rv, tid, l2g);
                __syncthreads();
                if (it + G < 1024) R1_ISSUE(it + G);
                f32x4 acc[8];
#pragma unroll
                for (int nb = 0; nb < 8; ++nb) acc[nb] = (f32x4){0.f, 0.f, 0.f, 0.f};
                mma128<true, true>(acc, lds, lds_addr, TILE_B, 0, 16 * wave, lane);
                float* o = SST + (size_t)it * 16384 + (16 * wave + fr) * 128 + 4 * fq;
#pragma unroll
                for (int nb = 0; nb < 8; ++nb) *(f32x4*)(o + 16 * nb) = acc[nb];
                __syncthreads();
            }
#undef R1_ISSUE
        }
    }
    SEAM(2);

    if (IN(3)) for (int rep = 0; rep < REPS(3); ++rep) {
        for (int idx = bx * 512 + tid; idx < 16 * 8192; idx += G * 512) {
            const int bh = idx >> 13, e2 = idx & 8191, h = bh & 3;
            const float gch = exp2f(128.0f * ret_log2_gamma(h));
            const float* sp = SST + (size_t)bh * 64 * 16384 + 2 * e2;
            unsigned* rp = (unsigned*)(RTB + (size_t)bh * 64 * 16384 + 2 * e2);
            float r0 = 0.f, r1 = 0.f;
            for (int n0 = 0; n0 < 64; n0 += 8) {
                f32x2 s[8];
#pragma unroll
                for (int j = 0; j < 8; ++j) s[j] = *(const f32x2*)(sp + (size_t)(n0 + j) * 16384);
#pragma unroll
                for (int j = 0; j < 8; ++j) { rp[(size_t)(n0 + j) * 8192] = cvt_pk_bf16(r0, r1); r0 = gch * r0 + s[j][0]; r1 = gch * r1 + s[j][1]; }
            }
        }
        {
            LAS float* X = (LAS float*)lds;
            for (int it = bx; it < 128; it += G) {
                const int b = it >> 5, g = it & 31, p = tid & 63, seg = tid >> 6;
                const float lre = fminf(lam_re[g * 64 + p], -1e-4f), lim = lam_im[g * 64 + p], dt = expf(log_dt[g]);
                float ar, ai, Ar, Ai; s5_pow(lre, lim, dt, 32.0f, ar, ai); s5_pow(lre, lim, dt, 1024.0f, Ar, Ai);
                const float* hp = HINC + ((size_t)(g * 1024 + b * 256 + seg * 32)) * 128 + p;
                float xr = 0.f, xi = 0.f;
                for (int i = 0; i < 32; ++i) { const float hr = hp[(size_t)i * 128], hi_ = hp[(size_t)i * 128 + 64]; const float nr = ar * xr - ai * xi + hr, ni = ar * xi + ai * xr + hi_; xr = nr; xi = ni; }
                X[(seg * 64 + p) * 2] = xr; X[(seg * 64 + p) * 2 + 1] = xi;
                __syncthreads();
                float cr = 0.f, ci = 0.f;
                for (int s = 0; s < seg; ++s) { const float tr = X[(s * 64 + p) * 2], ti = X[(s * 64 + p) * 2 + 1]; const float nr = Ar * cr - Ai * ci + tr, ni = Ar * ci + Ai * cr + ti; cr = nr; ci = ni; }
                bf16_t* op = AU + ((size_t)(g * 1024 + b * 256 + seg * 32)) * 640 + 512 + p;
                xr = cr; xi = ci;
                for (int i = 0; i < 32; ++i) {
                    op[(size_t)i * 640] = f2bf(xr); op[(size_t)i * 640 + 64] = f2bf(xi);
                    const float hr = hp[(size_t)i * 128], hi_ = hp[(size_t)i * 128 + 64]; const float nr = ar * xr - ai * xi + hr, ni = ar * xi + ai * xr + hi_; xr = nr; xi = ni;
                }
                __syncthreads();
            }
        }
    }
    SEAM(3);

    if (IN(4)) for (int rep = 0; rep < REPS(4); ++rep) {
        const bool solo = (hi - lo == 1);
        if (!(solo && PROBE_P4_PART == 2)) {
            pg8::Gemm g{AU, TW, 640, 640, 640, (size_t)1024 * 640, (size_t)512 * 640}; pg8::BatchOrder S{G, bx};
            pg8::EpiSsm E{AU, d_skip, YSSM};
            pg8::gemm_phase(lds, g, S, E);
        }
        const int fr = lane & 15, fq = lane >> 4;
        constexpr int OQ = 0, OK_ = TILE_B, OV = 2 * TILE_B, OR = 3 * TILE_B;
        u32x4 rq[4], rk[4], rv[4], rr[4];
        int it = bx;
#define R3_ISSUE(IT) do { const int n_ = (IT) & 63, h_ = ((IT) >> 6) & 3, b_ = (IT) >> 8; const size_t t0_ = (size_t)b_ * SEQ + n_ * 128; \
            tile_issue(rq, QB + t0_ * 512 + h_ * 128, 512, tid); tile_issue(rk, KB + t0_ * 512 + h_ * 128, 512, tid); \
            tile_issue(rv, VB + t0_ * 512 + h_ * 128, 512, tid); tile_issue(rr, RTB + (size_t)(IT) * 16384, 128, tid); } while (0)
        if (solo && PROBE_P4_PART == 1) it = 1024;
        if (it < 1024) R3_ISSUE(it);
        for (; it < 1024; it += G) {
            const int n = it & 63, h = (it >> 6) & 3, b = it >> 8;
            const float l2g = ret_log2_gamma(h);
            const size_t tok0 = (size_t)b * SEQ + n * 128;
            tile_commit(lds + OQ, rq, tid); tile_commit(lds + OK_, rk, tid); tile_commit(lds + OV, rv, tid); tile_commit(lds + OR, rr, tid);
            __syncthreads();
            if (it + G < 1024) R3_ISSUE(it + G);
            const int i = 16 * wave + fr;
            f32x4 sc[8];
#pragma unroll
            for (int nb = 0; nb < 8; ++nb) sc[nb] = (f32x4){0.f, 0.f, 0.f, 0.f};
            mma128<false, false>(sc, lds, lds_addr, OQ, OK_, 16 * wave, lane);
            __syncthreads();
#pragma unroll
            for (int nb = 0; nb < 8; ++nb) {
                f32x4 pv;
#pragma unroll
                for (int e = 0; e < 4; ++e) { const int j = 16 * nb + 4 * fq + e; pv[e] = (i >= j) ? sc[nb][e] * exp2f((float)(i - j) * l2g) : 0.f; }
                u32x2 w; w.x = cvt_pk_bf16(pv[0], pv[1]); w.y = cvt_pk_bf16(pv[2], pv[3]);
                *(LAS u32x2*)(lds + OK_ + i * TS + (16 * nb + 4 * fq) * 2) = w;
            }
            LDS_WAIT();
            __syncthreads();
            f32x4 a1[8], a2[8];
#pragma unroll
            for (int nb = 0; nb < 8; ++nb) { a1[nb] = (f32x4){0.f, 0.f, 0.f, 0.f}; a2[nb] = (f32x4){0.f, 0.f, 0.f, 0.f}; }
            mma128<false, true>(a1, lds, lds_addr, OK_, OV, 16 * wave, lane);
            mma128<false, false>(a2, lds, lds_addr, OQ, OR, 16 * wave, lane);
            const float xi = exp2f((float)(i + 1) * l2g);
            float s1 = 0.f, s2 = 0.f;
#pragma unroll
            for (int nb = 0; nb < 8; ++nb)
#pragma unroll
                for (int e = 0; e < 4; ++e) { const float o = a1[nb][e] + xi * a2[nb][e]; a1[nb][e] = o; s1 += o; s2 += o * o; }
            s1 += __shfl_xor(s1, 16); s1 += __shfl_xor(s1, 32); s2 += __shfl_xor(s2, 16); s2 += __shfl_xor(s2, 32);
            const float mu = s1 * (1.0f / 128.0f), var = fmaxf(s2 * (1.0f / 128.0f) - mu * mu, 0.f), rs = 1.0f / sqrtf(var + EPS);
            const size_t tok = tok0 + i;
#pragma unroll
            for (int nb = 0; nb < 8; ++nb) {
                const int d = 16 * nb + 4 * fq;
                const u32x2 gw = *(const u32x2*)(GB + tok * 512 + h * 128 + d);
                const f32x4 gg = *(const f32x4*)(gn_gain + h * 128 + d);
                const float g0 = bf_lo(gw.x), g1 = bf_hi(gw.x), g2 = bf_lo(gw.y), g3 = bf_hi(gw.y);
                const float y0 = (a1[nb][0] - mu) * rs * gg[0] * (g0 / (1.0f + __expf(-g0)));
                const float y1 = (a1[nb][1] - mu) * rs * gg[1] * (g1 / (1.0f + __expf(-g1)));
                const float y2 = (a1[nb][2] - mu) * rs * gg[2] * (g2 / (1.0f + __expf(-g2)));
                const float y3 = (a1[nb][3] - mu) * rs * gg[3] * (g3 / (1.0f + __expf(-g3)));
                u32x2 w; w.x = cvt_pk_bf16(y0, y1); w.y = cvt_pk_bf16(y2, y3);
                *(u32x2*)(YMIX + tok * 1024 + h * 128 + d) = w;
            }
            __syncthreads();
        }
    }
#undef R3_ISSUE
    SEAM(4);

    if (IN(5)) for (int rep = 0; rep < REPS(5); ++rep) {
        pg8::Gemm g{YSSM, WGLU, 512, 512, 512, 0, 0}; pg8::StaticOrder S; S.init(T, 1024, G, bx);
        pg8::EpiGlu E{YMIX};
        pg8::gemm_phase(lds, g, S, E);
    }
    SEAM(5);

    if (IN(6)) for (int rep = 0; rep < REPS(6); ++rep) {
        pg8::Gemm g{YMIX, WOUT, DM, DM, DM, 0, 0}; pg8::StaticOrder S; S.init(T, DM, G, bx);
        pg8::EpiSS E{MIXB, SS};
        pg8::gemm_phase(lds, g, S, E);
    }
    SEAM(6);

    if (IN(7)) for (int rep = 0; rep < REPS(7); ++rep) {
        const int gw = bx * 8 + wave, NGW = G * 8;
        for (int m = gw; m < T; m += NGW) {
            const f32x4* sp = (const f32x4*)(SS + (size_t)m * 16);
            const f32x4 p0 = sp[0], p1 = sp[1], p2 = sp[2], p3 = sp[3];
            const float ssum = ((p0[0] + p0[1]) + (p0[2] + p0[3])) + ((p1[0] + p1[1]) + (p1[2] + p1[3])) + ((p2[0] + p2[1]) + (p2[2] + p2[3])) + ((p3[0] + p3[1]) + (p3[2] + p3[3]));
            const float rstd = 1.0f / sqrtf(ssum * (1.0f / DM) + EPS);
            const f32x4* xr = (const f32x4*)(x + (size_t)m * DM) + lane;
            const u32x2* mr = (const u32x2*)(MIXB + (size_t)m * DM) + lane;
            const f32x4* gr = (const f32x4*)g_mix_post + lane;
            f32x4 v[4]; float s = 0.f;
#pragma unroll
            for (int j = 0; j < 4; ++j) {
                const f32x4 xv = xr[64 * j], gv = gr[64 * j]; const u32x2 mw = mr[64 * j];
                v[j][0] = xv[0] + bf_lo(mw.x) * rstd * gv[0]; v[j][1] = xv[1] + bf_hi(mw.x) * rstd * gv[1];
                v[j][2] = xv[2] + bf_lo(mw.y) * rstd * gv[2]; v[j][3] = xv[3] + bf_hi(mw.y) * rstd * gv[3];
                s += (v[j][0] * v[j][0] + v[j][1] * v[j][1]) + (v[j][2] * v[j][2] + v[j][3] * v[j][3]);
            }
            const float rstd1 = 1.0f / sqrtf(wave_sum(s) * (1.0f / DM) + EPS);
            u32x2* o8 = (u32x2*)(XN + (size_t)m * DM) + lane;
#pragma unroll
            for (int j = 0; j < 4; ++j) { u32x2 w; w.x = cvt_pk_bf16(v[j][0] * rstd1, v[j][1] * rstd1); w.y = cvt_pk_bf16(v[j][2] * rstd1, v[j][3] * rstd1); o8[64 * j] = w; }
        }
    }
    SEAM(7);

    if (IN(8)) for (int rep = 0; rep < REPS(8); ++rep) {
        pg8::Gemm g{XN, WFF1, DM, DM, DM, 0, 0}; pg8::StaticOrder S; S.init(T, DFF, G, bx);
        pg8::EpiRelu2 E{HID};
        pg8::gemm_phase(lds, g, S, E);
    }
    SEAM(8);

    if (IN(9)) for (int rep = 0; rep < REPS(9); ++rep) {
        pg8::Gemm g{HID, WFF2, DFF, DFF, DFF, 0, 0}; pg8::StaticOrder S; S.init(T, DM, G, bx);
        pg8::EpiSS E{MB, SS2};
        pg8::gemm_phase(lds, g, S, E);
    }
    SEAM(9);

    if (IN(10)) {
        const int gw = bx * 8 + wave, NGW = G * 8;
        for (int m = gw; m < T; m += NGW) {
            const f32x4 pa = *((const f32x4*)(SS + (size_t)m * 16) + (lane & 3)), pb = *((const f32x4*)(SS2 + (size_t)m * 16) + (lane & 3));
            float sa = (pa[0] + pa[1]) + (pa[2] + pa[3]), sb = (pb[0] + pb[1]) + (pb[2] + pb[3]);
            sa += __shfl_xor(sa, 1); sa += __shfl_xor(sa, 2); sb += __shfl_xor(sb, 1); sb += __shfl_xor(sb, 2);
            const float rstd1 = 1.0f / sqrtf(sa * (1.0f / DM) + EPS), rstd2 = 1.0f / sqrtf(sb * (1.0f / DM) + EPS);
            const f32x4* xr = (const f32x4*)(x + (size_t)m * DM) + lane;
            const u32x2* ar = (const u32x2*)(MIXB + (size_t)m * DM) + lane;
            const u32x2* mr = (const u32x2*)(MB + (size_t)m * DM) + lane;
            const f32x4* g1r = (const f32x4*)g_mix_post + lane; const f32x4* g2r = (const f32x4*)g_mlp_post + lane;
            f32x4* orow = (f32x4*)(out + (size_t)m * DM) + lane;
#pragma unroll
            for (int j = 0; j < 4; ++j) {
                f32x4 xv = xr[64 * j]; const f32x4 ga = g1r[64 * j], gb = g2r[64 * j]; const u32x2 aw = ar[64 * j], mw = mr[64 * j];
                xv[0] = (xv[0] + bf_lo(aw.x) * rstd1 * ga[0]) + bf_lo(mw.x) * rstd2 * gb[0]; xv[1] = (xv[1] + bf_hi(aw.x) * rstd1 * ga[1]) + bf_hi(mw.x) * rstd2 * gb[1];
                xv[2] = (xv[2] + bf_lo(aw.y) * rstd1 * ga[2]) + bf_lo(mw.y) * rstd2 * gb[2]; xv[3] = (xv[3] + bf_hi(aw.y) * rstd1 * ga[3]) + bf_hi(mw.y) * rstd2 * gb[3];
                orow[64 * j] = xv;
            }
        }
    }
#undef IN
#undef SEAM
}

extern "C" void kernel_launch(void* const* d_in, const int* in_sizes, int n_in, void* d_out, int out_size, void* d_ws, size_t ws_size, hipStream_t stream) {
    static int grid = 0;
    if (grid == 0) {
        int dev = 0, cus = 0, per_cu = 0;
        hipGetDevice(&dev);
        hipDeviceGetAttribute(&cus, hipDeviceAttributeMultiprocessorCount, dev);
        hipFuncSetAttribute((const void*)fwd_kernel, hipFuncAttributeMaxDynamicSharedMemorySize, LDS_BYTES);
        if (hipOccupancyMaxActiveBlocksPerMultiprocessor(&per_cu, (const void*)fwd_kernel, 512, LDS_BYTES) != hipSuccess || per_cu < 1) per_cu = 1;
        (void)hipGetLastError();
        grid = cus * per_cu;
        if (grid <= 0) grid = 256;
    }
    Args a{};
    for (int i = 0; i < 19; ++i) a.in[i] = (const float*)d_in[i];
    a.out = (float*)d_out; a.ws = (unsigned char*)d_ws;
#if N_LAUNCH_PER_PHASE
    for (int ph = 0; ph < NPHASE; ++ph) {
        a.ph_lo = ph; a.ph_hi = ph + 1;
        void* args[] = {&a};
        hipError_t e = hipLaunchCooperativeKernel((const void*)fwd_kernel, dim3(grid), dim3(512), args, LDS_BYTES, stream);
        if (e != hipSuccess) { fprintf(stderr, "cooperative launch (phase %d) failed: %s (grid %d)\n", ph, hipGetErrorString(e), grid); break; }
    }
#else
    a.ph_lo = 0; a.ph_hi = NPHASE;
    (void)hipMemsetAsync(d_ws, 0, 16384, stream);
    void* args[] = {&a};
    hipError_t e = hipLaunchCooperativeKernel((const void*)fwd_kernel, dim3(grid), dim3(512), args, LDS_BYTES, stream);
    if (e != hipSuccess) fprintf(stderr, "cooperative launch failed: %s (grid %d)\n", hipGetErrorString(e), grid);
#ifdef PROBE_EXTRA_PHASE
    {
        Args b = a; b.ph_lo = PROBE_EXTRA_PHASE; b.ph_hi = PROBE_EXTRA_PHASE + 1;
        void* args2[] = {&b};
        (void)hipLaunchCooperativeKernel((const void*)fwd_kernel, dim3(grid), dim3(512), args2, LDS_BYTES, stream);
    }
#endif
#endif
}
```

```cpp
#include <hip/hip_runtime.h>
#include <hip/hip_cooperative_groups.h>
#include <cstdio>
namespace cg = cooperative_groups;

#ifndef N_LAUNCH_PER_PHASE
#define N_LAUNCH_PER_PHASE 0
#endif

#ifndef PROBE_P4_PART
#define PROBE_P4_PART 0
#endif
#ifndef PROBE_DUP
#define PROBE_DUP 0
#endif
#define REPS(k) (1 + ((PROBE_DUP >> (k)) & 1))
#define LAS __attribute__((address_space(3)))
typedef unsigned short bf16_t;
typedef short bf16x8 __attribute__((ext_vector_type(8)));
typedef float f32x4 __attribute__((ext_vector_type(4)));
typedef float f32x2 __attribute__((ext_vector_type(2)));
typedef unsigned u32x4 __attribute__((ext_vector_type(4)));
typedef unsigned u32x2 __attribute__((ext_vector_type(2)));

constexpr int T = 32768, SEQ = 8192, DM = 1024, NIN = 2560, DFF = 4096;
constexpr float EPS = 1e-6f;
constexpr int NPHASE = 11;

constexpr size_t MiB = 1u << 20;
constexpr size_t WS_WIN = 1 * MiB, WS_WGLU = 6 * MiB, WS_WOUT = 7 * MiB, WS_WFF1 = 9 * MiB, WS_WFF2 = 17 * MiB;
constexpr size_t WS_ROPE = 25 * MiB, WS_TW = 29 * MiB, WS_W1S = 49 * MiB, WS_SS = 53 * MiB, WS_SS2 = 55 * MiB, WS_HINC = 57 * MiB;
constexpr size_t WS_XN = 80 * MiB;
constexpr size_t WS_QB = 144 * MiB, WS_KB = 176 * MiB, WS_VB = 208 * MiB, WS_GB = 240 * MiB, WS_AU = 272 * MiB;
constexpr size_t WS_SST = 440 * MiB, WS_RTB = 376 * MiB, WS_YSSM = 408 * MiB;
constexpr size_t WS_YMIX = 312 * MiB;
constexpr size_t WS_HID = 144 * MiB;
constexpr size_t WS_MIXB = 400 * MiB;
constexpr size_t WS_MB = 80 * MiB;

constexpr int LDS_BYTES = 147456;
constexpr int TS = 272;
constexpr int TILE_B = 128 * TS;

typedef __bf16 bf16x2_t __attribute__((ext_vector_type(2)));
__device__ __forceinline__ unsigned cvt_pk_bf16(float lo, float hi) { f32x2 v = {lo, hi}; return __builtin_bit_cast(unsigned, __builtin_convertvector(v, bf16x2_t)); }
__device__ __forceinline__ float bf_lo(unsigned w) { return __uint_as_float(w << 16); }
__device__ __forceinline__ float bf_hi(unsigned w) { return __uint_as_float(w & 0xffff0000u); }
__device__ __forceinline__ bf16_t f2bf(float f) { return (bf16_t)(cvt_pk_bf16(f, 0.f) & 0xffffu); }
__device__ __forceinline__ float wave_sum(float v) {
#pragma unroll
    for (int o = 1; o < 64; o <<= 1) v += __shfl_xor(v, o);
    return v;
}
#define LDS_WAIT() asm volatile("s_waitcnt lgkmcnt(0)" ::: "memory")

namespace pg8 {
constexpr int BM = 256, BK = 64, HALF = 128, HTB = HALF * BK * 2, STAGE_BYTES = 8 * HTB, NXCD = 8, WGM = 8;
__device__ __forceinline__ int lds_byte(int r, int c) { const int st = (r >> 4) * 2 + (c >> 5), rr = r & 15, cc = c & 31, ob = rr * 64 + cc * 2; return st * 1024 + (ob ^ (((ob >> 9) & 1) << 5)); }
__device__ __forceinline__ void stage_rc(int b, int& R, int& C) { const int st = b / 1024, sb = b % 1024, swz = sb ^ (((sb >> 9) & 1) << 5); R = (st >> 1) * 16 + swz / 64; C = (st & 1) * 32 + (swz % 64) / 2; }
__device__ __forceinline__ int perm32(int rho) { const int n = rho >> 4, i = rho & 15; return 8 * (i >> 2) + 4 * n + (i & 3); }

struct Unit { int pm, pn, pb; };
struct Gemm { const bf16_t* A; const bf16_t* Bt; int lda, ldb, K; size_t bsA, bsB; };

struct StaticOrder {
    int nM, nN, nwg, G, c;
    __device__ void init(int M, int N, int G_, int c_) { nM = M / BM; nN = N / BM; nwg = nM * nN; G = G_; c = c_; }
    __device__ bool next(int i, Unit& u) const {
        const long L = (long)i * G + c; if (L >= nwg) return false;
        int wgid = (int)L; { const int q = nwg / NXCD, r = nwg % NXCD, xcd = wgid % NXCD, off = wgid / NXCD; wgid = (xcd < r ? xcd * (q + 1) : r * (q + 1) + (xcd - r) * q) + off; }
        const int nig = WGM * nN, gid = wgid / nig, fm = gid * WGM, gsz = (nM - fm) < WGM ? (nM - fm) : WGM;
        u.pm = fm + ((wgid % nig) % gsz); u.pn = (wgid % nig) / gsz; u.pb = 0; return true;
    }
};
struct BatchOrder {
    int G, c;
    __device__ bool next(int i, Unit& u) const {
        const int L = i * G + c; if (L >= 256) return false;
        const int xcd = L & 7, slot = L >> 3;
        u.pb = xcd * 4 + (slot >> 3); const int r = slot & 7; u.pm = r & 3; u.pn = r >> 2; return true;
    }
};

template <class Epi, class Sched>
__device__ __forceinline__ void gemm_phase(LAS unsigned char* lds, const Gemm g, const Sched& S, const Epi& E) {
    const int tid = threadIdx.x, wid = __builtin_amdgcn_readfirstlane(tid >> 6), lane = tid & 63, wr = wid >> 2, wc = wid & 3, fr = lane & 15, fq = lane >> 4;
    const int K = g.K, nt = K / BK;
    unsigned voffA[2], voffB[2];
#pragma unroll
    for (int i = 0; i < 2; ++i) { int R, C; stage_rc(tid * 16 + i * 8192, R, C); const int Rb = Epi::PERM ? ((R & ~31) + perm32(R & 31)) : R;
        voffA[i] = (unsigned)(R * g.lda + C) * 2u; voffB[i] = (unsigned)(Rb * g.ldb + C) * 2u; }
    const size_t kstep = (size_t)(BK * 2);
    const size_t hstepA = (size_t)HALF * g.lda * 2, hstepB = (size_t)HALF * g.ldb * 2;
    const size_t tstepA = 2 * hstepA, tstepB = 2 * hstepB;
    const unsigned ldsw = (unsigned)wid * 1024u;
    const int aoff = lds_byte(wr * 64 + fr, fq * 8), boff = lds_byte(wc * 32 + fr, fq * 8);
#define PG8_SA(b, h) (((b) * 2 + (h)) * HTB)
#define PG8_SB(b, h) ((4 + (b) * 2 + (h)) * HTB)
#define PG8_STAGE(bufoff, gbase, voff) do { _Pragma("unroll") for (int _i = 0; _i < 2; ++_i) \
        __builtin_amdgcn_global_load_lds((const unsigned*)((const char*)(gbase) + (voff)[_i]), (LAS unsigned*)(lds + (bufoff) + ldsw + _i * 8192), 16, 0, 0); } while (0)
#define PG8_LDA(dst, b, h) do { _Pragma("unroll") for (int m = 0; m < 4; ++m) _Pragma("unroll") for (int k = 0; k < 2; ++k) dst[m][k] = *(const LAS bf16x8*)(lds + PG8_SA(b, h) + aoff + m * 2048 + k * 1024); } while (0)
#define PG8_LDB(dst, b, h) do { _Pragma("unroll") for (int n = 0; n < 2; ++n) _Pragma("unroll") for (int k = 0; k < 2; ++k) dst[n][k] = *(const LAS bf16x8*)(lds + PG8_SB(b, h) + boff + n * 2048 + k * 1024); } while (0)
#define PG8_MMA(ai, bj, At, Bt) do { __builtin_amdgcn_s_setprio(1); _Pragma("unroll") for (int m = 0; m < 4; ++m) _Pragma("unroll") for (int n = 0; n < 2; ++n) _Pragma("unroll") for (int k = 0; k < 2; ++k) \
        acc[ai][bj][m][n] = __builtin_amdgcn_mfma_f32_16x16x32_bf16(Bt[n][k], At[m][k], acc[ai][bj][m][n], 0, 0, 0); __builtin_amdgcn_s_setprio(0); } while (0)
#define PG8_WAIT_V(n) asm volatile("s_waitcnt vmcnt(" #n ")" ::: "memory")
#define PG8_WAIT_L(n) asm volatile("s_waitcnt lgkmcnt(" #n ")" ::: "memory")
#define PG8_BAR __builtin_amdgcn_s_barrier()
#define PG8_SCHED __builtin_amdgcn_sched_barrier(0)
    Unit cur, nxt; int ui = 0;
    if (!S.next(0, cur)) return;
    f32x4 acc[2][2][4][2];
#pragma unroll
    for (int a = 0; a < 2; ++a)
#pragma unroll
        for (int b = 0; b < 2; ++b)
#pragma unroll
            for (int m = 0; m < 4; ++m)
#pragma unroll
                for (int n = 0; n < 2; ++n) acc[a][b][m][n] = (f32x4){0.f, 0.f, 0.f, 0.f};
    bf16x8 At[4][2], B0[2][2], B1[2][2];
    const char* cA = (const char*)g.A + (size_t)cur.pb * g.bsA * 2 + (size_t)cur.pm * tstepA;
    const char* cB = (const char*)g.Bt + (size_t)cur.pb * g.bsB * 2 + (size_t)cur.pn * tstepB;
    PG8_STAGE(PG8_SB(0, 0), cB, voffB); PG8_STAGE(PG8_SA(0, 0), cA, voffA); PG8_STAGE(PG8_SB(0, 1), cB + hstepB, voffB); PG8_STAGE(PG8_SA(0, 1), cA + hstepA, voffA);
    if (wr == 1) PG8_BAR;
    PG8_WAIT_V(4); PG8_BAR;
    PG8_STAGE(PG8_SB(1, 0), cB + kstep, voffB); PG8_STAGE(PG8_SA(1, 0), cA + kstep, voffA); PG8_STAGE(PG8_SB(1, 1), cB + hstepB + kstep, voffB);
    PG8_WAIT_V(6); PG8_BAR;
    for (;;) {
        const bool has_next = S.next(ui + 1, nxt);
        const char* nA = has_next ? (const char*)g.A + (size_t)nxt.pb * g.bsA * 2 + (size_t)nxt.pm * tstepA : cA;
        const char* nB = has_next ? (const char*)g.Bt + (size_t)nxt.pb * g.bsB * 2 + (size_t)nxt.pn * tstepB : cB;
        for (int t = 0; t < nt; t += 2) {
            const bool last = (t == nt - 2);
            const char* a1 = cA + (size_t)(t + 1) * kstep;
            const char* a2 = last ? nA : cA + (size_t)(t + 2) * kstep; const char* b2 = last ? nB : cB + (size_t)(t + 2) * kstep;
            const char* a3 = a2 + kstep; const char* b3 = b2 + kstep;
            PG8_LDB(B0, 0, 0); PG8_SCHED; PG8_LDA(At, 0, 0); PG8_STAGE(PG8_SA(1, 1), a1 + hstepA, voffA);
            PG8_WAIT_L(8); PG8_BAR; PG8_WAIT_L(0); PG8_MMA(0, 0, At, B0); PG8_BAR; PG8_SCHED;
            PG8_LDB(B1, 0, 1); PG8_STAGE(PG8_SB(0, 0), b2, voffB);
            PG8_BAR; PG8_WAIT_L(0); PG8_MMA(0, 1, At, B1); PG8_BAR;
            PG8_LDA(At, 0, 1); PG8_STAGE(PG8_SA(0, 0), a2, voffA);
            PG8_BAR; PG8_WAIT_L(0); PG8_MMA(1, 0, At, B0); PG8_BAR; PG8_SCHED;
            PG8_STAGE(PG8_SB(0, 1), b2 + hstepB, voffB);
            PG8_WAIT_V(6); PG8_BAR; PG8_MMA(1, 1, At, B1); PG8_BAR;
            PG8_LDB(B0, 1, 0); PG8_SCHED; PG8_LDA(At, 1, 0); PG8_STAGE(PG8_SA(0, 1), a2 + hstepA, voffA);
            PG8_WAIT_L(8); PG8_BAR; PG8_WAIT_L(0); PG8_MMA(0, 0, At, B0); PG8_BAR; PG8_SCHED;
            PG8_LDB(B1, 1, 1); PG8_STAGE(PG8_SB(1, 0), b3, voffB);
            PG8_BAR; PG8_WAIT_L(0); PG8_MMA(0, 1, At, B1); PG8_BAR;
            PG8_LDA(At, 1, 1); PG8_STAGE(PG8_SA(1, 0), a3, voffA);
            PG8_BAR; PG8_WAIT_L(0); PG8_MMA(1, 0, At, B0); PG8_BAR; PG8_SCHED;
            PG8_STAGE(PG8_SB(1, 1), b3 + hstepB, voffB);
            PG8_WAIT_V(6); PG8_BAR; PG8_MMA(1, 1, At, B1); PG8_BAR;
        }
        E(acc, cur, wr, wc, fr, fq);
        if (!has_next) break;
#pragma unroll
        for (int a = 0; a < 2; ++a)
#pragma unroll
            for (int b = 0; b < 2; ++b)
#pragma unroll
                for (int m = 0; m < 4; ++m)
#pragma unroll
                    for (int n = 0; n < 2; ++n) acc[a][b][m][n] = (f32x4){0.f, 0.f, 0.f, 0.f};
        cur = nxt; cA = nA; cB = nB; ++ui;
    }
    PG8_WAIT_V(0);
    if (wr == 0) PG8_BAR;
    PG8_BAR;
#undef PG8_SA
#undef PG8_SB
#undef PG8_STAGE
#undef PG8_LDA
#undef PG8_LDB
#undef PG8_MMA
#undef PG8_WAIT_V
#undef PG8_WAIT_L
#undef PG8_BAR
#undef PG8_SCHED
}

__device__ __forceinline__ u32x4 pack8(const f32x4 v0, const f32x4 v1) {
    u32x4 w; w.x = cvt_pk_bf16(v0[0], v0[1]); w.y = cvt_pk_bf16(v0[2], v0[3]); w.z = cvt_pk_bf16(v1[0], v1[1]); w.w = cvt_pk_bf16(v1[2], v1[3]); return w;
}
__device__ __forceinline__ f32x4 rope4(const f32x4 v, const f32x4 cs) {
    f32x4 r; r[0] = v[0] * cs[0] - v[1] * cs[1]; r[1] = v[0] * cs[1] + v[1] * cs[0]; r[2] = v[2] * cs[2] - v[3] * cs[3]; r[3] = v[2] * cs[3] + v[3] * cs[2]; return r;
}
struct EpiInProj {
    static constexpr bool PERM = true;
    bf16_t *Q, *Kb, *V, *Gt, *AU; const float* rope;
    __device__ __forceinline__ void operator()(const f32x4 (&acc)[2][2][4][2], const Unit& u, int wr, int wc, int fr, int fq) const {
        const int sect = u.pn >> 1;
        const int row0 = u.pm * BM + wr * 64 + fr;
        const int colt = (u.pn & 1) * 256 + wc * 32 + 8 * fq;
        if (sect <= 1) {
            bf16_t* O = sect ? Kb : Q;
#pragma unroll
            for (int ai = 0; ai < 2; ++ai)
#pragma unroll
                for (int m = 0; m < 4; ++m) {
                    const int row = row0 + ai * HALF + m * 16, pos = row & (SEQ - 1);
                    const float* rp = rope + ((size_t)pos * 64 + 16 * wc + 4 * fq) * 2;
                    const f32x4 cs0 = *(const f32x4*)rp, cs1 = *(const f32x4*)(rp + 4);
#pragma unroll
                    for (int bj = 0; bj < 2; ++bj) {
                        const f32x4 v0 = rope4(acc[ai][bj][m][0], cs0), v1 = rope4(acc[ai][bj][m][1], cs1);
                        *(u32x4*)(O + (size_t)row * 512 + colt + bj * HALF) = pack8(v0, v1);
                    }
                }
        } else if (sect <= 3) {
            bf16_t* O = (sect == 2) ? V : Gt;
#pragma unroll
            for (int ai = 0; ai < 2; ++ai)
#pragma unroll
                for (int m = 0; m < 4; ++m) {
                    const int row = row0 + ai * HALF + m * 16;
#pragma unroll
                    for (int bj = 0; bj < 2; ++bj) *(u32x4*)(O + (size_t)row * 512 + colt + bj * HALF) = pack8(acc[ai][bj][m][0], acc[ai][bj][m][1]);
                }
        } else {
#pragma unroll
            for (int ai = 0; ai < 2; ++ai)
#pragma unroll
                for (int m = 0; m < 4; ++m) {
                    const int row = row0 + ai * HALF + m * 16, cr = row >> 5, s = row & 31;
#pragma unroll
                    for (int bj = 0; bj < 2; ++bj) {
                        const int cu = colt + bj * HALF, g = cu >> 4, c0 = cu & 15;
                        *(u32x4*)(AU + ((size_t)(g * 1024 + cr) * 640 + s * 16 + c0)) = pack8(acc[ai][bj][m][0], acc[ai][bj][m][1]);
                    }
                }
        }
    }
};
struct EpiGlu {
    static constexpr bool PERM = true;
    bf16_t* Y;
    __device__ __forceinline__ void operator()(const f32x4 (&acc)[2][2][4][2], const Unit& u, int wr, int wc, int fr, int fq) const {
        const int row0 = u.pm * BM + wr * 64 + fr, col = 512 + u.pn * 128 + wc * 32 + 8 * fq;
#pragma unroll
        for (int ai = 0; ai < 2; ++ai)
#pragma unroll
            for (int m = 0; m < 4; ++m) {
                const int row = row0 + ai * HALF + m * 16;
                f32x4 y0, y1;
#pragma unroll
                for (int j = 0; j < 4; ++j) {
                    y0[j] = acc[ai][0][m][0][j] / (1.0f + __expf(-acc[ai][1][m][0][j]));
                    y1[j] = acc[ai][0][m][1][j] / (1.0f + __expf(-acc[ai][1][m][1][j]));
                }
                *(u32x4*)(Y + (size_t)row * 1024 + col) = pack8(y0, y1);
            }
    }
};
struct EpiSS {
    static constexpr bool PERM = true;
    bf16_t* O; float* SS;
    __device__ __forceinline__ void operator()(const f32x4 (&acc)[2][2][4][2], const Unit& u, int wr, int wc, int fr, int fq) const {
        const int row0 = u.pm * BM + wr * 64 + fr, col = u.pn * BM + wc * 32 + 8 * fq;
#pragma unroll
        for (int ai = 0; ai < 2; ++ai)
#pragma unroll
            for (int m = 0; m < 4; ++m) {
                const int row = row0 + ai * HALF + m * 16; float q = 0.f;
#pragma unroll
                for (int bj = 0; bj < 2; ++bj) {
                    const f32x4 v0 = acc[ai][bj][m][0], v1 = acc[ai][bj][m][1];
                    q += (v0[0] * v0[0] + v0[1] * v0[1]) + (v0[2] * v0[2] + v0[3] * v0[3]) + (v1[0] * v1[0] + v1[1] * v1[1]) + (v1[2] * v1[2] + v1[3] * v1[3]);
                    *(u32x4*)(O + (size_t)row * 1024 + col + bj * HALF) = pack8(v0, v1);
                }
                q += __shfl_xor(q, 16); q += __shfl_xor(q, 32);
                if (fq == 0) SS[(size_t)row * 16 + u.pn * 4 + wc] = q;
            }
    }
};
struct EpiRelu2 {
    static constexpr bool PERM = true;
    bf16_t* O;
    __device__ __forceinline__ void operator()(const f32x4 (&acc)[2][2][4][2], const Unit& u, int wr, int wc, int fr, int fq) const {
        const int row0 = u.pm * BM + wr * 64 + fr, col = u.pn * BM + wc * 32 + 8 * fq;
#pragma unroll
        for (int ai = 0; ai < 2; ++ai)
#pragma unroll
            for (int m = 0; m < 4; ++m) {
                const int row = row0 + ai * HALF + m * 16;
#pragma unroll
                for (int bj = 0; bj < 2; ++bj) {
                    f32x4 v0 = acc[ai][bj][m][0], v1 = acc[ai][bj][m][1];
#pragma unroll
                    for (int j = 0; j < 4; ++j) { const float a = fmaxf(v0[j], 0.f), b = fmaxf(v1[j], 0.f); v0[j] = a * a; v1[j] = b * b; }
                    *(u32x4*)(O + (size_t)row * DFF + col + bj * HALF) = pack8(v0, v1);
                }
            }
    }
};
struct EpiSsm {
    static constexpr bool PERM = true;
    const bf16_t* AU; const float* dskip; bf16_t* Y;
    __device__ __forceinline__ void operator()(const f32x4 (&acc)[2][2][4][2], const Unit& u, int wr, int wc, int fr, int fq) const {
        const int g = u.pb;
        const int row0 = u.pm * BM + wr * 64 + fr, colt = u.pn * BM + wc * 32 + 8 * fq;
        const int c0 = 8 * (fq & 1);
        const f32x4 d0 = *(const f32x4*)(dskip + g * 16 + c0), d1 = *(const f32x4*)(dskip + g * 16 + c0 + 4);
#pragma unroll
        for (int ai = 0; ai < 2; ++ai)
#pragma unroll
            for (int m = 0; m < 4; ++m) {
                const int cr = row0 + ai * HALF + m * 16;
#pragma unroll
                for (int bj = 0; bj < 2; ++bj) {
                    const int col = colt + bj * HALF, s = col >> 4;
                    const u32x4 uw = *(const u32x4*)(AU + ((size_t)(g * 1024 + cr) * 640 + col));
                    f32x4 v0 = acc[ai][bj][m][0], v1 = acc[ai][bj][m][1];
                    v0[0] += d0[0] * bf_lo(uw.x); v0[1] += d0[1] * bf_hi(uw.x); v0[2] += d0[2] * bf_lo(uw.y); v0[3] += d0[3] * bf_hi(uw.y);
                    v1[0] += d1[0] * bf_lo(uw.z); v1[1] += d1[1] * bf_hi(uw.z); v1[2] += d1[2] * bf_lo(uw.w); v1[3] += d1[3] * bf_hi(uw.w);
#pragma unroll
                    for (int j = 0; j < 4; ++j) {
                        const float a = v0[j], za = 1.5957691216f * (a + 0.044715f * a * a * a); v0[j] = a / (1.0f + __expf(-za));
                        const float b = v1[j], zb = 1.5957691216f * (b + 0.044715f * b * b * b); v1[j] = b / (1.0f + __expf(-zb));
                    }
                    const size_t tok = (size_t)cr * 32 + s;
                    *(u32x4*)(Y + tok * 512 + g * 16 + c0) = pack8(v0, v1);
                }
            }
    }
};
}

__device__ __forceinline__ bf16x8 frag_nat(const LAS unsigned char* tile, int idx0, int k0, int fr, int fq) {
    return *(const LAS bf16x8*)(tile + (idx0 + fr) * TS + (k0 + 8 * fq) * 2);
}
__device__ __forceinline__ bf16x8 frag_tr(unsigned tile_addr, int k0, int idx0, int lane) {
    const int g = lane >> 4, q = (lane & 15) >> 2, p = lane & 3;
    const unsigned addr = tile_addr + (unsigned)((k0 + 8 * g + q) * TS + (idx0 + 4 * p) * 2);
    u32x2 lo, hi;
    asm volatile("ds_read_b64_tr_b16 %0, %2\n\tds_read_b64_tr_b16 %1, %2 offset:1088\n\ts_waitcnt lgkmcnt(0)" : "=&v"(lo), "=&v"(hi) : "v"(addr) : "memory");
    u32x4 r; r.x = lo.x; r.y = lo.y; r.z = hi.x; r.w = hi.y;
    return __builtin_bit_cast(bf16x8, r);
}
__device__ __forceinline__ void frags_tr8(bf16x8 (&b)[8], unsigned tile_addr, int k0, int lane) {
    const int g = lane >> 4, q = (lane & 15) >> 2, p = lane & 3;
    const unsigned addr = tile_addr + (unsigned)((k0 + 8 * g + q) * TS + (4 * p) * 2);
    u32x2 r0, r1, r2, r3, r4, r5, r6, r7, r8, r9, r10, r11, r12, r13, r14, r15;
    asm volatile(
        "ds_read_b64_tr_b16 %0, %16\n\t"
        "ds_read_b64_tr_b16 %1, %16 offset:1088\n\t"
        "ds_read_b64_tr_b16 %2, %16 offset:32\n\t"
        "ds_read_b64_tr_b16 %3, %16 offset:1120\n\t"
        "ds_read_b64_tr_b16 %4, %16 offset:64\n\t"
        "ds_read_b64_tr_b16 %5, %16 offset:1152\n\t"
        "ds_read_b64_tr_b16 %6, %16 offset:96\n\t"
        "ds_read_b64_tr_b16 %7, %16 offset:1184\n\t"
        "ds_read_b64_tr_b16 %8, %16 offset:128\n\t"
        "ds_read_b64_tr_b16 %9, %16 offset:1216\n\t"
        "ds_read_b64_tr_b16 %10, %16 offset:160\n\t"
        "ds_read_b64_tr_b16 %11, %16 offset:1248\n\t"
        "ds_read_b64_tr_b16 %12, %16 offset:192\n\t"
        "ds_read_b64_tr_b16 %13, %16 offset:1280\n\t"
        "ds_read_b64_tr_b16 %14, %16 offset:224\n\t"
        "ds_read_b64_tr_b16 %15, %16 offset:1312\n\t"
        "s_waitcnt lgkmcnt(0)"
        : "=&v"(r0), "=&v"(r1), "=&v"(r2), "=&v"(r3), "=&v"(r4), "=&v"(r5), "=&v"(r6), "=&v"(r7),
          "=&v"(r8), "=&v"(r9), "=&v"(r10), "=&v"(r11), "=&v"(r12), "=&v"(r13), "=&v"(r14), "=&v"(r15)
        : "v"(addr) : "memory");
    u32x4 w;
    w.x = r0.x; w.y = r0.y; w.z = r1.x; w.w = r1.y; b[0] = __builtin_bit_cast(bf16x8, w);
    w.x = r2.x; w.y = r2.y; w.z = r3.x; w.w = r3.y; b[1] = __builtin_bit_cast(bf16x8, w);
    w.x = r4.x; w.y = r4.y; w.z = r5.x; w.w = r5.y; b[2] = __builtin_bit_cast(bf16x8, w);
    w.x = r6.x; w.y = r6.y; w.z = r7.x; w.w = r7.y; b[3] = __builtin_bit_cast(bf16x8, w);
    w.x = r8.x; w.y = r8.y; w.z = r9.x; w.w = r9.y; b[4] = __builtin_bit_cast(bf16x8, w);
    w.x = r10.x; w.y = r10.y; w.z = r11.x; w.w = r11.y; b[5] = __builtin_bit_cast(bf16x8, w);
    w.x = r12.x; w.y = r12.y; w.z = r13.x; w.w = r13.y; b[6] = __builtin_bit_cast(bf16x8, w);
    w.x = r14.x; w.y = r14.y; w.z = r15.x; w.w = r15.y; b[7] = __builtin_bit_cast(bf16x8, w);
}
template <bool ATR, bool BTR>
__device__ __forceinline__ void mma128(f32x4 (&acc)[8], const LAS unsigned char* lds, unsigned lds_addr, int offA, int offB, int m0, int lane) {
    const int fr = lane & 15, fq = lane >> 4;
#pragma unroll
    for (int ks = 0; ks < 4; ++ks) {
        bf16x8 af, bfr[8];
        if (ATR) af = frag_tr(lds_addr + offA, 32 * ks, m0, lane); else af = frag_nat(lds + offA, m0, 32 * ks, fr, fq);
        if (BTR) frags_tr8(bfr, lds_addr + offB, 32 * ks, lane);
        else {
#pragma unroll
            for (int n = 0; n < 8; ++n) bfr[n] = frag_nat(lds + offB, 16 * n, 32 * ks, fr, fq);
        }
#pragma unroll
        for (int n = 0; n < 8; ++n) acc[n] = __builtin_amdgcn_mfma_f32_16x16x32_bf16(bfr[n], af, acc[n], 0, 0, 0);
    }
}
__device__ __forceinline__ void tile_load(LAS unsigned char* dst, const bf16_t* src, int ld, int tid) {
    u32x4 v[4];
#pragma unroll
    for (int i = 0; i < 4; ++i) { const int q = tid + 512 * i, row = q >> 4, pc = q & 15; v[i] = *(const u32x4*)(src + (size_t)row * ld + pc * 8); }
#pragma unroll
    for (int i = 0; i < 4; ++i) { const int q = tid + 512 * i, row = q >> 4, pc = q & 15; *(LAS u32x4*)(dst + row * TS + pc * 16) = v[i]; }
}
__device__ __forceinline__ void tile_load_zeta(LAS unsigned char* dst, const bf16_t* src, int ld, int tid, float l2g) {
    u32x4 v[4];
#pragma unroll
    for (int i = 0; i < 4; ++i) { const int q = tid + 512 * i, row = q >> 4, pc = q & 15; v[i] = *(const u32x4*)(src + (size_t)row * ld + pc * 8); }
#pragma unroll
    for (int i = 0; i < 4; ++i) {
        const int q = tid + 512 * i, row = q >> 4, pc = q & 15; const float z = exp2f((float)(127 - row) * l2g);
        u32x4 w;
        w.x = cvt_pk_bf16(bf_lo(v[i].x) * z, bf_hi(v[i].x) * z); w.y = cvt_pk_bf16(bf_lo(v[i].y) * z, bf_hi(v[i].y) * z);
        w.z = cvt_pk_bf16(bf_lo(v[i].z) * z, bf_hi(v[i].z) * z); w.w = cvt_pk_bf16(bf_lo(v[i].w) * z, bf_hi(v[i].w) * z);
        *(LAS u32x4*)(dst + row * TS + pc * 16) = w;
    }
}
__device__ __forceinline__ void tile_issue(u32x4 (&v)[4], const bf16_t* src, int ld, int tid) {
#pragma unroll
    for (int i = 0; i < 4; ++i) { const int q = tid + 512 * i, row = q >> 4, pc = q & 15; v[i] = *(const u32x4*)(src + (size_t)row * ld + pc * 8); }
}
__device__ __forceinline__ void tile_commit(LAS unsigned char* dst, const u32x4 (&v)[4], int tid) {
#pragma unroll
    for (int i = 0; i < 4; ++i) { const int q = tid + 512 * i, row = q >> 4, pc = q & 15; *(LAS u32x4*)(dst + row * TS + pc * 16) = v[i]; }
}
__device__ __forceinline__ void tile_commit_zeta(LAS unsigned char* dst, const u32x4 (&v)[4], int tid, float l2g) {
#pragma unroll
    for (int i = 0; i < 4; ++i) {
        const int q = tid + 512 * i, row = q >> 4, pc = q & 15; const float z = exp2f((float)(127 - row) * l2g);
        u32x4 w;
        w.x = cvt_pk_bf16(bf_lo(v[i].x) * z, bf_hi(v[i].x) * z); w.y = cvt_pk_bf16(bf_lo(v[i].y) * z, bf_hi(v[i].y) * z);
        w.z = cvt_pk_bf16(bf_lo(v[i].z) * z, bf_hi(v[i].z) * z); w.w = cvt_pk_bf16(bf_lo(v[i].w) * z, bf_hi(v[i].w) * z);
        *(LAS u32x4*)(dst + row * TS + pc * 16) = w;
    }
}
__device__ __forceinline__ float ret_log2_gamma(int h) { const float g = 1.0f - exp2f(-5.0f - (4.0f / 3.0f) * (float)h); return log2f(g); }

__device__ __forceinline__ int dest_row(int mode, int n) {
    if (mode == 1) { if (n < 1024) { const int sect = n >> 9, w = n & 511, h = w >> 7, j = w & 127; return (sect << 9) + (h << 7) + ((j & 63) << 1) + (j >> 6); } return n; }
    if (mode == 2) { const int bj = n >> 9, rem = n & 511, pn = rem >> 7, j = rem & 127; return (pn << 8) + (bj << 7) + j; }
    return n;
}
__device__ __forceinline__ void p0_transpose_item(const float* W, int K, int N, bf16_t* WT, const float* gain, int mode, LAS float* scr, int item, int lane) {
    const int nblk = N / 32, kb = item / nblk, nb = item % nblk, k0 = 64 * kb, n0 = 32 * nb;
    const float cs = (mode == 1 && n0 >= 512 && n0 < 1024) ? 0.08838834764831845f : 1.0f;
#pragma unroll 8
    for (int i = 0; i < 32; ++i) { const int kk = 2 * i + (lane >> 5); const float g = gain ? gain[k0 + kk] * cs : cs; scr[kk * 33 + (lane & 31)] = W[(size_t)(k0 + kk) * N + n0 + (lane & 31)] * g; }
    LDS_WAIT();
    const int c = lane & 7;
#pragma unroll
    for (int j = 0; j < 4; ++j) { const int n = (lane >> 3) + 8 * j; const LAS float* s = scr + (8 * c) * 33 + n;
        u32x4 o; o.x = cvt_pk_bf16(s[0 * 33], s[1 * 33]); o.y = cvt_pk_bf16(s[2 * 33], s[3 * 33]); o.z = cvt_pk_bf16(s[4 * 33], s[5 * 33]); o.w = cvt_pk_bf16(s[6 * 33], s[7 * 33]);
        *(u32x4*)(WT + (size_t)dest_row(mode, n0 + n) * K + k0 + 8 * c) = o; }
    LDS_WAIT();
}
__device__ __forceinline__ void s5_pow(float lre, float lim, float dt, float j, float& pr, float& pi) {
    const float mag = expf(j * (dt * lre)); float s, c; sincosf(j * (dt * lim), &s, &c); pr = mag * c; pi = mag * s;
}
__device__ __forceinline__ void s5_coef(float lre, float lim, float dt, float& cr, float& ci) {
    float br, bi; s5_pow(lre, lim, dt, 1.0f, br, bi); br -= 1.0f;
    const float den = lre * lre + lim * lim; cr = (br * lre + bi * lim) / den; ci = (bi * lre - br * lim) / den;
}

#define XB_TMO      128
#define XB_XCNT(j)  (256  + 64 * (j))
#define XB_XSUB(j)  (1280 + 64 * (j))
#define XB_XGEN(j)  (2304 + 64 * (j))
#define XB_TOP      3328
#define XB_TOPGEN   3392
#define XCD_BAR_WORDS 3456
#define XB_SPIN_CAP (1u << 18)
__device__ __forceinline__ unsigned xb_ld(unsigned* p)              { return __hip_atomic_load(p, __ATOMIC_RELAXED, __HIP_MEMORY_SCOPE_AGENT); }
__device__ __forceinline__ unsigned xb_add(unsigned* p, unsigned v) { return __hip_atomic_fetch_add(p, v, __ATOMIC_RELAXED, __HIP_MEMORY_SCOPE_AGENT); }
__device__ __forceinline__ unsigned xb_xcc_id() { return (unsigned)__builtin_amdgcn_s_getreg((3 << 11) | 20) & 0xFu; }
#define XB_SPIN(cond, bar) do { unsigned _sp = 0; while (cond) { __builtin_amdgcn_s_sleep(1); \
    if ((++_sp & 255u) == 0u) { if (xb_ld(&(bar)[XB_TMO])) break; if (_sp > XB_SPIN_CAP) { atomicAdd(&(bar)[XB_TMO], 1u); break; } } } } while (0)
struct XcdBarrier { unsigned* bar; unsigned x; volatile LAS unsigned* st; };
__device__ __forceinline__ XcdBarrier xcd_barrier_post(unsigned* bar, volatile LAS unsigned* st) {
    XcdBarrier b; b.bar = bar; b.x = xb_xcc_id(); b.st = st;
    if (threadIdx.x == 0) (void)xb_add(&bar[XB_XCNT(b.x)], 1u);
    return b;
}
__device__ __forceinline__ void xcd_barrier_complete(unsigned* bar, unsigned x, unsigned& nloc, unsigned& nx) {
    const unsigned G = gridDim.x * gridDim.y * gridDim.z;
    unsigned sum, cnt, mine, sp = 0u;
    for (;;) {
        sum = 0u; cnt = 0u; mine = 0u;
#pragma unroll
        for (unsigned j = 0; j < 16; ++j) { const unsigned c = xb_ld(&bar[XB_XCNT(j)]); sum += c; cnt += (c > 0u) ? 1u : 0u; mine = (j == x) ? c : mine; }
        if (sum == G) break;
        __builtin_amdgcn_s_sleep(1);
        if ((++sp & 255u) == 0u) { if (xb_ld(&bar[XB_TMO])) break; if (sp > XB_SPIN_CAP) { atomicAdd(&bar[XB_TMO], 1u); break; } }
    }
    nloc = mine > 0u ? mine : 1u; nx = cnt > 0u ? cnt : 1u;
}
__device__ __forceinline__ void xcd_barrier(const XcdBarrier& b) {
    asm volatile("s_waitcnt vmcnt(0)" ::: "memory");
    __syncthreads();
    if (threadIdx.x == 0) {
        unsigned* bar = b.bar;
        __builtin_amdgcn_s_waitcnt(0);
        unsigned nloc = b.st[0], nx = b.st[1];
        if (nloc == 0u) { xcd_barrier_complete(bar, b.x, nloc, nx); b.st[0] = nloc; b.st[1] = nx; }
        const unsigned old = xb_add(&bar[XB_XSUB(b.x)], 1u);
        const unsigned gen = old / nloc;
        if (old + 1u == (gen + 1u) * nloc) {
            __builtin_amdgcn_fence(__ATOMIC_RELEASE, "agent");
            asm volatile("s_waitcnt vmcnt(0)" ::: "memory");
            const unsigned og = xb_add(&bar[XB_TOP], 1u);
            const unsigned tg = og / nx;
            if (og + 1u == (tg + 1u) * nx) xb_add(&bar[XB_TOPGEN], 1u);
            else XB_SPIN(xb_ld(&bar[XB_TOPGEN]) == tg, bar);
            __builtin_amdgcn_fence(__ATOMIC_ACQUIRE, "agent");
            xb_add(&bar[XB_XGEN(b.x)], 1u);
            asm volatile("s_waitcnt vmcnt(0)" ::: "memory");
        } else {
            XB_SPIN(xb_ld(&bar[XB_XGEN(b.x)]) == gen, bar);
            __builtin_amdgcn_fence(__ATOMIC_ACQUIRE, "agent");
            asm volatile("s_waitcnt vmcnt(0)" ::: "memory");
        }
    }
    __syncthreads();
}

struct Args { const float* in[19]; float* out; unsigned char* ws; int ph_lo, ph_hi; };

__global__ void __launch_bounds__(512, 2) fwd_kernel(Args a) {
    extern __shared__ __attribute__((aligned(16))) unsigned char lds_raw[];
    LAS unsigned char* lds = (LAS unsigned char*)lds_raw;
    const unsigned lds_addr = (unsigned)(size_t)lds_raw;
    cg::grid_group grid = cg::this_grid();
    const int tid = threadIdx.x, lane = tid & 63, wave = __builtin_amdgcn_readfirstlane(tid >> 6);
    const int G = gridDim.x, bx = blockIdx.x;
    const int lo = a.ph_lo, hi = a.ph_hi;
    unsigned char* ws = a.ws;
#define IN(k) (lo <= (k) && (k) < hi)
#define SEAM(k) do { if (lo <= (k) && (k) + 1 < hi) xcd_barrier(xbar); } while (0)
    volatile LAS unsigned* misc = (volatile LAS unsigned*)(lds + (LDS_BYTES - 64));
    if (tid < 16) misc[tid] = 0u;
    __syncthreads();
    const XcdBarrier xbar = xcd_barrier_post((unsigned*)ws, misc);
    if (lo < 0) grid.sync();

    const float* x = a.in[0];
    const float* g_mix_pre = a.in[1]; const float* g_mix_post = a.in[2]; const float* w_in = a.in[3]; const float* gn_gain = a.in[4];
    const float* lam_re = a.in[5]; const float* lam_im = a.in[6]; const float* log_dt = a.in[7];
    const float* b_re = a.in[8]; const float* b_im = a.in[9]; const float* c_re = a.in[10]; const float* c_im = a.in[11]; const float* d_skip = a.in[12];
    const float* w_glu = a.in[13]; const float* w_out = a.in[14]; const float* g_mlp_pre = a.in[15]; const float* g_mlp_post = a.in[16];
    const float* w_ff1 = a.in[17]; const float* w_ff2 = a.in[18];
    float* out = a.out;

    bf16_t* WIN = (bf16_t*)(ws + WS_WIN); bf16_t* WGLU = (bf16_t*)(ws + WS_WGLU); bf16_t* WOUT = (bf16_t*)(ws + WS_WOUT);
    bf16_t* WFF1 = (bf16_t*)(ws + WS_WFF1); bf16_t* WFF2 = (bf16_t*)(ws + WS_WFF2);
    float* ROPE = (float*)(ws + WS_ROPE); bf16_t* TW = (bf16_t*)(ws + WS_TW); bf16_t* W1S = (bf16_t*)(ws + WS_W1S);
    float* SS = (float*)(ws + WS_SS); float* SS2 = (float*)(ws + WS_SS2); float* HINC = (float*)(ws + WS_HINC);
    bf16_t* XN = (bf16_t*)(ws + WS_XN);
    bf16_t* QB = (bf16_t*)(ws + WS_QB); bf16_t* KB = (bf16_t*)(ws + WS_KB); bf16_t* VB = (bf16_t*)(ws + WS_VB); bf16_t* GB = (bf16_t*)(ws + WS_GB);
    bf16_t* AU = (bf16_t*)(ws + WS_AU); bf16_t* SST = (bf16_t*)(ws + WS_SST); bf16_t* RTB = (bf16_t*)(ws + WS_RTB);
    bf16_t* YSSM = (bf16_t*)(ws + WS_YSSM); bf16_t* YMIX = (bf16_t*)(ws + WS_YMIX);
    bf16_t* MIXB = (bf16_t*)(ws + WS_MIXB); bf16_t* HID = (bf16_t*)(ws + WS_HID); bf16_t* MB = (bf16_t*)(ws + WS_MB);

    if (IN(0)) for (int rep = 0; rep < REPS(0); ++rep) {
        const int gw = bx * 8 + wave, NGW = G * 8;
        {
            LAS float* scr = (LAS float*)(lds + wave * 16384);
            constexpr int I_IN = (DM / 64) * (NIN / 32), I_GLU = (512 / 64) * (1024 / 32), I_OUT = (DM / 64) * (DM / 32), I_F1 = (DM / 64) * (DFF / 32), I_F2 = (DFF / 64) * (DM / 32);
            constexpr int NITEMS = I_IN + I_GLU + I_OUT + I_F1 + I_F2;
            for (int it = gw; it < NITEMS; it += NGW) {
                int r = it;
                if (r < I_IN) { p0_transpose_item(w_in, DM, NIN, WIN, g_mix_pre, 1, scr, r, lane); continue; } r -= I_IN;
                if (r < I_GLU) { p0_transpose_item(w_glu, 512, 1024, WGLU, nullptr, 2, scr, r, lane); continue; } r -= I_GLU;
                if (r < I_OUT) { p0_transpose_item(w_out, DM, DM, WOUT, nullptr, 0, scr, r, lane); continue; } r -= I_OUT;
                if (r < I_F1) { p0_transpose_item(w_ff1, DM, DFF, WFF1, g_mlp_pre, 0, scr, r, lane); continue; } r -= I_F1;
                p0_transpose_item(w_ff2, DFF, DM, WFF2, nullptr, 0, scr, r, lane);
            }
        }
        for (int m = gw; m < T; m += NGW) {
            const f32x4* xr = (const f32x4*)(x + (size_t)m * DM) + lane;
            f32x4 v[4]; float s = 0.f;
#pragma unroll
            for (int j = 0; j < 4; ++j) { v[j] = xr[64 * j]; s += (v[j][0] * v[j][0] + v[j][1] * v[j][1]) + (v[j][2] * v[j][2] + v[j][3] * v[j][3]); }
            const float rstd = 1.0f / sqrtf(wave_sum(s) * (1.0f / DM) + EPS);
            u32x2* o8 = (u32x2*)(XN + (size_t)m * DM) + lane;
#pragma unroll
            for (int j = 0; j < 4; ++j) { u32x2 w; w.x = cvt_pk_bf16(v[j][0] * rstd, v[j][1] * rstd); w.y = cvt_pk_bf16(v[j][2] * rstd, v[j][3] * rstd); o8[64 * j] = w; }
        }
        const float rope_inv = (float)pow(10000.0, -(double)(tid & 63) / 64.0);
        for (int i = bx * 512 + tid; i < SEQ * 64; i += G * 512) {
            const int pos = i >> 6;
            const float inv = rope_inv;
            const float ang = (float)pos * inv; float s, c; sincosf(ang, &s, &c);
            *(f32x2*)(ROPE + (size_t)i * 2) = (f32x2){c, s};
        }
        for (int i = bx * 512 + tid; i < 32 * 32 * 64; i += G * 512) {
            {
                const int q = i & 63, t = (i >> 6) & 31, g = i >> 11;
                const float lre = fminf(lam_re[g * 64 + q], -1e-4f), lim = lam_im[g * 64 + q], dt = expf(log_dt[g]);
                float pr, pi; s5_pow(lre, lim, dt, (float)(t + 1), pr, pi);
#pragma unroll 4
                for (int c = 0; c < 16; ++c) {
                    const float cr = c_re[(g * 16 + c) * 64 + q], ci = c_im[(g * 16 + c) * 64 + q];
                    const float zr = cr * pr - ci * pi, zi = cr * pi + ci * pr;
                    bf16_t* row = TW + (size_t)(g * 512 + t * 16 + c) * 640 + 512;
                    row[q] = f2bf(zr); row[64 + q] = f2bf(-zi);
                }
            }
            {
                const int s = i & 31, p = (i >> 5) & 63, g = i >> 11;
                const float lre = fminf(lam_re[g * 64 + p], -1e-4f), lim = lam_im[g * 64 + p], dt = expf(log_dt[g]);
                float pr, pi, cr, ci; s5_pow(lre, lim, dt, (float)(31 - s), pr, pi); s5_coef(lre, lim, dt, cr, ci);
                const float wr_ = pr * cr - pi * ci, wi_ = pr * ci + pi * cr;
                float zr[16], zi[16];
#pragma unroll
                for (int c = 0; c < 16; ++c) { const float br = b_re[(g * 64 + p) * 16 + c], bi = b_im[(g * 64 + p) * 16 + c]; zr[c] = wr_ * br - wi_ * bi; zi[c] = wr_ * bi + wi_ * br; }
                u32x4* o0 = (u32x4*)(W1S + (size_t)(g * 128 + p) * 512 + s * 16);
                u32x4* o1 = (u32x4*)(W1S + (size_t)(g * 128 + 64 + p) * 512 + s * 16);
                u32x4 w;
                w.x = cvt_pk_bf16(zr[0], zr[1]); w.y = cvt_pk_bf16(zr[2], zr[3]); w.z = cvt_pk_bf16(zr[4], zr[5]); w.w = cvt_pk_bf16(zr[6], zr[7]); o0[0] = w;
                w.x = cvt_pk_bf16(zr[8], zr[9]); w.y = cvt_pk_bf16(zr[10], zr[11]); w.z = cvt_pk_bf16(zr[12], zr[13]); w.w = cvt_pk_bf16(zr[14], zr[15]); o0[1] = w;
                w.x = cvt_pk_bf16(zi[0], zi[1]); w.y = cvt_pk_bf16(zi[2], zi[3]); w.z = cvt_pk_bf16(zi[4], zi[5]); w.w = cvt_pk_bf16(zi[6], zi[7]); o1[0] = w;
                w.x = cvt_pk_bf16(zi[8], zi[9]); w.y = cvt_pk_bf16(zi[10], zi[11]); w.z = cvt_pk_bf16(zi[12], zi[13]); w.w = cvt_pk_bf16(zi[14], zi[15]); o1[1] = w;
            }
        }
        for (int i = bx * 512 + tid; i < 16384 * 64; i += G * 512) {
            const int piece = i & 63, row = i >> 6, t = (row >> 4) & 31;
            if (piece >= 2 * (t + 1)) *(u32x4*)(TW + (size_t)row * 640 + piece * 8) = (u32x4){0u, 0u, 0u, 0u};
        }
        __syncthreads();
        {
            LAS float* Bre = (LAS float*)lds; LAS float* Bim = Bre + 1024; LAS float* Cre = Bre + 2048; LAS float* Cim = Bre + 3072;
            LAS float* cpr = Bre + 4096; LAS float* cpi = cpr + 256;
            for (int it = bx; it < 256; it += G) {
                const int g = it >> 3, jq = it & 7;
                {
                    const int q0 = tid, q1 = tid + 512;
                    const float* s0 = (q0 < 256 ? b_re : b_im) + g * 1024 + (q0 & 255) * 4;
                    const float* s1 = (q1 < 768 ? c_re : c_im) + g * 1024 + (q1 & 255) * 4;
                    *(LAS f32x4*)(Bre + q0 * 4) = *(const f32x4*)s0;
                    *(LAS f32x4*)(Bre + q1 * 4) = *(const f32x4*)s1;
                }
                if (tid < 256) {
                    const int p = tid & 63, jl = tid >> 6;
                    const float lre = fminf(lam_re[g * 64 + p], -1e-4f), lim = lam_im[g * 64 + p], dt = expf(log_dt[g]);
                    float pr, pi, cr, ci; s5_pow(lre, lim, dt, (float)(4 * jq + jl), pr, pi); s5_coef(lre, lim, dt, cr, ci);
                    cpr[jl * 64 + p] = pr * cr - pi * ci; cpi[jl * 64 + p] = pr * ci + pi * cr;
                }
                __syncthreads();
                {
                    const int cc = tid & 255, c = cc >> 4, c2 = cc & 15, jh = tid >> 8;
                    float v0 = 0.f, v1 = 0.f;
#pragma unroll 8
                    for (int p = 0; p < 64; ++p) {
                        const float cr = Cre[c * 64 + p], ci = Cim[c * 64 + p], br = Bre[p * 16 + c2], bi = Bim[p * 16 + c2];
                        const float mr = cr * br - ci * bi, mi = cr * bi + ci * br;
                        v0 += mr * cpr[(2 * jh) * 64 + p] - mi * cpi[(2 * jh) * 64 + p];
                        v1 += mr * cpr[(2 * jh + 1) * 64 + p] - mi * cpi[(2 * jh + 1) * 64 + p];
                    }
                    const int jj0 = 4 * jq + 2 * jh;
                    const bf16_t w0 = f2bf(v0), w1 = f2bf(v1);
                    for (int t = jj0; t < 32; ++t) TW[(size_t)(g * 512 + t * 16 + c) * 640 + (t - jj0) * 16 + c2] = w0;
                    for (int t = jj0 + 1; t < 32; ++t) TW[(size_t)(g * 512 + t * 16 + c) * 640 + (t - jj0 - 1) * 16 + c2] = w1;
                }
                __syncthreads();
            }
        }
    }
    SEAM(0);

    if (IN(1)) for (int rep = 0; rep < REPS(1); ++rep) {
        pg8::Gemm g{XN, WIN, DM, DM, DM, 0, 0}; pg8::StaticOrder S; S.init(T, NIN, G, bx);
        pg8::EpiInProj E{QB, KB, VB, GB, AU, ROPE};
        pg8::gemm_phase(lds, g, S, E);
    }
    SEAM(1);

    if (IN(2)) for (int rep = 0; rep < REPS(2); ++rep) {
        const int fr = lane & 15, fq = lane >> 4;
        for (int it = bx; it < 256; it += G) {
            const int g = it >> 3, rt = it & 7;
            const bf16_t* pA = AU + (size_t)(g * 1024 + rt * 128) * 640; const bf16_t* pB = W1S + (size_t)(g * 128) * 512;
            f32x4 acc[8];
#pragma unroll
            for (int n = 0; n < 8; ++n) acc[n] = (f32x4){0.f, 0.f, 0.f, 0.f};
            u32x4 ra[4], rb[4];
            tile_issue(ra, pA, 640, tid); tile_issue(rb, pB, 512, tid);
            for (int kt = 0; kt < 4; ++kt) {
                tile_commit(lds, ra, tid); tile_commit(lds + TILE_B, rb, tid);
                __syncthreads();
                if (kt < 3) { tile_issue(ra, pA + (kt + 1) * 128, 640, tid); tile_issue(rb, pB + (kt + 1) * 128, 512, tid); }
                mma128<false, false>(acc, lds, lds_addr, 0, TILE_B, 16 * wave, lane);
                __syncthreads();
            }
            float* o = HINC + ((size_t)(g * 1024 + rt * 128 + 16 * wave + fr)) * 128 + 4 * fq;
#pragma unroll
            for (int n = 0; n < 8; ++n) *(f32x4*)(o + 16 * n) = acc[n];
        }
        {
            u32x4 rk[4], rv[4];
            int it = bx;
#define R1_ISSUE(IT) do { const int n_ = (IT) & 63, h_ = ((IT) >> 6) & 3, b_ = (IT) >> 8; const size_t t0_ = (size_t)b_ * SEQ + n_ * 128; \
                tile_issue(rk, KB + t0_ * 512 + h_ * 128, 512, tid); tile_issue(rv, VB + t0_ * 512 + h_ * 128, 512, tid); } while (0)
            if (it < 1024) R1_ISSUE(it);
            for (; it < 1024; it += G) {
                const int h = (it >> 6) & 3;
                const float l2g = ret_log2_gamma(h);
                tile_commit(lds, rk, tid); tile_commit_zeta(lds + TILE_B, rv, tid, l2g);
                __syncthreads();
                if (it + G < 1024) R1_ISSUE(it + G);
                f32x4 acc[8];
#pragma unroll
                for (int nb = 0; nb < 8; ++nb) acc[nb] = (f32x4){0.f, 0.f, 0.f, 0.f};
                mma128<true, true>(acc, lds, lds_addr, TILE_B, 0, 16 * wave, lane);
                bf16_t* o = SST + (size_t)it * 16384 + (16 * wave + fr) * 128 + 4 * fq;
#pragma unroll
                for (int nb = 0; nb < 8; ++nb) { u32x2 w; w.x = cvt_pk_bf16(acc[nb][0], acc[nb][1]); w.y = cvt_pk_bf16(acc[nb][2], acc[nb][3]); *(u32x2*)(o + 16 * nb) = w; }
                __syncthreads();
            }
#undef R1_ISSUE
        }
    }
    SEAM(2);

    if (IN(3)) for (int rep = 0; rep < REPS(3); ++rep) {
        for (int idx = bx * 512 + tid; idx < 16 * 8192; idx += G * 512) {
            const int bh = idx >> 13, e2 = idx & 8191, h = bh & 3;
            const float gch = exp2f(128.0f * ret_log2_gamma(h));
            const unsigned* sp = (const unsigned*)(SST + (size_t)bh * 64 * 16384 + 2 * e2);
            unsigned* rp = (unsigned*)(RTB + (size_t)bh * 64 * 16384 + 2 * e2);
            float r0 = 0.f, r1 = 0.f;
            for (int n0 = 0; n0 < 64; n0 += 16) {
                unsigned s[16];
#pragma unroll
                for (int j = 0; j < 16; ++j) s[j] = sp[(size_t)(n0 + j) * 8192];
#pragma unroll
                for (int j = 0; j < 16; ++j) { rp[(size_t)(n0 + j) * 8192] = cvt_pk_bf16(r0, r1); r0 = gch * r0 + bf_lo(s[j]); r1 = gch * r1 + bf_hi(s[j]); }
            }
        }
        {
            LAS float* X = (LAS float*)lds;
            for (int it = bx; it < 128; it += G) {
                const int b = it >> 5, g = it & 31, p = tid & 63, seg = tid >> 6;
                const float lre = fminf(lam_re[g * 64 + p], -1e-4f), lim = lam_im[g * 64 + p], dt = expf(log_dt[g]);
                float ar, ai, Ar, Ai; s5_pow(lre, lim, dt, 32.0f, ar, ai); s5_pow(lre, lim, dt, 1024.0f, Ar, Ai);
                const float* hp = HINC + ((size_t)(g * 1024 + b * 256 + seg * 32)) * 128 + p;
                float xr = 0.f, xi = 0.f;
                for (int i = 0; i < 32; ++i) { const float hr = hp[(size_t)i * 128], hi_ = hp[(size_t)i * 128 + 64]; const float nr = ar * xr - ai * xi + hr, ni = ar * xi + ai * xr + hi_; xr = nr; xi = ni; }
                X[(seg * 64 + p) * 2] = xr; X[(seg * 64 + p) * 2 + 1] = xi;
                __syncthreads();
                float cr = 0.f, ci = 0.f;
                for (int s = 0; s < seg; ++s) { const float tr = X[(s * 64 + p) * 2], ti = X[(s * 64 + p) * 2 + 1]; const float nr = Ar * cr - Ai * ci + tr, ni = Ar * ci + Ai * cr + ti; cr = nr; ci = ni; }
                bf16_t* op = AU + ((size_t)(g * 1024 + b * 256 + seg * 32)) * 640 + 512 + p;
                xr = cr; xi = ci;
                for (int i = 0; i < 32; ++i) {
                    op[(size_t)i * 640] = f2bf(xr); op[(size_t)i * 640 + 64] = f2bf(xi);
                    const float hr = hp[(size_t)i * 128], hi_ = hp[(size_t)i * 128 + 64]; const float nr = ar * xr - ai * xi + hr, ni = ar * xi + ai * xr + hi_; xr = nr; xi = ni;
                }
                __syncthreads();
            }
        }
    }
    SEAM(3);

    if (IN(4)) for (int rep = 0; rep < REPS(4); ++rep) {
        const bool solo = (hi - lo == 1);
        if (!(solo && PROBE_P4_PART == 2)) {
            pg8::Gemm g{AU, TW, 640, 640, 640, (size_t)1024 * 640, (size_t)512 * 640}; pg8::BatchOrder S{G, bx};
            pg8::EpiSsm E{AU, d_skip, YSSM};
            pg8::gemm_phase(lds, g, S, E);
        }
        const int fr = lane & 15, fq = lane >> 4;
        constexpr int OQ = 0, OK_ = TILE_B, OV = 2 * TILE_B, OR = 3 * TILE_B;
        u32x4 rq[4], rk[4], rv[4], rr[4];
        int it = bx;
#define R3_ISSUE(IT) do { const int n_ = (IT) & 63, h_ = ((IT) >> 6) & 3, b_ = (IT) >> 8; const size_t t0_ = (size_t)b_ * SEQ + n_ * 128; \
            tile_issue(rq, QB + t0_ * 512 + h_ * 128, 512, tid); tile_issue(rk, KB + t0_ * 512 + h_ * 128, 512, tid); \
            tile_issue(rv, VB + t0_ * 512 + h_ * 128, 512, tid); tile_issue(rr, RTB + (size_t)(IT) * 16384, 128, tid); } while (0)
        if (solo && PROBE_P4_PART == 1) it = 1024;
        for (; it < 1024; it += G) {
            const int n = it & 63, h = (it >> 6) & 3, b = it >> 8;
            const float l2g = ret_log2_gamma(h);
            const size_t tok0 = (size_t)b * SEQ + n * 128;
            R3_ISSUE(it);
            tile_commit(lds + OQ, rq, tid); tile_commit(lds + OK_, rk, tid); tile_commit(lds + OV, rv, tid); tile_commit(lds + OR, rr, tid);
            __syncthreads();
            const int i = 16 * wave + fr;
            f32x4 sc[8];
#pragma unroll
            for (int nb = 0; nb < 8; ++nb) sc[nb] = (f32x4){0.f, 0.f, 0.f, 0.f};
            mma128<false, false>(sc, lds, lds_addr, OQ, OK_, 16 * wave, lane);
            __syncthreads();
#pragma unroll
            for (int nb = 0; nb < 8; ++nb) {
                f32x4 pv;
#pragma unroll
                for (int e = 0; e < 4; ++e) { const int j = 16 * nb + 4 * fq + e; pv[e] = (i >= j) ? sc[nb][e] * exp2f((float)(i - j) * l2g) : 0.f; }
                u32x2 w; w.x = cvt_pk_bf16(pv[0], pv[1]); w.y = cvt_pk_bf16(pv[2], pv[3]);
                *(LAS u32x2*)(lds + OK_ + i * TS + (16 * nb + 4 * fq) * 2) = w;
            }
            LDS_WAIT();
            __syncthreads();
            f32x4 a1[8], a2[8];
#pragma unroll
            for (int nb = 0; nb < 8; ++nb) { a1[nb] = (f32x4){0.f, 0.f, 0.f, 0.f}; a2[nb] = (f32x4){0.f, 0.f, 0.f, 0.f}; }
            mma128<false, true>(a1, lds, lds_addr, OK_, OV, 16 * wave, lane);
            mma128<false, false>(a2, lds, lds_addr, OQ, OR, 16 * wave, lane);
            const float xi = exp2f((float)(i + 1) * l2g);
            float s1 = 0.f, s2 = 0.f;
#pragma unroll
            for (int nb = 0; nb < 8; ++nb)
#pragma unroll
                for (int e = 0; e < 4; ++e) { const float o = a1[nb][e] + xi * a2[nb][e]; a1[nb][e] = o; s1 += o; s2 += o * o; }
            s1 += __shfl_xor(s1, 16); s1 += __shfl_xor(s1, 32); s2 += __shfl_xor(s2, 16); s2 += __shfl_xor(s2, 32);
            const float mu = s1 * (1.0f / 128.0f), var = fmaxf(s2 * (1.0f / 128.0f) - mu * mu, 0.f), rs = 1.0f / sqrtf(var + EPS);
            const size_t tok = tok0 + i;
#pragma unroll
            for (int nb = 0; nb < 8; ++nb) {
                const int d = 16 * nb + 4 * fq;
                const u32x2 gw = *(const u32x2*)(GB + tok * 512 + h * 128 + d);
                const f32x4 gg = *(const f32x4*)(gn_gain + h * 128 + d);
                const float g0 = bf_lo(gw.x), g1 = bf_hi(gw.x), g2 = bf_lo(gw.y), g3 = bf_hi(gw.y);
                const float y0 = (a1[nb][0] - mu) * rs * gg[0] * (g0 / (1.0f + __expf(-g0)));
                const float y1 = (a1[nb][1] - mu) * rs * gg[1] * (g1 / (1.0f + __expf(-g1)));
                const float y2 = (a1[nb][2] - mu) * rs * gg[2] * (g2 / (1.0f + __expf(-g2)));
                const float y3 = (a1[nb][3] - mu) * rs * gg[3] * (g3 / (1.0f + __expf(-g3)));
                u32x2 w; w.x = cvt_pk_bf16(y0, y1); w.y = cvt_pk_bf16(y2, y3);
                *(u32x2*)(YMIX + tok * 1024 + h * 128 + d) = w;
            }
            __syncthreads();
        }
    }
#undef R3_ISSUE
    SEAM(4);

    if (IN(5)) for (int rep = 0; rep < REPS(5); ++rep) {
        pg8::Gemm g{YSSM, WGLU, 512, 512, 512, 0, 0}; pg8::StaticOrder S; S.init(T, 1024, G, bx);
        pg8::EpiGlu E{YMIX};
        pg8::gemm_phase(lds, g, S, E);
    }
    SEAM(5);

    if (IN(6)) for (int rep = 0; rep < REPS(6); ++rep) {
        pg8::Gemm g{YMIX, WOUT, DM, DM, DM, 0, 0}; pg8::StaticOrder S; S.init(T, DM, G, bx);
        pg8::EpiSS E{MIXB, SS};
        pg8::gemm_phase(lds, g, S, E);
    }
    SEAM(6);

    if (IN(7)) for (int rep = 0; rep < REPS(7); ++rep) {
        const int gw = bx * 8 + wave, NGW = G * 8;
        for (int m = gw; m < T; m += NGW) {
            const f32x4* sp = (const f32x4*)(SS + (size_t)m * 16);
            const f32x4 p0 = sp[0], p1 = sp[1], p2 = sp[2], p3 = sp[3];
            const float ssum = ((p0[0] + p0[1]) + (p0[2] + p0[3])) + ((p1[0] + p1[1]) + (p1[2] + p1[3])) + ((p2[0] + p2[1]) + (p2[2] + p2[3])) + ((p3[0] + p3[1]) + (p3[2] + p3[3]));
            const float rstd = 1.0f / sqrtf(ssum * (1.0f / DM) + EPS);
            const f32x4* xr = (const f32x4*)(x + (size_t)m * DM) + lane;
            const u32x2* mr = (const u32x2*)(MIXB + (size_t)m * DM) + lane;
            const f32x4* gr = (const f32x4*)g_mix_post + lane;
            f32x4 v[4]; float s = 0.f;
#pragma unroll
            for (int j = 0; j < 4; ++j) {
                const f32x4 xv = xr[64 * j], gv = gr[64 * j]; const u32x2 mw = mr[64 * j];
                v[j][0] = xv[0] + bf_lo(mw.x) * rstd * gv[0]; v[j][1] = xv[1] + bf_hi(mw.x) * rstd * gv[1];
                v[j][2] = xv[2] + bf_lo(mw.y) * rstd * gv[2]; v[j][3] = xv[3] + bf_hi(mw.y) * rstd * gv[3];
                s += (v[j][0] * v[j][0] + v[j][1] * v[j][1]) + (v[j][2] * v[j][2] + v[j][3] * v[j][3]);
            }
            const float rstd1 = 1.0f / sqrtf(wave_sum(s) * (1.0f / DM) + EPS);
            u32x2* o8 = (u32x2*)(XN + (size_t)m * DM) + lane;
#pragma unroll
            for (int j = 0; j < 4; ++j) { u32x2 w; w.x = cvt_pk_bf16(v[j][0] * rstd1, v[j][1] * rstd1); w.y = cvt_pk_bf16(v[j][2] * rstd1, v[j][3] * rstd1); o8[64 * j] = w; }
        }
    }
    SEAM(7);

    if (IN(8)) for (int rep = 0; rep < REPS(8); ++rep) {
        pg8::Gemm g{XN, WFF1, DM, DM, DM, 0, 0}; pg8::StaticOrder S; S.init(T, DFF, G, bx);
        pg8::EpiRelu2 E{HID};
        pg8::gemm_phase(lds, g, S, E);
    }
    SEAM(8);

    if (IN(9)) for (int rep = 0; rep < REPS(9); ++rep) {
        pg8::Gemm g{HID, WFF2, DFF, DFF, DFF, 0, 0}; pg8::StaticOrder S; S.init(T, DM, G, bx);
        pg8::EpiSS E{MB, SS2};
        pg8::gemm_phase(lds, g, S, E);
    }
    SEAM(9);

    if (IN(10)) {
        const int gw = bx * 8 + wave, NGW = G * 8;
        for (int m = gw; m < T; m += NGW) {
            const f32x4 pa = *((const f32x4*)(SS + (size_t)m * 16) + (lane & 3)), pb = *((const f32x4*)(SS2 + (size_t)m * 16) + (lane & 3));
            float sa = (pa[0] + pa[1]) + (pa[2] + pa[3]), sb = (pb[0] + pb[1]) + (pb[2] + pb[3]);
            sa += __shfl_xor(sa, 1); sa += __shfl_xor(sa, 2); sb += __shfl_xor(sb, 1); sb += __shfl_xor(sb, 2);
            const float rstd1 = 1.0f / sqrtf(sa * (1.0f / DM) + EPS), rstd2 = 1.0f / sqrtf(sb * (1.0f / DM) + EPS);
            const f32x4* xr = (const f32x4*)(x + (size_t)m * DM) + lane;
            const u32x2* ar = (const u32x2*)(MIXB + (size_t)m * DM) + lane;
            const u32x2* mr = (const u32x2*)(MB + (size_t)m * DM) + lane;
            const f32x4* g1r = (const f32x4*)g_mix_post + lane; const f32x4* g2r = (const f32x4*)g_mlp_post + lane;
            f32x4* orow = (f32x4*)(out + (size_t)m * DM) + lane;
#pragma unroll
            for (int j = 0; j < 4; ++j) {
                f32x4 xv = xr[64 * j]; const f32x4 ga = g1r[64 * j], gb = g2r[64 * j]; const u32x2 aw = ar[64 * j], mw = mr[64 * j];
                xv[0] = (xv[0] + bf_lo(aw.x) * rstd1 * ga[0]) + bf_lo(mw.x) * rstd2 * gb[0]; xv[1] = (xv[1] + bf_hi(aw.x) * rstd1 * ga[1]) + bf_hi(mw.x) * rstd2 * gb[1];
                xv[2] = (xv[2] + bf_lo(aw.y) * rstd1 * ga[2]) + bf_lo(mw.y) * rstd2 * gb[2]; xv[3] = (xv[3] + bf_hi(aw.y) * rstd1 * ga[3]) + bf_hi(mw.y) * rstd2 * gb[3];
                orow[64 * j] = xv;
            }
        }
    }
#undef IN
#undef SEAM
}

extern "C" void kernel_launch(void* const* d_in, const int* in_sizes, int n_in, void* d_out, int out_size, void* d_ws, size_t ws_size, hipStream_t stream) {
    static int grid = 0;
    if (grid == 0) {
        int dev = 0, cus = 0, per_cu = 0;
        hipGetDevice(&dev);
        hipDeviceGetAttribute(&cus, hipDeviceAttributeMultiprocessorCount, dev);
        hipFuncSetAttribute((const void*)fwd_kernel, hipFuncAttributeMaxDynamicSharedMemorySize, LDS_BYTES);
        if (hipOccupancyMaxActiveBlocksPerMultiprocessor(&per_cu, (const void*)fwd_kernel, 512, LDS_BYTES) != hipSuccess || per_cu < 1) per_cu = 1;
        (void)hipGetLastError();
        grid = cus * per_cu;
        if (grid <= 0) grid = 256;
    }
    Args a{};
    for (int i = 0; i < 19; ++i) a.in[i] = (const float*)d_in[i];
    a.out = (float*)d_out; a.ws = (unsigned char*)d_ws;
#if N_LAUNCH_PER_PHASE
    for (int ph = 0; ph < NPHASE; ++ph) {
        a.ph_lo = ph; a.ph_hi = ph + 1;
        void* args[] = {&a};
        hipError_t e = hipLaunchCooperativeKernel((const void*)fwd_kernel, dim3(grid), dim3(512), args, LDS_BYTES, stream);
        if (e != hipSuccess) { fprintf(stderr, "cooperative launch (phase %d) failed: %s (grid %d)\n", ph, hipGetErrorString(e), grid); break; }
    }
#else
    a.ph_lo = 0; a.ph_hi = NPHASE;
    (void)hipMemsetAsync(d_ws, 0, 16384, stream);
    void* args[] = {&a};
    hipError_t e = hipLaunchCooperativeKernel((const void*)fwd_kernel, dim3(grid), dim3(512), args, LDS_BYTES, stream);
    if (e != hipSuccess) fprintf(stderr, "cooperative launch failed: %s (grid %d)\n", hipGetErrorString(e), grid);
#ifdef PROBE_EXTRA_PHASE
    {
        Args b = a; b.ph_lo = PROBE_EXTRA_PHASE; b.ph_hi = PROBE_EXTRA_PHASE + 1;
        void* args2[] = {&b};
        (void)hipLaunchCooperativeKernel((const void*)fwd_kernel, dim3(grid), dim3(512), args2, LDS_BYTES, stream);
    }
#endif
#endif
}
```

```cpp
#include <hip/hip_runtime.h>
#include <hip/hip_cooperative_groups.h>
#include <cstdio>
namespace cg = cooperative_groups;

#ifndef N_LAUNCH_PER_PHASE
#define N_LAUNCH_PER_PHASE 0
#endif

#ifndef PROBE_P4_DUP
#define PROBE_P4_DUP 0
#endif
#ifndef PROBE_P4_PART
#define PROBE_P4_PART 0
#endif
#ifndef PROBE_DUP
#define PROBE_DUP 0
#endif
#define REPS(k) (1 + ((PROBE_DUP >> (k)) & 1))
#define LAS __attribute__((address_space(3)))
typedef unsigned short bf16_t;
typedef short bf16x8 __attribute__((ext_vector_type(8)));
typedef float f32x4 __attribute__((ext_vector_type(4)));
typedef float f32x2 __attribute__((ext_vector_type(2)));
typedef unsigned u32x4 __attribute__((ext_vector_type(4)));
typedef unsigned u32x2 __attribute__((ext_vector_type(2)));

constexpr int T = 32768, SEQ = 8192, DM = 1024, NIN = 2560, DFF = 4096;
constexpr float EPS = 1e-6f;
constexpr int NPHASE = 11;

constexpr size_t MiB = 1u << 20;
constexpr size_t WS_WIN = 1 * MiB, WS_WGLU = 6 * MiB, WS_WOUT = 7 * MiB, WS_WFF1 = 9 * MiB, WS_WFF2 = 17 * MiB;
constexpr size_t WS_ROPE = 25 * MiB, WS_TW = 29 * MiB, WS_W1S = 49 * MiB, WS_SS = 53 * MiB, WS_SS2 = 55 * MiB, WS_HINC = 57 * MiB;
constexpr size_t WS_XN = 80 * MiB;
constexpr size_t WS_QB = 144 * MiB, WS_KB = 176 * MiB, WS_VB = 208 * MiB, WS_GB = 240 * MiB, WS_AU = 272 * MiB;
constexpr size_t WS_SST = 440 * MiB, WS_RTB = 376 * MiB, WS_YSSM = 408 * MiB;
constexpr size_t WS_YMIX = 312 * MiB;
constexpr size_t WS_HID = 144 * MiB;
constexpr size_t WS_MIXB = 400 * MiB;
constexpr size_t WS_MB = 80 * MiB;

constexpr int LDS_BYTES = 147456;
constexpr int TS = 272;
constexpr int TILE_B = 128 * TS;

typedef __bf16 bf16x2_t __attribute__((ext_vector_type(2)));
__device__ __forceinline__ unsigned cvt_pk_bf16(float lo, float hi) { f32x2 v = {lo, hi}; return __builtin_bit_cast(unsigned, __builtin_convertvector(v, bf16x2_t)); }
__device__ __forceinline__ float bf_lo(unsigned w) { return __uint_as_float(w << 16); }
__device__ __forceinline__ float bf_hi(unsigned w) { return __uint_as_float(w & 0xffff0000u); }
__device__ __forceinline__ bf16_t f2bf(float f) { return (bf16_t)(cvt_pk_bf16(f, 0.f) & 0xffffu); }
__device__ __forceinline__ float wave_sum(float v) {
#pragma unroll
    for (int o = 1; o < 64; o <<= 1) v += __shfl_xor(v, o);
    return v;
}
#define LDS_WAIT() asm volatile("s_waitcnt lgkmcnt(0)" ::: "memory")

namespace pg8 {
constexpr int BM = 256, BK = 64, HALF = 128, HTB = HALF * BK * 2, STAGE_BYTES = 8 * HTB, NXCD = 8, WGM = 8;
__device__ __forceinline__ int lds_byte(int r, int c) { const int st = (r >> 4) * 2 + (c >> 5), rr = r & 15, cc = c & 31, ob = rr * 64 + cc * 2; return st * 1024 + (ob ^ (((ob >> 9) & 1) << 5)); }
__device__ __forceinline__ void stage_rc(int b, int& R, int& C) { const int st = b / 1024, sb = b % 1024, swz = sb ^ (((sb >> 9) & 1) << 5); R = (st >> 1) * 16 + swz / 64; C = (st & 1) * 32 + (swz % 64) / 2; }
__device__ __forceinline__ int perm32(int rho) { const int n = rho >> 4, i = rho & 15; return 8 * (i >> 2) + 4 * n + (i & 3); }

struct Unit { int pm, pn, pb; };
struct Gemm { const bf16_t* A; const bf16_t* Bt; int lda, ldb, K; size_t bsA, bsB; };

struct StaticOrder {
    int nM, nN, nwg, G, c;
    __device__ void init(int M, int N, int G_, int c_) { nM = M / BM; nN = N / BM; nwg = nM * nN; G = G_; c = c_; }
    __device__ bool next(int i, Unit& u) const {
        const long L = (long)i * G + c; if (L >= nwg) return false;
        int wgid = (int)L; { const int q = nwg / NXCD, r = nwg % NXCD, xcd = wgid % NXCD, off = wgid / NXCD; wgid = (xcd < r ? xcd * (q + 1) : r * (q + 1) + (xcd - r) * q) + off; }
        const int nig = WGM * nN, gid = wgid / nig, fm = gid * WGM, gsz = (nM - fm) < WGM ? (nM - fm) : WGM;
        u.pm = fm + ((wgid % nig) % gsz); u.pn = (wgid % nig) / gsz; u.pb = 0; return true;
    }
};
struct BatchOrder {
    int G, c;
    __device__ bool next(int i, Unit& u) const {
        const int L = i * G + c; if (L >= 256) return false;
        const int xcd = L & 7, slot = L >> 3;
        u.pb = xcd * 4 + (slot >> 3); const int r = slot & 7; u.pm = r & 3; u.pn = r >> 2; return true;
    }
};

template <class Epi, class Sched>
__device__ __forceinline__ void gemm_phase(LAS unsigned char* lds, const Gemm g, const Sched& S, const Epi& E) {
    const int tid = threadIdx.x, wid = __builtin_amdgcn_readfirstlane(tid >> 6), lane = tid & 63, wr = wid >> 2, wc = wid & 3, fr = lane & 15, fq = lane >> 4;
    const int K = g.K, nt = K / BK;
    unsigned voffA[2], voffB[2];
#pragma unroll
    for (int i = 0; i < 2; ++i) { int R, C; stage_rc(tid * 16 + i * 8192, R, C); const int Rb = Epi::PERM ? ((R & ~31) + perm32(R & 31)) : R;
        voffA[i] = (unsigned)(R * g.lda + C) * 2u; voffB[i] = (unsigned)(Rb * g.ldb + C) * 2u; }
    const size_t kstep = (size_t)(BK * 2);
    const size_t hstepA = (size_t)HALF * g.lda * 2, hstepB = (size_t)HALF * g.ldb * 2;
    const size_t tstepA = 2 * hstepA, tstepB = 2 * hstepB;
    const unsigned ldsw = (unsigned)wid * 1024u;
    const int aoff = lds_byte(wr * 64 + fr, fq * 8), boff = lds_byte(wc * 32 + fr, fq * 8);
#define PG8_SA(b, h) (((b) * 2 + (h)) * HTB)
#define PG8_SB(b, h) ((4 + (b) * 2 + (h)) * HTB)
#define PG8_STAGE(bufoff, gbase, voff) do { _Pragma("unroll") for (int _i = 0; _i < 2; ++_i) \
        __builtin_amdgcn_global_load_lds((const unsigned*)((const char*)(gbase) + (voff)[_i]), (LAS unsigned*)(lds + (bufoff) + ldsw + _i * 8192), 16, 0, 0); } while (0)
#define PG8_LDA(dst, b, h) do { _Pragma("unroll") for (int m = 0; m < 4; ++m) _Pragma("unroll") for (int k = 0; k < 2; ++k) dst[m][k] = *(const LAS bf16x8*)(lds + PG8_SA(b, h) + aoff + m * 2048 + k * 1024); } while (0)
#define PG8_LDB(dst, b, h) do { _Pragma("unroll") for (int n = 0; n < 2; ++n) _Pragma("unroll") for (int k = 0; k < 2; ++k) dst[n][k] = *(const LAS bf16x8*)(lds + PG8_SB(b, h) + boff + n * 2048 + k * 1024); } while (0)
#define PG8_MMA(ai, bj, At, Bt) do { __builtin_amdgcn_s_setprio(1); _Pragma("unroll") for (int m = 0; m < 4; ++m) _Pragma("unroll") for (int n = 0; n < 2; ++n) _Pragma("unroll") for (int k = 0; k < 2; ++k) \
        acc[ai][bj][m][n] = __builtin_amdgcn_mfma_f32_16x16x32_bf16(Bt[n][k], At[m][k], acc[ai][bj][m][n], 0, 0, 0); __builtin_amdgcn_s_setprio(0); } while (0)
#define PG8_WAIT_V(n) asm volatile("s_waitcnt vmcnt(" #n ")" ::: "memory")
#define PG8_WAIT_L(n) asm volatile("s_waitcnt lgkmcnt(" #n ")" ::: "memory")
#define PG8_BAR __builtin_amdgcn_s_barrier()
#define PG8_SCHED __builtin_amdgcn_sched_barrier(0)
    Unit cur, nxt; int ui = 0;
    if (!S.next(0, cur)) return;
    f32x4 acc[2][2][4][2];
#pragma unroll
    for (int a = 0; a < 2; ++a)
#pragma unroll
        for (int b = 0; b < 2; ++b)
#pragma unroll
            for (int m = 0; m < 4; ++m)
#pragma unroll
                for (int n = 0; n < 2; ++n) acc[a][b][m][n] = (f32x4){0.f, 0.f, 0.f, 0.f};
    bf16x8 At[4][2], B0[2][2], B1[2][2];
    const char* cA = (const char*)g.A + (size_t)cur.pb * g.bsA * 2 + (size_t)cur.pm * tstepA;
    const char* cB = (const char*)g.Bt + (size_t)cur.pb * g.bsB * 2 + (size_t)cur.pn * tstepB;
    PG8_STAGE(PG8_SB(0, 0), cB, voffB); PG8_STAGE(PG8_SA(0, 0), cA, voffA); PG8_STAGE(PG8_SB(0, 1), cB + hstepB, voffB); PG8_STAGE(PG8_SA(0, 1), cA + hstepA, voffA);
    if (wr == 1) PG8_BAR;
    PG8_WAIT_V(4); PG8_BAR;
    PG8_STAGE(PG8_SB(1, 0), cB + kstep, voffB); PG8_STAGE(PG8_SA(1, 0), cA + kstep, voffA); PG8_STAGE(PG8_SB(1, 1), cB + hstepB + kstep, voffB);
    PG8_WAIT_V(6); PG8_BAR;
    for (;;) {
        const bool has_next = S.next(ui + 1, nxt);
        const char* nA = has_next ? (const char*)g.A + (size_t)nxt.pb * g.bsA * 2 + (size_t)nxt.pm * tstepA : cA;
        const char* nB = has_next ? (const char*)g.Bt + (size_t)nxt.pb * g.bsB * 2 + (size_t)nxt.pn * tstepB : cB;
        for (int t = 0; t < nt; t += 2) {
            const bool last = (t == nt - 2);
            const char* a1 = cA + (size_t)(t + 1) * kstep;
            const char* a2 = last ? nA : cA + (size_t)(t + 2) * kstep; const char* b2 = last ? nB : cB + (size_t)(t + 2) * kstep;
            const char* a3 = a2 + kstep; const char* b3 = b2 + kstep;
            PG8_LDB(B0, 0, 0); PG8_SCHED; PG8_LDA(At, 0, 0); PG8_STAGE(PG8_SA(1, 1), a1 + hstepA, voffA);
            PG8_WAIT_L(8); PG8_BAR; PG8_WAIT_L(0); PG8_MMA(0, 0, At, B0); PG8_BAR; PG8_SCHED;
            PG8_LDB(B1, 0, 1); PG8_STAGE(PG8_SB(0, 0), b2, voffB);
            PG8_BAR; PG8_WAIT_L(0); PG8_MMA(0, 1, At, B1); PG8_BAR;
            PG8_LDA(At, 0, 1); PG8_STAGE(PG8_SA(0, 0), a2, voffA);
            PG8_BAR; PG8_WAIT_L(0); PG8_MMA(1, 0, At, B0); PG8_BAR; PG8_SCHED;
            PG8_STAGE(PG8_SB(0, 1), b2 + hstepB, voffB);
            PG8_WAIT_V(6); PG8_BAR; PG8_MMA(1, 1, At, B1); PG8_BAR;
            PG8_LDB(B0, 1, 0); PG8_SCHED; PG8_LDA(At, 1, 0); PG8_STAGE(PG8_SA(0, 1), a2 + hstepA, voffA);
            PG8_WAIT_L(8); PG8_BAR; PG8_WAIT_L(0); PG8_MMA(0, 0, At, B0); PG8_BAR; PG8_SCHED;
            PG8_LDB(B1, 1, 1); PG8_STAGE(PG8_SB(1, 0), b3, voffB);
            PG8_BAR; PG8_WAIT_L(0); PG8_MMA(0, 1, At, B1); PG8_BAR;
            PG8_LDA(At, 1, 1); PG8_STAGE(PG8_SA(1, 0), a3, voffA);
            PG8_BAR; PG8_WAIT_L(0); PG8_MMA(1, 0, At, B0); PG8_BAR; PG8_SCHED;
            PG8_STAGE(PG8_SB(1, 1), b3 + hstepB, voffB);
            PG8_WAIT_V(6); PG8_BAR; PG8_MMA(1, 1, At, B1); PG8_BAR;
        }
        E(acc, cur, wr, wc, fr, fq);
        if (!has_next) break;
#pragma unroll
        for (int a = 0; a < 2; ++a)
#pragma unroll
            for (int b = 0; b < 2; ++b)
#pragma unroll
                for (int m = 0; m < 4; ++m)
#pragma unroll
                    for (int n = 0; n < 2; ++n) acc[a][b][m][n] = (f32x4){0.f, 0.f, 0.f, 0.f};
        cur = nxt; cA = nA; cB = nB; ++ui;
    }
    PG8_WAIT_V(0);
    if (wr == 0) PG8_BAR;
    PG8_BAR;
#undef PG8_SA
#undef PG8_SB
#undef PG8_STAGE
#undef PG8_LDA
#undef PG8_LDB
#undef PG8_MMA
#undef PG8_WAIT_V
#undef PG8_WAIT_L
#undef PG8_BAR
#undef PG8_SCHED
}

__device__ __forceinline__ u32x4 pack8(const f32x4 v0, const f32x4 v1) {
    u32x4 w; w.x = cvt_pk_bf16(v0[0], v0[1]); w.y = cvt_pk_bf16(v0[2], v0[3]); w.z = cvt_pk_bf16(v1[0], v1[1]); w.w = cvt_pk_bf16(v1[2], v1[3]); return w;
}
__device__ __forceinline__ f32x4 rope4(const f32x4 v, const f32x4 cs) {
    f32x4 r; r[0] = v[0] * cs[0] - v[1] * cs[1]; r[1] = v[0] * cs[1] + v[1] * cs[0]; r[2] = v[2] * cs[2] - v[3] * cs[3]; r[3] = v[2] * cs[3] + v[3] * cs[2]; return r;
}
struct EpiInProj {
    static constexpr bool PERM = true;
    bf16_t *Q, *Kb, *V, *Gt, *AU; const float* rope;
    __device__ __forceinline__ void operator()(const f32x4 (&acc)[2][2][4][2], const Unit& u, int wr, int wc, int fr, int fq) const {
        const int sect = u.pn >> 1;
        const int row0 = u.pm * BM + wr * 64 + fr;
        const int colt = (u.pn & 1) * 256 + wc * 32 + 8 * fq;
        if (sect <= 1) {
            bf16_t* O = sect ? Kb : Q;
#pragma unroll
            for (int ai = 0; ai < 2; ++ai)
#pragma unroll
                for (int m = 0; m < 4; ++m) {
                    const int row = row0 + ai * HALF + m * 16, pos = row & (SEQ - 1);
                    const float* rp = rope + ((size_t)pos * 64 + 16 * wc + 4 * fq) * 2;
                    const f32x4 cs0 = *(const f32x4*)rp, cs1 = *(const f32x4*)(rp + 4);
#pragma unroll
                    for (int bj = 0; bj < 2; ++bj) {
                        const f32x4 v0 = rope4(acc[ai][bj][m][0], cs0), v1 = rope4(acc[ai][bj][m][1], cs1);
                        *(u32x4*)(O + (size_t)row * 512 + colt + bj * HALF) = pack8(v0, v1);
                    }
                }
        } else if (sect <= 3) {
            bf16_t* O = (sect == 2) ? V : Gt;
#pragma unroll
            for (int ai = 0; ai < 2; ++ai)
#pragma unroll
                for (int m = 0; m < 4; ++m) {
                    const int row = row0 + ai * HALF + m * 16;
#pragma unroll
                    for (int bj = 0; bj < 2; ++bj) *(u32x4*)(O + (size_t)row * 512 + colt + bj * HALF) = pack8(acc[ai][bj][m][0], acc[ai][bj][m][1]);
                }
        } else {
#pragma unroll
            for (int ai = 0; ai < 2; ++ai)
#pragma unroll
                for (int m = 0; m < 4; ++m) {
                    const int row = row0 + ai * HALF + m * 16, cr = row >> 5, s = row & 31;
#pragma unroll
                    for (int bj = 0; bj < 2; ++bj) {
                        const int cu = colt + bj * HALF, g = cu >> 4, c0 = cu & 15;
                        *(u32x4*)(AU + ((size_t)(g * 1024 + cr) * 640 + s * 16 + c0)) = pack8(acc[ai][bj][m][0], acc[ai][bj][m][1]);
                    }
                }
        }
    }
};
struct EpiGlu {
    static constexpr bool PERM = true;
    bf16_t* Y;
    __device__ __forceinline__ void operator()(const f32x4 (&acc)[2][2][4][2], const Unit& u, int wr, int wc, int fr, int fq) const {
        const int row0 = u.pm * BM + wr * 64 + fr, col = 512 + u.pn * 128 + wc * 32 + 8 * fq;
#pragma unroll
        for (int ai = 0; ai < 2; ++ai)
#pragma unroll
            for (int m = 0; m < 4; ++m) {
                const int row = row0 + ai * HALF + m * 16;
                f32x4 y0, y1;
#pragma unroll
                for (int j = 0; j < 4; ++j) {
                    y0[j] = acc[ai][0][m][0][j] / (1.0f + __expf(-acc[ai][1][m][0][j]));
                    y1[j] = acc[ai][0][m][1][j] / (1.0f + __expf(-acc[ai][1][m][1][j]));
                }
                *(u32x4*)(Y + (size_t)row * 1024 + col) = pack8(y0, y1);
            }
    }
};
struct EpiSS {
    static constexpr bool PERM = true;
    bf16_t* O; float* SS;
    __device__ __forceinline__ void operator()(const f32x4 (&acc)[2][2][4][2], const Unit& u, int wr, int wc, int fr, int fq) const {
        const int row0 = u.pm * BM + wr * 64 + fr, col = u.pn * BM + wc * 32 + 8 * fq;
#pragma unroll
        for (int ai = 0; ai < 2; ++ai)
#pragma unroll
            for (int m = 0; m < 4; ++m) {
                const int row = row0 + ai * HALF + m * 16; float q = 0.f;
#pragma unroll
                for (int bj = 0; bj < 2; ++bj) {
                    const f32x4 v0 = acc[ai][bj][m][0], v1 = acc[ai][bj][m][1];
                    q += (v0[0] * v0[0] + v0[1] * v0[1]) + (v0[2] * v0[2] + v0[3] * v0[3]) + (v1[0] * v1[0] + v1[1] * v1[1]) + (v1[2] * v1[2] + v1[3] * v1[3]);
                    *(u32x4*)(O + (size_t)row * 1024 + col + bj * HALF) = pack8(v0, v1);
                }
                q += __shfl_xor(q, 16); q += __shfl_xor(q, 32);
                if (fq == 0) SS[(size_t)row * 16 + u.pn * 4 + wc] = q;
            }
    }
};
struct EpiRelu2 {
    static constexpr bool PERM = true;
    bf16_t* O;
    __device__ __forceinline__ void operator()(const f32x4 (&acc)[2][2][4][2], const Unit& u, int wr, int wc, int fr, int fq) const {
        const int row0 = u.pm * BM + wr * 64 + fr, col = u.pn * BM + wc * 32 + 8 * fq;
#pragma unroll
        for (int ai = 0; ai < 2; ++ai)
#pragma unroll
            for (int m = 0; m < 4; ++m) {
                const int row = row0 + ai * HALF + m * 16;
#pragma unroll
                for (int bj = 0; bj < 2; ++bj) {
                    f32x4 v0 = acc[ai][bj][m][0], v1 = acc[ai][bj][m][1];
#pragma unroll
                    for (int j = 0; j < 4; ++j) { const float a = fmaxf(v0[j], 0.f), b = fmaxf(v1[j], 0.f); v0[j] = a * a; v1[j] = b * b; }
                    *(u32x4*)(O + (size_t)row * DFF + col + bj * HALF) = pack8(v0, v1);
                }
            }
    }
};
struct EpiSsm {
    static constexpr bool PERM = true;
    const bf16_t* AU; const float* dskip; bf16_t* Y;
    __device__ __forceinline__ void operator()(const f32x4 (&acc)[2][2][4][2], const Unit& u, int wr, int wc, int fr, int fq) const {
        const int g = u.pb;
        const int row0 = u.pm * BM + wr * 64 + fr, colt = u.pn * BM + wc * 32 + 8 * fq;
        const int c0 = 8 * (fq & 1);
        const f32x4 d0 = *(const f32x4*)(dskip + g * 16 + c0), d1 = *(const f32x4*)(dskip + g * 16 + c0 + 4);
#pragma unroll
        for (int ai = 0; ai < 2; ++ai)
#pragma unroll
            for (int m = 0; m < 4; ++m) {
                const int cr = row0 + ai * HALF + m * 16;
#pragma unroll
                for (int bj = 0; bj < 2; ++bj) {
                    const int col = colt + bj * HALF, s = col >> 4;
                    const u32x4 uw = *(const u32x4*)(AU + ((size_t)(g * 1024 + cr) * 640 + col));
                    f32x4 v0 = acc[ai][bj][m][0], v1 = acc[ai][bj][m][1];
                    v0[0] += d0[0] * bf_lo(uw.x); v0[1] += d0[1] * bf_hi(uw.x); v0[2] += d0[2] * bf_lo(uw.y); v0[3] += d0[3] * bf_hi(uw.y);
                    v1[0] += d1[0] * bf_lo(uw.z); v1[1] += d1[1] * bf_hi(uw.z); v1[2] += d1[2] * bf_lo(uw.w); v1[3] += d1[3] * bf_hi(uw.w);
#pragma unroll
                    for (int j = 0; j < 4; ++j) {
                        const float a = v0[j], za = 1.5957691216f * (a + 0.044715f * a * a * a); v0[j] = a / (1.0f + __expf(-za));
                        const float b = v1[j], zb = 1.5957691216f * (b + 0.044715f * b * b * b); v1[j] = b / (1.0f + __expf(-zb));
                    }
                    const size_t tok = (size_t)cr * 32 + s;
                    *(u32x4*)(Y + tok * 512 + g * 16 + c0) = pack8(v0, v1);
                }
            }
    }
};
}

__device__ __forceinline__ bf16x8 frag_nat(const LAS unsigned char* tile, int idx0, int k0, int fr, int fq) {
    return *(const LAS bf16x8*)(tile + (idx0 + fr) * TS + (k0 + 8 * fq) * 2);
}
__device__ __forceinline__ bf16x8 frag_tr(unsigned tile_addr, int k0, int idx0, int lane) {
    const int g = lane >> 4, q = (lane & 15) >> 2, p = lane & 3;
    const unsigned addr = tile_addr + (unsigned)((k0 + 8 * g + q) * TS + (idx0 + 4 * p) * 2);
    u32x2 lo, hi;
    asm volatile("ds_read_b64_tr_b16 %0, %2\n\tds_read_b64_tr_b16 %1, %2 offset:1088\n\ts_waitcnt lgkmcnt(0)" : "=&v"(lo), "=&v"(hi) : "v"(addr) : "memory");
    u32x4 r; r.x = lo.x; r.y = lo.y; r.z = hi.x; r.w = hi.y;
    return __builtin_bit_cast(bf16x8, r);
}
__device__ __forceinline__ void frags_tr8(bf16x8 (&b)[8], unsigned tile_addr, int k0, int lane) {
    const int g = lane >> 4, q = (lane & 15) >> 2, p = lane & 3;
    const unsigned addr = tile_addr + (unsigned)((k0 + 8 * g + q) * TS + (4 * p) * 2);
    u32x2 r0, r1, r2, r3, r4, r5, r6, r7, r8, r9, r10, r11, r12, r13, r14, r15;
    asm volatile(
        "ds_read_b64_tr_b16 %0, %16\n\t"
        "ds_read_b64_tr_b16 %1, %16 offset:1088\n\t"
        "ds_read_b64_tr_b16 %2, %16 offset:32\n\t"
        "ds_read_b64_tr_b16 %3, %16 offset:1120\n\t"
        "ds_read_b64_tr_b16 %4, %16 offset:64\n\t"
        "ds_read_b64_tr_b16 %5, %16 offset:1152\n\t"
        "ds_read_b64_tr_b16 %6, %16 offset:96\n\t"
        "ds_read_b64_tr_b16 %7, %16 offset:1184\n\t"
        "ds_read_b64_tr_b16 %8, %16 offset:128\n\t"
        "ds_read_b64_tr_b16 %9, %16 offset:1216\n\t"
        "ds_read_b64_tr_b16 %10, %16 offset:160\n\t"
        "ds_read_b64_tr_b16 %11, %16 offset:1248\n\t"
        "ds_read_b64_tr_b16 %12, %16 offset:192\n\t"
        "ds_read_b64_tr_b16 %13, %16 offset:1280\n\t"
        "ds_read_b64_tr_b16 %14, %16 offset:224\n\t"
        "ds_read_b64_tr_b16 %15, %16 offset:1312\n\t"
        "s_waitcnt lgkmcnt(0)"
        : "=&v"(r0), "=&v"(r1), "=&v"(r2), "=&v"(r3), "=&v"(r4), "=&v"(r5), "=&v"(r6), "=&v"(r7),
          "=&v"(r8), "=&v"(r9), "=&v"(r10), "=&v"(r11), "=&v"(r12), "=&v"(r13), "=&v"(r14), "=&v"(r15)
        : "v"(addr) : "memory");
    u32x4 w;
    w.x = r0.x; w.y = r0.y; w.z = r1.x; w.w = r1.y; b[0] = __builtin_bit_cast(bf16x8, w);
    w.x = r2.x; w.y = r2.y; w.z = r3.x; w.w = r3.y; b[1] = __builtin_bit_cast(bf16x8, w);
    w.x = r4.x; w.y = r4.y; w.z = r5.x; w.w = r5.y; b[2] = __builtin_bit_cast(bf16x8, w);
    w.x = r6.x; w.y = r6.y; w.z = r7.x; w.w = r7.y; b[3] = __builtin_bit_cast(bf16x8, w);
    w.x = r8.x; w.y = r8.y; w.z = r9.x; w.w = r9.y; b[4] = __builtin_bit_cast(bf16x8, w);
    w.x = r10.x; w.y = r10.y; w.z = r11.x; w.w = r11.y; b[5] = __builtin_bit_cast(bf16x8, w);
    w.x = r12.x; w.y = r12.y; w.z = r13.x; w.w = r13.y; b[6] = __builtin_bit_cast(bf16x8, w);
    w.x = r14.x; w.y = r14.y; w.z = r15.x; w.w = r15.y; b[7] = __builtin_bit_cast(bf16x8, w);
}
template <bool ATR, bool BTR>
__device__ __forceinline__ void mma128(f32x4 (&acc)[8], const LAS unsigned char* lds, unsigned lds_addr, int offA, int offB, int m0, int lane) {
    const int fr = lane & 15, fq = lane >> 4;
#pragma unroll
    for (int ks = 0; ks < 4; ++ks) {
        bf16x8 af, bfr[8];
        if (ATR) af = frag_tr(lds_addr + offA, 32 * ks, m0, lane); else af = frag_nat(lds + offA, m0, 32 * ks, fr, fq);
        if (BTR) frags_tr8(bfr, lds_addr + offB, 32 * ks, lane);
        else {
#pragma unroll
            for (int n = 0; n < 8; ++n) bfr[n] = frag_nat(lds + offB, 16 * n, 32 * ks, fr, fq);
        }
#pragma unroll
        for (int n = 0; n < 8; ++n) acc[n] = __builtin_amdgcn_mfma_f32_16x16x32_bf16(bfr[n], af, acc[n], 0, 0, 0);
    }
}
__device__ __forceinline__ void tile_load(LAS unsigned char* dst, const bf16_t* src, int ld, int tid) {
    u32x4 v[4];
#pragma unroll
    for (int i = 0; i < 4; ++i) { const int q = tid + 512 * i, row = q >> 4, pc = q & 15; v[i] = *(const u32x4*)(src + (size_t)row * ld + pc * 8); }
#pragma unroll
    for (int i = 0; i < 4; ++i) { const int q = tid + 512 * i, row = q >> 4, pc = q & 15; *(LAS u32x4*)(dst + row * TS + pc * 16) = v[i]; }
}
__device__ __forceinline__ void tile_load_zeta(LAS unsigned char* dst, const bf16_t* src, int ld, int tid, float l2g) {
    u32x4 v[4];
#pragma unroll
    for (int i = 0; i < 4; ++i) { const int q = tid + 512 * i, row = q >> 4, pc = q & 15; v[i] = *(const u32x4*)(src + (size_t)row * ld + pc * 8); }
#pragma unroll
    for (int i = 0; i < 4; ++i) {
        const int q = tid + 512 * i, row = q >> 4, pc = q & 15; const float z = exp2f((float)(127 - row) * l2g);
        u32x4 w;
        w.x = cvt_pk_bf16(bf_lo(v[i].x) * z, bf_hi(v[i].x) * z); w.y = cvt_pk_bf16(bf_lo(v[i].y) * z, bf_hi(v[i].y) * z);
        w.z = cvt_pk_bf16(bf_lo(v[i].z) * z, bf_hi(v[i].z) * z); w.w = cvt_pk_bf16(bf_lo(v[i].w) * z, bf_hi(v[i].w) * z);
        *(LAS u32x4*)(dst + row * TS + pc * 16) = w;
    }
}
__device__ __forceinline__ void tile_issue(u32x4 (&v)[4], const bf16_t* src, int ld, int tid) {
#pragma unroll
    for (int i = 0; i < 4; ++i) { const int q = tid + 512 * i, row = q >> 4, pc = q & 15; v[i] = *(const u32x4*)(src + (size_t)row * ld + pc * 8); }
}
__device__ __forceinline__ void tile_commit(LAS unsigned char* dst, const u32x4 (&v)[4], int tid) {
#pragma unroll
    for (int i = 0; i < 4; ++i) { const int q = tid + 512 * i, row = q >> 4, pc = q & 15; *(LAS u32x4*)(dst + row * TS + pc * 16) = v[i]; }
}
__device__ __forceinline__ void tile_commit_zeta(LAS unsigned char* dst, const u32x4 (&v)[4], int tid, float l2g) {
#pragma unroll
    for (int i = 0; i < 4; ++i) {
        const int q = tid + 512 * i, row = q >> 4, pc = q & 15; const float z = exp2f((float)(127 - row) * l2g);
        u32x4 w;
        w.x = cvt_pk_bf16(bf_lo(v[i].x) * z, bf_hi(v[i].x) * z); w.y = cvt_pk_bf16(bf_lo(v[i].y) * z, bf_hi(v[i].y) * z);
        w.z = cvt_pk_bf16(bf_lo(v[i].z) * z, bf_hi(v[i].z) * z); w.w = cvt_pk_bf16(bf_lo(v[i].w) * z, bf_hi(v[i].w) * z);
        *(LAS u32x4*)(dst + row * TS + pc * 16) = w;
    }
}
__device__ __forceinline__ float ret_log2_gamma(int h) { const float g = 1.0f - exp2f(-5.0f - (4.0f / 3.0f) * (float)h); return log2f(g); }

__device__ __forceinline__ int dest_row(int mode, int n) {
    if (mode == 1) { if (n < 1024) { const int sect = n >> 9, w = n & 511, h = w >> 7, j = w & 127; return (sect << 9) + (h << 7) + ((j & 63) << 1) + (j >> 6); } return n; }
    if (mode == 2) { const int bj = n >> 9, rem = n & 511, pn = rem >> 7, j = rem & 127; return (pn << 8) + (bj << 7) + j; }
    return n;
}
struct TrItem { const float* W; bf16_t* WT; const float* gain; int K, N, mode, item; };
__device__ __forceinline__ void p0_tr_load(const TrItem& t, float (&v)[32], int lane) {
    const int nblk = t.N / 32, kb = t.item / nblk, nb = t.item % nblk, k0 = 64 * kb, n0 = 32 * nb;
    const float cs = (t.mode == 1 && n0 >= 512 && n0 < 1024) ? 0.08838834764831845f : 1.0f;
#pragma unroll
    for (int i = 0; i < 32; ++i) { const int kk = 2 * i + (lane >> 5); const float g = t.gain ? t.gain[k0 + kk] * cs : cs; v[i] = t.W[(size_t)(k0 + kk) * t.N + n0 + (lane & 31)] * g; }
}
__device__ __forceinline__ void p0_tr_finish(const TrItem& t, const float (&v)[32], LAS float* scr, int lane) {
    const int nblk = t.N / 32, kb = t.item / nblk, nb = t.item % nblk, k0 = 64 * kb, n0 = 32 * nb;
#pragma unroll
    for (int i = 0; i < 32; ++i) { const int kk = 2 * i + (lane >> 5); scr[kk * 33 + (lane & 31)] = v[i]; }
    LDS_WAIT();
    const int c = lane & 7;
#pragma unroll
    for (int j = 0; j < 4; ++j) { const int n = (lane >> 3) + 8 * j; const LAS float* s = scr + (8 * c) * 33 + n;
        u32x4 o; o.x = cvt_pk_bf16(s[0 * 33], s[1 * 33]); o.y = cvt_pk_bf16(s[2 * 33], s[3 * 33]); o.z = cvt_pk_bf16(s[4 * 33], s[5 * 33]); o.w = cvt_pk_bf16(s[6 * 33], s[7 * 33]);
        *(u32x4*)(t.WT + (size_t)dest_row(t.mode, n0 + n) * t.K + k0 + 8 * c) = o; }
    LDS_WAIT();
}
__device__ __forceinline__ void s5_pow(float lre, float lim, float dt, float j, float& pr, float& pi) {
    const float mag = expf(j * (dt * lre)); float s, c; sincosf(j * (dt * lim), &s, &c); pr = mag * c; pi = mag * s;
}
__device__ __forceinline__ void s5_coef(float lre, float lim, float dt, float& cr, float& ci) {
    float br, bi; s5_pow(lre, lim, dt, 1.0f, br, bi); br -= 1.0f;
    const float den = lre * lre + lim * lim; cr = (br * lre + bi * lim) / den; ci = (bi * lre - br * lim) / den;
}

#define XB_TMO      128
#define XB_XCNT(j)  (256  + 64 * (j))
#define XB_XSUB(j)  (1280 + 64 * (j))
#define XB_XGEN(j)  (2304 + 64 * (j))
#define XB_TOP      3328
#define XB_TOPGEN   3392
#define XCD_BAR_WORDS 3456
#define XB_SPIN_CAP (1u << 18)
__device__ __forceinline__ unsigned xb_ld(unsigned* p)              { return __hip_atomic_load(p, __ATOMIC_RELAXED, __HIP_MEMORY_SCOPE_AGENT); }
__device__ __forceinline__ unsigned xb_add(unsigned* p, unsigned v) { return __hip_atomic_fetch_add(p, v, __ATOMIC_RELAXED, __HIP_MEMORY_SCOPE_AGENT); }
__device__ __forceinline__ unsigned xb_xcc_id() { return (unsigned)__builtin_amdgcn_s_getreg((3 << 11) | 20) & 0xFu; }
#define XB_SPIN(cond, bar) do { unsigned _sp = 0; while (cond) { __builtin_amdgcn_s_sleep(1); \
    if ((++_sp & 255u) == 0u) { if (xb_ld(&(bar)[XB_TMO])) break; if (_sp > XB_SPIN_CAP) { atomicAdd(&(bar)[XB_TMO], 1u); break; } } } } while (0)
struct XcdBarrier { unsigned* bar; unsigned x; volatile LAS unsigned* st; };
__device__ __forceinline__ XcdBarrier xcd_barrier_post(unsigned* bar, volatile LAS unsigned* st) {
    XcdBarrier b; b.bar = bar; b.x = xb_xcc_id(); b.st = st;
    if (threadIdx.x == 0) (void)xb_add(&bar[XB_XCNT(b.x)], 1u);
    return b;
}
__device__ __forceinline__ void xcd_barrier_complete(unsigned* bar, unsigned x, unsigned& nloc, unsigned& nx) {
    const unsigned G = gridDim.x * gridDim.y * gridDim.z;
    unsigned sum, cnt, mine, sp = 0u;
    for (;;) {
        sum = 0u; cnt = 0u; mine = 0u;
#pragma unroll
        for (unsigned j = 0; j < 16; ++j) { const unsigned c = xb_ld(&bar[XB_XCNT(j)]); sum += c; cnt += (c > 0u) ? 1u : 0u; mine = (j == x) ? c : mine; }
        if (sum == G) break;
        __builtin_amdgcn_s_sleep(1);
        if ((++sp & 255u) == 0u) { if (xb_ld(&bar[XB_TMO])) break; if (sp > XB_SPIN_CAP) { atomicAdd(&bar[XB_TMO], 1u); break; } }
    }
    nloc = mine > 0u ? mine : 1u; nx = cnt > 0u ? cnt : 1u;
}
__device__ __forceinline__ void xcd_barrier(const XcdBarrier& b) {
    asm volatile("s_waitcnt vmcnt(0)" ::: "memory");
    __syncthreads();
    if (threadIdx.x == 0) {
        unsigned* bar = b.bar;
        __builtin_amdgcn_s_waitcnt(0);
        unsigned nloc = b.st[0], nx = b.st[1];
        if (nloc == 0u) { xcd_barrier_complete(bar, b.x, nloc, nx); b.st[0] = nloc; b.st[1] = nx; }
        const unsigned old = xb_add(&bar[XB_XSUB(b.x)], 1u);
        const unsigned gen = old / nloc;
        if (old + 1u == (gen + 1u) * nloc) {
            __builtin_amdgcn_fence(__ATOMIC_RELEASE, "agent");
            asm volatile("s_waitcnt vmcnt(0)" ::: "memory");
            const unsigned og = xb_add(&bar[XB_TOP], 1u);
            const unsigned tg = og / nx;
            if (og + 1u == (tg + 1u) * nx) xb_add(&bar[XB_TOPGEN], 1u);
            else XB_SPIN(xb_ld(&bar[XB_TOPGEN]) == tg, bar);
            __builtin_amdgcn_fence(__ATOMIC_ACQUIRE, "agent");
            xb_add(&bar[XB_XGEN(b.x)], 1u);
            asm volatile("s_waitcnt vmcnt(0)" ::: "memory");
        } else {
            XB_SPIN(xb_ld(&bar[XB_XGEN(b.x)]) == gen, bar);
            __builtin_amdgcn_fence(__ATOMIC_ACQUIRE, "agent");
            asm volatile("s_waitcnt vmcnt(0)" ::: "memory");
        }
    }
    __syncthreads();
}

struct Args { const float* in[19]; float* out; unsigned char* ws; int ph_lo, ph_hi; };

__global__ void __launch_bounds__(512, 2) fwd_kernel(Args a) {
    extern __shared__ __attribute__((aligned(16))) unsigned char lds_raw[];
    LAS unsigned char* lds = (LAS unsigned char*)lds_raw;
    const unsigned lds_addr = (unsigned)(size_t)lds_raw;
    cg::grid_group grid = cg::this_grid();
    const int tid = threadIdx.x, lane = tid & 63, wave = __builtin_amdgcn_readfirstlane(tid >> 6);
    const int G = gridDim.x, bx = blockIdx.x;
    const int lo = a.ph_lo, hi = a.ph_hi;
    unsigned char* ws = a.ws;
#define IN(k) (lo <= (k) && (k) < hi)
#define SEAM(k) do { if (lo <= (k) && (k) + 1 < hi) xcd_barrier(xbar); } while (0)
    volatile LAS unsigned* misc = (volatile LAS unsigned*)(lds + (LDS_BYTES - 64));
    if (tid < 16) misc[tid] = 0u;
    __syncthreads();
    const XcdBarrier xbar = xcd_barrier_post((unsigned*)ws, misc);
    if (lo < 0) grid.sync();

    const float* x = a.in[0];
    const float* g_mix_pre = a.in[1]; const float* g_mix_post = a.in[2]; const float* w_in = a.in[3]; const float* gn_gain = a.in[4];
    const float* lam_re = a.in[5]; const float* lam_im = a.in[6]; const float* log_dt = a.in[7];
    const float* b_re = a.in[8]; const float* b_im = a.in[9]; const float* c_re = a.in[10]; const float* c_im = a.in[11]; const float* d_skip = a.in[12];
    const float* w_glu = a.in[13]; const float* w_out = a.in[14]; const float* g_mlp_pre = a.in[15]; const float* g_mlp_post = a.in[16];
    const float* w_ff1 = a.in[17]; const float* w_ff2 = a.in[18];
    float* out = a.out;

    bf16_t* WIN = (bf16_t*)(ws + WS_WIN); bf16_t* WGLU = (bf16_t*)(ws + WS_WGLU); bf16_t* WOUT = (bf16_t*)(ws + WS_WOUT);
    bf16_t* WFF1 = (bf16_t*)(ws + WS_WFF1); bf16_t* WFF2 = (bf16_t*)(ws + WS_WFF2);
    float* ROPE = (float*)(ws + WS_ROPE); bf16_t* TW = (bf16_t*)(ws + WS_TW); bf16_t* W1S = (bf16_t*)(ws + WS_W1S);
    float* XSC = (float*)(ws + 73 * MiB);
    float* SS = (float*)(ws + WS_SS); float* SS2 = (float*)(ws + WS_SS2); float* HINC = (float*)(ws + WS_HINC);
    bf16_t* XN = (bf16_t*)(ws + WS_XN);
    bf16_t* QB = (bf16_t*)(ws + WS_QB); bf16_t* KB = (bf16_t*)(ws + WS_KB); bf16_t* VB = (bf16_t*)(ws + WS_VB); bf16_t* GB = (bf16_t*)(ws + WS_GB);
    bf16_t* AU = (bf16_t*)(ws + WS_AU); bf16_t* SST = (bf16_t*)(ws + WS_SST); bf16_t* RTB = (bf16_t*)(ws + WS_RTB);
    bf16_t* YSSM = (bf16_t*)(ws + WS_YSSM); bf16_t* YMIX = (bf16_t*)(ws + WS_YMIX);
    bf16_t* MIXB = (bf16_t*)(ws + WS_MIXB); bf16_t* HID = (bf16_t*)(ws + WS_HID); bf16_t* MB = (bf16_t*)(ws + WS_MB);

    if (IN(0)) for (int rep = 0; rep < REPS(0); ++rep) {
        const int gw = bx * 8 + wave, NGW = G * 8;
        {
            LAS float* scr = (LAS float*)(lds + wave * 16384);
            constexpr int I_IN = (DM / 64) * (NIN / 32), I_GLU = (512 / 64) * (1024 / 32), I_OUT = (DM / 64) * (DM / 32), I_F1 = (DM / 64) * (DFF / 32), I_F2 = (DFF / 64) * (DM / 32);
            constexpr int NITEMS = I_IN + I_GLU + I_OUT + I_F1 + I_F2;
#define TR_DECODE(IT, t) do { int r_ = (IT); \
                if (r_ < I_IN) { t = TrItem{w_in, WIN, g_mix_pre, DM, NIN, 1, r_}; break; } r_ -= I_IN; \
                if (r_ < I_GLU) { t = TrItem{w_glu, WGLU, nullptr, 512, 1024, 2, r_}; break; } r_ -= I_GLU; \
                if (r_ < I_OUT) { t = TrItem{w_out, WOUT, nullptr, DM, DM, 0, r_}; break; } r_ -= I_OUT; \
                if (r_ < I_F1) { t = TrItem{w_ff1, WFF1, g_mlp_pre, DM, DFF, 0, r_}; break; } r_ -= I_F1; \
                t = TrItem{w_ff2, WFF2, nullptr, DFF, DM, 0, r_}; } while (0)
            int it = gw;
            TrItem cur, nxt; float va[32], vb[32];
            if (it < NITEMS) { TR_DECODE(it, cur); p0_tr_load(cur, va, lane); }
            while (it < NITEMS) {
                const int itn = it + NGW;
                if (itn < NITEMS) { TR_DECODE(itn, nxt); p0_tr_load(nxt, vb, lane); }
                p0_tr_finish(cur, va, scr, lane);
                it = itn;
                if (it >= NITEMS) break;
                const int itn2 = it + NGW;
                if (itn2 < NITEMS) { TR_DECODE(itn2, cur); p0_tr_load(cur, va, lane); }
                p0_tr_finish(nxt, vb, scr, lane);
                it = itn2;
            }
#undef TR_DECODE
        }
        for (int m = gw; m < T; m += 2 * NGW) {
            const int m2 = m + NGW;
            const bool has2 = m2 < T;
            const f32x4* xr0 = (const f32x4*)(x + (size_t)m * DM) + lane;
            const f32x4* xr1 = (const f32x4*)(x + (size_t)(has2 ? m2 : m) * DM) + lane;
            f32x4 v0[4], v1[4]; float s0 = 0.f, s1 = 0.f;
#pragma unroll
            for (int j = 0; j < 4; ++j) { v0[j] = xr0[64 * j]; v1[j] = xr1[64 * j]; }
#pragma unroll
            for (int j = 0; j < 4; ++j) {
                s0 += (v0[j][0] * v0[j][0] + v0[j][1] * v0[j][1]) + (v0[j][2] * v0[j][2] + v0[j][3] * v0[j][3]);
                s1 += (v1[j][0] * v1[j][0] + v1[j][1] * v1[j][1]) + (v1[j][2] * v1[j][2] + v1[j][3] * v1[j][3]);
            }
            const float q0 = sqrtf(wave_sum(s0) * (1.0f / DM) + EPS), q1 = sqrtf(wave_sum(s1) * (1.0f / DM) + EPS);
            const float r0 = 1.0f / q0, r1 = 1.0f / q1;
            if (lane == 0) { XSC[m] = q0; if (has2) XSC[m2] = q1; }
            u32x2* o0 = (u32x2*)(XN + (size_t)m * DM) + lane; u32x2* o1 = (u32x2*)(XN + (size_t)m2 * DM) + lane;
#pragma unroll
            for (int j = 0; j < 4; ++j) { u32x2 w; w.x = cvt_pk_bf16(v0[j][0] * r0, v0[j][1] * r0); w.y = cvt_pk_bf16(v0[j][2] * r0, v0[j][3] * r0); o0[64 * j] = w; }
            if (has2) {
#pragma unroll
                for (int j = 0; j < 4; ++j) { u32x2 w; w.x = cvt_pk_bf16(v1[j][0] * r1, v1[j][1] * r1); w.y = cvt_pk_bf16(v1[j][2] * r1, v1[j][3] * r1); o1[64 * j] = w; }
            }
        }
        const float rope_inv = (float)pow(10000.0, -(double)(tid & 63) / 64.0);
        for (int i = bx * 512 + tid; i < SEQ * 64; i += G * 512) {
            const int pos = i >> 6;
            const float inv = rope_inv;
            const float ang = (float)pos * inv; float s, c; sincosf(ang, &s, &c);
            *(f32x2*)(ROPE + (size_t)i * 2) = (f32x2){c, s};
        }
        for (int i = bx * 512 + tid; i < 32 * 32 * 64; i += G * 512) {
            {
                const int q = i & 63, t = (i >> 6) & 31, g = i >> 11;
                const float lre = fminf(lam_re[g * 64 + q], -1e-4f), lim = lam_im[g * 64 + q], dt = expf(log_dt[g]);
                float pr, pi; s5_pow(lre, lim, dt, (float)(t + 1), pr, pi);
#pragma unroll 4
                for (int c = 0; c < 16; ++c) {
                    const float cr = c_re[(g * 16 + c) * 64 + q], ci = c_im[(g * 16 + c) * 64 + q];
                    const float zr = cr * pr - ci * pi, zi = cr * pi + ci * pr;
                    bf16_t* row = TW + (size_t)(g * 512 + t * 16 + c) * 640 + 512;
                    row[q] = f2bf(zr); row[64 + q] = f2bf(-zi);
                }
            }
            {
                const int s = i & 31, p = (i >> 5) & 63, g = i >> 11;
                const float lre = fminf(lam_re[g * 64 + p], -1e-4f), lim = lam_im[g * 64 + p], dt = expf(log_dt[g]);
                float pr, pi, cr, ci; s5_pow(lre, lim, dt, (float)(31 - s), pr, pi); s5_coef(lre, lim, dt, cr, ci);
                const float wr_ = pr * cr - pi * ci, wi_ = pr * ci + pi * cr;
                float zr[16], zi[16];
#pragma unroll
                for (int c = 0; c < 16; ++c) { const float br = b_re[(g * 64 + p) * 16 + c], bi = b_im[(g * 64 + p) * 16 + c]; zr[c] = wr_ * br - wi_ * bi; zi[c] = wr_ * bi + wi_ * br; }
                u32x4* o0 = (u32x4*)(W1S + (size_t)(g * 128 + p) * 512 + s * 16);
                u32x4* o1 = (u32x4*)(W1S + (size_t)(g * 128 + 64 + p) * 512 + s * 16);
                u32x4 w;
                w.x = cvt_pk_bf16(zr[0], zr[1]); w.y = cvt_pk_bf16(zr[2], zr[3]); w.z = cvt_pk_bf16(zr[4], zr[5]); w.w = cvt_pk_bf16(zr[6], zr[7]); o0[0] = w;
                w.x = cvt_pk_bf16(zr[8], zr[9]); w.y = cvt_pk_bf16(zr[10], zr[11]); w.z = cvt_pk_bf16(zr[12], zr[13]); w.w = cvt_pk_bf16(zr[14], zr[15]); o0[1] = w;
                w.x = cvt_pk_bf16(zi[0], zi[1]); w.y = cvt_pk_bf16(zi[2], zi[3]); w.z = cvt_pk_bf16(zi[4], zi[5]); w.w = cvt_pk_bf16(zi[6], zi[7]); o1[0] = w;
                w.x = cvt_pk_bf16(zi[8], zi[9]); w.y = cvt_pk_bf16(zi[10], zi[11]); w.z = cvt_pk_bf16(zi[12], zi[13]); w.w = cvt_pk_bf16(zi[14], zi[15]); o1[1] = w;
            }
        }
        for (int i = bx * 512 + tid; i < 16384 * 64; i += G * 512) {
            const int piece = i & 63, row = i >> 6, t = (row >> 4) & 31;
            if (piece >= 2 * (t + 1)) *(u32x4*)(TW + (size_t)row * 640 + piece * 8) = (u32x4){0u, 0u, 0u, 0u};
        }
        __syncthreads();
        {
            LAS float* Bre = (LAS float*)lds; LAS float* Bim = Bre + 1024; LAS float* Cre = Bre + 2048; LAS float* Cim = Bre + 3072;
            LAS float* cpr = Bre + 4096; LAS float* cpi = cpr + 256;
            for (int it = bx; it < 256; it += G) {
                const int g = it >> 3, jq = it & 7;
                {
                    const int q0 = tid, q1 = tid + 512;
                    const float* s0 = (q0 < 256 ? b_re : b_im) + g * 1024 + (q0 & 255) * 4;
                    const float* s1 = (q1 < 768 ? c_re : c_im) + g * 1024 + (q1 & 255) * 4;
                    *(LAS f32x4*)(Bre + q0 * 4) = *(const f32x4*)s0;
                    *(LAS f32x4*)(Bre + q1 * 4) = *(const f32x4*)s1;
                }
                if (tid < 256) {
                    const int p = tid & 63, jl = tid >> 6;
                    const float lre = fminf(lam_re[g * 64 + p], -1e-4f), lim = lam_im[g * 64 + p], dt = expf(log_dt[g]);
                    float pr, pi, cr, ci; s5_pow(lre, lim, dt, (float)(4 * jq + jl), pr, pi); s5_coef(lre, lim, dt, cr, ci);
                    cpr[jl * 64 + p] = pr * cr - pi * ci; cpi[jl * 64 + p] = pr * ci + pi * cr;
                }
                __syncthreads();
                {
                    const int cc = tid & 255, c = cc >> 4, c2 = cc & 15, jh = tid >> 8;
                    float v0 = 0.f, v1 = 0.f;
#pragma unroll 8
                    for (int p = 0; p < 64; ++p) {
                        const float cr = Cre[c * 64 + p], ci = Cim[c * 64 + p], br = Bre[p * 16 + c2], bi = Bim[p * 16 + c2];
                        const float mr = cr * br - ci * bi, mi = cr * bi + ci * br;
                        v0 += mr * cpr[(2 * jh) * 64 + p] - mi * cpi[(2 * jh) * 64 + p];
                        v1 += mr * cpr[(2 * jh + 1) * 64 + p] - mi * cpi[(2 * jh + 1) * 64 + p];
                    }
                    const int jj0 = 4 * jq + 2 * jh;
                    const bf16_t w0 = f2bf(v0), w1 = f2bf(v1);
                    for (int t = jj0; t < 32; ++t) TW[(size_t)(g * 512 + t * 16 + c) * 640 + (t - jj0) * 16 + c2] = w0;
                    for (int t = jj0 + 1; t < 32; ++t) TW[(size_t)(g * 512 + t * 16 + c) * 640 + (t - jj0 - 1) * 16 + c2] = w1;
                }
                __syncthreads();
            }
        }
    }
    SEAM(0);

    if (IN(1)) for (int rep = 0; rep < REPS(1); ++rep) {
        pg8::Gemm g{XN, WIN, DM, DM, DM, 0, 0}; pg8::StaticOrder S; S.init(T, NIN, G, bx);
        pg8::EpiInProj E{QB, KB, VB, GB, AU, ROPE};
        pg8::gemm_phase(lds, g, S, E);
    }
    SEAM(1);

    if (IN(2)) for (int rep = 0; rep < REPS(2); ++rep) {
        const int fr = lane & 15, fq = lane >> 4;
        for (int it = bx; it < 256; it += G) {
            const int g = it >> 3, rt = it & 7;
            const bf16_t* pA = AU + (size_t)(g * 1024 + rt * 128) * 640; const bf16_t* pB = W1S + (size_t)(g * 128) * 512;
            f32x4 acc[8];
#pragma unroll
            for (int n = 0; n < 8; ++n) acc[n] = (f32x4){0.f, 0.f, 0.f, 0.f};
            u32x4 ra[4], rb[4];
            tile_issue(ra, pA, 640, tid); tile_issue(rb, pB, 512, tid);
            for (int kt = 0; kt < 4; ++kt) {
                tile_commit(lds, ra, tid); tile_commit(lds + TILE_B, rb, tid);
                __syncthreads();
                if (kt < 3) { tile_issue(ra, pA + (kt + 1) * 128, 640, tid); tile_issue(rb, pB + (kt + 1) * 128, 512, tid); }
                mma128<false, false>(acc, lds, lds_addr, 0, TILE_B, 16 * wave, lane);
                __syncthreads();
            }
            float* o = HINC + ((size_t)(g * 1024 + rt * 128 + 16 * wave + fr)) * 128 + 4 * fq;
#pragma unroll
            for (int n = 0; n < 8; ++n) *(f32x4*)(o + 16 * n) = acc[n];
        }
        {
            u32x4 rk[4], rv[4];
            int it = bx;
#define R1_ISSUE(IT) do { const int n_ = (IT) & 63, h_ = ((IT) >> 6) & 3, b_ = (IT) >> 8; const size_t t0_ = (size_t)b_ * SEQ + n_ * 128; \
                tile_issue(rk, KB + t0_ * 512 + h_ * 128, 512, tid); tile_issue(rv, VB + t0_ * 512 + h_ * 128, 512, tid); } while (0)
            if (it < 1024) R1_ISSUE(it);
            for (; it < 1024; it += G) {
                const int h = (it >> 6) & 3;
                const float l2g = ret_log2_gamma(h);
                tile_commit(lds, rk, tid); tile_commit_zeta(lds + TILE_B, rv, tid, l2g);
                __syncthreads();
                if (it + G < 1024) R1_ISSUE(it + G);
                f32x4 acc[8];
#pragma unroll
                for (int nb = 0; nb < 8; ++nb) acc[nb] = (f32x4){0.f, 0.f, 0.f, 0.f};
                mma128<true, true>(acc, lds, lds_addr, TILE_B, 0, 16 * wave, lane);
                bf16_t* o = SST + (size_t)it * 16384 + (16 * wave + fr) * 128 + 4 * fq;
#pragma unroll
                for (int nb = 0; nb < 8; ++nb) { u32x2 w; w.x = cvt_pk_bf16(acc[nb][0], acc[nb][1]); w.y = cvt_pk_bf16(acc[nb][2], acc[nb][3]); *(u32x2*)(o + 16 * nb) = w; }
                __syncthreads();
            }
#undef R1_ISSUE
        }
    }
    SEAM(2);

    if (IN(3)) for (int rep = 0; rep < REPS(3); ++rep) {
        for (int idx = bx * 512 + tid; idx < 16 * 8192; idx += G * 512) {
            const int bh = idx >> 13, e2 = idx & 8191, h = bh & 3;
            const float gch = exp2f(128.0f * ret_log2_gamma(h));
            const unsigned* sp = (const unsigned*)(SST + (size_t)bh * 64 * 16384 + 2 * e2);
            unsigned* rp = (unsigned*)(RTB + (size_t)bh * 64 * 16384 + 2 * e2);
            float r0 = 0.f, r1 = 0.f;
            for (int n0 = 0; n0 < 64; n0 += 16) {
                unsigned s[16];
#pragma unroll
                for (int j = 0; j < 16; ++j) s[j] = sp[(size_t)(n0 + j) * 8192];
#pragma unroll
                for (int j = 0; j < 16; ++j) { rp[(size_t)(n0 + j) * 8192] = cvt_pk_bf16(r0, r1); r0 = gch * r0 + bf_lo(s[j]); r1 = gch * r1 + bf_hi(s[j]); }
            }
        }
        {
            LAS float* X = (LAS float*)lds;
            for (int it = bx; it < 128; it += G) {
                const int b = it >> 5, g = it & 31, p = tid & 63, seg = tid >> 6;
                const float lre = fminf(lam_re[g * 64 + p], -1e-4f), lim = lam_im[g * 64 + p], dt = expf(log_dt[g]);
                float ar, ai, Ar, Ai; s5_pow(lre, lim, dt, 32.0f, ar, ai); s5_pow(lre, lim, dt, 1024.0f, Ar, Ai);
                const float* hp = HINC + ((size_t)(g * 1024 + b * 256 + seg * 32)) * 128 + p;
                float xr = 0.f, xi = 0.f;
                for (int i = 0; i < 32; ++i) { const float hr = hp[(size_t)i * 128], hi_ = hp[(size_t)i * 128 + 64]; const float nr = ar * xr - ai * xi + hr, ni = ar * xi + ai * xr + hi_; xr = nr; xi = ni; }
                X[(seg * 64 + p) * 2] = xr; X[(seg * 64 + p) * 2 + 1] = xi;
                __syncthreads();
                float cr = 0.f, ci = 0.f;
                for (int s = 0; s < seg; ++s) { const float tr = X[(s * 64 + p) * 2], ti = X[(s * 64 + p) * 2 + 1]; const float nr = Ar * cr - Ai * ci + tr, ni = Ar * ci + Ai * cr + ti; cr = nr; ci = ni; }
                bf16_t* op = AU + ((size_t)(g * 1024 + b * 256 + seg * 32)) * 640 + 512 + p;
                xr = cr; xi = ci;
                for (int i = 0; i < 32; ++i) {
                    op[(size_t)i * 640] = f2bf(xr); op[(size_t)i * 640 + 64] = f2bf(xi);
                    const float hr = hp[(size_t)i * 128], hi_ = hp[(size_t)i * 128 + 64]; const float nr = ar * xr - ai * xi + hr, ni = ar * xi + ai * xr + hi_; xr = nr; xi = ni;
                }
                __syncthreads();
            }
        }
    }
    SEAM(3);

    if (IN(4)) for (int rep = 0; rep < REPS(4); ++rep) {
        const bool solo = (hi - lo == 1);
        if (!(solo && PROBE_P4_PART == 2)) for (int rep4 = 0; rep4 < (PROBE_P4_DUP == 1 ? 2 : 1); ++rep4) {
            pg8::Gemm g{AU, TW, 640, 640, 640, (size_t)1024 * 640, (size_t)512 * 640}; pg8::BatchOrder S{G, bx};
            pg8::EpiSsm E{AU, d_skip, YSSM};
            pg8::gemm_phase(lds, g, S, E);
        }
        const int fr = lane & 15, fq = lane >> 4;
        constexpr int OQ = 0, OK_ = TILE_B, OV = 2 * TILE_B, OR = 3 * TILE_B;
        for (int rep4 = 0; rep4 < (PROBE_P4_DUP == 2 ? 2 : 1); ++rep4) {
        u32x4 rq[4], rk[4], rv[4], rr[4];
        int it = bx;
#define R3_ISSUE(IT) do { const int n_ = (IT) & 63, h_ = ((IT) >> 6) & 3, b_ = (IT) >> 8; const size_t t0_ = (size_t)b_ * SEQ + n_ * 128; \
            tile_issue(rq, QB + t0_ * 512 + h_ * 128, 512, tid); tile_issue(rk, KB + t0_ * 512 + h_ * 128, 512, tid); \
            tile_issue(rv, VB + t0_ * 512 + h_ * 128, 512, tid); tile_issue(rr, RTB + (size_t)(IT) * 16384, 128, tid); } while (0)
        if (solo && PROBE_P4_PART == 1) it = 1024;
        for (; it < 1024; it += G) {
            const int n = it & 63, h = (it >> 6) & 3, b = it >> 8;
            const float l2g = ret_log2_gamma(h);
            const size_t tok0 = (size_t)b * SEQ + n * 128;
            R3_ISSUE(it);
            tile_commit(lds + OQ, rq, tid); tile_commit(lds + OK_, rk, tid); tile_commit(lds + OV, rv, tid); tile_commit(lds + OR, rr, tid);
            __syncthreads();
            const int i = 16 * wave + fr;
            f32x4 sc[8];
#pragma unroll
            for (int nb = 0; nb < 8; ++nb) sc[nb] = (f32x4){0.f, 0.f, 0.f, 0.f};
            mma128<false, false>(sc, lds, lds_addr, OQ, OK_, 16 * wave, lane);
            __syncthreads();
#pragma unroll
            for (int nb = 0; nb < 8; ++nb) {
                f32x4 pv;
#pragma unroll
                for (int e = 0; e < 4; ++e) { const int j = 16 * nb + 4 * fq + e; pv[e] = (i >= j) ? sc[nb][e] * exp2f((float)(i - j) * l2g) : 0.f; }
                u32x2 w; w.x = cvt_pk_bf16(pv[0], pv[1]); w.y = cvt_pk_bf16(pv[2], pv[3]);
                *(LAS u32x2*)(lds + OK_ + i * TS + (16 * nb + 4 * fq) * 2) = w;
            }
            LDS_WAIT();
            __syncthreads();
            f32x4 a1[8], a2[8];
#pragma unroll
            for (int nb = 0; nb < 8; ++nb) { a1[nb] = (f32x4){0.f, 0.f, 0.f, 0.f}; a2[nb] = (f32x4){0.f, 0.f, 0.f, 0.f}; }
            mma128<false, true>(a1, lds, lds_addr, OK_, OV, 16 * wave, lane);
            mma128<false, false>(a2, lds, lds_addr, OQ, OR, 16 * wave, lane);
            const float xi = exp2f((float)(i + 1) * l2g);
            float s1 = 0.f, s2 = 0.f;
#pragma unroll
            for (int nb = 0; nb < 8; ++nb)
#pragma unroll
                for (int e = 0; e < 4; ++e) { const float o = a1[nb][e] + xi * a2[nb][e]; a1[nb][e] = o; s1 += o; s2 += o * o; }
            s1 += __shfl_xor(s1, 16); s1 += __shfl_xor(s1, 32); s2 += __shfl_xor(s2, 16); s2 += __shfl_xor(s2, 32);
            const float mu = s1 * (1.0f / 128.0f), var = fmaxf(s2 * (1.0f / 128.0f) - mu * mu, 0.f), rs = 1.0f / sqrtf(var + EPS);
            const size_t tok = tok0 + i;
#pragma unroll
            for (int nb = 0; nb < 8; ++nb) {
                const int d = 16 * nb + 4 * fq;
                const u32x2 gw = *(const u32x2*)(GB + tok * 512 + h * 128 + d);
                const f32x4 gg = *(const f32x4*)(gn_gain + h * 128 + d);
                const float g0 = bf_lo(gw.x), g1 = bf_hi(gw.x), g2 = bf_lo(gw.y), g3 = bf_hi(gw.y);
                const float y0 = (a1[nb][0] - mu) * rs * gg[0] * (g0 / (1.0f + __expf(-g0)));
                const float y1 = (a1[nb][1] - mu) * rs * gg[1] * (g1 / (1.0f + __expf(-g1)));
                const float y2 = (a1[nb][2] - mu) * rs * gg[2] * (g2 / (1.0f + __expf(-g2)));
                const float y3 = (a1[nb][3] - mu) * rs * gg[3] * (g3 / (1.0f + __expf(-g3)));
                u32x2 w; w.x = cvt_pk_bf16(y0, y1); w.y = cvt_pk_bf16(y2, y3);
                *(u32x2*)(YMIX + tok * 1024 + h * 128 + d) = w;
            }
            __syncthreads();
        }
        }
    }
#undef R3_ISSUE
    SEAM(4);

    if (IN(5)) for (int rep = 0; rep < REPS(5); ++rep) {
        pg8::Gemm g{YSSM, WGLU, 512, 512, 512, 0, 0}; pg8::StaticOrder S; S.init(T, 1024, G, bx);
        pg8::EpiGlu E{YMIX};
        pg8::gemm_phase(lds, g, S, E);
    }
    SEAM(5);

    if (IN(6)) for (int rep = 0; rep < REPS(6); ++rep) {
        pg8::Gemm g{YMIX, WOUT, DM, DM, DM, 0, 0}; pg8::StaticOrder S; S.init(T, DM, G, bx);
        pg8::EpiSS E{MIXB, SS};
        pg8::gemm_phase(lds, g, S, E);
    }
    SEAM(6);

    if (IN(7)) for (int rep = 0; rep < REPS(7); ++rep) {
        const int gw = bx * 8 + wave, NGW = G * 8;
        const f32x4* gr = (const f32x4*)g_mix_post + lane;
        f32x4 gv[4];
#pragma unroll
        for (int j = 0; j < 4; ++j) gv[j] = gr[64 * j];
        for (int m0 = gw; m0 < T; m0 += 2 * NGW) {
            f32x4 xv[2][4]; u32x2 mw[2][4]; float rs[2];
#pragma unroll
            for (int r = 0; r < 2; ++r) {
                const int m = (m0 + r * NGW < T) ? m0 + r * NGW : m0;
                const f32x4 pa = *((const f32x4*)(SS + (size_t)m * 16) + (lane & 3));
                float sa = (pa[0] + pa[1]) + (pa[2] + pa[3]); sa += __shfl_xor(sa, 1); sa += __shfl_xor(sa, 2);
                rs[r] = 1.0f / sqrtf(sa * (1.0f / DM) + EPS);
                const u32x2* xr = (const u32x2*)(XN + (size_t)m * DM) + lane; const u32x2* mr = (const u32x2*)(MIXB + (size_t)m * DM) + lane;
                const float xs = XSC[m];
#pragma unroll
                for (int j = 0; j < 4; ++j) { const u32x2 xw = xr[64 * j]; xv[r][j] = (f32x4){bf_lo(xw.x) * xs, bf_hi(xw.x) * xs, bf_lo(xw.y) * xs, bf_hi(xw.y) * xs}; mw[r][j] = mr[64 * j]; }
            }
#pragma unroll
            for (int r = 0; r < 2; ++r) {
                const int m = m0 + r * NGW;
                if (m < T) {
                    float sq = 0.f;
#pragma unroll
                    for (int j = 0; j < 4; ++j) {
                        f32x4& v = xv[r][j];
                        v[0] += bf_lo(mw[r][j].x) * rs[r] * gv[j][0]; v[1] += bf_hi(mw[r][j].x) * rs[r] * gv[j][1];
                        v[2] += bf_lo(mw[r][j].y) * rs[r] * gv[j][2]; v[3] += bf_hi(mw[r][j].y) * rs[r] * gv[j][3];
                        sq += (v[0] * v[0] + v[1] * v[1]) + (v[2] * v[2] + v[3] * v[3]);
                    }
                    const float rstd1 = 1.0f / sqrtf(wave_sum(sq) * (1.0f / DM) + EPS);
                    u32x2* o8 = (u32x2*)(XN + (size_t)m * DM) + lane;
#pragma unroll
                    for (int j = 0; j < 4; ++j) { const f32x4 v = xv[r][j]; u32x2 w; w.x = cvt_pk_bf16(v[0] * rstd1, v[1] * rstd1); w.y = cvt_pk_bf16(v[2] * rstd1, v[3] * rstd1); o8[64 * j] = w; }
                }
            }
        }
    }
    SEAM(7);

    if (IN(8)) for (int rep = 0; rep < REPS(8); ++rep) {
        pg8::Gemm g{XN, WFF1, DM, DM, DM, 0, 0}; pg8::StaticOrder S; S.init(T, DFF, G, bx);
        pg8::EpiRelu2 E{HID};
        pg8::gemm_phase(lds, g, S, E);
    }
    SEAM(8);

    if (IN(9)) for (int rep = 0; rep < REPS(9); ++rep) {
        pg8::Gemm g{HID, WFF2, DFF, DFF, DFF, 0, 0}; pg8::StaticOrder S; S.init(T, DM, G, bx);
        pg8::EpiSS E{MB, SS2};
        pg8::gemm_phase(lds, g, S, E);
    }
    SEAM(9);

    if (IN(10)) {
        const int gw = bx * 8 + wave, NGW = G * 8;
        const f32x4* g1r = (const f32x4*)g_mix_post + lane; const f32x4* g2r = (const f32x4*)g_mlp_post + lane;
        f32x4 ga[4], gb[4];
#pragma unroll
        for (int j = 0; j < 4; ++j) { ga[j] = g1r[64 * j]; gb[j] = g2r[64 * j]; }
        for (int m0 = gw; m0 < T; m0 += 2 * NGW) {
            f32x4 xv[2][4]; u32x2 aw[2][4], mw[2][4]; float r1[2], r2[2];
#pragma unroll
            for (int r = 0; r < 2; ++r) {
                const int m = (m0 + r * NGW < T) ? m0 + r * NGW : m0;
                const f32x4 pa = *((const f32x4*)(SS + (size_t)m * 16) + (lane & 3)), pb = *((const f32x4*)(SS2 + (size_t)m * 16) + (lane & 3));
                float sa = (pa[0] + pa[1]) + (pa[2] + pa[3]), sb = (pb[0] + pb[1]) + (pb[2] + pb[3]);
                sa += __shfl_xor(sa, 1); sa += __shfl_xor(sa, 2); sb += __shfl_xor(sb, 1); sb += __shfl_xor(sb, 2);
                r1[r] = 1.0f / sqrtf(sa * (1.0f / DM) + EPS); r2[r] = 1.0f / sqrtf(sb * (1.0f / DM) + EPS);
                const f32x4* xr = (const f32x4*)(x + (size_t)m * DM) + lane;
                const u32x2* ar = (const u32x2*)(MIXB + (size_t)m * DM) + lane; const u32x2* mr = (const u32x2*)(MB + (size_t)m * DM) + lane;
#pragma unroll
                for (int j = 0; j < 4; ++j) { xv[r][j] = xr[64 * j]; aw[r][j] = ar[64 * j]; mw[r][j] = mr[64 * j]; }
            }
#pragma unroll
            for (int r = 0; r < 2; ++r) {
                const int m = m0 + r * NGW;
                if (m < T) {
                    f32x4* orow = (f32x4*)(out + (size_t)m * DM) + lane;
#pragma unroll
                    for (int j = 0; j < 4; ++j) {
                        f32x4 v = xv[r][j];
                        v[0] = (v[0] + bf_lo(aw[r][j].x) * r1[r] * ga[j][0]) + bf_lo(mw[r][j].x) * r2[r] * gb[j][0]; v[1] = (v[1] + bf_hi(aw[r][j].x) * r1[r] * ga[j][1]) + bf_hi(mw[r][j].x) * r2[r] * gb[j][1];
                        v[2] = (v[2] + bf_lo(aw[r][j].y) * r1[r] * ga[j][2]) + bf_lo(mw[r][j].y) * r2[r] * gb[j][2]; v[3] = (v[3] + bf_hi(aw[r][j].y) * r1[r] * ga[j][3]) + bf_hi(mw[r][j].y) * r2[r] * gb[j][3];
                        orow[64 * j] = v;
                    }
                }
            }
        }
    }
#undef IN
#undef SEAM
}

extern "C" void kernel_launch(void* const* d_in, const int* in_sizes, int n_in, void* d_out, int out_size, void* d_ws, size_t ws_size, hipStream_t stream) {
    static int grid = 0;
    if (grid == 0) {
        int dev = 0, cus = 0, per_cu = 0;
        hipGetDevice(&dev);
        hipDeviceGetAttribute(&cus, hipDeviceAttributeMultiprocessorCount, dev);
        hipFuncSetAttribute((const void*)fwd_kernel, hipFuncAttributeMaxDynamicSharedMemorySize, LDS_BYTES);
        if (hipOccupancyMaxActiveBlocksPerMultiprocessor(&per_cu, (const void*)fwd_kernel, 512, LDS_BYTES) != hipSuccess || per_cu < 1) per_cu = 1;
        (void)hipGetLastError();
        grid = cus * per_cu;
        if (grid <= 0) grid = 256;
    }
    Args a{};
    for (int i = 0; i < 19; ++i) a.in[i] = (const float*)d_in[i];
    a.out = (float*)d_out; a.ws = (unsigned char*)d_ws;
#if N_LAUNCH_PER_PHASE
    for (int ph = 0; ph < NPHASE; ++ph) {
        a.ph_lo = ph; a.ph_hi = ph + 1;
        void* args[] = {&a};
        hipError_t e = hipLaunchCooperativeKernel((const void*)fwd_kernel, dim3(grid), dim3(512), args, LDS_BYTES, stream);
        if (e != hipSuccess) { fprintf(stderr, "cooperative launch (phase %d) failed: %s (grid %d)\n", ph, hipGetErrorString(e), grid); break; }
    }
#else
    a.ph_lo = 0; a.ph_hi = NPHASE;
    (void)hipMemsetAsync(d_ws, 0, 16384, stream);
    void* args[] = {&a};
    hipError_t e = hipLaunchCooperativeKernel((const void*)fwd_kernel, dim3(grid), dim3(512), args, LDS_BYTES, stream);
    if (e != hipSuccess) fprintf(stderr, "cooperative launch failed: %s (grid %d)\n", hipGetErrorString(e), grid);
#ifdef PROBE_EXTRA_PHASE
    {
        Args b = a; b.ph_lo = PROBE_EXTRA_PHASE; b.ph_hi = PROBE_EXTRA_PHASE + 1;
        void* args2[] = {&b};
        (void)hipLaunchCooperativeKernel((const void*)fwd_kernel, dim3(grid), dim3(512), args2, LDS_BYTES, stream);
    }
#endif
#endif
}
```

```cpp
#include <hip/hip_runtime.h>
#include <hip/hip_cooperative_groups.h>
#include <cstdio>
namespace cg = cooperative_groups;

#ifndef N_LAUNCH_PER_PHASE
#define N_LAUNCH_PER_PHASE 0
#endif

#ifndef PROBE_P4_DUP
#define PROBE_P4_DUP 0
#endif
#ifndef PROBE_P4_PART
#define PROBE_P4_PART 0
#endif
#ifndef PROBE_DUP
#define PROBE_DUP 0
#endif
#define REPS(k) (1 + ((PROBE_DUP >> (k)) & 1))
#define LAS __attribute__((address_space(3)))
typedef unsigned short bf16_t;
typedef short bf16x8 __attribute__((ext_vector_type(8)));
typedef float f32x4 __attribute__((ext_vector_type(4)));
typedef float f32x2 __attribute__((ext_vector_type(2)));
typedef unsigned u32x4 __attribute__((ext_vector_type(4)));
typedef unsigned u32x2 __attribute__((ext_vector_type(2)));

constexpr int T = 32768, SEQ = 8192, DM = 1024, NIN = 2560, DFF = 4096;
constexpr float EPS = 1e-6f;
constexpr int NPHASE = 11;

constexpr size_t MiB = 1u << 20;
constexpr size_t WS_WIN = 1 * MiB, WS_WGLU = 6 * MiB, WS_WOUT = 7 * MiB, WS_WFF1 = 9 * MiB, WS_WFF2 = 17 * MiB;
constexpr size_t WS_ROPE = 25 * MiB, WS_TW = 29 * MiB, WS_W1S = 49 * MiB, WS_SS = 53 * MiB, WS_SS2 = 55 * MiB, WS_HINC = 57 * MiB;
constexpr size_t WS_XN = 80 * MiB;
constexpr size_t WS_QB = 144 * MiB, WS_KB = 176 * MiB, WS_VB = 208 * MiB, WS_GB = 240 * MiB, WS_AU = 272 * MiB;
constexpr size_t WS_SST = 440 * MiB, WS_RTB = 376 * MiB, WS_YSSM = 408 * MiB;
constexpr size_t WS_YMIX = 312 * MiB;
constexpr size_t WS_HID = 144 * MiB;
constexpr size_t WS_MIXB = 400 * MiB;
constexpr size_t WS_MB = 80 * MiB;

constexpr int LDS_BYTES = 147456;
constexpr int TS = 272;
constexpr int TILE_B = 128 * TS;

typedef __bf16 bf16x2_t __attribute__((ext_vector_type(2)));
__device__ __forceinline__ unsigned cvt_pk_bf16(float lo, float hi) { f32x2 v = {lo, hi}; return __builtin_bit_cast(unsigned, __builtin_convertvector(v, bf16x2_t)); }
__device__ __forceinline__ float bf_lo(unsigned w) { return __uint_as_float(w << 16); }
__device__ __forceinline__ float bf_hi(unsigned w) { return __uint_as_float(w & 0xffff0000u); }
__device__ __forceinline__ bf16_t f2bf(float f) { return (bf16_t)(cvt_pk_bf16(f, 0.f) & 0xffffu); }
__device__ __forceinline__ float wave_sum(float v) {
#pragma unroll
    for (int o = 1; o < 64; o <<= 1) v += __shfl_xor(v, o);
    return v;
}
#define LDS_WAIT() asm volatile("s_waitcnt lgkmcnt(0)" ::: "memory")

namespace pg8 {
constexpr int BM = 256, BK = 64, HALF = 128, HTB = HALF * BK * 2, STAGE_BYTES = 8 * HTB, NXCD = 8, WGM = 8;
__device__ __forceinline__ int lds_byte(int r, int c) { const int st = (r >> 4) * 2 + (c >> 5), rr = r & 15, cc = c & 31, ob = rr * 64 + cc * 2; return st * 1024 + (ob ^ (((ob >> 9) & 1) << 5)); }
__device__ __forceinline__ void stage_rc(int b, int& R, int& C) { const int st = b / 1024, sb = b % 1024, swz = sb ^ (((sb >> 9) & 1) << 5); R = (st >> 1) * 16 + swz / 64; C = (st & 1) * 32 + (swz % 64) / 2; }
__device__ __forceinline__ int perm32(int rho) { const int n = rho >> 4, i = rho & 15; return 8 * (i >> 2) + 4 * n + (i & 3); }

struct Unit { int pm, pn, pb; };
struct Gemm { const bf16_t* A; const bf16_t* Bt; int lda, ldb, K; size_t bsA, bsB; };

struct StaticOrder {
    int nM, nN, nwg, G, c;
    __device__ void init(int M, int N, int G_, int c_) { nM = M / BM; nN = N / BM; nwg = nM * nN; G = G_; c = c_; }
    __device__ bool next(int i, Unit& u) const {
        const long L = (long)i * G + c; if (L >= nwg) return false;
        int wgid = (int)L; { const int q = nwg / NXCD, r = nwg % NXCD, xcd = wgid % NXCD, off = wgid / NXCD; wgid = (xcd < r ? xcd * (q + 1) : r * (q + 1) + (xcd - r) * q) + off; }
        const int nig = WGM * nN, gid = wgid / nig, fm = gid * WGM, gsz = (nM - fm) < WGM ? (nM - fm) : WGM;
        u.pm = fm + ((wgid % nig) % gsz); u.pn = (wgid % nig) / gsz; u.pb = 0; return true;
    }
};
struct BatchOrder {
    int G, c;
    __device__ bool next(int i, Unit& u) const {
        const int L = i * G + c; if (L >= 256) return false;
        const int xcd = L & 7, slot = L >> 3;
        u.pb = xcd * 4 + (slot >> 3); const int r = slot & 7; u.pm = r & 3; u.pn = r >> 2; return true;
    }
};

template <class Epi, class Sched>
__device__ __forceinline__ void gemm_phase(LAS unsigned char* lds, const Gemm g, const Sched& S, const Epi& E) {
    const int tid = threadIdx.x, wid = __builtin_amdgcn_readfirstlane(tid >> 6), lane = tid & 63, wr = wid >> 2, wc = wid & 3, fr = lane & 15, fq = lane >> 4;
    const int K = g.K, nt = K / BK;
    unsigned voffA[2], voffB[2];
#pragma unroll
    for (int i = 0; i < 2; ++i) { int R, C; stage_rc(tid * 16 + i * 8192, R, C); const int Rb = Epi::PERM ? ((R & ~31) + perm32(R & 31)) : R;
        voffA[i] = (unsigned)(R * g.lda + C) * 2u; voffB[i] = (unsigned)(Rb * g.ldb + C) * 2u; }
    const size_t kstep = (size_t)(BK * 2);
    const size_t hstepA = (size_t)HALF * g.lda * 2, hstepB = (size_t)HALF * g.ldb * 2;
    const size_t tstepA = 2 * hstepA, tstepB = 2 * hstepB;
    const unsigned ldsw = (unsigned)wid * 1024u;
    const int aoff = lds_byte(wr * 64 + fr, fq * 8), boff = lds_byte(wc * 32 + fr, fq * 8);
#define PG8_SA(b, h) (((b) * 2 + (h)) * HTB)
#define PG8_SB(b, h) ((4 + (b) * 2 + (h)) * HTB)
#define PG8_STAGE(bufoff, gbase, voff) do { _Pragma("unroll") for (int _i = 0; _i < 2; ++_i) \
        __builtin_amdgcn_global_load_lds((const unsigned*)((const char*)(gbase) + (voff)[_i]), (LAS unsigned*)(lds + (bufoff) + ldsw + _i * 8192), 16, 0, 0); } while (0)
#define PG8_LDA(dst, b, h) do { _Pragma("unroll") for (int m = 0; m < 4; ++m) _Pragma("unroll") for (int k = 0; k < 2; ++k) dst[m][k] = *(const LAS bf16x8*)(lds + PG8_SA(b, h) + aoff + m * 2048 + k * 1024); } while (0)
#define PG8_LDB(dst, b, h) do { _Pragma("unroll") for (int n = 0; n < 2; ++n) _Pragma("unroll") for (int k = 0; k < 2; ++k) dst[n][k] = *(const LAS bf16x8*)(lds + PG8_SB(b, h) + boff + n * 2048 + k * 1024); } while (0)
#define PG8_MMA(ai, bj, At, Bt) do { __builtin_amdgcn_s_setprio(1); _Pragma("unroll") for (int m = 0; m < 4; ++m) _Pragma("unroll") for (int n = 0; n < 2; ++n) _Pragma("unroll") for (int k = 0; k < 2; ++k) \
        acc[ai][bj][m][n] = __builtin_amdgcn_mfma_f32_16x16x32_bf16(Bt[n][k], At[m][k], acc[ai][bj][m][n], 0, 0, 0); __builtin_amdgcn_s_setprio(0); } while (0)
#define PG8_WAIT_V(n) asm volatile("s_waitcnt vmcnt(" #n ")" ::: "memory")
#define PG8_WAIT_L(n) asm volatile("s_waitcnt lgkmcnt(" #n ")" ::: "memory")
#define PG8_BAR __builtin_amdgcn_s_barrier()
#define PG8_SCHED __builtin_amdgcn_sched_barrier(0)
    Unit cur, nxt; int ui = 0;
    if (!S.next(0, cur)) return;
    f32x4 acc[2][2][4][2];
#pragma unroll
    for (int a = 0; a < 2; ++a)
#pragma unroll
        for (int b = 0; b < 2; ++b)
#pragma unroll
            for (int m = 0; m < 4; ++m)
#pragma unroll
                for (int n = 0; n < 2; ++n) acc[a][b][m][n] = (f32x4){0.f, 0.f, 0.f, 0.f};
    bf16x8 At[4][2], B0[2][2], B1[2][2];
    const char* cA = (const char*)g.A + (size_t)cur.pb * g.bsA * 2 + (size_t)cur.pm * tstepA;
    const char* cB = (const char*)g.Bt + (size_t)cur.pb * g.bsB * 2 + (size_t)cur.pn * tstepB;
    PG8_STAGE(PG8_SB(0, 0), cB, voffB); PG8_STAGE(PG8_SA(0, 0), cA, voffA); PG8_STAGE(PG8_SB(0, 1), cB + hstepB, voffB); PG8_STAGE(PG8_SA(0, 1), cA + hstepA, voffA);
    if (wr == 1) PG8_BAR;
    PG8_WAIT_V(4); PG8_BAR;
    PG8_STAGE(PG8_SB(1, 0), cB + kstep, voffB); PG8_STAGE(PG8_SA(1, 0), cA + kstep, voffA); PG8_STAGE(PG8_SB(1, 1), cB + hstepB + kstep, voffB);
    PG8_WAIT_V(6); PG8_BAR;
    for (;;) {
        const bool has_next = S.next(ui + 1, nxt);
        const char* nA = has_next ? (const char*)g.A + (size_t)nxt.pb * g.bsA * 2 + (size_t)nxt.pm * tstepA : cA;
        const char* nB = has_next ? (const char*)g.Bt + (size_t)nxt.pb * g.bsB * 2 + (size_t)nxt.pn * tstepB : cB;
        for (int t = 0; t < nt; t += 2) {
            const bool last = (t == nt - 2);
            const char* a1 = cA + (size_t)(t + 1) * kstep;
            const char* a2 = last ? nA : cA + (size_t)(t + 2) * kstep; const char* b2 = last ? nB : cB + (size_t)(t + 2) * kstep;
            const char* a3 = a2 + kstep; const char* b3 = b2 + kstep;
            PG8_LDB(B0, 0, 0); PG8_SCHED; PG8_LDA(At, 0, 0); PG8_STAGE(PG8_SA(1, 1), a1 + hstepA, voffA);
            PG8_WAIT_L(8); PG8_BAR; PG8_WAIT_L(0); PG8_MMA(0, 0, At, B0); PG8_BAR; PG8_SCHED;
            PG8_LDB(B1, 0, 1); PG8_STAGE(PG8_SB(0, 0), b2, voffB);
            PG8_BAR; PG8_WAIT_L(0); PG8_MMA(0, 1, At, B1); PG8_BAR;
            PG8_LDA(At, 0, 1); PG8_STAGE(PG8_SA(0, 0), a2, voffA);
            PG8_BAR; PG8_WAIT_L(0); PG8_MMA(1, 0, At, B0); PG8_BAR; PG8_SCHED;
            PG8_STAGE(PG8_SB(0, 1), b2 + hstepB, voffB);
            PG8_WAIT_V(6); PG8_BAR; PG8_MMA(1, 1, At, B1); PG8_BAR;
            PG8_LDB(B0, 1, 0); PG8_SCHED; PG8_LDA(At, 1, 0); PG8_STAGE(PG8_SA(0, 1), a2 + hstepA, voffA);
            PG8_WAIT_L(8); PG8_BAR; PG8_WAIT_L(0); PG8_MMA(0, 0, At, B0); PG8_BAR; PG8_SCHED;
            PG8_LDB(B1, 1, 1); PG8_STAGE(PG8_SB(1, 0), b3, voffB);
            PG8_BAR; PG8_WAIT_L(0); PG8_MMA(0, 1, At, B1); PG8_BAR;
            PG8_LDA(At, 1, 1); PG8_STAGE(PG8_SA(1, 0), a3, voffA);
            PG8_BAR; PG8_WAIT_L(0); PG8_MMA(1, 0, At, B0); PG8_BAR; PG8_SCHED;
            PG8_STAGE(PG8_SB(1, 1), b3 + hstepB, voffB);
            PG8_WAIT_V(6); PG8_BAR; PG8_MMA(1, 1, At, B1); PG8_BAR;
        }
        E(acc, cur, wr, wc, fr, fq);
        if (!has_next) break;
#pragma unroll
        for (int a = 0; a < 2; ++a)
#pragma unroll
            for (int b = 0; b < 2; ++b)
#pragma unroll
                for (int m = 0; m < 4; ++m)
#pragma unroll
                    for (int n = 0; n < 2; ++n) acc[a][b][m][n] = (f32x4){0.f, 0.f, 0.f, 0.f};
        cur = nxt; cA = nA; cB = nB; ++ui;
    }
    PG8_WAIT_V(0);
    if (wr == 0) PG8_BAR;
    PG8_BAR;
#undef PG8_SA
#undef PG8_SB
#undef PG8_STAGE
#undef PG8_LDA
#undef PG8_LDB
#undef PG8_MMA
#undef PG8_WAIT_V
#undef PG8_WAIT_L
#undef PG8_BAR
#undef PG8_SCHED
}

__device__ __forceinline__ u32x4 pack8(const f32x4 v0, const f32x4 v1) {
    u32x4 w; w.x = cvt_pk_bf16(v0[0], v0[1]); w.y = cvt_pk_bf16(v0[2], v0[3]); w.z = cvt_pk_bf16(v1[0], v1[1]); w.w = cvt_pk_bf16(v1[2], v1[3]); return w;
}
__device__ __forceinline__ f32x4 rope4(const f32x4 v, const f32x4 cs) {
    f32x4 r; r[0] = v[0] * cs[0] - v[1] * cs[1]; r[1] = v[0] * cs[1] + v[1] * cs[0]; r[2] = v[2] * cs[2] - v[3] * cs[3]; r[3] = v[2] * cs[3] + v[3] * cs[2]; return r;
}
struct EpiInProj {
    static constexpr bool PERM = true;
    bf16_t *Q, *Kb, *V, *Gt, *AU; const float* rope;
    __device__ __forceinline__ void operator()(const f32x4 (&acc)[2][2][4][2], const Unit& u, int wr, int wc, int fr, int fq) const {
        const int sect = u.pn >> 1;
        const int row0 = u.pm * BM + wr * 64 + fr;
        const int colt = (u.pn & 1) * 256 + wc * 32 + 8 * fq;
        if (sect <= 1) {
            bf16_t* O = sect ? Kb : Q;
            f32x4 cs[2][4][2];
#pragma unroll
            for (int ai = 0; ai < 2; ++ai)
#pragma unroll
                for (int m = 0; m < 4; ++m) {
                    const int pos = (row0 + ai * HALF + m * 16) & (SEQ - 1);
                    const float* rp = rope + ((size_t)pos * 64 + 16 * wc + 4 * fq) * 2;
                    cs[ai][m][0] = *(const f32x4*)rp; cs[ai][m][1] = *(const f32x4*)(rp + 4);
                }
#pragma unroll
            for (int ai = 0; ai < 2; ++ai)
#pragma unroll
                for (int m = 0; m < 4; ++m) {
                    const int row = row0 + ai * HALF + m * 16;
#pragma unroll
                    for (int bj = 0; bj < 2; ++bj) {
                        const f32x4 v0 = rope4(acc[ai][bj][m][0], cs[ai][m][0]), v1 = rope4(acc[ai][bj][m][1], cs[ai][m][1]);
                        *(u32x4*)(O + (size_t)row * 512 + colt + bj * HALF) = pack8(v0, v1);
                    }
                }
        } else if (sect <= 3) {
            bf16_t* O = (sect == 2) ? V : Gt;
#pragma unroll
            for (int ai = 0; ai < 2; ++ai)
#pragma unroll
                for (int m = 0; m < 4; ++m) {
                    const int row = row0 + ai * HALF + m * 16;
#pragma unroll
                    for (int bj = 0; bj < 2; ++bj) *(u32x4*)(O + (size_t)row * 512 + colt + bj * HALF) = pack8(acc[ai][bj][m][0], acc[ai][bj][m][1]);
                }
        } else {
#pragma unroll
            for (int ai = 0; ai < 2; ++ai)
#pragma unroll
                for (int m = 0; m < 4; ++m) {
                    const int row = row0 + ai * HALF + m * 16, cr = row >> 5, s = row & 31;
#pragma unroll
                    for (int bj = 0; bj < 2; ++bj) {
                        const int cu = colt + bj * HALF, g = cu >> 4, c0 = cu & 15;
                        *(u32x4*)(AU + ((size_t)(g * 1024 + cr) * 640 + s * 16 + c0)) = pack8(acc[ai][bj][m][0], acc[ai][bj][m][1]);
                    }
                }
        }
    }
};
struct EpiGlu {
    static constexpr bool PERM = true;
    bf16_t* Y;
    __device__ __forceinline__ void operator()(const f32x4 (&acc)[2][2][4][2], const Unit& u, int wr, int wc, int fr, int fq) const {
        const int row0 = u.pm * BM + wr * 64 + fr, col = 512 + u.pn * 128 + wc * 32 + 8 * fq;
#pragma unroll
        for (int ai = 0; ai < 2; ++ai)
#pragma unroll
            for (int m = 0; m < 4; ++m) {
                const int row = row0 + ai * HALF + m * 16;
                f32x4 y0, y1;
#pragma unroll
                for (int j = 0; j < 4; ++j) {
                    y0[j] = acc[ai][0][m][0][j] / (1.0f + __expf(-acc[ai][1][m][0][j]));
                    y1[j] = acc[ai][0][m][1][j] / (1.0f + __expf(-acc[ai][1][m][1][j]));
                }
                *(u32x4*)(Y + (size_t)row * 1024 + col) = pack8(y0, y1);
            }
    }
};
struct EpiSS {
    static constexpr bool PERM = true;
    bf16_t* O; float* SS;
    __device__ __forceinline__ void operator()(const f32x4 (&acc)[2][2][4][2], const Unit& u, int wr, int wc, int fr, int fq) const {
        const int row0 = u.pm * BM + wr * 64 + fr, col = u.pn * BM + wc * 32 + 8 * fq;
#pragma unroll
        for (int ai = 0; ai < 2; ++ai)
#pragma unroll
            for (int m = 0; m < 4; ++m) {
                const int row = row0 + ai * HALF + m * 16; float q = 0.f;
#pragma unroll
                for (int bj = 0; bj < 2; ++bj) {
                    const f32x4 v0 = acc[ai][bj][m][0], v1 = acc[ai][bj][m][1];
                    q += (v0[0] * v0[0] + v0[1] * v0[1]) + (v0[2] * v0[2] + v0[3] * v0[3]) + (v1[0] * v1[0] + v1[1] * v1[1]) + (v1[2] * v1[2] + v1[3] * v1[3]);
                    *(u32x4*)(O + (size_t)row * 1024 + col + bj * HALF) = pack8(v0, v1);
                }
                q += __shfl_xor(q, 16); q += __shfl_xor(q, 32);
                if (fq == 0) SS[(size_t)row * 16 + u.pn * 4 + wc] = q;
            }
    }
};
struct EpiRelu2 {
    static constexpr bool PERM = true;
    bf16_t* O;
    __device__ __forceinline__ void operator()(const f32x4 (&acc)[2][2][4][2], const Unit& u, int wr, int wc, int fr, int fq) const {
        const int row0 = u.pm * BM + wr * 64 + fr, col = u.pn * BM + wc * 32 + 8 * fq;
#pragma unroll
        for (int ai = 0; ai < 2; ++ai)
#pragma unroll
            for (int m = 0; m < 4; ++m) {
                const int row = row0 + ai * HALF + m * 16;
#pragma unroll
                for (int bj = 0; bj < 2; ++bj) {
                    f32x4 v0 = acc[ai][bj][m][0], v1 = acc[ai][bj][m][1];
#pragma unroll
                    for (int j = 0; j < 4; ++j) { const float a = fmaxf(v0[j], 0.f), b = fmaxf(v1[j], 0.f); v0[j] = a * a; v1[j] = b * b; }
                    *(u32x4*)(O + (size_t)row * DFF + col + bj * HALF) = pack8(v0, v1);
                }
            }
    }
};
struct EpiSsm {
    static constexpr bool PERM = true;
    const bf16_t* AU; const float* dskip; bf16_t* Y;
    __device__ __forceinline__ void operator()(const f32x4 (&acc)[2][2][4][2], const Unit& u, int wr, int wc, int fr, int fq) const {
        const int g = u.pb;
        const int row0 = u.pm * BM + wr * 64 + fr, colt = u.pn * BM + wc * 32 + 8 * fq;
        const int c0 = 8 * (fq & 1);
        const f32x4 d0 = *(const f32x4*)(dskip + g * 16 + c0), d1 = *(const f32x4*)(dskip + g * 16 + c0 + 4);
        u32x4 uwv[2][4][2];
#pragma unroll
        for (int ai = 0; ai < 2; ++ai)
#pragma unroll
            for (int m = 0; m < 4; ++m)
#pragma unroll
                for (int bj = 0; bj < 2; ++bj) uwv[ai][m][bj] = *(const u32x4*)(AU + ((size_t)(g * 1024 + row0 + ai * HALF + m * 16) * 640 + colt + bj * HALF));
#pragma unroll
        for (int ai = 0; ai < 2; ++ai)
#pragma unroll
            for (int m = 0; m < 4; ++m) {
                const int cr = row0 + ai * HALF + m * 16;
#pragma unroll
                for (int bj = 0; bj < 2; ++bj) {
                    const int col = colt + bj * HALF, s = col >> 4;
                    const u32x4 uw = uwv[ai][m][bj];
                    f32x4 v0 = acc[ai][bj][m][0], v1 = acc[ai][bj][m][1];
                    v0[0] += d0[0] * bf_lo(uw.x); v0[1] += d0[1] * bf_hi(uw.x); v0[2] += d0[2] * bf_lo(uw.y); v0[3] += d0[3] * bf_hi(uw.y);
                    v1[0] += d1[0] * bf_lo(uw.z); v1[1] += d1[1] * bf_hi(uw.z); v1[2] += d1[2] * bf_lo(uw.w); v1[3] += d1[3] * bf_hi(uw.w);
#pragma unroll
                    for (int j = 0; j < 4; ++j) {
                        const float a = v0[j], za = 1.5957691216f * (a + 0.044715f * a * a * a); v0[j] = a / (1.0f + __expf(-za));
                        const float b = v1[j], zb = 1.5957691216f * (b + 0.044715f * b * b * b); v1[j] = b / (1.0f + __expf(-zb));
                    }
                    const size_t tok = (size_t)cr * 32 + s;
                    *(u32x4*)(Y + tok * 512 + g * 16 + c0) = pack8(v0, v1);
                }
            }
    }
};
}

__device__ __forceinline__ bf16x8 frag_nat(const LAS unsigned char* tile, int idx0, int k0, int fr, int fq) {
    return *(const LAS bf16x8*)(tile + (idx0 + fr) * TS + (k0 + 8 * fq) * 2);
}
__device__ __forceinline__ bf16x8 frag_tr(unsigned tile_addr, int k0, int idx0, int lane) {
    const int g = lane >> 4, q = (lane & 15) >> 2, p = lane & 3;
    const unsigned addr = tile_addr + (unsigned)((k0 + 8 * g + q) * TS + (idx0 + 4 * p) * 2);
    u32x2 lo, hi;
    asm volatile("ds_read_b64_tr_b16 %0, %2\n\tds_read_b64_tr_b16 %1, %2 offset:1088\n\ts_waitcnt lgkmcnt(0)" : "=&v"(lo), "=&v"(hi) : "v"(addr) : "memory");
    u32x4 r; r.x = lo.x; r.y = lo.y; r.z = hi.x; r.w = hi.y;
    return __builtin_bit_cast(bf16x8, r);
}
__device__ __forceinline__ void frags_tr8(bf16x8 (&b)[8], unsigned tile_addr, int k0, int lane) {
    const int g = lane >> 4, q = (lane & 15) >> 2, p = lane & 3;
    const unsigned addr = tile_addr + (unsigned)((k0 + 8 * g + q) * TS + (4 * p) * 2);
    u32x2 r0, r1, r2, r3, r4, r5, r6, r7, r8, r9, r10, r11, r12, r13, r14, r15;
    asm volatile(
        "ds_read_b64_tr_b16 %0, %16\n\t"
        "ds_read_b64_tr_b16 %1, %16 offset:1088\n\t"
        "ds_read_b64_tr_b16 %2, %16 offset:32\n\t"
        "ds_read_b64_tr_b16 %3, %16 offset:1120\n\t"
        "ds_read_b64_tr_b16 %4, %16 offset:64\n\t"
        "ds_read_b64_tr_b16 %5, %16 offset:1152\n\t"
        "ds_read_b64_tr_b16 %6, %16 offset:96\n\t"
        "ds_read_b64_tr_b16 %7, %16 offset:1184\n\t"
        "ds_read_b64_tr_b16 %8, %16 offset:128\n\t"
        "ds_read_b64_tr_b16 %9, %16 offset:1216\n\t"
        "ds_read_b64_tr_b16 %10, %16 offset:160\n\t"
        "ds_read_b64_tr_b16 %11, %16 offset:1248\n\t"
        "ds_read_b64_tr_b16 %12, %16 offset:192\n\t"
        "ds_read_b64_tr_b16 %13, %16 offset:1280\n\t"
        "ds_read_b64_tr_b16 %14, %16 offset:224\n\t"
        "ds_read_b64_tr_b16 %15, %16 offset:1312\n\t"
        "s_waitcnt lgkmcnt(0)"
        : "=&v"(r0), "=&v"(r1), "=&v"(r2), "=&v"(r3), "=&v"(r4), "=&v"(r5), "=&v"(r6), "=&v"(r7),
          "=&v"(r8), "=&v"(r9), "=&v"(r10), "=&v"(r11), "=&v"(r12), "=&v"(r13), "=&v"(r14), "=&v"(r15)
        : "v"(addr) : "memory");
    u32x4 w;
    w.x = r0.x; w.y = r0.y; w.z = r1.x; w.w = r1.y; b[0] = __builtin_bit_cast(bf16x8, w);
    w.x = r2.x; w.y = r2.y; w.z = r3.x; w.w = r3.y; b[1] = __builtin_bit_cast(bf16x8, w);
    w.x = r4.x; w.y = r4.y; w.z = r5.x; w.w = r5.y; b[2] = __builtin_bit_cast(bf16x8, w);
    w.x = r6.x; w.y = r6.y; w.z = r7.x; w.w = r7.y; b[3] = __builtin_bit_cast(bf16x8, w);
    w.x = r8.x; w.y = r8.y; w.z = r9.x; w.w = r9.y; b[4] = __builtin_bit_cast(bf16x8, w);
    w.x = r10.x; w.y = r10.y; w.z = r11.x; w.w = r11.y; b[5] = __builtin_bit_cast(bf16x8, w);
    w.x = r12.x; w.y = r12.y; w.z = r13.x; w.w = r13.y; b[6] = __builtin_bit_cast(bf16x8, w);
    w.x = r14.x; w.y = r14.y; w.z = r15.x; w.w = r15.y; b[7] = __builtin_bit_cast(bf16x8, w);
}
template <bool ATR, bool BTR>
__device__ __forceinline__ void mma128(f32x4 (&acc)[8], const LAS unsigned char* lds, unsigned lds_addr, int offA, int offB, int m0, int lane) {
    const int fr = lane & 15, fq = lane >> 4;
#pragma unroll
    for (int ks = 0; ks < 4; ++ks) {
        bf16x8 af, bfr[8];
        if (ATR) af = frag_tr(lds_addr + offA, 32 * ks, m0, lane); else af = frag_nat(lds + offA, m0, 32 * ks, fr, fq);
        if (BTR) frags_tr8(bfr, lds_addr + offB, 32 * ks, lane);
        else {
#pragma unroll
            for (int n = 0; n < 8; ++n) bfr[n] = frag_nat(lds + offB, 16 * n, 32 * ks, fr, fq);
        }
#pragma unroll
        for (int n = 0; n < 8; ++n) acc[n] = __builtin_amdgcn_mfma_f32_16x16x32_bf16(bfr[n], af, acc[n], 0, 0, 0);
    }
}
__device__ __forceinline__ void tile_load(LAS unsigned char* dst, const bf16_t* src, int ld, int tid) {
    u32x4 v[4];
#pragma unroll
    for (int i = 0; i < 4; ++i) { const int q = tid + 512 * i, row = q >> 4, pc = q & 15; v[i] = *(const u32x4*)(src + (size_t)row * ld + pc * 8); }
#pragma unroll
    for (int i = 0; i < 4; ++i) { const int q = tid + 512 * i, row = q >> 4, pc = q & 15; *(LAS u32x4*)(dst + row * TS + pc * 16) = v[i]; }
}
__device__ __forceinline__ void tile_load_zeta(LAS unsigned char* dst, const bf16_t* src, int ld, int tid, float l2g) {
    u32x4 v[4];
#pragma unroll
    for (int i = 0; i < 4; ++i) { const int q = tid + 512 * i, row = q >> 4, pc = q & 15; v[i] = *(const u32x4*)(src + (size_t)row * ld + pc * 8); }
#pragma unroll
    for (int i = 0; i < 4; ++i) {
        const int q = tid + 512 * i, row = q >> 4, pc = q & 15; const float z = exp2f((float)(127 - row) * l2g);
        u32x4 w;
        w.x = cvt_pk_bf16(bf_lo(v[i].x) * z, bf_hi(v[i].x) * z); w.y = cvt_pk_bf16(bf_lo(v[i].y) * z, bf_hi(v[i].y) * z);
        w.z = cvt_pk_bf16(bf_lo(v[i].z) * z, bf_hi(v[i].z) * z); w.w = cvt_pk_bf16(bf_lo(v[i].w) * z, bf_hi(v[i].w) * z);
        *(LAS u32x4*)(dst + row * TS + pc * 16) = w;
    }
}
__device__ __forceinline__ void tile_issue(u32x4 (&v)[4], const bf16_t* src, int ld, int tid) {
#pragma unroll
    for (int i = 0; i < 4; ++i) { const int q = tid + 512 * i, row = q >> 4, pc = q & 15; v[i] = *(const u32x4*)(src + (size_t)row * ld + pc * 8); }
}
__device__ __forceinline__ void tile_commit(LAS unsigned char* dst, const u32x4 (&v)[4], int tid) {
#pragma unroll
    for (int i = 0; i < 4; ++i) { const int q = tid + 512 * i, row = q >> 4, pc = q & 15; *(LAS u32x4*)(dst + row * TS + pc * 16) = v[i]; }
}
__device__ __forceinline__ void tile_commit_zeta(LAS unsigned char* dst, const u32x4 (&v)[4], int tid, float l2g) {
#pragma unroll
    for (int i = 0; i < 4; ++i) {
        const int q = tid + 512 * i, row = q >> 4, pc = q & 15; const float z = exp2f((float)(127 - row) * l2g);
        u32x4 w;
        w.x = cvt_pk_bf16(bf_lo(v[i].x) * z, bf_hi(v[i].x) * z); w.y = cvt_pk_bf16(bf_lo(v[i].y) * z, bf_hi(v[i].y) * z);
        w.z = cvt_pk_bf16(bf_lo(v[i].z) * z, bf_hi(v[i].z) * z); w.w = cvt_pk_bf16(bf_lo(v[i].w) * z, bf_hi(v[i].w) * z);
        *(LAS u32x4*)(dst + row * TS + pc * 16) = w;
    }
}
__device__ __forceinline__ float ret_log2_gamma(int h) { const float g = 1.0f - exp2f(-5.0f - (4.0f / 3.0f) * (float)h); return log2f(g); }

__device__ __forceinline__ int dest_row(int mode, int n) {
    if (mode == 1) { if (n < 1024) { const int sect = n >> 9, w = n & 511, h = w >> 7, j = w & 127; return (sect << 9) + (h << 7) + ((j & 63) << 1) + (j >> 6); } return n; }
    if (mode == 2) { const int bj = n >> 9, rem = n & 511, pn = rem >> 7, j = rem & 127; return (pn << 8) + (bj << 7) + j; }
    return n;
}
struct TrItem { const float* W; bf16_t* WT; const float* gain; int K, N, mode, item; };
__device__ __forceinline__ void p0_tr_load(const TrItem& t, float (&v)[32], int lane) {
    const int nblk = t.N / 32, kb = t.item / nblk, nb = t.item % nblk, k0 = 64 * kb, n0 = 32 * nb;
    const float cs = (t.mode == 1 && n0 >= 512 && n0 < 1024) ? 0.08838834764831845f : 1.0f;
#pragma unroll
    for (int i = 0; i < 32; ++i) { const int kk = 2 * i + (lane >> 5); const float g = t.gain ? t.gain[k0 + kk] * cs : cs; v[i] = t.W[(size_t)(k0 + kk) * t.N + n0 + (lane & 31)] * g; }
}
__device__ __forceinline__ void p0_tr_finish(const TrItem& t, const float (&v)[32], LAS float* scr, int lane) {
    const int nblk = t.N / 32, kb = t.item / nblk, nb = t.item % nblk, k0 = 64 * kb, n0 = 32 * nb;
#pragma unroll
    for (int i = 0; i < 32; ++i) { const int kk = 2 * i + (lane >> 5); scr[kk * 33 + (lane & 31)] = v[i]; }
    LDS_WAIT();
    const int c = lane & 7;
#pragma unroll
    for (int j = 0; j < 4; ++j) { const int n = (lane >> 3) + 8 * j; const LAS float* s = scr + (8 * c) * 33 + n;
        u32x4 o; o.x = cvt_pk_bf16(s[0 * 33], s[1 * 33]); o.y = cvt_pk_bf16(s[2 * 33], s[3 * 33]); o.z = cvt_pk_bf16(s[4 * 33], s[5 * 33]); o.w = cvt_pk_bf16(s[6 * 33], s[7 * 33]);
        *(u32x4*)(t.WT + (size_t)dest_row(t.mode, n0 + n) * t.K + k0 + 8 * c) = o; }
    LDS_WAIT();
}
__device__ __forceinline__ void s5_pow(float lre, float lim, float dt, float j, float& pr, float& pi) {
    const float mag = expf(j * (dt * lre)); float s, c; sincosf(j * (dt * lim), &s, &c); pr = mag * c; pi = mag * s;
}
__device__ __forceinline__ void s5_coef(float lre, float lim, float dt, float& cr, float& ci) {
    float br, bi; s5_pow(lre, lim, dt, 1.0f, br, bi); br -= 1.0f;
    const float den = lre * lre + lim * lim; cr = (br * lre + bi * lim) / den; ci = (bi * lre - br * lim) / den;
}

#define XB_TMO      128
#define XB_XCNT(j)  (256  + 64 * (j))
#define XB_XSUB(j)  (1280 + 64 * (j))
#define XB_XGEN(j)  (2304 + 64 * (j))
#define XB_TOP      3328
#define XB_TOPGEN   3392
#define XCD_BAR_WORDS 3456
#define XB_SPIN_CAP (1u << 18)
__device__ __forceinline__ unsigned xb_ld(unsigned* p)              { return __hip_atomic_load(p, __ATOMIC_RELAXED, __HIP_MEMORY_SCOPE_AGENT); }
__device__ __forceinline__ unsigned xb_add(unsigned* p, unsigned v) { return __hip_atomic_fetch_add(p, v, __ATOMIC_RELAXED, __HIP_MEMORY_SCOPE_AGENT); }
__device__ __forceinline__ unsigned xb_xcc_id() { return (unsigned)__builtin_amdgcn_s_getreg((3 << 11) | 20) & 0xFu; }
#define XB_SPIN(cond, bar) do { unsigned _sp = 0; while (cond) { __builtin_amdgcn_s_sleep(1); \
    if ((++_sp & 255u) == 0u) { if (xb_ld(&(bar)[XB_TMO])) break; if (_sp > XB_SPIN_CAP) { atomicAdd(&(bar)[XB_TMO], 1u); break; } } } } while (0)
struct XcdBarrier { unsigned* bar; unsigned x; volatile LAS unsigned* st; };
__device__ __forceinline__ XcdBarrier xcd_barrier_post(unsigned* bar, volatile LAS unsigned* st) {
    XcdBarrier b; b.bar = bar; b.x = xb_xcc_id(); b.st = st;
    if (threadIdx.x == 0) (void)xb_add(&bar[XB_XCNT(b.x)], 1u);
    return b;
}
__device__ __forceinline__ void xcd_barrier_complete(unsigned* bar, unsigned x, unsigned& nloc, unsigned& nx) {
    const unsigned G = gridDim.x * gridDim.y * gridDim.z;
    unsigned sum, cnt, mine, sp = 0u;
    for (;;) {
        sum = 0u; cnt = 0u; mine = 0u;
#pragma unroll
        for (unsigned j = 0; j < 16; ++j) { const unsigned c = xb_ld(&bar[XB_XCNT(j)]); sum += c; cnt += (c > 0u) ? 1u : 0u; mine = (j == x) ? c : mine; }
        if (sum == G) break;
        __builtin_amdgcn_s_sleep(1);
        if ((++sp & 255u) == 0u) { if (xb_ld(&bar[XB_TMO])) break; if (sp > XB_SPIN_CAP) { atomicAdd(&bar[XB_TMO], 1u); break; } }
    }
    nloc = mine > 0u ? mine : 1u; nx = cnt > 0u ? cnt : 1u;
}
__device__ __forceinline__ void xcd_barrier(const XcdBarrier& b) {
    asm volatile("s_waitcnt vmcnt(0)" ::: "memory");
    __syncthreads();
    if (threadIdx.x == 0) {
        unsigned* bar = b.bar;
        __builtin_amdgcn_s_waitcnt(0);
        unsigned nloc = b.st[0], nx = b.st[1];
        if (nloc == 0u) { xcd_barrier_complete(bar, b.x, nloc, nx); b.st[0] = nloc; b.st[1] = nx; }
        const unsigned old = xb_add(&bar[XB_XSUB(b.x)], 1u);
        const unsigned gen = old / nloc;
        if (old + 1u == (gen + 1u) * nloc) {
            __builtin_amdgcn_fence(__ATOMIC_RELEASE, "agent");
            asm volatile("s_waitcnt vmcnt(0)" ::: "memory");
            const unsigned og = xb_add(&bar[XB_TOP], 1u);
            const unsigned tg = og / nx;
            if (og + 1u == (tg + 1u) * nx) xb_add(&bar[XB_TOPGEN], 1u);
            else XB_SPIN(xb_ld(&bar[XB_TOPGEN]) == tg, bar);
            __builtin_amdgcn_fence(__ATOMIC_ACQUIRE, "agent");
            xb_add(&bar[XB_XGEN(b.x)], 1u);
            asm volatile("s_waitcnt vmcnt(0)" ::: "memory");
        } else {
            XB_SPIN(xb_ld(&bar[XB_XGEN(b.x)]) == gen, bar);
            __builtin_amdgcn_fence(__ATOMIC_ACQUIRE, "agent");
            asm volatile("s_waitcnt vmcnt(0)" ::: "memory");
        }
    }
    __syncthreads();
}

struct Args { const float* in[19]; float* out; unsigned char* ws; int ph_lo, ph_hi; };

__global__ void __launch_bounds__(512, 2) fwd_kernel(Args a) {
    extern __shared__ __attribute__((aligned(16))) unsigned char lds_raw[];
    LAS unsigned char* lds = (LAS unsigned char*)lds_raw;
    const unsigned lds_addr = (unsigned)(size_t)lds_raw;
    cg::grid_group grid = cg::this_grid();
    const int tid = threadIdx.x, lane = tid & 63, wave = __builtin_amdgcn_readfirstlane(tid >> 6);
    const int G = gridDim.x, bx = blockIdx.x;
    const int lo = a.ph_lo, hi = a.ph_hi;
    unsigned char* ws = a.ws;
#define IN(k) (lo <= (k) && (k) < hi)
#define SEAM(k) do { if (lo <= (k) && (k) + 1 < hi) xcd_barrier(xbar); } while (0)
    volatile LAS unsigned* misc = (volatile LAS unsigned*)(lds + (LDS_BYTES - 64));
    if (tid < 16) misc[tid] = 0u;
    __syncthreads();
    const XcdBarrier xbar = xcd_barrier_post((unsigned*)ws, misc);
    if (lo < 0) grid.sync();

    const float* x = a.in[0];
    const float* g_mix_pre = a.in[1]; const float* g_mix_post = a.in[2]; const float* w_in = a.in[3]; const float* gn_gain = a.in[4];
    const float* lam_re = a.in[5]; const float* lam_im = a.in[6]; const float* log_dt = a.in[7];
    const float* b_re = a.in[8]; const float* b_im = a.in[9]; const float* c_re = a.in[10]; const float* c_im = a.in[11]; const float* d_skip = a.in[12];
    const float* w_glu = a.in[13]; const float* w_out = a.in[14]; const float* g_mlp_pre = a.in[15]; const float* g_mlp_post = a.in[16];
    const float* w_ff1 = a.in[17]; const float* w_ff2 = a.in[18];
    float* out = a.out;

    bf16_t* WIN = (bf16_t*)(ws + WS_WIN); bf16_t* WGLU = (bf16_t*)(ws + WS_WGLU); bf16_t* WOUT = (bf16_t*)(ws + WS_WOUT);
    bf16_t* WFF1 = (bf16_t*)(ws + WS_WFF1); bf16_t* WFF2 = (bf16_t*)(ws + WS_WFF2);
    float* ROPE = (float*)(ws + WS_ROPE); bf16_t* TW = (bf16_t*)(ws + WS_TW); bf16_t* W1S = (bf16_t*)(ws + WS_W1S);
    float* XSC = (float*)(ws + 73 * MiB);
    float* SS = (float*)(ws + WS_SS); float* SS2 = (float*)(ws + WS_SS2); float* HINC = (float*)(ws + WS_HINC);
    bf16_t* XN = (bf16_t*)(ws + WS_XN);
    bf16_t* QB = (bf16_t*)(ws + WS_QB); bf16_t* KB = (bf16_t*)(ws + WS_KB); bf16_t* VB = (bf16_t*)(ws + WS_VB); bf16_t* GB = (bf16_t*)(ws + WS_GB);
    bf16_t* AU = (bf16_t*)(ws + WS_AU); bf16_t* SST = (bf16_t*)(ws + WS_SST); bf16_t* RTB = (bf16_t*)(ws + WS_RTB);
    bf16_t* YSSM = (bf16_t*)(ws + WS_YSSM); bf16_t* YMIX = (bf16_t*)(ws + WS_YMIX);
    bf16_t* MIXB = (bf16_t*)(ws + WS_MIXB); bf16_t* HID = (bf16_t*)(ws + WS_HID); bf16_t* MB = (bf16_t*)(ws + WS_MB);

    if (IN(0)) for (int rep = 0; rep < REPS(0); ++rep) {
        const int gw = bx * 8 + wave, NGW = G * 8;
        {
            LAS float* scr = (LAS float*)(lds + wave * 16384);
            constexpr int I_IN = (DM / 64) * (NIN / 32), I_GLU = (512 / 64) * (1024 / 32), I_OUT = (DM / 64) * (DM / 32), I_F1 = (DM / 64) * (DFF / 32), I_F2 = (DFF / 64) * (DM / 32);
            constexpr int NITEMS = I_IN + I_GLU + I_OUT + I_F1 + I_F2;
#define TR_DECODE(IT, t) do { int r_ = (IT); \
                if (r_ < I_IN) { t = TrItem{w_in, WIN, g_mix_pre, DM, NIN, 1, r_}; break; } r_ -= I_IN; \
                if (r_ < I_GLU) { t = TrItem{w_glu, WGLU, nullptr, 512, 1024, 2, r_}; break; } r_ -= I_GLU; \
                if (r_ < I_OUT) { t = TrItem{w_out, WOUT, nullptr, DM, DM, 0, r_}; break; } r_ -= I_OUT; \
                if (r_ < I_F1) { t = TrItem{w_ff1, WFF1, g_mlp_pre, DM, DFF, 0, r_}; break; } r_ -= I_F1; \
                t = TrItem{w_ff2, WFF2, nullptr, DFF, DM, 0, r_}; } while (0)
            int it = gw;
            TrItem cur, nxt; float va[32], vb[32];
            if (it < NITEMS) { TR_DECODE(it, cur); p0_tr_load(cur, va, lane); }
            while (it < NITEMS) {
                const int itn = it + NGW;
                if (itn < NITEMS) { TR_DECODE(itn, nxt); p0_tr_load(nxt, vb, lane); }
                p0_tr_finish(cur, va, scr, lane);
                it = itn;
                if (it >= NITEMS) break;
                const int itn2 = it + NGW;
                if (itn2 < NITEMS) { TR_DECODE(itn2, cur); p0_tr_load(cur, va, lane); }
                p0_tr_finish(nxt, vb, scr, lane);
                it = itn2;
            }
#undef TR_DECODE
        }
        for (int m = gw; m < T; m += 2 * NGW) {
            const int m2 = m + NGW;
            const bool has2 = m2 < T;
            const f32x4* xr0 = (const f32x4*)(x + (size_t)m * DM) + lane;
            const f32x4* xr1 = (const f32x4*)(x + (size_t)(has2 ? m2 : m) * DM) + lane;
            f32x4 v0[4], v1[4]; float s0 = 0.f, s1 = 0.f;
#pragma unroll
            for (int j = 0; j < 4; ++j) { v0[j] = xr0[64 * j]; v1[j] = xr1[64 * j]; }
#pragma unroll
            for (int j = 0; j < 4; ++j) {
                s0 += (v0[j][0] * v0[j][0] + v0[j][1] * v0[j][1]) + (v0[j][2] * v0[j][2] + v0[j][3] * v0[j][3]);
                s1 += (v1[j][0] * v1[j][0] + v1[j][1] * v1[j][1]) + (v1[j][2] * v1[j][2] + v1[j][3] * v1[j][3]);
            }
            const float q0 = sqrtf(wave_sum(s0) * (1.0f / DM) + EPS), q1 = sqrtf(wave_sum(s1) * (1.0f / DM) + EPS);
            const float r0 = 1.0f / q0, r1 = 1.0f / q1;
            if (lane == 0) { XSC[m] = q0; if (has2) XSC[m2] = q1; }
            u32x2* o0 = (u32x2*)(XN + (size_t)m * DM) + lane; u32x2* o1 = (u32x2*)(XN + (size_t)m2 * DM) + lane;
#pragma unroll
            for (int j = 0; j < 4; ++j) { u32x2 w; w.x = cvt_pk_bf16(v0[j][0] * r0, v0[j][1] * r0); w.y = cvt_pk_bf16(v0[j][2] * r0, v0[j][3] * r0); o0[64 * j] = w; }
            if (has2) {
#pragma unroll
                for (int j = 0; j < 4; ++j) { u32x2 w; w.x = cvt_pk_bf16(v1[j][0] * r1, v1[j][1] * r1); w.y = cvt_pk_bf16(v1[j][2] * r1, v1[j][3] * r1); o1[64 * j] = w; }
            }
        }
        const float rope_inv = (float)pow(10000.0, -(double)(tid & 63) / 64.0);
        for (int i = bx * 512 + tid; i < SEQ * 64; i += G * 512) {
            const int pos = i >> 6;
            const float inv = rope_inv;
            const float ang = (float)pos * inv; float s, c; sincosf(ang, &s, &c);
            *(f32x2*)(ROPE + (size_t)i * 2) = (f32x2){c, s};
        }
        for (int i = bx * 512 + tid; i < 32 * 32 * 64; i += G * 512) {
            {
                const int q = i & 63, t = (i >> 6) & 31, g = i >> 11;
                const float lre = fminf(lam_re[g * 64 + q], -1e-4f), lim = lam_im[g * 64 + q], dt = expf(log_dt[g]);
                float pr, pi; s5_pow(lre, lim, dt, (float)(t + 1), pr, pi);
                float crv[16], civ[16];
#pragma unroll
                for (int c = 0; c < 16; ++c) { crv[c] = c_re[(g * 16 + c) * 64 + q]; civ[c] = c_im[(g * 16 + c) * 64 + q]; }
#pragma unroll
                for (int c = 0; c < 16; ++c) {
                    const float zr = crv[c] * pr - civ[c] * pi, zi = crv[c] * pi + civ[c] * pr;
                    bf16_t* row = TW + (size_t)(g * 512 + t * 16 + c) * 640 + 512;
                    row[q] = f2bf(zr); row[64 + q] = f2bf(-zi);
                }
            }
            {
                const int s = i & 31, p = (i >> 5) & 63, g = i >> 11;
                const float lre = fminf(lam_re[g * 64 + p], -1e-4f), lim = lam_im[g * 64 + p], dt = expf(log_dt[g]);
                float pr, pi, cr, ci; s5_pow(lre, lim, dt, (float)(31 - s), pr, pi); s5_coef(lre, lim, dt, cr, ci);
                const float wr_ = pr * cr - pi * ci, wi_ = pr * ci + pi * cr;
                float zr[16], zi[16];
#pragma unroll
                for (int c = 0; c < 16; ++c) { const float br = b_re[(g * 64 + p) * 16 + c], bi = b_im[(g * 64 + p) * 16 + c]; zr[c] = wr_ * br - wi_ * bi; zi[c] = wr_ * bi + wi_ * br; }
                u32x4* o0 = (u32x4*)(W1S + (size_t)(g * 128 + p) * 512 + s * 16);
                u32x4* o1 = (u32x4*)(W1S + (size_t)(g * 128 + 64 + p) * 512 + s * 16);
                u32x4 w;
                w.x = cvt_pk_bf16(zr[0], zr[1]); w.y = cvt_pk_bf16(zr[2], zr[3]); w.z = cvt_pk_bf16(zr[4], zr[5]); w.w = cvt_pk_bf16(zr[6], zr[7]); o0[0] = w;
                w.x = cvt_pk_bf16(zr[8], zr[9]); w.y = cvt_pk_bf16(zr[10], zr[11]); w.z = cvt_pk_bf16(zr[12], zr[13]); w.w = cvt_pk_bf16(zr[14], zr[15]); o0[1] = w;
                w.x = cvt_pk_bf16(zi[0], zi[1]); w.y = cvt_pk_bf16(zi[2], zi[3]); w.z = cvt_pk_bf16(zi[4], zi[5]); w.w = cvt_pk_bf16(zi[6], zi[7]); o1[0] = w;
                w.x = cvt_pk_bf16(zi[8], zi[9]); w.y = cvt_pk_bf16(zi[10], zi[11]); w.z = cvt_pk_bf16(zi[12], zi[13]); w.w = cvt_pk_bf16(zi[14], zi[15]); o1[1] = w;
            }
        }
        for (int i = bx * 512 + tid; i < 16384 * 64; i += G * 512) {
            const int piece = i & 63, row = i >> 6, t = (row >> 4) & 31;
            if (piece >= 2 * (t + 1)) *(u32x4*)(TW + (size_t)row * 640 + piece * 8) = (u32x4){0u, 0u, 0u, 0u};
        }
        __syncthreads();
        {
            LAS float* Bre = (LAS float*)lds; LAS float* Bim = Bre + 1024; LAS float* Cre = Bre + 2048; LAS float* Cim = Bre + 3072;
            LAS float* cpr = Bre + 4096; LAS float* cpi = cpr + 256;
            for (int it = bx; it < 256; it += G) {
                const int g = it >> 3, jq = it & 7;
                {
                    const int q0 = tid, q1 = tid + 512;
                    const float* s0 = (q0 < 256 ? b_re : b_im) + g * 1024 + (q0 & 255) * 4;
                    const float* s1 = (q1 < 768 ? c_re : c_im) + g * 1024 + (q1 & 255) * 4;
                    *(LAS f32x4*)(Bre + q0 * 4) = *(const f32x4*)s0;
                    *(LAS f32x4*)(Bre + q1 * 4) = *(const f32x4*)s1;
                }
                if (tid < 256) {
                    const int p = tid & 63, jl = tid >> 6;
                    const float lre = fminf(lam_re[g * 64 + p], -1e-4f), lim = lam_im[g * 64 + p], dt = expf(log_dt[g]);
                    float pr, pi, cr, ci; s5_pow(lre, lim, dt, (float)(4 * jq + jl), pr, pi); s5_coef(lre, lim, dt, cr, ci);
                    cpr[jl * 64 + p] = pr * cr - pi * ci; cpi[jl * 64 + p] = pr * ci + pi * cr;
                }
                __syncthreads();
                {
                    const int cc = tid & 255, c = cc >> 4, c2 = cc & 15, jh = tid >> 8;
                    float v0 = 0.f, v1 = 0.f;
#pragma unroll 8
                    for (int p = 0; p < 64; ++p) {
                        const float cr = Cre[c * 64 + p], ci = Cim[c * 64 + p], br = Bre[p * 16 + c2], bi = Bim[p * 16 + c2];
                        const float mr = cr * br - ci * bi, mi = cr * bi + ci * br;
                        v0 += mr * cpr[(2 * jh) * 64 + p] - mi * cpi[(2 * jh) * 64 + p];
                        v1 += mr * cpr[(2 * jh + 1) * 64 + p] - mi * cpi[(2 * jh + 1) * 64 + p];
                    }
                    const int jj0 = 4 * jq + 2 * jh;
                    const bf16_t w0 = f2bf(v0), w1 = f2bf(v1);
                    for (int t = jj0; t < 32; ++t) TW[(size_t)(g * 512 + t * 16 + c) * 640 + (t - jj0) * 16 + c2] = w0;
                    for (int t = jj0 + 1; t < 32; ++t) TW[(size_t)(g * 512 + t * 16 + c) * 640 + (t - jj0 - 1) * 16 + c2] = w1;
                }
                __syncthreads();
            }
        }
    }
    SEAM(0);

    if (IN(1)) for (int rep = 0; rep < REPS(1); ++rep) {
        pg8::Gemm g{XN, WIN, DM, DM, DM, 0, 0}; pg8::StaticOrder S; S.init(T, NIN, G, bx);
        pg8::EpiInProj E{QB, KB, VB, GB, AU, ROPE};
        pg8::gemm_phase(lds, g, S, E);
    }
    SEAM(1);

    if (IN(2)) for (int rep = 0; rep < REPS(2); ++rep) {
        const int fr = lane & 15, fq = lane >> 4;
        for (int it = bx; it < 256; it += G) {
            const int g = it >> 3, rt = it & 7;
            const bf16_t* pA = AU + (size_t)(g * 1024 + rt * 128) * 640; const bf16_t* pB = W1S + (size_t)(g * 128) * 512;
            f32x4 acc[8];
#pragma unroll
            for (int n = 0; n < 8; ++n) acc[n] = (f32x4){0.f, 0.f, 0.f, 0.f};
            u32x4 ra[4], rb[4];
            tile_issue(ra, pA, 640, tid); tile_issue(rb, pB, 512, tid);
            for (int kt = 0; kt < 4; ++kt) {
                tile_commit(lds, ra, tid); tile_commit(lds + TILE_B, rb, tid);
                __syncthreads();
                if (kt < 3) { tile_issue(ra, pA + (kt + 1) * 128, 640, tid); tile_issue(rb, pB + (kt + 1) * 128, 512, tid); }
                mma128<false, false>(acc, lds, lds_addr, 0, TILE_B, 16 * wave, lane);
                __syncthreads();
            }
            float* o = HINC + ((size_t)(g * 1024 + rt * 128 + 16 * wave + fr)) * 128 + 4 * fq;
#pragma unroll
            for (int n = 0; n < 8; ++n) *(f32x4*)(o + 16 * n) = acc[n];
        }
        {
            u32x4 rk[4], rv[4];
            int it = bx;
#define R1_ISSUE(IT) do { const int n_ = (IT) & 63, h_ = ((IT) >> 6) & 3, b_ = (IT) >> 8; const size_t t0_ = (size_t)b_ * SEQ + n_ * 128; \
                tile_issue(rk, KB + t0_ * 512 + h_ * 128, 512, tid); tile_issue(rv, VB + t0_ * 512 + h_ * 128, 512, tid); } while (0)
            if (it < 1024) R1_ISSUE(it);
            for (; it < 1024; it += G) {
                const int h = (it >> 6) & 3;
                const float l2g = ret_log2_gamma(h);
                tile_commit(lds, rk, tid); tile_commit_zeta(lds + TILE_B, rv, tid, l2g);
                __syncthreads();
                if (it + G < 1024) R1_ISSUE(it + G);
                f32x4 acc[8];
#pragma unroll
                for (int nb = 0; nb < 8; ++nb) acc[nb] = (f32x4){0.f, 0.f, 0.f, 0.f};
                mma128<true, true>(acc, lds, lds_addr, TILE_B, 0, 16 * wave, lane);
                bf16_t* o = SST + (size_t)it * 16384 + (16 * wave + fr) * 128 + 4 * fq;
#pragma unroll
                for (int nb = 0; nb < 8; ++nb) { u32x2 w; w.x = cvt_pk_bf16(acc[nb][0], acc[nb][1]); w.y = cvt_pk_bf16(acc[nb][2], acc[nb][3]); *(u32x2*)(o + 16 * nb) = w; }
                __syncthreads();
            }
#undef R1_ISSUE
        }
    }
    SEAM(2);

    if (IN(3)) for (int rep = 0; rep < REPS(3); ++rep) {
        for (int idx = bx * 512 + tid; idx < 16 * 8192; idx += G * 512) {
            const int bh = idx >> 13, e2 = idx & 8191, h = bh & 3;
            const float gch = exp2f(128.0f * ret_log2_gamma(h));
            const unsigned* sp = (const unsigned*)(SST + (size_t)bh * 64 * 16384 + 2 * e2);
            unsigned* rp = (unsigned*)(RTB + (size_t)bh * 64 * 16384 + 2 * e2);
            float r0 = 0.f, r1 = 0.f;
            for (int n0 = 0; n0 < 64; n0 += 16) {
                unsigned s[16];
#pragma unroll
                for (int j = 0; j < 16; ++j) s[j] = sp[(size_t)(n0 + j) * 8192];
#pragma unroll
                for (int j = 0; j < 16; ++j) { rp[(size_t)(n0 + j) * 8192] = cvt_pk_bf16(r0, r1); r0 = gch * r0 + bf_lo(s[j]); r1 = gch * r1 + bf_hi(s[j]); }
            }
        }
        {
            LAS float* X = (LAS float*)lds;
            for (int it = bx; it < 128; it += G) {
                const int b = it >> 5, g = it & 31, p = tid & 63, seg = tid >> 6;
                const float lre = fminf(lam_re[g * 64 + p], -1e-4f), lim = lam_im[g * 64 + p], dt = expf(log_dt[g]);
                float ar, ai, Ar, Ai; s5_pow(lre, lim, dt, 32.0f, ar, ai); s5_pow(lre, lim, dt, 1024.0f, Ar, Ai);
                const float* hp = HINC + ((size_t)(g * 1024 + b * 256 + seg * 32)) * 128 + p;
                float xr = 0.f, xi = 0.f;
                for (int i = 0; i < 32; ++i) { const float hr = hp[(size_t)i * 128], hi_ = hp[(size_t)i * 128 + 64]; const float nr = ar * xr - ai * xi + hr, ni = ar * xi + ai * xr + hi_; xr = nr; xi = ni; }
                X[(seg * 64 + p) * 2] = xr; X[(seg * 64 + p) * 2 + 1] = xi;
                __syncthreads();
                float cr = 0.f, ci = 0.f;
                for (int s = 0; s < seg; ++s) { const float tr = X[(s * 64 + p) * 2], ti = X[(s * 64 + p) * 2 + 1]; const float nr = Ar * cr - Ai * ci + tr, ni = Ar * ci + Ai * cr + ti; cr = nr; ci = ni; }
                bf16_t* op = AU + ((size_t)(g * 1024 + b * 256 + seg * 32)) * 640 + 512 + p;
                xr = cr; xi = ci;
                for (int i = 0; i < 32; ++i) {
                    op[(size_t)i * 640] = f2bf(xr); op[(size_t)i * 640 + 64] = f2bf(xi);
                    const float hr = hp[(size_t)i * 128], hi_ = hp[(size_t)i * 128 + 64]; const float nr = ar * xr - ai * xi + hr, ni = ar * xi + ai * xr + hi_; xr = nr; xi = ni;
                }
                __syncthreads();
            }
        }
    }
    SEAM(3);

    if (IN(4)) for (int rep = 0; rep < REPS(4); ++rep) {
        const bool solo = (hi - lo == 1);
        if (!(solo && PROBE_P4_PART == 2)) for (int rep4 = 0; rep4 < (PROBE_P4_DUP == 1 ? 2 : 1); ++rep4) {
            pg8::Gemm g{AU, TW, 640, 640, 640, (size_t)1024 * 640, (size_t)512 * 640}; pg8::BatchOrder S{G, bx};
            pg8::EpiSsm E{AU, d_skip, YSSM};
            pg8::gemm_phase(lds, g, S, E);
        }
        const int fr = lane & 15, fq = lane >> 4;
        constexpr int OQ = 0, OK_ = TILE_B, OV = 2 * TILE_B, OR = 3 * TILE_B;
        for (int rep4 = 0; rep4 < (PROBE_P4_DUP == 2 ? 2 : 1); ++rep4) {
        u32x4 rq[4], rk[4], rv[4], rr[4];
        int it = bx;
#define R3_ISSUE(IT) do { const int n_ = (IT) & 63, h_ = ((IT) >> 6) & 3, b_ = (IT) >> 8; const size_t t0_ = (size_t)b_ * SEQ + n_ * 128; \
            tile_issue(rq, QB + t0_ * 512 + h_ * 128, 512, tid); tile_issue(rk, KB + t0_ * 512 + h_ * 128, 512, tid); \
            tile_issue(rv, VB + t0_ * 512 + h_ * 128, 512, tid); tile_issue(rr, RTB + (size_t)(IT) * 16384, 128, tid); } while (0)
        if (solo && PROBE_P4_PART == 1) it = 1024;
        for (; it < 1024; it += G) {
            const int n = it & 63, h = (it >> 6) & 3, b = it >> 8;
            const float l2g = ret_log2_gamma(h);
            const size_t tok0 = (size_t)b * SEQ + n * 128;
            R3_ISSUE(it);
            tile_commit(lds + OQ, rq, tid); tile_commit(lds + OK_, rk, tid); tile_commit(lds + OV, rv, tid); tile_commit(lds + OR, rr, tid);
            __syncthreads();
            const int i = 16 * wave + fr;
            f32x4 sc[8];
#pragma unroll
            for (int nb = 0; nb < 8; ++nb) sc[nb] = (f32x4){0.f, 0.f, 0.f, 0.f};
            mma128<false, false>(sc, lds, lds_addr, OQ, OK_, 16 * wave, lane);
            __syncthreads();
#pragma unroll
            for (int nb = 0; nb < 8; ++nb) {
                f32x4 pv;
#pragma unroll
                for (int e = 0; e < 4; ++e) { const int j = 16 * nb + 4 * fq + e; pv[e] = (i >= j) ? sc[nb][e] * exp2f((float)(i - j) * l2g) : 0.f; }
                u32x2 w; w.x = cvt_pk_bf16(pv[0], pv[1]); w.y = cvt_pk_bf16(pv[2], pv[3]);
                *(LAS u32x2*)(lds + OK_ + i * TS + (16 * nb + 4 * fq) * 2) = w;
            }
            LDS_WAIT();
            __syncthreads();
            f32x4 a1[8], a2[8];
#pragma unroll
            for (int nb = 0; nb < 8; ++nb) { a1[nb] = (f32x4){0.f, 0.f, 0.f, 0.f}; a2[nb] = (f32x4){0.f, 0.f, 0.f, 0.f}; }
            mma128<false, true>(a1, lds, lds_addr, OK_, OV, 16 * wave, lane);
            mma128<false, false>(a2, lds, lds_addr, OQ, OR, 16 * wave, lane);
            const float xi = exp2f((float)(i + 1) * l2g);
            float s1 = 0.f, s2 = 0.f;
#pragma unroll
            for (int nb = 0; nb < 8; ++nb)
#pragma unroll
                for (int e = 0; e < 4; ++e) { const float o = a1[nb][e] + xi * a2[nb][e]; a1[nb][e] = o; s1 += o; s2 += o * o; }
            s1 += __shfl_xor(s1, 16); s1 += __shfl_xor(s1, 32); s2 += __shfl_xor(s2, 16); s2 += __shfl_xor(s2, 32);
            const float mu = s1 * (1.0f / 128.0f), var = fmaxf(s2 * (1.0f / 128.0f) - mu * mu, 0.f), rs = 1.0f / sqrtf(var + EPS);
            const size_t tok = tok0 + i;
            u32x2 gwv[8]; f32x4 ggv[8];
#pragma unroll
            for (int nb = 0; nb < 8; ++nb) { gwv[nb] = *(const u32x2*)(GB + tok * 512 + h * 128 + 16 * nb + 4 * fq); ggv[nb] = *(const f32x4*)(gn_gain + h * 128 + 16 * nb + 4 * fq); }
#pragma unroll
            for (int nb = 0; nb < 8; ++nb) {
                const int d = 16 * nb + 4 * fq;
                const u32x2 gw = gwv[nb];
                const f32x4 gg = ggv[nb];
                const float g0 = bf_lo(gw.x), g1 = bf_hi(gw.x), g2 = bf_lo(gw.y), g3 = bf_hi(gw.y);
                const float y0 = (a1[nb][0] - mu) * rs * gg[0] * (g0 / (1.0f + __expf(-g0)));
                const float y1 = (a1[nb][1] - mu) * rs * gg[1] * (g1 / (1.0f + __expf(-g1)));
                const float y2 = (a1[nb][2] - mu) * rs * gg[2] * (g2 / (1.0f + __expf(-g2)));
                const float y3 = (a1[nb][3] - mu) * rs * gg[3] * (g3 / (1.0f + __expf(-g3)));
                u32x2 w; w.x = cvt_pk_bf16(y0, y1); w.y = cvt_pk_bf16(y2, y3);
                *(u32x2*)(YMIX + tok * 1024 + h * 128 + d) = w;
            }
            __syncthreads();
        }
        }
    }
#undef R3_ISSUE
    SEAM(4);

    if (IN(5)) for (int rep = 0; rep < REPS(5); ++rep) {
        pg8::Gemm g{YSSM, WGLU, 512, 512, 512, 0, 0}; pg8::StaticOrder S; S.init(T, 1024, G, bx);
        pg8::EpiGlu E{YMIX};
        pg8::gemm_phase(lds, g, S, E);
    }
    SEAM(5);

    if (IN(6)) for (int rep = 0; rep < REPS(6); ++rep) {
        pg8::Gemm g{YMIX, WOUT, DM, DM, DM, 0, 0}; pg8::StaticOrder S; S.init(T, DM, G, bx);
        pg8::EpiSS E{MIXB, SS};
        pg8::gemm_phase(lds, g, S, E);
    }
    SEAM(6);

    if (IN(7)) for (int rep = 0; rep < REPS(7); ++rep) {
        const int gw = bx * 8 + wave, NGW = G * 8;
        const f32x4* gr = (const f32x4*)g_mix_post + lane;
        f32x4 gv[4];
#pragma unroll
        for (int j = 0; j < 4; ++j) gv[j] = gr[64 * j];
        for (int m0 = gw; m0 < T; m0 += 2 * NGW) {
            f32x4 xv[2][4]; u32x2 mw[2][4]; float rs[2];
#pragma unroll
            for (int r = 0; r < 2; ++r) {
                const int m = (m0 + r * NGW < T) ? m0 + r * NGW : m0;
                const f32x4 pa = *((const f32x4*)(SS + (size_t)m * 16) + (lane & 3));
                float sa = (pa[0] + pa[1]) + (pa[2] + pa[3]); sa += __shfl_xor(sa, 1); sa += __shfl_xor(sa, 2);
                rs[r] = 1.0f / sqrtf(sa * (1.0f / DM) + EPS);
                const u32x2* xr = (const u32x2*)(XN + (size_t)m * DM) + lane; const u32x2* mr = (const u32x2*)(MIXB + (size_t)m * DM) + lane;
                const float xs = XSC[m];
#pragma unroll
                for (int j = 0; j < 4; ++j) { const u32x2 xw = xr[64 * j]; xv[r][j] = (f32x4){bf_lo(xw.x) * xs, bf_hi(xw.x) * xs, bf_lo(xw.y) * xs, bf_hi(xw.y) * xs}; mw[r][j] = mr[64 * j]; }
            }
#pragma unroll
            for (int r = 0; r < 2; ++r) {
                const int m = m0 + r * NGW;
                if (m < T) {
                    float sq = 0.f;
#pragma unroll
                    for (int j = 0; j < 4; ++j) {
                        f32x4& v = xv[r][j];
                        v[0] += bf_lo(mw[r][j].x) * rs[r] * gv[j][0]; v[1] += bf_hi(mw[r][j].x) * rs[r] * gv[j][1];
                        v[2] += bf_lo(mw[r][j].y) * rs[r] * gv[j][2]; v[3] += bf_hi(mw[r][j].y) * rs[r] * gv[j][3];
                        sq += (v[0] * v[0] + v[1] * v[1]) + (v[2] * v[2] + v[3] * v[3]);
                    }
                    const float rstd1 = 1.0f / sqrtf(wave_sum(sq) * (1.0f / DM) + EPS);
                    u32x2* o8 = (u32x2*)(XN + (size_t)m * DM) + lane;
#pragma unroll
                    for (int j = 0; j < 4; ++j) { const f32x4 v = xv[r][j]; u32x2 w; w.x = cvt_pk_bf16(v[0] * rstd1, v[1] * rstd1); w.y = cvt_pk_bf16(v[2] * rstd1, v[3] * rstd1); o8[64 * j] = w; }
                }
            }
        }
    }
    SEAM(7);

    if (IN(8)) for (int rep = 0; rep < REPS(8); ++rep) {
        pg8::Gemm g{XN, WFF1, DM, DM, DM, 0, 0}; pg8::StaticOrder S; S.init(T, DFF, G, bx);
        pg8::EpiRelu2 E{HID};
        pg8::gemm_phase(lds, g, S, E);
    }
    SEAM(8);

    if (IN(9)) for (int rep = 0; rep < REPS(9); ++rep) {
        pg8::Gemm g{HID, WFF2, DFF, DFF, DFF, 0, 0}; pg8::StaticOrder S; S.init(T, DM, G, bx);
        pg8::EpiSS E{MB, SS2};
        pg8::gemm_phase(lds, g, S, E);
    }
    SEAM(9);

    if (IN(10)) {
        const int gw = bx * 8 + wave, NGW = G * 8;
        const f32x4* g1r = (const f32x4*)g_mix_post + lane; const f32x4* g2r = (const f32x4*)g_mlp_post + lane;
        f32x4 ga[4], gb[4];
#pragma unroll
        for (int j = 0; j < 4; ++j) { ga[j] = g1r[64 * j]; gb[j] = g2r[64 * j]; }
        for (int m0 = gw; m0 < T; m0 += 2 * NGW) {
            f32x4 xv[2][4]; u32x2 aw[2][4], mw[2][4]; float r1[2], r2[2];
#pragma unroll
            for (int r = 0; r < 2; ++r) {
                const int m = (m0 + r * NGW < T) ? m0 + r * NGW : m0;
                const f32x4 pa = *((const f32x4*)(SS + (size_t)m * 16) + (lane & 3)), pb = *((const f32x4*)(SS2 + (size_t)m * 16) + (lane & 3));
                float sa = (pa[0] + pa[1]) + (pa[2] + pa[3]), sb = (pb[0] + pb[1]) + (pb[2] + pb[3]);
                sa += __shfl_xor(sa, 1); sa += __shfl_xor(sa, 2); sb += __shfl_xor(sb, 1); sb += __shfl_xor(sb, 2);
                r1[r] = 1.0f / sqrtf(sa * (1.0f / DM) + EPS); r2[r] = 1.0f / sqrtf(sb * (1.0f / DM) + EPS);
                const f32x4* xr = (const f32x4*)(x + (size_t)m * DM) + lane;
                const u32x2* ar = (const u32x2*)(MIXB + (size_t)m * DM) + lane; const u32x2* mr = (const u32x2*)(MB + (size_t)m * DM) + lane;
#pragma unroll
                for (int j = 0; j < 4; ++j) { xv[r][j] = xr[64 * j]; aw[r][j] = ar[64 * j]; mw[r][j] = mr[64 * j]; }
            }
#pragma unroll
            for (int r = 0; r < 2; ++r) {
                const int m = m0 + r * NGW;
                if (m < T) {
                    f32x4* orow = (f32x4*)(out + (size_t)m * DM) + lane;
#pragma unroll
                    for (int j = 0; j < 4; ++j) {
                        f32x4 v = xv[r][j];
                        v[0] = (v[0] + bf_lo(aw[r][j].x) * r1[r] * ga[j][0]) + bf_lo(mw[r][j].x) * r2[r] * gb[j][0]; v[1] = (v[1] + bf_hi(aw[r][j].x) * r1[r] * ga[j][1]) + bf_hi(mw[r][j].x) * r2[r] * gb[j][1];
                        v[2] = (v[2] + bf_lo(aw[r][j].y) * r1[r] * ga[j][2]) + bf_lo(mw[r][j].y) * r2[r] * gb[j][2]; v[3] = (v[3] + bf_hi(aw[r][j].y) * r1[r] * ga[j][3]) + bf_hi(mw[r][j].y) * r2[r] * gb[j][3];
                        orow[64 * j] = v;
                    }
                }
            }
        }
    }
#undef IN
#undef SEAM
}

extern "C" void kernel_launch(void* const* d_in, const int* in_sizes, int n_in, void* d_out, int out_size, void* d_ws, size_t ws_size, hipStream_t stream) {
    static int grid = 0;
    if (grid == 0) {
        int dev = 0, cus = 0, per_cu = 0;
        hipGetDevice(&dev);
        hipDeviceGetAttribute(&cus, hipDeviceAttributeMultiprocessorCount, dev);
        hipFuncSetAttribute((const void*)fwd_kernel, hipFuncAttributeMaxDynamicSharedMemorySize, LDS_BYTES);
        if (hipOccupancyMaxActiveBlocksPerMultiprocessor(&per_cu, (const void*)fwd_kernel, 512, LDS_BYTES) != hipSuccess || per_cu < 1) per_cu = 1;
        (void)hipGetLastError();
        grid = cus * per_cu;
        if (grid <= 0) grid = 256;
    }
    Args a{};
    for (int i = 0; i < 19; ++i) a.in[i] = (const float*)d_in[i];
    a.out = (float*)d_out; a.ws = (unsigned char*)d_ws;
#if N_LAUNCH_PER_PHASE
    for (int ph = 0; ph < NPHASE; ++ph) {
        a.ph_lo = ph; a.ph_hi = ph + 1;
        void* args[] = {&a};
        hipError_t e = hipLaunchCooperativeKernel((const void*)fwd_kernel, dim3(grid), dim3(512), args, LDS_BYTES, stream);
        if (e != hipSuccess) { fprintf(stderr, "cooperative launch (phase %d) failed: %s (grid %d)\n", ph, hipGetErrorString(e), grid); break; }
    }
#else
    a.ph_lo = 0; a.ph_hi = NPHASE;
    (void)hipMemsetAsync(d_ws, 0, 16384, stream);
    void* args[] = {&a};
    hipError_t e = hipLaunchCooperativeKernel((const void*)fwd_kernel, dim3(grid), dim3(512), args, LDS_BYTES, stream);
    if (e != hipSuccess) fprintf(stderr, "cooperative launch failed: %s (grid %d)\n", hipGetErrorString(e), grid);
#ifdef PROBE_EXTRA_PHASE
    {
        Args b = a; b.ph_lo = PROBE_EXTRA_PHASE; b.ph_hi = PROBE_EXTRA_PHASE + 1;
        void* args2[] = {&b};
        (void)hipLaunchCooperativeKernel((const void*)fwd_kernel, dim3(grid), dim3(512), args2, LDS_BYTES, stream);
    }
#endif
#endif
}
```

```cpp
#include <hip/hip_runtime.h>
#include <hip/hip_cooperative_groups.h>
#include <cstdio>
namespace cg = cooperative_groups;

#ifndef N_LAUNCH_PER_PHASE
#define N_LAUNCH_PER_PHASE 0
#endif

#ifndef PROBE_P4_DUP
#define PROBE_P4_DUP 0
#endif
#ifndef PROBE_P4_PART
#define PROBE_P4_PART 0
#endif
#ifndef PROBE_DUP
#define PROBE_DUP 0
#endif
#define REPS(k) (1 + ((PROBE_DUP >> (k)) & 1))
#define LAS __attribute__((address_space(3)))
typedef unsigned short bf16_t;
typedef short bf16x8 __attribute__((ext_vector_type(8)));
typedef float f32x4 __attribute__((ext_vector_type(4)));
typedef float f32x2 __attribute__((ext_vector_type(2)));
typedef unsigned u32x4 __attribute__((ext_vector_type(4)));
typedef unsigned u32x2 __attribute__((ext_vector_type(2)));

constexpr int T = 32768, SEQ = 8192, DM = 1024, NIN = 2560, DFF = 4096;
constexpr float EPS = 1e-6f;
constexpr int NPHASE = 11;

constexpr size_t MiB = 1u << 20;
constexpr size_t WS_WIN = 1 * MiB, WS_WGLU = 6 * MiB, WS_WOUT = 7 * MiB, WS_WFF1 = 9 * MiB, WS_WFF2 = 17 * MiB;
constexpr size_t WS_ROPE = 25 * MiB, WS_TW = 29 * MiB, WS_W1S = 49 * MiB, WS_SS = 53 * MiB, WS_SS2 = 55 * MiB, WS_HINC = 57 * MiB;
constexpr size_t WS_XN = 80 * MiB;
constexpr size_t WS_QB = 144 * MiB, WS_KB = 176 * MiB, WS_VB = 208 * MiB, WS_GB = 240 * MiB, WS_AU = 272 * MiB;
constexpr size_t WS_SST = 440 * MiB, WS_RTB = 376 * MiB, WS_YSSM = 408 * MiB;
constexpr size_t WS_YMIX = 312 * MiB;
constexpr size_t WS_HID = 144 * MiB;
constexpr size_t WS_MIXB = 400 * MiB;
constexpr size_t WS_MB = 80 * MiB;

constexpr int LDS_BYTES = 147456;
constexpr int TS = 272;
constexpr int TILE_B = 128 * TS;

typedef __bf16 bf16x2_t __attribute__((ext_vector_type(2)));
__device__ __forceinline__ unsigned cvt_pk_bf16(float lo, float hi) { f32x2 v = {lo, hi}; return __builtin_bit_cast(unsigned, __builtin_convertvector(v, bf16x2_t)); }
__device__ __forceinline__ float bf_lo(unsigned w) { return __uint_as_float(w << 16); }
__device__ __forceinline__ float bf_hi(unsigned w) { return __uint_as_float(w & 0xffff0000u); }
__device__ __forceinline__ bf16_t f2bf(float f) { return (bf16_t)(cvt_pk_bf16(f, 0.f) & 0xffffu); }
__device__ __forceinline__ float wave_sum(float v) {
#pragma unroll
    for (int o = 1; o < 64; o <<= 1) v += __shfl_xor(v, o);
    return v;
}
#define LDS_WAIT() asm volatile("s_waitcnt lgkmcnt(0)" ::: "memory")
template <class Tv> __device__ __forceinline__ Tv ld_nt(const Tv* p) { return __builtin_nontemporal_load(p); }
__device__ __forceinline__ void st_nt(f32x4* p, f32x4 v) { __builtin_nontemporal_store(v, p); }

namespace pg8 {
constexpr int BM = 256, BK = 64, HALF = 128, HTB = HALF * BK * 2, STAGE_BYTES = 8 * HTB, NXCD = 8, WGM = 8;
__device__ __forceinline__ int lds_byte(int r, int c) { const int st = (r >> 4) * 2 + (c >> 5), rr = r & 15, cc = c & 31, ob = rr * 64 + cc * 2; return st * 1024 + (ob ^ (((ob >> 9) & 1) << 5)); }
__device__ __forceinline__ void stage_rc(int b, int& R, int& C) { const int st = b / 1024, sb = b % 1024, swz = sb ^ (((sb >> 9) & 1) << 5); R = (st >> 1) * 16 + swz / 64; C = (st & 1) * 32 + (swz % 64) / 2; }
__device__ __forceinline__ int perm32(int rho) { const int n = rho >> 4, i = rho & 15; return 8 * (i >> 2) + 4 * n + (i & 3); }

struct Unit { int pm, pn, pb; };
struct Gemm { const bf16_t* A; const bf16_t* Bt; int lda, ldb, K; size_t bsA, bsB; };

struct StaticOrder {
    int nM, nN, nwg, G, c;
    __device__ void init(int M, int N, int G_, int c_) { nM = M / BM; nN = N / BM; nwg = nM * nN; G = G_; c = c_; }
    __device__ bool next(int i, Unit& u) const {
        const long L = (long)i * G + c; if (L >= nwg) return false;
        int wgid = (int)L; { const int q = nwg / NXCD, r = nwg % NXCD, xcd = wgid % NXCD, off = wgid / NXCD; wgid = (xcd < r ? xcd * (q + 1) : r * (q + 1) + (xcd - r) * q) + off; }
        const int nig = WGM * nN, gid = wgid / nig, fm = gid * WGM, gsz = (nM - fm) < WGM ? (nM - fm) : WGM;
        u.pm = fm + ((wgid % nig) % gsz); u.pn = (wgid % nig) / gsz; u.pb = 0; return true;
    }
};
struct BatchOrder {
    int G, c;
    __device__ bool next(int i, Unit& u) const {
        const int L = i * G + c; if (L >= 256) return false;
        const int xcd = L & 7, slot = L >> 3;
        u.pb = xcd * 4 + (slot >> 3); const int r = slot & 7; u.pm = r & 3; u.pn = r >> 2; return true;
    }
};

template <class Epi, class Sched>
__device__ __forceinline__ void gemm_phase(LAS unsigned char* lds, const Gemm g, const Sched& S, const Epi& E) {
    const int tid = threadIdx.x, wid = __builtin_amdgcn_readfirstlane(tid >> 6), lane = tid & 63, wr = wid >> 2, wc = wid & 3, fr = lane & 15, fq = lane >> 4;
    const int K = g.K, nt = K / BK;
    unsigned voffA[2], voffB[2];
#pragma unroll
    for (int i = 0; i < 2; ++i) { int R, C; stage_rc(tid * 16 + i * 8192, R, C); const int Rb = Epi::PERM ? ((R & ~31) + perm32(R & 31)) : R;
        voffA[i] = (unsigned)(R * g.lda + C) * 2u; voffB[i] = (unsigned)(Rb * g.ldb + C) * 2u; }
    const size_t kstep = (size_t)(BK * 2);
    const size_t hstepA = (size_t)HALF * g.lda * 2, hstepB = (size_t)HALF * g.ldb * 2;
    const size_t tstepA = 2 * hstepA, tstepB = 2 * hstepB;
    const unsigned ldsw = (unsigned)wid * 1024u;
    const int aoff = lds_byte(wr * 64 + fr, fq * 8), boff = lds_byte(wc * 32 + fr, fq * 8);
#define PG8_SA(b, h) (((b) * 2 + (h)) * HTB)
#define PG8_SB(b, h) ((4 + (b) * 2 + (h)) * HTB)
#define PG8_STAGE(bufoff, gbase, voff) do { _Pragma("unroll") for (int _i = 0; _i < 2; ++_i) \
        __builtin_amdgcn_global_load_lds((const unsigned*)((const char*)(gbase) + (voff)[_i]), (LAS unsigned*)(lds + (bufoff) + ldsw + _i * 8192), 16, 0, 0); } while (0)
#define PG8_LDA(dst, b, h) do { _Pragma("unroll") for (int m = 0; m < 4; ++m) _Pragma("unroll") for (int k = 0; k < 2; ++k) dst[m][k] = *(const LAS bf16x8*)(lds + PG8_SA(b, h) + aoff + m * 2048 + k * 1024); } while (0)
#define PG8_LDB(dst, b, h) do { _Pragma("unroll") for (int n = 0; n < 2; ++n) _Pragma("unroll") for (int k = 0; k < 2; ++k) dst[n][k] = *(const LAS bf16x8*)(lds + PG8_SB(b, h) + boff + n * 2048 + k * 1024); } while (0)
#define PG8_MMA(ai, bj, At, Bt) do { __builtin_amdgcn_s_setprio(1); _Pragma("unroll") for (int m = 0; m < 4; ++m) _Pragma("unroll") for (int n = 0; n < 2; ++n) _Pragma("unroll") for (int k = 0; k < 2; ++k) \
        acc[ai][bj][m][n] = __builtin_amdgcn_mfma_f32_16x16x32_bf16(Bt[n][k], At[m][k], acc[ai][bj][m][n], 0, 0, 0); __builtin_amdgcn_s_setprio(0); } while (0)
#define PG8_WAIT_V(n) asm volatile("s_waitcnt vmcnt(" #n ")" ::: "memory")
#define PG8_WAIT_L(n) asm volatile("s_waitcnt lgkmcnt(" #n ")" ::: "memory")
#define PG8_BAR __builtin_amdgcn_s_barrier()
#define PG8_SCHED __builtin_amdgcn_sched_barrier(0)
    Unit cur, nxt; int ui = 0;
    if (!S.next(0, cur)) return;
    f32x4 acc[2][2][4][2];
#pragma unroll
    for (int a = 0; a < 2; ++a)
#pragma unroll
        for (int b = 0; b < 2; ++b)
#pragma unroll
            for (int m = 0; m < 4; ++m)
#pragma unroll
                for (int n = 0; n < 2; ++n) acc[a][b][m][n] = (f32x4){0.f, 0.f, 0.f, 0.f};
    bf16x8 At[4][2], B0[2][2], B1[2][2];
    const char* cA = (const char*)g.A + (size_t)cur.pb * g.bsA * 2 + (size_t)cur.pm * tstepA;
    const char* cB = (const char*)g.Bt + (size_t)cur.pb * g.bsB * 2 + (size_t)cur.pn * tstepB;
    PG8_STAGE(PG8_SB(0, 0), cB, voffB); PG8_STAGE(PG8_SA(0, 0), cA, voffA); PG8_STAGE(PG8_SB(0, 1), cB + hstepB, voffB); PG8_STAGE(PG8_SA(0, 1), cA + hstepA, voffA);
    if (wr == 1) PG8_BAR;
    PG8_WAIT_V(4); PG8_BAR;
    PG8_STAGE(PG8_SB(1, 0), cB + kstep, voffB); PG8_STAGE(PG8_SA(1, 0), cA + kstep, voffA); PG8_STAGE(PG8_SB(1, 1), cB + hstepB + kstep, voffB);
    PG8_WAIT_V(6); PG8_BAR;
    for (;;) {
        const bool has_next = S.next(ui + 1, nxt);
        const char* nA = has_next ? (const char*)g.A + (size_t)nxt.pb * g.bsA * 2 + (size_t)nxt.pm * tstepA : cA;
        const char* nB = has_next ? (const char*)g.Bt + (size_t)nxt.pb * g.bsB * 2 + (size_t)nxt.pn * tstepB : cB;
        for (int t = 0; t < nt; t += 2) {
            const bool last = (t == nt - 2);
            const char* a1 = cA + (size_t)(t + 1) * kstep;
            const char* a2 = last ? nA : cA + (size_t)(t + 2) * kstep; const char* b2 = last ? nB : cB + (size_t)(t + 2) * kstep;
            const char* a3 = a2 + kstep; const char* b3 = b2 + kstep;
            PG8_LDB(B0, 0, 0); PG8_SCHED; PG8_LDA(At, 0, 0); PG8_STAGE(PG8_SA(1, 1), a1 + hstepA, voffA);
            PG8_WAIT_L(8); PG8_BAR; PG8_WAIT_L(0); PG8_MMA(0, 0, At, B0); PG8_BAR; PG8_SCHED;
            PG8_LDB(B1, 0, 1); PG8_STAGE(PG8_SB(0, 0), b2, voffB);
            PG8_BAR; PG8_WAIT_L(0); PG8_MMA(0, 1, At, B1); PG8_BAR;
            PG8_LDA(At, 0, 1); PG8_STAGE(PG8_SA(0, 0), a2, voffA);
            PG8_BAR; PG8_WAIT_L(0); PG8_MMA(1, 0, At, B0); PG8_BAR; PG8_SCHED;
            PG8_STAGE(PG8_SB(0, 1), b2 + hstepB, voffB);
            PG8_WAIT_V(6); PG8_BAR; PG8_MMA(1, 1, At, B1); PG8_BAR;
            PG8_LDB(B0, 1, 0); PG8_SCHED; PG8_LDA(At, 1, 0); PG8_STAGE(PG8_SA(0, 1), a2 + hstepA, voffA);
            PG8_WAIT_L(8); PG8_BAR; PG8_WAIT_L(0); PG8_MMA(0, 0, At, B0); PG8_BAR; PG8_SCHED;
            PG8_LDB(B1, 1, 1); PG8_STAGE(PG8_SB(1, 0), b3, voffB);
            PG8_BAR; PG8_WAIT_L(0); PG8_MMA(0, 1, At, B1); PG8_BAR;
            PG8_LDA(At, 1, 1); PG8_STAGE(PG8_SA(1, 0), a3, voffA);
            PG8_BAR; PG8_WAIT_L(0); PG8_MMA(1, 0, At, B0); PG8_BAR; PG8_SCHED;
            PG8_STAGE(PG8_SB(1, 1), b3 + hstepB, voffB);
            PG8_WAIT_V(6); PG8_BAR; PG8_MMA(1, 1, At, B1); PG8_BAR;
        }
        E(acc, cur, wr, wc, fr, fq);
        if (!has_next) break;
#pragma unroll
        for (int a = 0; a < 2; ++a)
#pragma unroll
            for (int b = 0; b < 2; ++b)
#pragma unroll
                for (int m = 0; m < 4; ++m)
#pragma unroll
                    for (int n = 0; n < 2; ++n) acc[a][b][m][n] = (f32x4){0.f, 0.f, 0.f, 0.f};
        cur = nxt; cA = nA; cB = nB; ++ui;
    }
    PG8_WAIT_V(0);
    if (wr == 0) PG8_BAR;
    PG8_BAR;
#undef PG8_SA
#undef PG8_SB
#undef PG8_STAGE
#undef PG8_LDA
#undef PG8_LDB
#undef PG8_MMA
#undef PG8_WAIT_V
#undef PG8_WAIT_L
#undef PG8_BAR
#undef PG8_SCHED
}

__device__ __forceinline__ u32x4 pack8(const f32x4 v0, const f32x4 v1) {
    u32x4 w; w.x = cvt_pk_bf16(v0[0], v0[1]); w.y = cvt_pk_bf16(v0[2], v0[3]); w.z = cvt_pk_bf16(v1[0], v1[1]); w.w = cvt_pk_bf16(v1[2], v1[3]); return w;
}
__device__ __forceinline__ f32x4 rope4(const f32x4 v, const f32x4 cs) {
    f32x4 r; r[0] = v[0] * cs[0] - v[1] * cs[1]; r[1] = v[0] * cs[1] + v[1] * cs[0]; r[2] = v[2] * cs[2] - v[3] * cs[3]; r[3] = v[2] * cs[3] + v[3] * cs[2]; return r;
}
struct EpiInProj {
    static constexpr bool PERM = true;
    bf16_t *Q, *Kb, *V, *Gt, *AU; const float* rope;
    __device__ __forceinline__ void operator()(const f32x4 (&acc)[2][2][4][2], const Unit& u, int wr, int wc, int fr, int fq) const {
        const int sect = u.pn >> 1;
        const int row0 = u.pm * BM + wr * 64 + fr;
        const int colt = (u.pn & 1) * 256 + wc * 32 + 8 * fq;
        if (sect <= 1) {
            bf16_t* O = sect ? Kb : Q;
            f32x4 cs[2][4][2];
#pragma unroll
            for (int ai = 0; ai < 2; ++ai)
#pragma unroll
                for (int m = 0; m < 4; ++m) {
                    const int pos = (row0 + ai * HALF + m * 16) & (SEQ - 1);
                    const float* rp = rope + ((size_t)pos * 64 + 16 * wc + 4 * fq) * 2;
                    cs[ai][m][0] = *(const f32x4*)rp; cs[ai][m][1] = *(const f32x4*)(rp + 4);
                }
#pragma unroll
            for (int ai = 0; ai < 2; ++ai)
#pragma unroll
                for (int m = 0; m < 4; ++m) {
                    const int row = row0 + ai * HALF + m * 16;
#pragma unroll
                    for (int bj = 0; bj < 2; ++bj) {
                        const f32x4 v0 = rope4(acc[ai][bj][m][0], cs[ai][m][0]), v1 = rope4(acc[ai][bj][m][1], cs[ai][m][1]);
                        *(u32x4*)(O + (size_t)row * 512 + colt + bj * HALF) = pack8(v0, v1);
                    }
                }
        } else if (sect <= 3) {
            bf16_t* O = (sect == 2) ? V : Gt;
#pragma unroll
            for (int ai = 0; ai < 2; ++ai)
#pragma unroll
                for (int m = 0; m < 4; ++m) {
                    const int row = row0 + ai * HALF + m * 16;
#pragma unroll
                    for (int bj = 0; bj < 2; ++bj) *(u32x4*)(O + (size_t)row * 512 + colt + bj * HALF) = pack8(acc[ai][bj][m][0], acc[ai][bj][m][1]);
                }
        } else {
#pragma unroll
            for (int ai = 0; ai < 2; ++ai)
#pragma unroll
                for (int m = 0; m < 4; ++m) {
                    const int row = row0 + ai * HALF + m * 16, cr = row >> 5, s = row & 31;
#pragma unroll
                    for (int bj = 0; bj < 2; ++bj) {
                        const int cu = colt + bj * HALF, g = cu >> 4, c0 = cu & 15;
                        *(u32x4*)(AU + ((size_t)(g * 1024 + cr) * 640 + s * 16 + c0)) = pack8(acc[ai][bj][m][0], acc[ai][bj][m][1]);
                    }
                }
        }
    }
};
struct EpiGlu {
    static constexpr bool PERM = true;
    bf16_t* Y;
    __device__ __forceinline__ void operator()(const f32x4 (&acc)[2][2][4][2], const Unit& u, int wr, int wc, int fr, int fq) const {
        const int row0 = u.pm * BM + wr * 64 + fr, col = 512 + u.pn * 128 + wc * 32 + 8 * fq;
#pragma unroll
        for (int ai = 0; ai < 2; ++ai)
#pragma unroll
            for (int m = 0; m < 4; ++m) {
                const int row = row0 + ai * HALF + m * 16;
                f32x4 y0, y1;
#pragma unroll
                for (int j = 0; j < 4; ++j) {
                    y0[j] = acc[ai][0][m][0][j] / (1.0f + __expf(-acc[ai][1][m][0][j]));
                    y1[j] = acc[ai][0][m][1][j] / (1.0f + __expf(-acc[ai][1][m][1][j]));
                }
                *(u32x4*)(Y + (size_t)row * 1024 + col) = pack8(y0, y1);
            }
    }
};
struct EpiSS {
    static constexpr bool PERM = true;
    bf16_t* O; float* SS;
    __device__ __forceinline__ void operator()(const f32x4 (&acc)[2][2][4][2], const Unit& u, int wr, int wc, int fr, int fq) const {
        const int row0 = u.pm * BM + wr * 64 + fr, col = u.pn * BM + wc * 32 + 8 * fq;
#pragma unroll
        for (int ai = 0; ai < 2; ++ai)
#pragma unroll
            for (int m = 0; m < 4; ++m) {
                const int row = row0 + ai * HALF + m * 16; float q = 0.f;
#pragma unroll
                for (int bj = 0; bj < 2; ++bj) {
                    const f32x4 v0 = acc[ai][bj][m][0], v1 = acc[ai][bj][m][1];
                    q += (v0[0] * v0[0] + v0[1] * v0[1]) + (v0[2] * v0[2] + v0[3] * v0[3]) + (v1[0] * v1[0] + v1[1] * v1[1]) + (v1[2] * v1[2] + v1[3] * v1[3]);
                    *(u32x4*)(O + (size_t)row * 1024 + col + bj * HALF) = pack8(v0, v1);
                }
                q += __shfl_xor(q, 16); q += __shfl_xor(q, 32);
                if (fq == 0) SS[(size_t)row * 16 + u.pn * 4 + wc] = q;
            }
    }
};
struct EpiRelu2 {
    static constexpr bool PERM = true;
    bf16_t* O;
    __device__ __forceinline__ void operator()(const f32x4 (&acc)[2][2][4][2], const Unit& u, int wr, int wc, int fr, int fq) const {
        const int row0 = u.pm * BM + wr * 64 + fr, col = u.pn * BM + wc * 32 + 8 * fq;
#pragma unroll
        for (int ai = 0; ai < 2; ++ai)
#pragma unroll
            for (int m = 0; m < 4; ++m) {
                const int row = row0 + ai * HALF + m * 16;
#pragma unroll
                for (int bj = 0; bj < 2; ++bj) {
                    f32x4 v0 = acc[ai][bj][m][0], v1 = acc[ai][bj][m][1];
#pragma unroll
                    for (int j = 0; j < 4; ++j) { const float a = fmaxf(v0[j], 0.f), b = fmaxf(v1[j], 0.f); v0[j] = a * a; v1[j] = b * b; }
                    *(u32x4*)(O + (size_t)row * DFF + col + bj * HALF) = pack8(v0, v1);
                }
            }
    }
};
struct EpiSsm {
    static constexpr bool PERM = true;
    const bf16_t* AU; const float* dskip; bf16_t* Y;
    __device__ __forceinline__ void operator()(const f32x4 (&acc)[2][2][4][2], const Unit& u, int wr, int wc, int fr, int fq) const {
        const int g = u.pb;
        const int row0 = u.pm * BM + wr * 64 + fr, colt = u.pn * BM + wc * 32 + 8 * fq;
        const int c0 = 8 * (fq & 1);
        const f32x4 d0 = *(const f32x4*)(dskip + g * 16 + c0), d1 = *(const f32x4*)(dskip + g * 16 + c0 + 4);
        u32x4 uwv[2][4][2];
#pragma unroll
        for (int ai = 0; ai < 2; ++ai)
#pragma unroll
            for (int m = 0; m < 4; ++m)
#pragma unroll
                for (int bj = 0; bj < 2; ++bj) uwv[ai][m][bj] = *(const u32x4*)(AU + ((size_t)(g * 1024 + row0 + ai * HALF + m * 16) * 640 + colt + bj * HALF));
#pragma unroll
        for (int ai = 0; ai < 2; ++ai)
#pragma unroll
            for (int m = 0; m < 4; ++m) {
                const int cr = row0 + ai * HALF + m * 16;
#pragma unroll
                for (int bj = 0; bj < 2; ++bj) {
                    const int col = colt + bj * HALF, s = col >> 4;
                    const u32x4 uw = uwv[ai][m][bj];
                    f32x4 v0 = acc[ai][bj][m][0], v1 = acc[ai][bj][m][1];
                    v0[0] += d0[0] * bf_lo(uw.x); v0[1] += d0[1] * bf_hi(uw.x); v0[2] += d0[2] * bf_lo(uw.y); v0[3] += d0[3] * bf_hi(uw.y);
                    v1[0] += d1[0] * bf_lo(uw.z); v1[1] += d1[1] * bf_hi(uw.z); v1[2] += d1[2] * bf_lo(uw.w); v1[3] += d1[3] * bf_hi(uw.w);
#pragma unroll
                    for (int j = 0; j < 4; ++j) {
                        const float a = v0[j], za = 1.5957691216f * (a + 0.044715f * a * a * a); v0[j] = a / (1.0f + __expf(-za));
                        const float b = v1[j], zb = 1.5957691216f * (b + 0.044715f * b * b * b); v1[j] = b / (1.0f + __expf(-zb));
                    }
                    const size_t tok = (size_t)cr * 32 + s;
                    *(u32x4*)(Y + tok * 512 + g * 16 + c0) = pack8(v0, v1);
                }
            }
    }
};
}

__device__ __forceinline__ bf16x8 frag_nat(const LAS unsigned char* tile, int idx0, int k0, int fr, int fq) {
    return *(const LAS bf16x8*)(tile + (idx0 + fr) * TS + (k0 + 8 * fq) * 2);
}
__device__ __forceinline__ bf16x8 frag_tr(unsigned tile_addr, int k0, int idx0, int lane) {
    const int g = lane >> 4, q = (lane & 15) >> 2, p = lane & 3;
    const unsigned addr = tile_addr + (unsigned)((k0 + 8 * g + q) * TS + (idx0 + 4 * p) * 2);
    u32x2 lo, hi;
    asm volatile("ds_read_b64_tr_b16 %0, %2\n\tds_read_b64_tr_b16 %1, %2 offset:1088\n\ts_waitcnt lgkmcnt(0)" : "=&v"(lo), "=&v"(hi) : "v"(addr) : "memory");
    u32x4 r; r.x = lo.x; r.y = lo.y; r.z = hi.x; r.w = hi.y;
    return __builtin_bit_cast(bf16x8, r);
}
__device__ __forceinline__ void frags_tr8(bf16x8 (&b)[8], unsigned tile_addr, int k0, int lane) {
    const int g = lane >> 4, q = (lane & 15) >> 2, p = lane & 3;
    const unsigned addr = tile_addr + (unsigned)((k0 + 8 * g + q) * TS + (4 * p) * 2);
    u32x2 r0, r1, r2, r3, r4, r5, r6, r7, r8, r9, r10, r11, r12, r13, r14, r15;
    asm volatile(
        "ds_read_b64_tr_b16 %0, %16\n\t"
        "ds_read_b64_tr_b16 %1, %16 offset:1088\n\t"
        "ds_read_b64_tr_b16 %2, %16 offset:32\n\t"
        "ds_read_b64_tr_b16 %3, %16 offset:1120\n\t"
        "ds_read_b64_tr_b16 %4, %16 offset:64\n\t"
        "ds_read_b64_tr_b16 %5, %16 offset:1152\n\t"
        "ds_read_b64_tr_b16 %6, %16 offset:96\n\t"
        "ds_read_b64_tr_b16 %7, %16 offset:1184\n\t"
        "ds_read_b64_tr_b16 %8, %16 offset:128\n\t"
        "ds_read_b64_tr_b16 %9, %16 offset:1216\n\t"
        "ds_read_b64_tr_b16 %10, %16 offset:160\n\t"
        "ds_read_b64_tr_b16 %11, %16 offset:1248\n\t"
        "ds_read_b64_tr_b16 %12, %16 offset:192\n\t"
        "ds_read_b64_tr_b16 %13, %16 offset:1280\n\t"
        "ds_read_b64_tr_b16 %14, %16 offset:224\n\t"
        "ds_read_b64_tr_b16 %15, %16 offset:1312\n\t"
        "s_waitcnt lgkmcnt(0)"
        : "=&v"(r0), "=&v"(r1), "=&v"(r2), "=&v"(r3), "=&v"(r4), "=&v"(r5), "=&v"(r6), "=&v"(r7),
          "=&v"(r8), "=&v"(r9), "=&v"(r10), "=&v"(r11), "=&v"(r12), "=&v"(r13), "=&v"(r14), "=&v"(r15)
        : "v"(addr) : "memory");
    u32x4 w;
    w.x = r0.x; w.y = r0.y; w.z = r1.x; w.w = r1.y; b[0] = __builtin_bit_cast(bf16x8, w);
    w.x = r2.x; w.y = r2.y; w.z = r3.x; w.w = r3.y; b[1] = __builtin_bit_cast(bf16x8, w);
    w.x = r4.x; w.y = r4.y; w.z = r5.x; w.w = r5.y; b[2] = __builtin_bit_cast(bf16x8, w);
    w.x = r6.x; w.y = r6.y; w.z = r7.x; w.w = r7.y; b[3] = __builtin_bit_cast(bf16x8, w);
    w.x = r8.x; w.y = r8.y; w.z = r9.x; w.w = r9.y; b[4] = __builtin_bit_cast(bf16x8, w);
    w.x = r10.x; w.y = r10.y; w.z = r11.x; w.w = r11.y; b[5] = __builtin_bit_cast(bf16x8, w);
    w.x = r12.x; w.y = r12.y; w.z = r13.x; w.w = r13.y; b[6] = __builtin_bit_cast(bf16x8, w);
    w.x = r14.x; w.y = r14.y; w.z = r15.x; w.w = r15.y; b[7] = __builtin_bit_cast(bf16x8, w);
}
template <bool ATR, bool BTR>
__device__ __forceinline__ void mma128(f32x4 (&acc)[8], const LAS unsigned char* lds, unsigned lds_addr, int offA, int offB, int m0, int lane) {
    const int fr = lane & 15, fq = lane >> 4;
#pragma unroll
    for (int ks = 0; ks < 4; ++ks) {
        bf16x8 af, bfr[8];
        if (ATR) af = frag_tr(lds_addr + offA, 32 * ks, m0, lane); else af = frag_nat(lds + offA, m0, 32 * ks, fr, fq);
        if (BTR) frags_tr8(bfr, lds_addr + offB, 32 * ks, lane);
        else {
#pragma unroll
            for (int n = 0; n < 8; ++n) bfr[n] = frag_nat(lds + offB, 16 * n, 32 * ks, fr, fq);
        }
#pragma unroll
        for (int n = 0; n < 8; ++n) acc[n] = __builtin_amdgcn_mfma_f32_16x16x32_bf16(bfr[n], af, acc[n], 0, 0, 0);
    }
}
__device__ __forceinline__ void tile_load(LAS unsigned char* dst, const bf16_t* src, int ld, int tid) {
    u32x4 v[4];
#pragma unroll
    for (int i = 0; i < 4; ++i) { const int q = tid + 512 * i, row = q >> 4, pc = q & 15; v[i] = *(const u32x4*)(src + (size_t)row * ld + pc * 8); }
#pragma unroll
    for (int i = 0; i < 4; ++i) { const int q = tid + 512 * i, row = q >> 4, pc = q & 15; *(LAS u32x4*)(dst + row * TS + pc * 16) = v[i]; }
}
__device__ __forceinline__ void tile_load_zeta(LAS unsigned char* dst, const bf16_t* src, int ld, int tid, float l2g) {
    u32x4 v[4];
#pragma unroll
    for (int i = 0; i < 4; ++i) { const int q = tid + 512 * i, row = q >> 4, pc = q & 15; v[i] = *(const u32x4*)(src + (size_t)row * ld + pc * 8); }
#pragma unroll
    for (int i = 0; i < 4; ++i) {
        const int q = tid + 512 * i, row = q >> 4, pc = q & 15; const float z = exp2f((float)(127 - row) * l2g);
        u32x4 w;
        w.x = cvt_pk_bf16(bf_lo(v[i].x) * z, bf_hi(v[i].x) * z); w.y = cvt_pk_bf16(bf_lo(v[i].y) * z, bf_hi(v[i].y) * z);
        w.z = cvt_pk_bf16(bf_lo(v[i].z) * z, bf_hi(v[i].z) * z); w.w = cvt_pk_bf16(bf_lo(v[i].w) * z, bf_hi(v[i].w) * z);
        *(LAS u32x4*)(dst + row * TS + pc * 16) = w;
    }
}
__device__ __forceinline__ void tile_issue(u32x4 (&v)[4], const bf16_t* src, int ld, int tid) {
#pragma unroll
    for (int i = 0; i < 4; ++i) { const int q = tid + 512 * i, row = q >> 4, pc = q & 15; v[i] = *(const u32x4*)(src + (size_t)row * ld + pc * 8); }
}
__device__ __forceinline__ void tile_issue_nt(u32x4 (&v)[4], const bf16_t* src, int ld, int tid) {
#pragma unroll
    for (int i = 0; i < 4; ++i) { const int q = tid + 512 * i, row = q >> 4, pc = q & 15; v[i] = ld_nt((const u32x4*)(src + (size_t)row * ld + pc * 8)); }
}
__device__ __forceinline__ void tile_commit(LAS unsigned char* dst, const u32x4 (&v)[4], int tid) {
#pragma unroll
    for (int i = 0; i < 4; ++i) { const int q = tid + 512 * i, row = q >> 4, pc = q & 15; *(LAS u32x4*)(dst + row * TS + pc * 16) = v[i]; }
}
__device__ __forceinline__ void tile_commit_zeta(LAS unsigned char* dst, const u32x4 (&v)[4], int tid, float l2g) {
#pragma unroll
    for (int i = 0; i < 4; ++i) {
        const int q = tid + 512 * i, row = q >> 4, pc = q & 15; const float z = exp2f((float)(127 - row) * l2g);
        u32x4 w;
        w.x = cvt_pk_bf16(bf_lo(v[i].x) * z, bf_hi(v[i].x) * z); w.y = cvt_pk_bf16(bf_lo(v[i].y) * z, bf_hi(v[i].y) * z);
        w.z = cvt_pk_bf16(bf_lo(v[i].z) * z, bf_hi(v[i].z) * z); w.w = cvt_pk_bf16(bf_lo(v[i].w) * z, bf_hi(v[i].w) * z);
        *(LAS u32x4*)(dst + row * TS + pc * 16) = w;
    }
}
__device__ __forceinline__ float ret_log2_gamma(int h) { const float g = 1.0f - exp2f(-5.0f - (4.0f / 3.0f) * (float)h); return log2f(g); }

__device__ __forceinline__ int dest_row(int mode, int n) {
    if (mode == 1) { if (n < 1024) { const int sect = n >> 9, w = n & 511, h = w >> 7, j = w & 127; return (sect << 9) + (h << 7) + ((j & 63) << 1) + (j >> 6); } return n; }
    if (mode == 2) { const int bj = n >> 9, rem = n & 511, pn = rem >> 7, j = rem & 127; return (pn << 8) + (bj << 7) + j; }
    return n;
}
struct TrItem { const float* W; bf16_t* WT; const float* gain; int K, N, mode, item; };
__device__ __forceinline__ void p0_tr_load(const TrItem& t, float (&v)[32], int lane) {
    const int nblk = t.N / 32, kb = t.item / nblk, nb = t.item % nblk, k0 = 64 * kb, n0 = 32 * nb;
    const float cs = (t.mode == 1 && n0 >= 512 && n0 < 1024) ? 0.08838834764831845f : 1.0f;
#pragma unroll
    for (int i = 0; i < 32; ++i) { const int kk = 2 * i + (lane >> 5); const float g = t.gain ? t.gain[k0 + kk] * cs : cs; v[i] = ld_nt(t.W + (size_t)(k0 + kk) * t.N + n0 + (lane & 31)) * g; }
}
__device__ __forceinline__ void p0_tr_finish(const TrItem& t, const float (&v)[32], LAS float* scr, int lane) {
    const int nblk = t.N / 32, kb = t.item / nblk, nb = t.item % nblk, k0 = 64 * kb, n0 = 32 * nb;
#pragma unroll
    for (int i = 0; i < 32; ++i) { const int kk = 2 * i + (lane >> 5); scr[kk * 33 + (lane & 31)] = v[i]; }
    LDS_WAIT();
    const int c = lane & 7;
#pragma unroll
    for (int j = 0; j < 4; ++j) { const int n = (lane >> 3) + 8 * j; const LAS float* s = scr + (8 * c) * 33 + n;
        u32x4 o; o.x = cvt_pk_bf16(s[0 * 33], s[1 * 33]); o.y = cvt_pk_bf16(s[2 * 33], s[3 * 33]); o.z = cvt_pk_bf16(s[4 * 33], s[5 * 33]); o.w = cvt_pk_bf16(s[6 * 33], s[7 * 33]);
        *(u32x4*)(t.WT + (size_t)dest_row(t.mode, n0 + n) * t.K + k0 + 8 * c) = o; }
    LDS_WAIT();
}
__device__ __forceinline__ void s5_pow(float lre, float lim, float dt, float j, float& pr, float& pi) {
    const float mag = expf(j * (dt * lre)); float s, c; sincosf(j * (dt * lim), &s, &c); pr = mag * c; pi = mag * s;
}
__device__ __forceinline__ void s5_coef(float lre, float lim, float dt, float& cr, float& ci) {
    float br, bi; s5_pow(lre, lim, dt, 1.0f, br, bi); br -= 1.0f;
    const float den = lre * lre + lim * lim; cr = (br * lre + bi * lim) / den; ci = (bi * lre - br * lim) / den;
}

#define XB_TMO      128
#define XB_XCNT(j)  (256  + 64 * (j))
#define XB_XSUB(j)  (1280 + 64 * (j))
#define XB_XGEN(j)  (2304 + 64 * (j))
#define XB_TOP      3328
#define XB_TOPGEN   3392
#define XCD_BAR_WORDS 3456
#define XB_SPIN_CAP (1u << 18)
__device__ __forceinline__ unsigned xb_ld(unsigned* p)              { return __hip_atomic_load(p, __ATOMIC_RELAXED, __HIP_MEMORY_SCOPE_AGENT); }
__device__ __forceinline__ unsigned xb_add(unsigned* p, unsigned v) { return __hip_atomic_fetch_add(p, v, __ATOMIC_RELAXED, __HIP_MEMORY_SCOPE_AGENT); }
__device__ __forceinline__ unsigned xb_xcc_id() { return (unsigned)__builtin_amdgcn_s_getreg((3 << 11) | 20) & 0xFu; }
#define XB_SPIN(cond, bar) do { unsigned _sp = 0; while (cond) { __builtin_amdgcn_s_sleep(1); \
    if ((++_sp & 255u) == 0u) { if (xb_ld(&(bar)[XB_TMO])) break; if (_sp > XB_SPIN_CAP) { atomicAdd(&(bar)[XB_TMO], 1u); break; } } } } while (0)
struct XcdBarrier { unsigned* bar; unsigned x; volatile LAS unsigned* st; };
__device__ __forceinline__ XcdBarrier xcd_barrier_post(unsigned* bar, volatile LAS unsigned* st) {
    XcdBarrier b; b.bar = bar; b.x = xb_xcc_id(); b.st = st;
    if (threadIdx.x == 0) (void)xb_add(&bar[XB_XCNT(b.x)], 1u);
    return b;
}
__device__ __forceinline__ void xcd_barrier_complete(unsigned* bar, unsigned x, unsigned& nloc, unsigned& nx) {
    const unsigned G = gridDim.x * gridDim.y * gridDim.z;
    unsigned sum, cnt, mine, sp = 0u;
    for (;;) {
        sum = 0u; cnt = 0u; mine = 0u;
#pragma unroll
        for (unsigned j = 0; j < 16; ++j) { const unsigned c = xb_ld(&bar[XB_XCNT(j)]); sum += c; cnt += (c > 0u) ? 1u : 0u; mine = (j == x) ? c : mine; }
        if (sum == G) break;
        __builtin_amdgcn_s_sleep(1);
        if ((++sp & 255u) == 0u) { if (xb_ld(&bar[XB_TMO])) break; if (sp > XB_SPIN_CAP) { atomicAdd(&bar[XB_TMO], 1u); break; } }
    }
    nloc = mine > 0u ? mine : 1u; nx = cnt > 0u ? cnt : 1u;
}
__device__ __forceinline__ void xcd_barrier(const XcdBarrier& b) {
    asm volatile("s_waitcnt vmcnt(0)" ::: "memory");
    __syncthreads();
    if (threadIdx.x == 0) {
        unsigned* bar = b.bar;
        __builtin_amdgcn_s_waitcnt(0);
        unsigned nloc = b.st[0], nx = b.st[1];
        if (nloc == 0u) { xcd_barrier_complete(bar, b.x, nloc, nx); b.st[0] = nloc; b.st[1] = nx; }
        const unsigned old = xb_add(&bar[XB_XSUB(b.x)], 1u);
        const unsigned gen = old / nloc;
        if (old + 1u == (gen + 1u) * nloc) {
            __builtin_amdgcn_fence(__ATOMIC_RELEASE, "agent");
            asm volatile("s_waitcnt vmcnt(0)" ::: "memory");
            const unsigned og = xb_add(&bar[XB_TOP], 1u);
            const unsigned tg = og / nx;
            if (og + 1u == (tg + 1u) * nx) xb_add(&bar[XB_TOPGEN], 1u);
            else XB_SPIN(xb_ld(&bar[XB_TOPGEN]) == tg, bar);
            __builtin_amdgcn_fence(__ATOMIC_ACQUIRE, "agent");
            xb_add(&bar[XB_XGEN(b.x)], 1u);
            asm volatile("s_waitcnt vmcnt(0)" ::: "memory");
        } else {
            XB_SPIN(xb_ld(&bar[XB_XGEN(b.x)]) == gen, bar);
            __builtin_amdgcn_fence(__ATOMIC_ACQUIRE, "agent");
            asm volatile("s_waitcnt vmcnt(0)" ::: "memory");
        }
    }
    __syncthreads();
}

struct Args { const float* in[19]; float* out; unsigned char* ws; int ph_lo, ph_hi; };

__global__ void __launch_bounds__(512, 2) fwd_kernel(Args a) {
    extern __shared__ __attribute__((aligned(16))) unsigned char lds_raw[];
    LAS unsigned char* lds = (LAS unsigned char*)lds_raw;
    const unsigned lds_addr = (unsigned)(size_t)lds_raw;
    cg::grid_group grid = cg::this_grid();
    const int tid = threadIdx.x, lane = tid & 63, wave = __builtin_amdgcn_readfirstlane(tid >> 6);
    const int G = gridDim.x, bx = blockIdx.x;
    const int lo = a.ph_lo, hi = a.ph_hi;
    unsigned char* ws = a.ws;
#define IN(k) (lo <= (k) && (k) < hi)
#define SEAM(k) do { if (lo <= (k) && (k) + 1 < hi) xcd_barrier(xbar); } while (0)
    volatile LAS unsigned* misc = (volatile LAS unsigned*)(lds + (LDS_BYTES - 64));
    if (tid < 16) misc[tid] = 0u;
    __syncthreads();
    const XcdBarrier xbar = xcd_barrier_post((unsigned*)ws, misc);
    if (lo < 0) grid.sync();

    const float* x = a.in[0];
    const float* g_mix_pre = a.in[1]; const float* g_mix_post = a.in[2]; const float* w_in = a.in[3]; const float* gn_gain = a.in[4];
    const float* lam_re = a.in[5]; const float* lam_im = a.in[6]; const float* log_dt = a.in[7];
    const float* b_re = a.in[8]; const float* b_im = a.in[9]; const float* c_re = a.in[10]; const float* c_im = a.in[11]; const float* d_skip = a.in[12];
    const float* w_glu = a.in[13]; const float* w_out = a.in[14]; const float* g_mlp_pre = a.in[15]; const float* g_mlp_post = a.in[16];
    const float* w_ff1 = a.in[17]; const float* w_ff2 = a.in[18];
    float* out = a.out;

    bf16_t* WIN = (bf16_t*)(ws + WS_WIN); bf16_t* WGLU = (bf16_t*)(ws + WS_WGLU); bf16_t* WOUT = (bf16_t*)(ws + WS_WOUT);
    bf16_t* WFF1 = (bf16_t*)(ws + WS_WFF1); bf16_t* WFF2 = (bf16_t*)(ws + WS_WFF2);
    float* ROPE = (float*)(ws + WS_ROPE); bf16_t* TW = (bf16_t*)(ws + WS_TW); bf16_t* W1S = (bf16_t*)(ws + WS_W1S);
    float* XSC = (float*)(ws + 73 * MiB);
    float* SS = (float*)(ws + WS_SS); float* SS2 = (float*)(ws + WS_SS2); float* HINC = (float*)(ws + WS_HINC);
    bf16_t* XN = (bf16_t*)(ws + WS_XN);
    bf16_t* QB = (bf16_t*)(ws + WS_QB); bf16_t* KB = (bf16_t*)(ws + WS_KB); bf16_t* VB = (bf16_t*)(ws + WS_VB); bf16_t* GB = (bf16_t*)(ws + WS_GB);
    bf16_t* AU = (bf16_t*)(ws + WS_AU); bf16_t* SST = (bf16_t*)(ws + WS_SST); bf16_t* RTB = (bf16_t*)(ws + WS_RTB);
    bf16_t* YSSM = (bf16_t*)(ws + WS_YSSM); bf16_t* YMIX = (bf16_t*)(ws + WS_YMIX);
    bf16_t* MIXB = (bf16_t*)(ws + WS_MIXB); bf16_t* HID = (bf16_t*)(ws + WS_HID); bf16_t* MB = (bf16_t*)(ws + WS_MB);

    if (IN(0)) for (int rep = 0; rep < REPS(0); ++rep) {
        const int gw = bx * 8 + wave, NGW = G * 8;
        {
            LAS float* scr = (LAS float*)(lds + wave * 16384);
            constexpr int I_IN = (DM / 64) * (NIN / 32), I_GLU = (512 / 64) * (1024 / 32), I_OUT = (DM / 64) * (DM / 32), I_F1 = (DM / 64) * (DFF / 32), I_F2 = (DFF / 64) * (DM / 32);
            constexpr int NITEMS = I_IN + I_GLU + I_OUT + I_F1 + I_F2;
#define TR_DECODE(IT, t) do { int r_ = (IT); \
                if (r_ < I_IN) { t = TrItem{w_in, WIN, g_mix_pre, DM, NIN, 1, r_}; break; } r_ -= I_IN; \
                if (r_ < I_GLU) { t = TrItem{w_glu, WGLU, nullptr, 512, 1024, 2, r_}; break; } r_ -= I_GLU; \
                if (r_ < I_OUT) { t = TrItem{w_out, WOUT, nullptr, DM, DM, 0, r_}; break; } r_ -= I_OUT; \
                if (r_ < I_F1) { t = TrItem{w_ff1, WFF1, g_mlp_pre, DM, DFF, 0, r_}; break; } r_ -= I_F1; \
                t = TrItem{w_ff2, WFF2, nullptr, DFF, DM, 0, r_}; } while (0)
            int it = gw;
            TrItem cur, nxt; float va[32], vb[32];
            if (it < NITEMS) { TR_DECODE(it, cur); p0_tr_load(cur, va, lane); }
            while (it < NITEMS) {
                const int itn = it + NGW;
                if (itn < NITEMS) { TR_DECODE(itn, nxt); p0_tr_load(nxt, vb, lane); }
                p0_tr_finish(cur, va, scr, lane);
                it = itn;
                if (it >= NITEMS) break;
                const int itn2 = it + NGW;
                if (itn2 < NITEMS) { TR_DECODE(itn2, cur); p0_tr_load(cur, va, lane); }
                p0_tr_finish(nxt, vb, scr, lane);
                it = itn2;
            }
#undef TR_DECODE
        }
        for (int m = gw; m < T; m += 2 * NGW) {
            const int m2 = m + NGW;
            const bool has2 = m2 < T;
            const f32x4* xr0 = (const f32x4*)(x + (size_t)m * DM) + lane;
            const f32x4* xr1 = (const f32x4*)(x + (size_t)(has2 ? m2 : m) * DM) + lane;
            f32x4 v0[4], v1[4]; float s0 = 0.f, s1 = 0.f;
#pragma unroll
            for (int j = 0; j < 4; ++j) { v0[j] = ld_nt(xr0 + 64 * j); v1[j] = ld_nt(xr1 + 64 * j); }
#pragma unroll
            for (int j = 0; j < 4; ++j) {
                s0 += (v0[j][0] * v0[j][0] + v0[j][1] * v0[j][1]) + (v0[j][2] * v0[j][2] + v0[j][3] * v0[j][3]);
                s1 += (v1[j][0] * v1[j][0] + v1[j][1] * v1[j][1]) + (v1[j][2] * v1[j][2] + v1[j][3] * v1[j][3]);
            }
            const float q0 = sqrtf(wave_sum(s0) * (1.0f / DM) + EPS), q1 = sqrtf(wave_sum(s1) * (1.0f / DM) + EPS);
            const float r0 = 1.0f / q0, r1 = 1.0f / q1;
            if (lane == 0) { XSC[m] = q0; if (has2) XSC[m2] = q1; }
            u32x2* o0 = (u32x2*)(XN + (size_t)m * DM) + lane; u32x2* o1 = (u32x2*)(XN + (size_t)m2 * DM) + lane;
#pragma unroll
            for (int j = 0; j < 4; ++j) { u32x2 w; w.x = cvt_pk_bf16(v0[j][0] * r0, v0[j][1] * r0); w.y = cvt_pk_bf16(v0[j][2] * r0, v0[j][3] * r0); o0[64 * j] = w; }
            if (has2) {
#pragma unroll
                for (int j = 0; j < 4; ++j) { u32x2 w; w.x = cvt_pk_bf16(v1[j][0] * r1, v1[j][1] * r1); w.y = cvt_pk_bf16(v1[j][2] * r1, v1[j][3] * r1); o1[64 * j] = w; }
            }
        }
        const float rope_inv = (float)pow(10000.0, -(double)(tid & 63) / 64.0);
        for (int i = bx * 512 + tid; i < SEQ * 64; i += G * 512) {
            const int pos = i >> 6;
            const float inv = rope_inv;
            const float ang = (float)pos * inv; float s, c; sincosf(ang, &s, &c);
            *(f32x2*)(ROPE + (size_t)i * 2) = (f32x2){c, s};
        }
        for (int i = bx * 512 + tid; i < 32 * 32 * 64; i += G * 512) {
            {
                const int q = i & 63, t = (i >> 6) & 31, g = i >> 11;
                const float lre = fminf(lam_re[g * 64 + q], -1e-4f), lim = lam_im[g * 64 + q], dt = expf(log_dt[g]);
                float pr, pi; s5_pow(lre, lim, dt, (float)(t + 1), pr, pi);
                float crv[16], civ[16];
#pragma unroll
                for (int c = 0; c < 16; ++c) { crv[c] = c_re[(g * 16 + c) * 64 + q]; civ[c] = c_im[(g * 16 + c) * 64 + q]; }
#pragma unroll
                for (int c = 0; c < 16; ++c) {
                    const float zr = crv[c] * pr - civ[c] * pi, zi = crv[c] * pi + civ[c] * pr;
                    bf16_t* row = TW + (size_t)(g * 512 + t * 16 + c) * 640 + 512;
                    row[q] = f2bf(zr); row[64 + q] = f2bf(-zi);
                }
            }
            {
                const int s = i & 31, p = (i >> 5) & 63, g = i >> 11;
                const float lre = fminf(lam_re[g * 64 + p], -1e-4f), lim = lam_im[g * 64 + p], dt = expf(log_dt[g]);
                float pr, pi, cr, ci; s5_pow(lre, lim, dt, (float)(31 - s), pr, pi); s5_coef(lre, lim, dt, cr, ci);
                const float wr_ = pr * cr - pi * ci, wi_ = pr * ci + pi * cr;
                float zr[16], zi[16];
#pragma unroll
                for (int c = 0; c < 16; ++c) { const float br = b_re[(g * 64 + p) * 16 + c], bi = b_im[(g * 64 + p) * 16 + c]; zr[c] = wr_ * br - wi_ * bi; zi[c] = wr_ * bi + wi_ * br; }
                u32x4* o0 = (u32x4*)(W1S + (size_t)(g * 128 + p) * 512 + s * 16);
                u32x4* o1 = (u32x4*)(W1S + (size_t)(g * 128 + 64 + p) * 512 + s * 16);
                u32x4 w;
                w.x = cvt_pk_bf16(zr[0], zr[1]); w.y = cvt_pk_bf16(zr[2], zr[3]); w.z = cvt_pk_bf16(zr[4], zr[5]); w.w = cvt_pk_bf16(zr[6], zr[7]); o0[0] = w;
                w.x = cvt_pk_bf16(zr[8], zr[9]); w.y = cvt_pk_bf16(zr[10], zr[11]); w.z = cvt_pk_bf16(zr[12], zr[13]); w.w = cvt_pk_bf16(zr[14], zr[15]); o0[1] = w;
                w.x = cvt_pk_bf16(zi[0], zi[1]); w.y = cvt_pk_bf16(zi[2], zi[3]); w.z = cvt_pk_bf16(zi[4], zi[5]); w.w = cvt_pk_bf16(zi[6], zi[7]); o1[0] = w;
                w.x = cvt_pk_bf16(zi[8], zi[9]); w.y = cvt_pk_bf16(zi[10], zi[11]); w.z = cvt_pk_bf16(zi[12], zi[13]); w.w = cvt_pk_bf16(zi[14], zi[15]); o1[1] = w;
            }
        }
        for (int i = bx * 512 + tid; i < 16384 * 64; i += G * 512) {
            const int piece = i & 63, row = i >> 6, t = (row >> 4) & 31;
            if (piece >= 2 * (t + 1)) *(u32x4*)(TW + (size_t)row * 640 + piece * 8) = (u32x4){0u, 0u, 0u, 0u};
        }
        __syncthreads();
        {
            LAS float* Bre = (LAS float*)lds; LAS float* Bim = Bre + 1024; LAS float* Cre = Bre + 2048; LAS float* Cim = Bre + 3072;
            LAS float* cpr = Bre + 4096; LAS float* cpi = cpr + 256;
            for (int it = bx; it < 256; it += G) {
                const int g = it >> 3, jq = it & 7;
                {
                    const int q0 = tid, q1 = tid + 512;
                    const float* s0 = (q0 < 256 ? b_re : b_im) + g * 1024 + (q0 & 255) * 4;
                    const float* s1 = (q1 < 768 ? c_re : c_im) + g * 1024 + (q1 & 255) * 4;
                    *(LAS f32x4*)(Bre + q0 * 4) = *(const f32x4*)s0;
                    *(LAS f32x4*)(Bre + q1 * 4) = *(const f32x4*)s1;
                }
                if (tid < 256) {
                    const int p = tid & 63, jl = tid >> 6;
                    const float lre = fminf(lam_re[g * 64 + p], -1e-4f), lim = lam_im[g * 64 + p], dt = expf(log_dt[g]);
                    float pr, pi, cr, ci; s5_pow(lre, lim, dt, (float)(4 * jq + jl), pr, pi); s5_coef(lre, lim, dt, cr, ci);
                    cpr[jl * 64 + p] = pr * cr - pi * ci; cpi[jl * 64 + p] = pr * ci + pi * cr;
                }
                __syncthreads();
                {
                    const int cc = tid & 255, c = cc >> 4, c2 = cc & 15, jh = tid >> 8;
                    float v0 = 0.f, v1 = 0.f;
#pragma unroll 8
                    for (int p = 0; p < 64; ++p) {
                        const float cr = Cre[c * 64 + p], ci = Cim[c * 64 + p], br = Bre[p * 16 + c2], bi = Bim[p * 16 + c2];
                        const float mr = cr * br - ci * bi, mi = cr * bi + ci * br;
                        v0 += mr * cpr[(2 * jh) * 64 + p] - mi * cpi[(2 * jh) * 64 + p];
                        v1 += mr * cpr[(2 * jh + 1) * 64 + p] - mi * cpi[(2 * jh + 1) * 64 + p];
                    }
                    const int jj0 = 4 * jq + 2 * jh;
                    const bf16_t w0 = f2bf(v0), w1 = f2bf(v1);
                    for (int t = jj0; t < 32; ++t) TW[(size_t)(g * 512 + t * 16 + c) * 640 + (t - jj0) * 16 + c2] = w0;
                    for (int t = jj0 + 1; t < 32; ++t) TW[(size_t)(g * 512 + t * 16 + c) * 640 + (t - jj0 - 1) * 16 + c2] = w1;
                }
                __syncthreads();
            }
        }
    }
    SEAM(0);

    if (IN(1)) for (int rep = 0; rep < REPS(1); ++rep) {
        pg8::Gemm g{XN, WIN, DM, DM, DM, 0, 0}; pg8::StaticOrder S; S.init(T, NIN, G, bx);
        pg8::EpiInProj E{QB, KB, VB, GB, AU, ROPE};
        pg8::gemm_phase(lds, g, S, E);
    }
    SEAM(1);

    if (IN(2)) for (int rep = 0; rep < REPS(2); ++rep) {
        const int fr = lane & 15, fq = lane >> 4;
        for (int it = bx; it < 256; it += G) {
            const int g = it >> 3, rt = it & 7;
            const bf16_t* pA = AU + (size_t)(g * 1024 + rt * 128) * 640; const bf16_t* pB = W1S + (size_t)(g * 128) * 512;
            f32x4 acc[8];
#pragma unroll
            for (int n = 0; n < 8; ++n) acc[n] = (f32x4){0.f, 0.f, 0.f, 0.f};
            u32x4 ra[4], rb[4];
            tile_issue(ra, pA, 640, tid); tile_issue(rb, pB, 512, tid);
            for (int kt = 0; kt < 4; ++kt) {
                tile_commit(lds, ra, tid); tile_commit(lds + TILE_B, rb, tid);
                __syncthreads();
                if (kt < 3) { tile_issue(ra, pA + (kt + 1) * 128, 640, tid); tile_issue(rb, pB + (kt + 1) * 128, 512, tid); }
                mma128<false, false>(acc, lds, lds_addr, 0, TILE_B, 16 * wave, lane);
                __syncthreads();
            }
            float* o = HINC + ((size_t)(g * 1024 + rt * 128 + 16 * wave + fr)) * 128 + 4 * fq;
#pragma unroll
            for (int n = 0; n < 8; ++n) *(f32x4*)(o + 16 * n) = acc[n];
        }
        {
            u32x4 rk[4], rv[4];
            int it = bx;
#define R1_ISSUE(IT) do { const int n_ = (IT) & 63, h_ = ((IT) >> 6) & 3, b_ = (IT) >> 8; const size_t t0_ = (size_t)b_ * SEQ + n_ * 128; \
                tile_issue(rk, KB + t0_ * 512 + h_ * 128, 512, tid); tile_issue(rv, VB + t0_ * 512 + h_ * 128, 512, tid); } while (0)
            if (it < 1024) R1_ISSUE(it);
            for (; it < 1024; it += G) {
                const int h = (it >> 6) & 3;
                const float l2g = ret_log2_gamma(h);
                tile_commit(lds, rk, tid); tile_commit_zeta(lds + TILE_B, rv, tid, l2g);
                __syncthreads();
                if (it + G < 1024) R1_ISSUE(it + G);
                f32x4 acc[8];
#pragma unroll
                for (int nb = 0; nb < 8; ++nb) acc[nb] = (f32x4){0.f, 0.f, 0.f, 0.f};
                mma128<true, true>(acc, lds, lds_addr, TILE_B, 0, 16 * wave, lane);
                bf16_t* o = SST + (size_t)it * 16384 + (16 * wave + fr) * 128 + 4 * fq;
#pragma unroll
                for (int nb = 0; nb < 8; ++nb) { u32x2 w; w.x = cvt_pk_bf16(acc[nb][0], acc[nb][1]); w.y = cvt_pk_bf16(acc[nb][2], acc[nb][3]); *(u32x2*)(o + 16 * nb) = w; }
                __syncthreads();
            }
#undef R1_ISSUE
        }
    }
    SEAM(2);

    if (IN(3)) for (int rep = 0; rep < REPS(3); ++rep) {
        for (int idx = bx * 512 + tid; idx < 16 * 8192; idx += G * 512) {
            const int bh = idx >> 13, e2 = idx & 8191, h = bh & 3;
            const float gch = exp2f(128.0f * ret_log2_gamma(h));
            const unsigned* sp = (const unsigned*)(SST + (size_t)bh * 64 * 16384 + 2 * e2);
            unsigned* rp = (unsigned*)(RTB + (size_t)bh * 64 * 16384 + 2 * e2);
            float r0 = 0.f, r1 = 0.f;
            for (int n0 = 0; n0 < 64; n0 += 16) {
                unsigned s[16];
#pragma unroll
                for (int j = 0; j < 16; ++j) s[j] = ld_nt(sp + (size_t)(n0 + j) * 8192);
#pragma unroll
                for (int j = 0; j < 16; ++j) { rp[(size_t)(n0 + j) * 8192] = cvt_pk_bf16(r0, r1); r0 = gch * r0 + bf_lo(s[j]); r1 = gch * r1 + bf_hi(s[j]); }
            }
        }
        {
            LAS float* X = (LAS float*)lds;
            for (int it = bx; it < 128; it += G) {
                const int b = it >> 5, g = it & 31, p = tid & 63, seg = tid >> 6;
                const float lre = fminf(lam_re[g * 64 + p], -1e-4f), lim = lam_im[g * 64 + p], dt = expf(log_dt[g]);
                float ar, ai, Ar, Ai; s5_pow(lre, lim, dt, 32.0f, ar, ai); s5_pow(lre, lim, dt, 1024.0f, Ar, Ai);
                const float* hp = HINC + ((size_t)(g * 1024 + b * 256 + seg * 32)) * 128 + p;
                float xr = 0.f, xi = 0.f;
                for (int i = 0; i < 32; ++i) { const float hr = hp[(size_t)i * 128], hi_ = hp[(size_t)i * 128 + 64]; const float nr = ar * xr - ai * xi + hr, ni = ar * xi + ai * xr + hi_; xr = nr; xi = ni; }
                X[(seg * 64 + p) * 2] = xr; X[(seg * 64 + p) * 2 + 1] = xi;
                __syncthreads();
                float cr = 0.f, ci = 0.f;
                for (int s = 0; s < seg; ++s) { const float tr = X[(s * 64 + p) * 2], ti = X[(s * 64 + p) * 2 + 1]; const float nr = Ar * cr - Ai * ci + tr, ni = Ar * ci + Ai * cr + ti; cr = nr; ci = ni; }
                bf16_t* op = AU + ((size_t)(g * 1024 + b * 256 + seg * 32)) * 640 + 512 + p;
                xr = cr; xi = ci;
                for (int i = 0; i < 32; ++i) {
                    op[(size_t)i * 640] = f2bf(xr); op[(size_t)i * 640 + 64] = f2bf(xi);
                    const float hr = hp[(size_t)i * 128], hi_ = hp[(size_t)i * 128 + 64]; const float nr = ar * xr - ai * xi + hr, ni = ar * xi + ai * xr + hi_; xr = nr; xi = ni;
                }
                __syncthreads();
            }
        }
    }
    SEAM(3);

    if (IN(4)) for (int rep = 0; rep < REPS(4); ++rep) {
        const bool solo = (hi - lo == 1);
        if (!(solo && PROBE_P4_PART == 2)) for (int rep4 = 0; rep4 < (PROBE_P4_DUP == 1 ? 2 : 1); ++rep4) {
            pg8::Gemm g{AU, TW, 640, 640, 640, (size_t)1024 * 640, (size_t)512 * 640}; pg8::BatchOrder S{G, bx};
            pg8::EpiSsm E{AU, d_skip, YSSM};
            pg8::gemm_phase(lds, g, S, E);
        }
        const int fr = lane & 15, fq = lane >> 4;
        constexpr int OQ = 0, OK_ = TILE_B, OV = 2 * TILE_B, OR = 3 * TILE_B;
        for (int rep4 = 0; rep4 < (PROBE_P4_DUP == 2 ? 2 : 1); ++rep4) {
        u32x4 rq[4], rk[4], rv[4], rr[4];
        int it = bx;
#define R3_ISSUE(IT) do { const int n_ = (IT) & 63, h_ = ((IT) >> 6) & 3, b_ = (IT) >> 8; const size_t t0_ = (size_t)b_ * SEQ + n_ * 128; \
            tile_issue_nt(rq, QB + t0_ * 512 + h_ * 128, 512, tid); tile_issue_nt(rk, KB + t0_ * 512 + h_ * 128, 512, tid); \
            tile_issue_nt(rv, VB + t0_ * 512 + h_ * 128, 512, tid); tile_issue_nt(rr, RTB + (size_t)(IT) * 16384, 128, tid); } while (0)
        if (solo && PROBE_P4_PART == 1) it = 1024;
        for (; it < 1024; it += G) {
            const int n = it & 63, h = (it >> 6) & 3, b = it >> 8;
            const float l2g = ret_log2_gamma(h);
            const size_t tok0 = (size_t)b * SEQ + n * 128;
            R3_ISSUE(it);
            tile_commit(lds + OQ, rq, tid); tile_commit(lds + OK_, rk, tid); tile_commit(lds + OV, rv, tid); tile_commit(lds + OR, rr, tid);
            __syncthreads();
            const int i = 16 * wave + fr;
            f32x4 sc[8];
#pragma unroll
            for (int nb = 0; nb < 8; ++nb) sc[nb] = (f32x4){0.f, 0.f, 0.f, 0.f};
            mma128<false, false>(sc, lds, lds_addr, OQ, OK_, 16 * wave, lane);
            __syncthreads();
#pragma unroll
            for (int nb = 0; nb < 8; ++nb) {
                f32x4 pv;
#pragma unroll
                for (int e = 0; e < 4; ++e) { const int j = 16 * nb + 4 * fq + e; pv[e] = (i >= j) ? sc[nb][e] * exp2f((float)(i - j) * l2g) : 0.f; }
                u32x2 w; w.x = cvt_pk_bf16(pv[0], pv[1]); w.y = cvt_pk_bf16(pv[2], pv[3]);
                *(LAS u32x2*)(lds + OK_ + i * TS + (16 * nb + 4 * fq) * 2) = w;
            }
            LDS_WAIT();
            __syncthreads();
            f32x4 a1[8], a2[8];
#pragma unroll
            for (int nb = 0; nb < 8; ++nb) { a1[nb] = (f32x4){0.f, 0.f, 0.f, 0.f}; a2[nb] = (f32x4){0.f, 0.f, 0.f, 0.f}; }
            mma128<false, true>(a1, lds, lds_addr, OK_, OV, 16 * wave, lane);
            mma128<false, false>(a2, lds, lds_addr, OQ, OR, 16 * wave, lane);
            const float xi = exp2f((float)(i + 1) * l2g);
            float s1 = 0.f, s2 = 0.f;
#pragma unroll
            for (int nb = 0; nb < 8; ++nb)
#pragma unroll
                for (int e = 0; e < 4; ++e) { const float o = a1[nb][e] + xi * a2[nb][e]; a1[nb][e] = o; s1 += o; s2 += o * o; }
            s1 += __shfl_xor(s1, 16); s1 += __shfl_xor(s1, 32); s2 += __shfl_xor(s2, 16); s2 += __shfl_xor(s2, 32);
            const float mu = s1 * (1.0f / 128.0f), var = fmaxf(s2 * (1.0f / 128.0f) - mu * mu, 0.f), rs = 1.0f / sqrtf(var + EPS);
            const size_t tok = tok0 + i;
            u32x2 gwv[8]; f32x4 ggv[8];
#pragma unroll
            for (int nb = 0; nb < 8; ++nb) { gwv[nb] = ld_nt((const u32x2*)(GB + tok * 512 + h * 128 + 16 * nb + 4 * fq)); ggv[nb] = *(const f32x4*)(gn_gain + h * 128 + 16 * nb + 4 * fq); }
#pragma unroll
            for (int nb = 0; nb < 8; ++nb) {
                const int d = 16 * nb + 4 * fq;
                const u32x2 gw = gwv[nb];
                const f32x4 gg = ggv[nb];
                const float g0 = bf_lo(gw.x), g1 = bf_hi(gw.x), g2 = bf_lo(gw.y), g3 = bf_hi(gw.y);
                const float y0 = (a1[nb][0] - mu) * rs * gg[0] * (g0 / (1.0f + __expf(-g0)));
                const float y1 = (a1[nb][1] - mu) * rs * gg[1] * (g1 / (1.0f + __expf(-g1)));
                const float y2 = (a1[nb][2] - mu) * rs * gg[2] * (g2 / (1.0f + __expf(-g2)));
                const float y3 = (a1[nb][3] - mu) * rs * gg[3] * (g3 / (1.0f + __expf(-g3)));
                u32x2 w; w.x = cvt_pk_bf16(y0, y1); w.y = cvt_pk_bf16(y2, y3);
                *(u32x2*)(YMIX + tok * 1024 + h * 128 + d) = w;
            }
            __syncthreads();
        }
        }
    }
#undef R3_ISSUE
    SEAM(4);

    if (IN(5)) for (int rep = 0; rep < REPS(5); ++rep) {
        pg8::Gemm g{YSSM, WGLU, 512, 512, 512, 0, 0}; pg8::StaticOrder S; S.init(T, 1024, G, bx);
        pg8::EpiGlu E{YMIX};
        pg8::gemm_phase(lds, g, S, E);
    }
    SEAM(5);

    if (IN(6)) for (int rep = 0; rep < REPS(6); ++rep) {
        pg8::Gemm g{YMIX, WOUT, DM, DM, DM, 0, 0}; pg8::StaticOrder S; S.init(T, DM, G, bx);
        pg8::EpiSS E{MIXB, SS};
        pg8::gemm_phase(lds, g, S, E);
    }
    SEAM(6);

    if (IN(7)) for (int rep = 0; rep < REPS(7); ++rep) {
        const int gw = bx * 8 + wave, NGW = G * 8;
        const f32x4* gr = (const f32x4*)g_mix_post + lane;
        f32x4 gv[4];
#pragma unroll
        for (int j = 0; j < 4; ++j) gv[j] = gr[64 * j];
        for (int m0 = gw; m0 < T; m0 += 2 * NGW) {
            f32x4 xv[2][4]; u32x2 mw[2][4]; float rs[2];
#pragma unroll
            for (int r = 0; r < 2; ++r) {
                const int m = (m0 + r * NGW < T) ? m0 + r * NGW : m0;
                const f32x4 pa = *((const f32x4*)(SS + (size_t)m * 16) + (lane & 3));
                float sa = (pa[0] + pa[1]) + (pa[2] + pa[3]); sa += __shfl_xor(sa, 1); sa += __shfl_xor(sa, 2);
                rs[r] = 1.0f / sqrtf(sa * (1.0f / DM) + EPS);
                const u32x2* xr = (const u32x2*)(XN + (size_t)m * DM) + lane; const u32x2* mr = (const u32x2*)(MIXB + (size_t)m * DM) + lane;
                const float xs = XSC[m];
#pragma unroll
                for (int j = 0; j < 4; ++j) { const u32x2 xw = ld_nt(xr + 64 * j); xv[r][j] = (f32x4){bf_lo(xw.x) * xs, bf_hi(xw.x) * xs, bf_lo(xw.y) * xs, bf_hi(xw.y) * xs}; mw[r][j] = ld_nt(mr + 64 * j); }
            }
#pragma unroll
            for (int r = 0; r < 2; ++r) {
                const int m = m0 + r * NGW;
                if (m < T) {
                    float sq = 0.f;
#pragma unroll
                    for (int j = 0; j < 4; ++j) {
                        f32x4& v = xv[r][j];
                        v[0] += bf_lo(mw[r][j].x) * rs[r] * gv[j][0]; v[1] += bf_hi(mw[r][j].x) * rs[r] * gv[j][1];
                        v[2] += bf_lo(mw[r][j].y) * rs[r] * gv[j][2]; v[3] += bf_hi(mw[r][j].y) * rs[r] * gv[j][3];
                        sq += (v[0] * v[0] + v[1] * v[1]) + (v[2] * v[2] + v[3] * v[3]);
                    }
                    const float rstd1 = 1.0f / sqrtf(wave_sum(sq) * (1.0f / DM) + EPS);
                    u32x2* o8 = (u32x2*)(XN + (size_t)m * DM) + lane;
#pragma unroll
                    for (int j = 0; j < 4; ++j) { const f32x4 v = xv[r][j]; u32x2 w; w.x = cvt_pk_bf16(v[0] * rstd1, v[1] * rstd1); w.y = cvt_pk_bf16(v[2] * rstd1, v[3] * rstd1); o8[64 * j] = w; }
                }
            }
        }
    }
    SEAM(7);

    if (IN(8)) for (int rep = 0; rep < REPS(8); ++rep) {
        pg8::Gemm g{XN, WFF1, DM, DM, DM, 0, 0}; pg8::StaticOrder S; S.init(T, DFF, G, bx);
        pg8::EpiRelu2 E{HID};
        pg8::gemm_phase(lds, g, S, E);
    }
    SEAM(8);

    if (IN(9)) for (int rep = 0; rep < REPS(9); ++rep) {
        pg8::Gemm g{HID, WFF2, DFF, DFF, DFF, 0, 0}; pg8::StaticOrder S; S.init(T, DM, G, bx);
        pg8::EpiSS E{MB, SS2};
        pg8::gemm_phase(lds, g, S, E);
    }
    SEAM(9);

    if (IN(10)) {
        const int gw = bx * 8 + wave, NGW = G * 8;
        const f32x4* g1r = (const f32x4*)g_mix_post + lane; const f32x4* g2r = (const f32x4*)g_mlp_post + lane;
        f32x4 ga[4], gb[4];
#pragma unroll
        for (int j = 0; j < 4; ++j) { ga[j] = g1r[64 * j]; gb[j] = g2r[64 * j]; }
        for (int m0 = gw; m0 < T; m0 += 2 * NGW) {
            f32x4 xv[2][4]; u32x2 aw[2][4], mw[2][4]; float r1[2], r2[2];
#pragma unroll
            for (int r = 0; r < 2; ++r) {
                const int m = (m0 + r * NGW < T) ? m0 + r * NGW : m0;
                const f32x4 pa = *((const f32x4*)(SS + (size_t)m * 16) + (lane & 3)), pb = *((const f32x4*)(SS2 + (size_t)m * 16) + (lane & 3));
                float sa = (pa[0] + pa[1]) + (pa[2] + pa[3]), sb = (pb[0] + pb[1]) + (pb[2] + pb[3]);
                sa += __shfl_xor(sa, 1); sa += __shfl_xor(sa, 2); sb += __shfl_xor(sb, 1); sb += __shfl_xor(sb, 2);
                r1[r] = 1.0f / sqrtf(sa * (1.0f / DM) + EPS); r2[r] = 1.0f / sqrtf(sb * (1.0f / DM) + EPS);
                const f32x4* xr = (const f32x4*)(x + (size_t)m * DM) + lane;
                const u32x2* ar = (const u32x2*)(MIXB + (size_t)m * DM) + lane; const u32x2* mr = (const u32x2*)(MB + (size_t)m * DM) + lane;
#pragma unroll
                for (int j = 0; j < 4; ++j) { xv[r][j] = ld_nt(xr + 64 * j); aw[r][j] = ld_nt(ar + 64 * j); mw[r][j] = ld_nt(mr + 64 * j); }
            }
#pragma unroll
            for (int r = 0; r < 2; ++r) {
                const int m = m0 + r * NGW;
                if (m < T) {
                    f32x4* orow = (f32x4*)(out + (size_t)m * DM) + lane;
#pragma unroll
                    for (int j = 0; j < 4; ++j) {
                        f32x4 v = xv[r][j];
                        v[0] = (v[0] + bf_lo(aw[r][j].x) * r1[r] * ga[j][0]) + bf_lo(mw[r][j].x) * r2[r] * gb[j][0]; v[1] = (v[1] + bf_hi(aw[r][j].x) * r1[r] * ga[j][1]) + bf_hi(mw[r][j].x) * r2[r] * gb[j][1];
                        v[2] = (v[2] + bf_lo(aw[r][j].y) * r1[r] * ga[j][2]) + bf_lo(mw[r][j].y) * r2[r] * gb[j][2]; v[3] = (v[3] + bf_hi(aw[r][j].y) * r1[r] * ga[j][3]) + bf_hi(mw[r][j].y) * r2[r] * gb[j][3];
                        st_nt(orow + 64 * j, v);
                    }
                }
            }
        }
    }
#undef IN
#undef SEAM
}

extern "C" void kernel_launch(void* const* d_in, const int* in_sizes, int n_in, void* d_out, int out_size, void* d_ws, size_t ws_size, hipStream_t stream) {
    static int grid = 0;
    if (grid == 0) {
        int dev = 0, cus = 0, per_cu = 0;
        hipGetDevice(&dev);
        hipDeviceGetAttribute(&cus, hipDeviceAttributeMultiprocessorCount, dev);
        hipFuncSetAttribute((const void*)fwd_kernel, hipFuncAttributeMaxDynamicSharedMemorySize, LDS_BYTES);
        if (hipOccupancyMaxActiveBlocksPerMultiprocessor(&per_cu, (const void*)fwd_kernel, 512, LDS_BYTES) != hipSuccess || per_cu < 1) per_cu = 1;
        (void)hipGetLastError();
        grid = cus * per_cu;
        if (grid <= 0) grid = 256;
    }
    Args a{};
    for (int i = 0; i < 19; ++i) a.in[i] = (const float*)d_in[i];
    a.out = (float*)d_out; a.ws = (unsigned char*)d_ws;
#if N_LAUNCH_PER_PHASE
    for (int ph = 0; ph < NPHASE; ++ph) {
        a.ph_lo = ph; a.ph_hi = ph + 1;
        void* args[] = {&a};
        hipError_t e = hipLaunchCooperativeKernel((const void*)fwd_kernel, dim3(grid), dim3(512), args, LDS_BYTES, stream);
        if (e != hipSuccess) { fprintf(stderr, "cooperative launch (phase %d) failed: %s (grid %d)\n", ph, hipGetErrorString(e), grid); break; }
    }
#else
    a.ph_lo = 0; a.ph_hi = NPHASE;
    (void)hipMemsetAsync(d_ws, 0, 16384, stream);
    void* args[] = {&a};
    hipError_t e = hipLaunchCooperativeKernel((const void*)fwd_kernel, dim3(grid), dim3(512), args, LDS_BYTES, stream);
    if (e != hipSuccess) fprintf(stderr, "cooperative launch failed: %s (grid %d)\n", hipGetErrorString(e), grid);
#ifdef PROBE_EXTRA_PHASE
    {
        Args b = a; b.ph_lo = PROBE_EXTRA_PHASE; b.ph_hi = PROBE_EXTRA_PHASE + 1;
        void* args2[] = {&b};
        (void)hipLaunchCooperativeKernel((const void*)fwd_kernel, dim3(grid), dim3(512), args2, LDS_BYTES, stream);
    }
#endif
#endif
}
```

```cpp
#include <hip/hip_runtime.h>
#include <hip/hip_cooperative_groups.h>
#include <cstdio>
namespace cg = cooperative_groups;

#ifndef N_LAUNCH_PER_PHASE
#define N_LAUNCH_PER_PHASE 0
#endif

#ifndef PROBE_P4_DUP
#define PROBE_P4_DUP 0
#endif
#ifndef PROBE_P4_PART
#define PROBE_P4_PART 0
#endif
#ifndef PROBE_DUP
#define PROBE_DUP 0
#endif
#define REPS(k) (1 + ((PROBE_DUP >> (k)) & 1))
#define LAS __attribute__((address_space(3)))
typedef unsigned short bf16_t;
typedef short bf16x8 __attribute__((ext_vector_type(8)));
typedef float f32x4 __attribute__((ext_vector_type(4)));
typedef float f32x2 __attribute__((ext_vector_type(2)));
typedef unsigned u32x4 __attribute__((ext_vector_type(4)));
typedef unsigned u32x2 __attribute__((ext_vector_type(2)));

constexpr int T = 32768, SEQ = 8192, DM = 1024, NIN = 2560, DFF = 4096;
constexpr float EPS = 1e-6f;
constexpr int NPHASE = 11;

constexpr size_t MiB = 1u << 20;
constexpr size_t WS_WIN = 1 * MiB, WS_WGLU = 6 * MiB, WS_WOUT = 7 * MiB, WS_WFF1 = 9 * MiB, WS_WFF2 = 17 * MiB;
constexpr size_t WS_ROPE = 25 * MiB, WS_TW = 29 * MiB, WS_W1S = 49 * MiB, WS_SS = 53 * MiB, WS_SS2 = 55 * MiB, WS_HINC = 57 * MiB;
constexpr size_t WS_XN = 80 * MiB;
constexpr size_t WS_QB = 144 * MiB, WS_KB = 176 * MiB, WS_VB = 208 * MiB, WS_GB = 240 * MiB, WS_AU = 272 * MiB;
constexpr size_t WS_SST = 440 * MiB, WS_RTB = 376 * MiB, WS_YSSM = 408 * MiB;
constexpr size_t WS_YMIX = 312 * MiB;
constexpr size_t WS_HID = 144 * MiB;
constexpr size_t WS_MIXB = 400 * MiB;
constexpr size_t WS_MB = 80 * MiB;

constexpr int LDS_BYTES = 147456;
constexpr int TS = 272;
constexpr int TILE_B = 128 * TS;

typedef __bf16 bf16x2_t __attribute__((ext_vector_type(2)));
__device__ __forceinline__ unsigned cvt_pk_bf16(float lo, float hi) { f32x2 v = {lo, hi}; return __builtin_bit_cast(unsigned, __builtin_convertvector(v, bf16x2_t)); }
__device__ __forceinline__ float bf_lo(unsigned w) { return __uint_as_float(w << 16); }
__device__ __forceinline__ float bf_hi(unsigned w) { return __uint_as_float(w & 0xffff0000u); }
__device__ __forceinline__ bf16_t f2bf(float f) { return (bf16_t)(cvt_pk_bf16(f, 0.f) & 0xffffu); }
__device__ __forceinline__ float wave_sum(float v) {
#pragma unroll
    for (int o = 1; o < 64; o <<= 1) v += __shfl_xor(v, o);
    return v;
}
#define LDS_WAIT() asm volatile("s_waitcnt lgkmcnt(0)" ::: "memory")
template <class Tv> __device__ __forceinline__ Tv ld_nt(const Tv* p) { return __builtin_nontemporal_load(p); }
__device__ __forceinline__ void st_nt(f32x4* p, f32x4 v) { __builtin_nontemporal_store(v, p); }

namespace pg8 {
constexpr int BM = 256, BK = 64, HALF = 128, HTB = HALF * BK * 2, STAGE_BYTES = 8 * HTB, NXCD = 8, WGM = 8;
__device__ __forceinline__ int lds_byte(int r, int c) { const int st = (r >> 4) * 2 + (c >> 5), rr = r & 15, cc = c & 31, ob = rr * 64 + cc * 2; return st * 1024 + (ob ^ (((ob >> 9) & 1) << 5)); }
__device__ __forceinline__ void stage_rc(int b, int& R, int& C) { const int st = b / 1024, sb = b % 1024, swz = sb ^ (((sb >> 9) & 1) << 5); R = (st >> 1) * 16 + swz / 64; C = (st & 1) * 32 + (swz % 64) / 2; }
__device__ __forceinline__ int perm32(int rho) { const int n = rho >> 4, i = rho & 15; return 8 * (i >> 2) + 4 * n + (i & 3); }

struct Unit { int pm, pn, pb; };
struct Gemm { const bf16_t* A; const bf16_t* Bt; int lda, ldb, K; size_t bsA, bsB; };

struct StaticOrder {
    int nM, nN, nwg, G, c;
    __device__ void init(int M, int N, int G_, int c_) { nM = M / BM; nN = N / BM; nwg = nM * nN; G = G_; c = c_; }
    __device__ bool next(int i, Unit& u) const {
        const long L = (long)i * G + c; if (L >= nwg) return false;
        int wgid = (int)L; { const int q = nwg / NXCD, r = nwg % NXCD, xcd = wgid % NXCD, off = wgid / NXCD; wgid = (xcd < r ? xcd * (q + 1) : r * (q + 1) + (xcd - r) * q) + off; }
        const int nig = WGM * nN, gid = wgid / nig, fm = gid * WGM, gsz = (nM - fm) < WGM ? (nM - fm) : WGM;
        u.pm = fm + ((wgid % nig) % gsz); u.pn = (wgid % nig) / gsz; u.pb = 0; return true;
    }
};
struct BatchOrder {
    int G, c;
    __device__ bool next(int i, Unit& u) const {
        const int L = i * G + c; if (L >= 256) return false;
        const int xcd = L & 7, slot = L >> 3;
        u.pb = xcd * 4 + (slot >> 3); const int r = slot & 7; u.pm = r & 3; u.pn = r >> 2; return true;
    }
};

template <class Epi, class Sched>
__device__ __forceinline__ void gemm_phase(LAS unsigned char* lds, const Gemm g, const Sched& S, const Epi& E) {
    const int tid = threadIdx.x, wid = __builtin_amdgcn_readfirstlane(tid >> 6), lane = tid & 63, wr = wid >> 2, wc = wid & 3, fr = lane & 15, fq = lane >> 4;
    const int K = g.K, nt = K / BK;
    unsigned voffA[2], voffB[2];
#pragma unroll
    for (int i = 0; i < 2; ++i) { int R, C; stage_rc(tid * 16 + i * 8192, R, C); const int Rb = Epi::PERM ? ((R & ~31) + perm32(R & 31)) : R;
        voffA[i] = (unsigned)(R * g.lda + C) * 2u; voffB[i] = (unsigned)(Rb * g.ldb + C) * 2u; }
    const size_t kstep = (size_t)(BK * 2);
    const size_t hstepA = (size_t)HALF * g.lda * 2, hstepB = (size_t)HALF * g.ldb * 2;
    const size_t tstepA = 2 * hstepA, tstepB = 2 * hstepB;
    const unsigned ldsw = (unsigned)wid * 1024u;
    const int aoff = lds_byte(wr * 64 + fr, fq * 8), boff = lds_byte(wc * 32 + fr, fq * 8);
#define PG8_SA(b, h) (((b) * 2 + (h)) * HTB)
#define PG8_SB(b, h) ((4 + (b) * 2 + (h)) * HTB)
#define PG8_STAGE(bufoff, gbase, voff) do { _Pragma("unroll") for (int _i = 0; _i < 2; ++_i) \
        __builtin_amdgcn_global_load_lds((const unsigned*)((const char*)(gbase) + (voff)[_i]), (LAS unsigned*)(lds + (bufoff) + ldsw + _i * 8192), 16, 0, 0); } while (0)
#define PG8_LDA(dst, b, h) do { _Pragma("unroll") for (int m = 0; m < 4; ++m) _Pragma("unroll") for (int k = 0; k < 2; ++k) dst[m][k] = *(const LAS bf16x8*)(lds + PG8_SA(b, h) + aoff + m * 2048 + k * 1024); } while (0)
#define PG8_LDB(dst, b, h) do { _Pragma("unroll") for (int n = 0; n < 2; ++n) _Pragma("unroll") for (int k = 0; k < 2; ++k) dst[n][k] = *(const LAS bf16x8*)(lds + PG8_SB(b, h) + boff + n * 2048 + k * 1024); } while (0)
#define PG8_MMA(ai, bj, At, Bt) do { __builtin_amdgcn_s_setprio(1); _Pragma("unroll") for (int m = 0; m < 4; ++m) _Pragma("unroll") for (int n = 0; n < 2; ++n) _Pragma("unroll") for (int k = 0; k < 2; ++k) \
        acc[ai][bj][m][n] = __builtin_amdgcn_mfma_f32_16x16x32_bf16(Bt[n][k], At[m][k], acc[ai][bj][m][n], 0, 0, 0); __builtin_amdgcn_s_setprio(0); } while (0)
#define PG8_WAIT_V(n) asm volatile("s_waitcnt vmcnt(" #n ")" ::: "memory")
#define PG8_WAIT_L(n) asm volatile("s_waitcnt lgkmcnt(" #n ")" ::: "memory")
#define PG8_BAR __builtin_amdgcn_s_barrier()
#define PG8_SCHED __builtin_amdgcn_sched_barrier(0)
    Unit cur, nxt; int ui = 0;
    if (!S.next(0, cur)) return;
    f32x4 acc[2][2][4][2];
#pragma unroll
    for (int a = 0; a < 2; ++a)
#pragma unroll
        for (int b = 0; b < 2; ++b)
#pragma unroll
            for (int m = 0; m < 4; ++m)
#pragma unroll
                for (int n = 0; n < 2; ++n) acc[a][b][m][n] = (f32x4){0.f, 0.f, 0.f, 0.f};
    bf16x8 At[4][2], B0[2][2], B1[2][2];
    const char* cA = (const char*)g.A + (size_t)cur.pb * g.bsA * 2 + (size_t)cur.pm * tstepA;
    const char* cB = (const char*)g.Bt + (size_t)cur.pb * g.bsB * 2 + (size_t)cur.pn * tstepB;
    PG8_STAGE(PG8_SB(0, 0), cB, voffB); PG8_STAGE(PG8_SA(0, 0), cA, voffA); PG8_STAGE(PG8_SB(0, 1), cB + hstepB, voffB); PG8_STAGE(PG8_SA(0, 1), cA + hstepA, voffA);
    if (wr == 1) PG8_BAR;
    PG8_WAIT_V(4); PG8_BAR;
    PG8_STAGE(PG8_SB(1, 0), cB + kstep, voffB); PG8_STAGE(PG8_SA(1, 0), cA + kstep, voffA); PG8_STAGE(PG8_SB(1, 1), cB + hstepB + kstep, voffB);
    PG8_WAIT_V(6); PG8_BAR;
    for (;;) {
        const bool has_next = S.next(ui + 1, nxt);
        const char* nA = has_next ? (const char*)g.A + (size_t)nxt.pb * g.bsA * 2 + (size_t)nxt.pm * tstepA : cA;
        const char* nB = has_next ? (const char*)g.Bt + (size_t)nxt.pb * g.bsB * 2 + (size_t)nxt.pn * tstepB : cB;
        for (int t = 0; t < nt; t += 2) {
            const bool last = (t == nt - 2);
            const char* a1 = cA + (size_t)(t + 1) * kstep;
            const char* a2 = last ? nA : cA + (size_t)(t + 2) * kstep; const char* b2 = last ? nB : cB + (size_t)(t + 2) * kstep;
            const char* a3 = a2 + kstep; const char* b3 = b2 + kstep;
            PG8_LDB(B0, 0, 0); PG8_SCHED; PG8_LDA(At, 0, 0); PG8_STAGE(PG8_SA(1, 1), a1 + hstepA, voffA);
            PG8_WAIT_L(8); PG8_BAR; PG8_WAIT_L(0); PG8_MMA(0, 0, At, B0); PG8_BAR; PG8_SCHED;
            PG8_LDB(B1, 0, 1); PG8_STAGE(PG8_SB(0, 0), b2, voffB);
            PG8_BAR; PG8_WAIT_L(0); PG8_MMA(0, 1, At, B1); PG8_BAR;
            PG8_LDA(At, 0, 1); PG8_STAGE(PG8_SA(0, 0), a2, voffA);
            PG8_BAR; PG8_WAIT_L(0); PG8_MMA(1, 0, At, B0); PG8_BAR; PG8_SCHED;
            PG8_STAGE(PG8_SB(0, 1), b2 + hstepB, voffB);
            PG8_WAIT_V(6); PG8_BAR; PG8_MMA(1, 1, At, B1); PG8_BAR;
            PG8_LDB(B0, 1, 0); PG8_SCHED; PG8_LDA(At, 1, 0); PG8_STAGE(PG8_SA(0, 1), a2 + hstepA, voffA);
            PG8_WAIT_L(8); PG8_BAR; PG8_WAIT_L(0); PG8_MMA(0, 0, At, B0); PG8_BAR; PG8_SCHED;
            PG8_LDB(B1, 1, 1); PG8_STAGE(PG8_SB(1, 0), b3, voffB);
            PG8_BAR; PG8_WAIT_L(0); PG8_MMA(0, 1, At, B1); PG8_BAR;
            PG8_LDA(At, 1, 1); PG8_STAGE(PG8_SA(1, 0), a3, voffA);
            PG8_BAR; PG8_WAIT_L(0); PG8_MMA(1, 0, At, B0); PG8_BAR; PG8_SCHED;
            PG8_STAGE(PG8_SB(1, 1), b3 + hstepB, voffB);
            PG8_WAIT_V(6); PG8_BAR; PG8_MMA(1, 1, At, B1); PG8_BAR;
        }
        E(acc, cur, wr, wc, fr, fq);
        if (!has_next) break;
#pragma unroll
        for (int a = 0; a < 2; ++a)
#pragma unroll
            for (int b = 0; b < 2; ++b)
#pragma unroll
                for (int m = 0; m < 4; ++m)
#pragma unroll
                    for (int n = 0; n < 2; ++n) acc[a][b][m][n] = (f32x4){0.f, 0.f, 0.f, 0.f};
        cur = nxt; cA = nA; cB = nB; ++ui;
    }
    PG8_WAIT_V(0);
    if (wr == 0) PG8_BAR;
    PG8_BAR;
#undef PG8_SA
#undef PG8_SB
#undef PG8_STAGE
#undef PG8_LDA
#undef PG8_LDB
#undef PG8_MMA
#undef PG8_WAIT_V
#undef PG8_WAIT_L
#undef PG8_BAR
#undef PG8_SCHED
}

__device__ __forceinline__ u32x4 pack8(const f32x4 v0, const f32x4 v1) {
    u32x4 w; w.x = cvt_pk_bf16(v0[0], v0[1]); w.y = cvt_pk_bf16(v0[2], v0[3]); w.z = cvt_pk_bf16(v1[0], v1[1]); w.w = cvt_pk_bf16(v1[2], v1[3]); return w;
}
__device__ __forceinline__ f32x4 rope4(const f32x4 v, const f32x4 cs) {
    f32x4 r; r[0] = v[0] * cs[0] - v[1] * cs[1]; r[1] = v[0] * cs[1] + v[1] * cs[0]; r[2] = v[2] * cs[2] - v[3] * cs[3]; r[3] = v[2] * cs[3] + v[3] * cs[2]; return r;
}
struct EpiInProj {
    static constexpr bool PERM = true;
    bf16_t *Q, *Kb, *V, *Gt, *AU; const float* rope;
    __device__ __forceinline__ void operator()(const f32x4 (&acc)[2][2][4][2], const Unit& u, int wr, int wc, int fr, int fq) const {
        const int sect = u.pn >> 1;
        const int row0 = u.pm * BM + wr * 64 + fr;
        const int colt = (u.pn & 1) * 256 + wc * 32 + 8 * fq;
        if (sect <= 1) {
            bf16_t* O = sect ? Kb : Q;
            f32x4 cs[2][4][2];
#pragma unroll
            for (int ai = 0; ai < 2; ++ai)
#pragma unroll
                for (int m = 0; m < 4; ++m) {
                    const int pos = (row0 + ai * HALF + m * 16) & (SEQ - 1);
                    const float* rp = rope + ((size_t)pos * 64 + 16 * wc + 4 * fq) * 2;
                    cs[ai][m][0] = *(const f32x4*)rp; cs[ai][m][1] = *(const f32x4*)(rp + 4);
                }
#pragma unroll
            for (int ai = 0; ai < 2; ++ai)
#pragma unroll
                for (int m = 0; m < 4; ++m) {
                    const int row = row0 + ai * HALF + m * 16;
#pragma unroll
                    for (int bj = 0; bj < 2; ++bj) {
                        const f32x4 v0 = rope4(acc[ai][bj][m][0], cs[ai][m][0]), v1 = rope4(acc[ai][bj][m][1], cs[ai][m][1]);
                        *(u32x4*)(O + (size_t)row * 512 + colt + bj * HALF) = pack8(v0, v1);
                    }
                }
        } else if (sect <= 3) {
            bf16_t* O = (sect == 2) ? V : Gt;
#pragma unroll
            for (int ai = 0; ai < 2; ++ai)
#pragma unroll
                for (int m = 0; m < 4; ++m) {
                    const int row = row0 + ai * HALF + m * 16;
#pragma unroll
                    for (int bj = 0; bj < 2; ++bj) *(u32x4*)(O + (size_t)row * 512 + colt + bj * HALF) = pack8(acc[ai][bj][m][0], acc[ai][bj][m][1]);
                }
        } else {
#pragma unroll
            for (int ai = 0; ai < 2; ++ai)
#pragma unroll
                for (int m = 0; m < 4; ++m) {
                    const int row = row0 + ai * HALF + m * 16, cr = row >> 5, s = row & 31;
#pragma unroll
                    for (int bj = 0; bj < 2; ++bj) {
                        const int cu = colt + bj * HALF, g = cu >> 4, c0 = cu & 15;
                        *(u32x4*)(AU + ((size_t)(g * 1024 + cr) * 640 + s * 16 + c0)) = pack8(acc[ai][bj][m][0], acc[ai][bj][m][1]);
                    }
                }
        }
    }
};
struct EpiGlu {
    static constexpr bool PERM = true;
    bf16_t* Y;
    __device__ __forceinline__ void operator()(const f32x4 (&acc)[2][2][4][2], const Unit& u, int wr, int wc, int fr, int fq) const {
        const int row0 = u.pm * BM + wr * 64 + fr, col = 512 + u.pn * 128 + wc * 32 + 8 * fq;
#pragma unroll
        for (int ai = 0; ai < 2; ++ai)
#pragma unroll
            for (int m = 0; m < 4; ++m) {
                const int row = row0 + ai * HALF + m * 16;
                f32x4 y0, y1;
#pragma unroll
                for (int j = 0; j < 4; ++j) {
                    y0[j] = acc[ai][0][m][0][j] / (1.0f + __expf(-acc[ai][1][m][0][j]));
                    y1[j] = acc[ai][0][m][1][j] / (1.0f + __expf(-acc[ai][1][m][1][j]));
                }
                *(u32x4*)(Y + (size_t)row * 1024 + col) = pack8(y0, y1);
            }
    }
};
struct EpiSS {
    static constexpr bool PERM = true;
    bf16_t* O; float* SS;
    __device__ __forceinline__ void operator()(const f32x4 (&acc)[2][2][4][2], const Unit& u, int wr, int wc, int fr, int fq) const {
        const int row0 = u.pm * BM + wr * 64 + fr, col = u.pn * BM + wc * 32 + 8 * fq;
#pragma unroll
        for (int ai = 0; ai < 2; ++ai)
#pragma unroll
            for (int m = 0; m < 4; ++m) {
                const int row = row0 + ai * HALF + m * 16; float q = 0.f;
#pragma unroll
                for (int bj = 0; bj < 2; ++bj) {
                    const f32x4 v0 = acc[ai][bj][m][0], v1 = acc[ai][bj][m][1];
                    q += (v0[0] * v0[0] + v0[1] * v0[1]) + (v0[2] * v0[2] + v0[3] * v0[3]) + (v1[0] * v1[0] + v1[1] * v1[1]) + (v1[2] * v1[2] + v1[3] * v1[3]);
                    *(u32x4*)(O + (size_t)row * 1024 + col + bj * HALF) = pack8(v0, v1);
                }
                q += __shfl_xor(q, 16); q += __shfl_xor(q, 32);
                if (fq == 0) SS[(size_t)row * 16 + u.pn * 4 + wc] = q;
            }
    }
};
struct EpiRelu2 {
    static constexpr bool PERM = true;
    bf16_t* O;
    __device__ __forceinline__ void operator()(const f32x4 (&acc)[2][2][4][2], const Unit& u, int wr, int wc, int fr, int fq) const {
        const int row0 = u.pm * BM + wr * 64 + fr, col = u.pn * BM + wc * 32 + 8 * fq;
#pragma unroll
        for (int ai = 0; ai < 2; ++ai)
#pragma unroll
            for (int m = 0; m < 4; ++m) {
                const int row = row0 + ai * HALF + m * 16;
#pragma unroll
                for (int bj = 0; bj < 2; ++bj) {
                    f32x4 v0 = acc[ai][bj][m][0], v1 = acc[ai][bj][m][1];
#pragma unroll
                    for (int j = 0; j < 4; ++j) { const float a = fmaxf(v0[j], 0.f), b = fmaxf(v1[j], 0.f); v0[j] = a * a; v1[j] = b * b; }
                    *(u32x4*)(O + (size_t)row * DFF + col + bj * HALF) = pack8(v0, v1);
                }
            }
    }
};
struct EpiSsm {
    static constexpr bool PERM = true;
    const bf16_t* AU; const float* dskip; bf16_t* Y;
    __device__ __forceinline__ void operator()(const f32x4 (&acc)[2][2][4][2], const Unit& u, int wr, int wc, int fr, int fq) const {
        const int g = u.pb;
        const int row0 = u.pm * BM + wr * 64 + fr, colt = u.pn * BM + wc * 32 + 8 * fq;
        const int c0 = 8 * (fq & 1);
        const f32x4 d0 = *(const f32x4*)(dskip + g * 16 + c0), d1 = *(const f32x4*)(dskip + g * 16 + c0 + 4);
        u32x4 uwv[2][4][2];
#pragma unroll
        for (int ai = 0; ai < 2; ++ai)
#pragma unroll
            for (int m = 0; m < 4; ++m)
#pragma unroll
                for (int bj = 0; bj < 2; ++bj) uwv[ai][m][bj] = *(const u32x4*)(AU + ((size_t)(g * 1024 + row0 + ai * HALF + m * 16) * 640 + colt + bj * HALF));
#pragma unroll
        for (int ai = 0; ai < 2; ++ai)
#pragma unroll
            for (int m = 0; m < 4; ++m) {
                const int cr = row0 + ai * HALF + m * 16;
#pragma unroll
                for (int bj = 0; bj < 2; ++bj) {
                    const int col = colt + bj * HALF, s = col >> 4;
                    const u32x4 uw = uwv[ai][m][bj];
                    f32x4 v0 = acc[ai][bj][m][0], v1 = acc[ai][bj][m][1];
                    v0[0] += d0[0] * bf_lo(uw.x); v0[1] += d0[1] * bf_hi(uw.x); v0[2] += d0[2] * bf_lo(uw.y); v0[3] += d0[3] * bf_hi(uw.y);
                    v1[0] += d1[0] * bf_lo(uw.z); v1[1] += d1[1] * bf_hi(uw.z); v1[2] += d1[2] * bf_lo(uw.w); v1[3] += d1[3] * bf_hi(uw.w);
#pragma unroll
                    for (int j = 0; j < 4; ++j) {
                        const float a = v0[j], za = 1.5957691216f * (a + 0.044715f * a * a * a); v0[j] = a / (1.0f + __expf(-za));
                        const float b = v1[j], zb = 1.5957691216f * (b + 0.044715f * b * b * b); v1[j] = b / (1.0f + __expf(-zb));
                    }
                    const size_t tok = (size_t)cr * 32 + s;
                    *(u32x4*)(Y + tok * 512 + g * 16 + c0) = pack8(v0, v1);
                }
            }
    }
};
}

__device__ __forceinline__ bf16x8 frag_nat(const LAS unsigned char* tile, int idx0, int k0, int fr, int fq) {
    return *(const LAS bf16x8*)(tile + (idx0 + fr) * TS + (k0 + 8 * fq) * 2);
}
__device__ __forceinline__ bf16x8 frag_tr(unsigned tile_addr, int k0, int idx0, int lane) {
    const int g = lane >> 4, q = (lane & 15) >> 2, p = lane & 3;
    const unsigned addr = tile_addr + (unsigned)((k0 + 8 * g + q) * TS + (idx0 + 4 * p) * 2);
    u32x2 lo, hi;
    asm volatile("ds_read_b64_tr_b16 %0, %2\n\tds_read_b64_tr_b16 %1, %2 offset:1088\n\ts_waitcnt lgkmcnt(0)" : "=&v"(lo), "=&v"(hi) : "v"(addr) : "memory");
    u32x4 r; r.x = lo.x; r.y = lo.y; r.z = hi.x; r.w = hi.y;
    return __builtin_bit_cast(bf16x8, r);
}
__device__ __forceinline__ void frags_tr8(bf16x8 (&b)[8], unsigned tile_addr, int k0, int lane) {
    const int g = lane >> 4, q = (lane & 15) >> 2, p = lane & 3;
    const unsigned addr = tile_addr + (unsigned)((k0 + 8 * g + q) * TS + (4 * p) * 2);
    u32x2 r0, r1, r2, r3, r4, r5, r6, r7, r8, r9, r10, r11, r12, r13, r14, r15;
    asm volatile(
        "ds_read_b64_tr_b16 %0, %16\n\t"
        "ds_read_b64_tr_b16 %1, %16 offset:1088\n\t"
        "ds_read_b64_tr_b16 %2, %16 offset:32\n\t"
        "ds_read_b64_tr_b16 %3, %16 offset:1120\n\t"
        "ds_read_b64_tr_b16 %4, %16 offset:64\n\t"
        "ds_read_b64_tr_b16 %5, %16 offset:1152\n\t"
        "ds_read_b64_tr_b16 %6, %16 offset:96\n\t"
        "ds_read_b64_tr_b16 %7, %16 offset:1184\n\t"
        "ds_read_b64_tr_b16 %8, %16 offset:128\n\t"
        "ds_read_b64_tr_b16 %9, %16 offset:1216\n\t"
        "ds_read_b64_tr_b16 %10, %16 offset:160\n\t"
        "ds_read_b64_tr_b16 %11, %16 offset:1248\n\t"
        "ds_read_b64_tr_b16 %12, %16 offset:192\n\t"
        "ds_read_b64_tr_b16 %13, %16 offset:1280\n\t"
        "ds_read_b64_tr_b16 %14, %16 offset:224\n\t"
        "ds_read_b64_tr_b16 %15, %16 offset:1312\n\t"
        "s_waitcnt lgkmcnt(0)"
        : "=&v"(r0), "=&v"(r1), "=&v"(r2), "=&v"(r3), "=&v"(r4), "=&v"(r5), "=&v"(r6), "=&v"(r7),
          "=&v"(r8), "=&v"(r9), "=&v"(r10), "=&v"(r11), "=&v"(r12), "=&v"(r13), "=&v"(r14), "=&v"(r15)
        : "v"(addr) : "memory");
    u32x4 w;
    w.x = r0.x; w.y = r0.y; w.z = r1.x; w.w = r1.y; b[0] = __builtin_bit_cast(bf16x8, w);
    w.x = r2.x; w.y = r2.y; w.z = r3.x; w.w = r3.y; b[1] = __builtin_bit_cast(bf16x8, w);
    w.x = r4.x; w.y = r4.y; w.z = r5.x; w.w = r5.y; b[2] = __builtin_bit_cast(bf16x8, w);
    w.x = r6.x; w.y = r6.y; w.z = r7.x; w.w = r7.y; b[3] = __builtin_bit_cast(bf16x8, w);
    w.x = r8.x; w.y = r8.y; w.z = r9.x; w.w = r9.y; b[4] = __builtin_bit_cast(bf16x8, w);
    w.x = r10.x; w.y = r10.y; w.z = r11.x; w.w = r11.y; b[5] = __builtin_bit_cast(bf16x8, w);
    w.x = r12.x; w.y = r12.y; w.z = r13.x; w.w = r13.y; b[6] = __builtin_bit_cast(bf16x8, w);
    w.x = r14.x; w.y = r14.y; w.z = r15.x; w.w = r15.y; b[7] = __builtin_bit_cast(bf16x8, w);
}
template <bool ATR, bool BTR>
__device__ __forceinline__ void mma128(f32x4 (&acc)[8], const LAS unsigned char* lds, unsigned lds_addr, int offA, int offB, int m0, int lane) {
    const int fr = lane & 15, fq = lane >> 4;
#pragma unroll
    for (int ks = 0; ks < 4; ++ks) {
        bf16x8 af, bfr[8];
        if (ATR) af = frag_tr(lds_addr + offA, 32 * ks, m0, lane); else af = frag_nat(lds + offA, m0, 32 * ks, fr, fq);
        if (BTR) frags_tr8(bfr, lds_addr + offB, 32 * ks, lane);
        else {
#pragma unroll
            for (int n = 0; n < 8; ++n) bfr[n] = frag_nat(lds + offB, 16 * n, 32 * ks, fr, fq);
        }
#pragma unroll
        for (int n = 0; n < 8; ++n) acc[n] = __builtin_amdgcn_mfma_f32_16x16x32_bf16(bfr[n], af, acc[n], 0, 0, 0);
    }
}
__device__ __forceinline__ void tile_load(LAS unsigned char* dst, const bf16_t* src, int ld, int tid) {
    u32x4 v[4];
#pragma unroll
    for (int i = 0; i < 4; ++i) { const int q = tid + 512 * i, row = q >> 4, pc = q & 15; v[i] = *(const u32x4*)(src + (size_t)row * ld + pc * 8); }
#pragma unroll
    for (int i = 0; i < 4; ++i) { const int q = tid + 512 * i, row = q >> 4, pc = q & 15; *(LAS u32x4*)(dst + row * TS + pc * 16) = v[i]; }
}
__device__ __forceinline__ void tile_load_zeta(LAS unsigned char* dst, const bf16_t* src, int ld, int tid, float l2g) {
    u32x4 v[4];
#pragma unroll
    for (int i = 0; i < 4; ++i) { const int q = tid + 512 * i, row = q >> 4, pc = q & 15; v[i] = *(const u32x4*)(src + (size_t)row * ld + pc * 8); }
#pragma unroll
    for (int i = 0; i < 4; ++i) {
        const int q = tid + 512 * i, row = q >> 4, pc = q & 15; const float z = exp2f((float)(127 - row) * l2g);
        u32x4 w;
        w.x = cvt_pk_bf16(bf_lo(v[i].x) * z, bf_hi(v[i].x) * z); w.y = cvt_pk_bf16(bf_lo(v[i].y) * z, bf_hi(v[i].y) * z);
        w.z = cvt_pk_bf16(bf_lo(v[i].z) * z, bf_hi(v[i].z) * z); w.w = cvt_pk_bf16(bf_lo(v[i].w) * z, bf_hi(v[i].w) * z);
        *(LAS u32x4*)(dst + row * TS + pc * 16) = w;
    }
}
__device__ __forceinline__ void tile_issue(u32x4 (&v)[4], const bf16_t* src, int ld, int tid) {
#pragma unroll
    for (int i = 0; i < 4; ++i) { const int q = tid + 512 * i, row = q >> 4, pc = q & 15; v[i] = *(const u32x4*)(src + (size_t)row * ld + pc * 8); }
}
__device__ __forceinline__ void tile_issue_nt(u32x4 (&v)[4], const bf16_t* src, int ld, int tid) {
#pragma unroll
    for (int i = 0; i < 4; ++i) { const int q = tid + 512 * i, row = q >> 4, pc = q & 15; v[i] = ld_nt((const u32x4*)(src + (size_t)row * ld + pc * 8)); }
}
__device__ __forceinline__ void tile_commit(LAS unsigned char* dst, const u32x4 (&v)[4], int tid) {
#pragma unroll
    for (int i = 0; i < 4; ++i) { const int q = tid + 512 * i, row = q >> 4, pc = q & 15; *(LAS u32x4*)(dst + row * TS + pc * 16) = v[i]; }
}
__device__ __forceinline__ void tile_commit_zeta(LAS unsigned char* dst, const u32x4 (&v)[4], int tid, float l2g) {
#pragma unroll
    for (int i = 0; i < 4; ++i) {
        const int q = tid + 512 * i, row = q >> 4, pc = q & 15; const float z = exp2f((float)(127 - row) * l2g);
        u32x4 w;
        w.x = cvt_pk_bf16(bf_lo(v[i].x) * z, bf_hi(v[i].x) * z); w.y = cvt_pk_bf16(bf_lo(v[i].y) * z, bf_hi(v[i].y) * z);
        w.z = cvt_pk_bf16(bf_lo(v[i].z) * z, bf_hi(v[i].z) * z); w.w = cvt_pk_bf16(bf_lo(v[i].w) * z, bf_hi(v[i].w) * z);
        *(LAS u32x4*)(dst + row * TS + pc * 16) = w;
    }
}
__device__ __forceinline__ float ret_log2_gamma(int h) { const float g = 1.0f - exp2f(-5.0f - (4.0f / 3.0f) * (float)h); return log2f(g); }

__device__ __forceinline__ int dest_row(int mode, int n) {
    if (mode == 1) { if (n < 1024) { const int sect = n >> 9, w = n & 511, h = w >> 7, j = w & 127; return (sect << 9) + (h << 7) + ((j & 63) << 1) + (j >> 6); } return n; }
    if (mode == 2) { const int bj = n >> 9, rem = n & 511, pn = rem >> 7, j = rem & 127; return (pn << 8) + (bj << 7) + j; }
    return n;
}
struct TrItem { const float* W; bf16_t* WT; const float* gain; int K, N, mode, item; };
__device__ __forceinline__ void p0_tr_load(const TrItem& t, float (&v)[32], int lane) {
    const int nblk = t.N / 32, kb = t.item / nblk, nb = t.item % nblk, k0 = 64 * kb, n0 = 32 * nb;
    const float cs = (t.mode == 1 && n0 >= 512 && n0 < 1024) ? 0.08838834764831845f : 1.0f;
#pragma unroll
    for (int i = 0; i < 32; ++i) { const int kk = 2 * i + (lane >> 5); const float g = t.gain ? t.gain[k0 + kk] * cs : cs; v[i] = ld_nt(t.W + (size_t)(k0 + kk) * t.N + n0 + (lane & 31)) * g; }
}
__device__ __forceinline__ void p0_tr_finish(const TrItem& t, const float (&v)[32], LAS float* scr, int lane) {
    const int nblk = t.N / 32, kb = t.item / nblk, nb = t.item % nblk, k0 = 64 * kb, n0 = 32 * nb;
#pragma unroll
    for (int i = 0; i < 32; ++i) { const int kk = 2 * i + (lane >> 5); scr[kk * 33 + (lane & 31)] = v[i]; }
    LDS_WAIT();
    const int c = lane & 7;
#pragma unroll
    for (int j = 0; j < 4; ++j) { const int n = (lane >> 3) + 8 * j; const LAS float* s = scr + (8 * c) * 33 + n;
        u32x4 o; o.x = cvt_pk_bf16(s[0 * 33], s[1 * 33]); o.y = cvt_pk_bf16(s[2 * 33], s[3 * 33]); o.z = cvt_pk_bf16(s[4 * 33], s[5 * 33]); o.w = cvt_pk_bf16(s[6 * 33], s[7 * 33]);
        *(u32x4*)(t.WT + (size_t)dest_row(t.mode, n0 + n) * t.K + k0 + 8 * c) = o; }
    LDS_WAIT();
}
__device__ __forceinline__ void s5_pow(float lre, float lim, float dt, float j, float& pr, float& pi) {
    const float mag = expf(j * (dt * lre)); float s, c; sincosf(j * (dt * lim), &s, &c); pr = mag * c; pi = mag * s;
}
__device__ __forceinline__ void s5_coef(float lre, float lim, float dt, float& cr, float& ci) {
    float br, bi; s5_pow(lre, lim, dt, 1.0f, br, bi); br -= 1.0f;
    const float den = lre * lre + lim * lim; cr = (br * lre + bi * lim) / den; ci = (bi * lre - br * lim) / den;
}

#define XB_TMO      128
#define XB_XCNT(j)  (256  + 64 * (j))
#define XB_XSUB(j)  (1280 + 64 * (j))
#define XB_XGEN(j)  (2304 + 64 * (j))
#define XB_TOP      3328
#define XB_TOPGEN   3392
#define XCD_BAR_WORDS 3456
#define XB_SPIN_CAP (1u << 18)
__device__ __forceinline__ unsigned xb_ld(unsigned* p)              { return __hip_atomic_load(p, __ATOMIC_RELAXED, __HIP_MEMORY_SCOPE_AGENT); }
__device__ __forceinline__ unsigned xb_add(unsigned* p, unsigned v) { return __hip_atomic_fetch_add(p, v, __ATOMIC_RELAXED, __HIP_MEMORY_SCOPE_AGENT); }
__device__ __forceinline__ unsigned xb_xcc_id() { return (unsigned)__builtin_amdgcn_s_getreg((3 << 11) | 20) & 0xFu; }
#define XB_SPIN(cond, bar) do { unsigned _sp = 0; while (cond) { __builtin_amdgcn_s_sleep(1); \
    if ((++_sp & 255u) == 0u) { if (xb_ld(&(bar)[XB_TMO])) break; if (_sp > XB_SPIN_CAP) { atomicAdd(&(bar)[XB_TMO], 1u); break; } } } } while (0)
struct XcdBarrier { unsigned* bar; unsigned x; volatile LAS unsigned* st; };
__device__ __forceinline__ XcdBarrier xcd_barrier_post(unsigned* bar, volatile LAS unsigned* st) {
    XcdBarrier b; b.bar = bar; b.x = xb_xcc_id(); b.st = st;
    if (threadIdx.x == 0) (void)xb_add(&bar[XB_XCNT(b.x)], 1u);
    return b;
}
__device__ __forceinline__ void xcd_barrier_complete(unsigned* bar, unsigned x, unsigned& nloc, unsigned& nx) {
    const unsigned G = gridDim.x * gridDim.y * gridDim.z;
    unsigned sum, cnt, mine, sp = 0u;
    for (;;) {
        sum = 0u; cnt = 0u; mine = 0u;
#pragma unroll
        for (unsigned j = 0; j < 16; ++j) { const unsigned c = xb_ld(&bar[XB_XCNT(j)]); sum += c; cnt += (c > 0u) ? 1u : 0u; mine = (j == x) ? c : mine; }
        if (sum == G) break;
        __builtin_amdgcn_s_sleep(1);
        if ((++sp & 255u) == 0u) { if (xb_ld(&bar[XB_TMO])) break; if (sp > XB_SPIN_CAP) { atomicAdd(&bar[XB_TMO], 1u); break; } }
    }
    nloc = mine > 0u ? mine : 1u; nx = cnt > 0u ? cnt : 1u;
}
__device__ __forceinline__ void xcd_barrier(const XcdBarrier& b) {
    asm volatile("s_waitcnt vmcnt(0)" ::: "memory");
    __syncthreads();
    if (threadIdx.x == 0) {
        unsigned* bar = b.bar;
        __builtin_amdgcn_s_waitcnt(0);
        unsigned nloc = b.st[0], nx = b.st[1];
        if (nloc == 0u) { xcd_barrier_complete(bar, b.x, nloc, nx); b.st[0] = nloc; b.st[1] = nx; }
        const unsigned old = xb_add(&bar[XB_XSUB(b.x)], 1u);
        const unsigned gen = old / nloc;
        if (old + 1u == (gen + 1u) * nloc) {
            __builtin_amdgcn_fence(__ATOMIC_RELEASE, "agent");
            asm volatile("s_waitcnt vmcnt(0)" ::: "memory");
            const unsigned og = xb_add(&bar[XB_TOP], 1u);
            const unsigned tg = og / nx;
            if (og + 1u == (tg + 1u) * nx) xb_add(&bar[XB_TOPGEN], 1u);
            else XB_SPIN(xb_ld(&bar[XB_TOPGEN]) == tg, bar);
            __builtin_amdgcn_fence(__ATOMIC_ACQUIRE, "agent");
            xb_add(&bar[XB_XGEN(b.x)], 1u);
            asm volatile("s_waitcnt vmcnt(0)" ::: "memory");
        } else {
            XB_SPIN(xb_ld(&bar[XB_XGEN(b.x)]) == gen, bar);
            __builtin_amdgcn_fence(__ATOMIC_ACQUIRE, "agent");
            asm volatile("s_waitcnt vmcnt(0)" ::: "memory");
        }
    }
    __syncthreads();
}

struct Args { const float* in[19]; float* out; unsigned char* ws; int ph_lo, ph_hi; };

__global__ void __launch_bounds__(512, 2) fwd_kernel(Args a) {
    extern __shared__ __attribute__((aligned(16))) unsigned char lds_raw[];
    LAS unsigned char* lds = (LAS unsigned char*)lds_raw;
    const unsigned lds_addr = (unsigned)(size_t)lds_raw;
    cg::grid_group grid = cg::this_grid();
    const int tid = threadIdx.x, lane = tid & 63, wave = __builtin_amdgcn_readfirstlane(tid >> 6);
    const int G = gridDim.x, bx = blockIdx.x;
    const int lo = a.ph_lo, hi = a.ph_hi;
    unsigned char* ws = a.ws;
#define IN(k) (lo <= (k) && (k) < hi)
#define SEAM(k) do { if (lo <= (k) && (k) + 1 < hi) xcd_barrier(xbar); } while (0)
    volatile LAS unsigned* misc = (volatile LAS unsigned*)(lds + (LDS_BYTES - 64));
    if (tid < 16) misc[tid] = 0u;
    __syncthreads();
    const XcdBarrier xbar = xcd_barrier_post((unsigned*)ws, misc);
    if (lo < 0) grid.sync();

    const float* x = a.in[0];
    const float* g_mix_pre = a.in[1]; const float* g_mix_post = a.in[2]; const float* w_in = a.in[3]; const float* gn_gain = a.in[4];
    const float* lam_re = a.in[5]; const float* lam_im = a.in[6]; const float* log_dt = a.in[7];
    const float* b_re = a.in[8]; const float* b_im = a.in[9]; const float* c_re = a.in[10]; const float* c_im = a.in[11]; const float* d_skip = a.in[12];
    const float* w_glu = a.in[13]; const float* w_out = a.in[14]; const float* g_mlp_pre = a.in[15]; const float* g_mlp_post = a.in[16];
    const float* w_ff1 = a.in[17]; const float* w_ff2 = a.in[18];
    float* out = a.out;

    bf16_t* WIN = (bf16_t*)(ws + WS_WIN); bf16_t* WGLU = (bf16_t*)(ws + WS_WGLU); bf16_t* WOUT = (bf16_t*)(ws + WS_WOUT);
    bf16_t* WFF1 = (bf16_t*)(ws + WS_WFF1); bf16_t* WFF2 = (bf16_t*)(ws + WS_WFF2);
    float* ROPE = (float*)(ws + WS_ROPE); bf16_t* TW = (bf16_t*)(ws + WS_TW); bf16_t* W1S = (bf16_t*)(ws + WS_W1S);
    float* XSC = (float*)(ws + 73 * MiB);
    float* SS = (float*)(ws + WS_SS); float* SS2 = (float*)(ws + WS_SS2); float* HINC = (float*)(ws + WS_HINC);
    bf16_t* XN = (bf16_t*)(ws + WS_XN);
    bf16_t* QB = (bf16_t*)(ws + WS_QB); bf16_t* KB = (bf16_t*)(ws + WS_KB); bf16_t* VB = (bf16_t*)(ws + WS_VB); bf16_t* GB = (bf16_t*)(ws + WS_GB);
    bf16_t* AU = (bf16_t*)(ws + WS_AU); bf16_t* SST = (bf16_t*)(ws + WS_SST); bf16_t* RTB = (bf16_t*)(ws + WS_RTB);
    bf16_t* YSSM = (bf16_t*)(ws + WS_YSSM); bf16_t* YMIX = (bf16_t*)(ws + WS_YMIX);
    bf16_t* MIXB = (bf16_t*)(ws + WS_MIXB); bf16_t* HID = (bf16_t*)(ws + WS_HID); bf16_t* MB = (bf16_t*)(ws + WS_MB);

    if (IN(0)) for (int rep = 0; rep < REPS(0); ++rep) {
        const int gw = bx * 8 + wave, NGW = G * 8;
        {
            LAS float* scr = (LAS float*)(lds + wave * 16384);
            constexpr int I_IN = (DM / 64) * (NIN / 32), I_GLU = (512 / 64) * (1024 / 32), I_OUT = (DM / 64) * (DM / 32), I_F1 = (DM / 64) * (DFF / 32), I_F2 = (DFF / 64) * (DM / 32);
            constexpr int NITEMS = I_IN + I_GLU + I_OUT + I_F1 + I_F2;
#define TR_DECODE(IT, t) do { int r_ = (IT); \
                if (r_ < I_IN) { t = TrItem{w_in, WIN, g_mix_pre, DM, NIN, 1, r_}; break; } r_ -= I_IN; \
                if (r_ < I_GLU) { t = TrItem{w_glu, WGLU, nullptr, 512, 1024, 2, r_}; break; } r_ -= I_GLU; \
                if (r_ < I_OUT) { t = TrItem{w_out, WOUT, nullptr, DM, DM, 0, r_}; break; } r_ -= I_OUT; \
                if (r_ < I_F1) { t = TrItem{w_ff1, WFF1, g_mlp_pre, DM, DFF, 0, r_}; break; } r_ -= I_F1; \
                t = TrItem{w_ff2, WFF2, nullptr, DFF, DM, 0, r_}; } while (0)
            int it = gw;
            TrItem cur, nxt; float va[32], vb[32];
            if (it < NITEMS) { TR_DECODE(it, cur); p0_tr_load(cur, va, lane); }
            while (it < NITEMS) {
                const int itn = it + NGW;
                if (itn < NITEMS) { TR_DECODE(itn, nxt); p0_tr_load(nxt, vb, lane); }
                p0_tr_finish(cur, va, scr, lane);
                it = itn;
                if (it >= NITEMS) break;
                const int itn2 = it + NGW;
                if (itn2 < NITEMS) { TR_DECODE(itn2, cur); p0_tr_load(cur, va, lane); }
                p0_tr_finish(nxt, vb, scr, lane);
                it = itn2;
            }
#undef TR_DECODE
        }
        for (int m = gw; m < T; m += 2 * NGW) {
            const int m2 = m + NGW;
            const bool has2 = m2 < T;
            const f32x4* xr0 = (const f32x4*)(x + (size_t)m * DM) + lane;
            const f32x4* xr1 = (const f32x4*)(x + (size_t)(has2 ? m2 : m) * DM) + lane;
            f32x4 v0[4], v1[4]; float s0 = 0.f, s1 = 0.f;
#pragma unroll
            for (int j = 0; j < 4; ++j) { v0[j] = ld_nt(xr0 + 64 * j); v1[j] = ld_nt(xr1 + 64 * j); }
#pragma unroll
            for (int j = 0; j < 4; ++j) {
                s0 += (v0[j][0] * v0[j][0] + v0[j][1] * v0[j][1]) + (v0[j][2] * v0[j][2] + v0[j][3] * v0[j][3]);
                s1 += (v1[j][0] * v1[j][0] + v1[j][1] * v1[j][1]) + (v1[j][2] * v1[j][2] + v1[j][3] * v1[j][3]);
            }
            const float q0 = sqrtf(wave_sum(s0) * (1.0f / DM) + EPS), q1 = sqrtf(wave_sum(s1) * (1.0f / DM) + EPS);
            const float r0 = 1.0f / q0, r1 = 1.0f / q1;
            if (lane == 0) { XSC[m] = q0; if (has2) XSC[m2] = q1; }
            u32x2* o0 = (u32x2*)(XN + (size_t)m * DM) + lane; u32x2* o1 = (u32x2*)(XN + (size_t)m2 * DM) + lane;
#pragma unroll
            for (int j = 0; j < 4; ++j) { u32x2 w; w.x = cvt_pk_bf16(v0[j][0] * r0, v0[j][1] * r0); w.y = cvt_pk_bf16(v0[j][2] * r0, v0[j][3] * r0); o0[64 * j] = w; }
            if (has2) {
#pragma unroll
                for (int j = 0; j < 4; ++j) { u32x2 w; w.x = cvt_pk_bf16(v1[j][0] * r1, v1[j][1] * r1); w.y = cvt_pk_bf16(v1[j][2] * r1, v1[j][3] * r1); o1[64 * j] = w; }
            }
        }
        const float rope_inv = (float)pow(10000.0, -(double)(tid & 63) / 64.0);
        for (int i = bx * 512 + tid; i < SEQ * 64; i += G * 512) {
            const int pos = i >> 6;
            const float inv = rope_inv;
            const float ang = (float)pos * inv; float s, c; sincosf(ang, &s, &c);
            *(f32x2*)(ROPE + (size_t)i * 2) = (f32x2){c, s};
        }
        for (int i = bx * 512 + tid; i < 32 * 32 * 64; i += G * 512) {
            {
                const int q = i & 63, t = (i >> 6) & 31, g = i >> 11;
                const float lre = fminf(lam_re[g * 64 + q], -1e-4f), lim = lam_im[g * 64 + q], dt = expf(log_dt[g]);
                float pr, pi; s5_pow(lre, lim, dt, (float)(t + 1), pr, pi);
                float crv[16], civ[16];
#pragma unroll
                for (int c = 0; c < 16; ++c) { crv[c] = c_re[(g * 16 + c) * 64 + q]; civ[c] = c_im[(g * 16 + c) * 64 + q]; }
#pragma unroll
                for (int c = 0; c < 16; ++c) {
                    const float zr = crv[c] * pr - civ[c] * pi, zi = crv[c] * pi + civ[c] * pr;
                    bf16_t* row = TW + (size_t)(g * 512 + t * 16 + c) * 640 + 512;
                    row[q] = f2bf(zr); row[64 + q] = f2bf(-zi);
                }
            }
            {
                const int s = i & 31, p = (i >> 5) & 63, g = i >> 11;
                const float lre = fminf(lam_re[g * 64 + p], -1e-4f), lim = lam_im[g * 64 + p], dt = expf(log_dt[g]);
                float pr, pi, cr, ci; s5_pow(lre, lim, dt, (float)(31 - s), pr, pi); s5_coef(lre, lim, dt, cr, ci);
                const float wr_ = pr * cr - pi * ci, wi_ = pr * ci + pi * cr;
                float zr[16], zi[16];
#pragma unroll
                for (int c = 0; c < 16; ++c) { const float br = b_re[(g * 64 + p) * 16 + c], bi = b_im[(g * 64 + p) * 16 + c]; zr[c] = wr_ * br - wi_ * bi; zi[c] = wr_ * bi + wi_ * br; }
                u32x4* o0 = (u32x4*)(W1S + (size_t)(g * 128 + p) * 512 + s * 16);
                u32x4* o1 = (u32x4*)(W1S + (size_t)(g * 128 + 64 + p) * 512 + s * 16);
                u32x4 w;
                w.x = cvt_pk_bf16(zr[0], zr[1]); w.y = cvt_pk_bf16(zr[2], zr[3]); w.z = cvt_pk_bf16(zr[4], zr[5]); w.w = cvt_pk_bf16(zr[6], zr[7]); o0[0] = w;
                w.x = cvt_pk_bf16(zr[8], zr[9]); w.y = cvt_pk_bf16(zr[10], zr[11]); w.z = cvt_pk_bf16(zr[12], zr[13]); w.w = cvt_pk_bf16(zr[14], zr[15]); o0[1] = w;
                w.x = cvt_pk_bf16(zi[0], zi[1]); w.y = cvt_pk_bf16(zi[2], zi[3]); w.z = cvt_pk_bf16(zi[4], zi[5]); w.w = cvt_pk_bf16(zi[6], zi[7]); o1[0] = w;
                w.x = cvt_pk_bf16(zi[8], zi[9]); w.y = cvt_pk_bf16(zi[10], zi[11]); w.z = cvt_pk_bf16(zi[12], zi[13]); w.w = cvt_pk_bf16(zi[14], zi[15]); o1[1] = w;
            }
        }
        for (int i = bx * 512 + tid; i < 16384 * 64; i += G * 512) {
            const int piece = i & 63, row = i >> 6, t = (row >> 4) & 31;
            if (piece >= 2 * (t + 1)) *(u32x4*)(TW + (size_t)row * 640 + piece * 8) = (u32x4){0u, 0u, 0u, 0u};
        }
        __syncthreads();
        {
            LAS float* Bre = (LAS float*)lds; LAS float* Bim = Bre + 1024; LAS float* Cre = Bre + 2048; LAS float* Cim = Bre + 3072;
            LAS float* cpr = Bre + 4096; LAS float* cpi = cpr + 256;
            for (int it = bx; it < 256; it += G) {
                const int g = it >> 3, jq = it & 7;
                {
                    const int q0 = tid, q1 = tid + 512;
                    const float* s0 = (q0 < 256 ? b_re : b_im) + g * 1024 + (q0 & 255) * 4;
                    const float* s1 = (q1 < 768 ? c_re : c_im) + g * 1024 + (q1 & 255) * 4;
                    *(LAS f32x4*)(Bre + q0 * 4) = *(const f32x4*)s0;
                    *(LAS f32x4*)(Bre + q1 * 4) = *(const f32x4*)s1;
                }
                if (tid < 256) {
                    const int p = tid & 63, jl = tid >> 6;
                    const float lre = fminf(lam_re[g * 64 + p], -1e-4f), lim = lam_im[g * 64 + p], dt = expf(log_dt[g]);
                    float pr, pi, cr, ci; s5_pow(lre, lim, dt, (float)(4 * jq + jl), pr, pi); s5_coef(lre, lim, dt, cr, ci);
                    cpr[jl * 64 + p] = pr * cr - pi * ci; cpi[jl * 64 + p] = pr * ci + pi * cr;
                }
                __syncthreads();
                {
                    const int cc = tid & 255, c = cc >> 4, c2 = cc & 15, jh = tid >> 8;
                    float v0 = 0.f, v1 = 0.f;
#pragma unroll 8
                    for (int p = 0; p < 64; ++p) {
                        const float cr = Cre[c * 64 + p], ci = Cim[c * 64 + p], br = Bre[p * 16 + c2], bi = Bim[p * 16 + c2];
                        const float mr = cr * br - ci * bi, mi = cr * bi + ci * br;
                        v0 += mr * cpr[(2 * jh) * 64 + p] - mi * cpi[(2 * jh) * 64 + p];
                        v1 += mr * cpr[(2 * jh + 1) * 64 + p] - mi * cpi[(2 * jh + 1) * 64 + p];
                    }
                    const int jj0 = 4 * jq + 2 * jh;
                    const bf16_t w0 = f2bf(v0), w1 = f2bf(v1);
                    for (int t = jj0; t < 32; ++t) TW[(size_t)(g * 512 + t * 16 + c) * 640 + (t - jj0) * 16 + c2] = w0;
                    for (int t = jj0 + 1; t < 32; ++t) TW[(size_t)(g * 512 + t * 16 + c) * 640 + (t - jj0 - 1) * 16 + c2] = w1;
                }
                __syncthreads();
            }
        }
    }
    SEAM(0);

    if (IN(1)) for (int rep = 0; rep < REPS(1); ++rep) {
        pg8::Gemm g{XN, WIN, DM, DM, DM, 0, 0}; pg8::StaticOrder S; S.init(T, NIN, G, bx);
        pg8::EpiInProj E{QB, KB, VB, GB, AU, ROPE};
        pg8::gemm_phase(lds, g, S, E);
    }
    SEAM(1);

    if (IN(2)) for (int rep = 0; rep < REPS(2); ++rep) {
        const int fr = lane & 15, fq = lane >> 4;
        for (int it = bx; it < 256; it += G) {
            const int g = it >> 3, rt = it & 7;
            const bf16_t* pA = AU + (size_t)(g * 1024 + rt * 128) * 640; const bf16_t* pB = W1S + (size_t)(g * 128) * 512;
            f32x4 acc[8];
#pragma unroll
            for (int n = 0; n < 8; ++n) acc[n] = (f32x4){0.f, 0.f, 0.f, 0.f};
            u32x4 ra[4], rb[4];
            tile_issue(ra, pA, 640, tid); tile_issue(rb, pB, 512, tid);
            for (int kt = 0; kt < 4; ++kt) {
                tile_commit(lds, ra, tid); tile_commit(lds + TILE_B, rb, tid);
                __syncthreads();
                if (kt < 3) { tile_issue(ra, pA + (kt + 1) * 128, 640, tid); tile_issue(rb, pB + (kt + 1) * 128, 512, tid); }
                mma128<false, false>(acc, lds, lds_addr, 0, TILE_B, 16 * wave, lane);
                __syncthreads();
            }
            float* o = HINC + ((size_t)(g * 1024 + rt * 128 + 16 * wave + fr)) * 128 + 4 * fq;
#pragma unroll
            for (int n = 0; n < 8; ++n) *(f32x4*)(o + 16 * n) = acc[n];
        }
        {
            u32x4 rk[4], rv[4];
            int it = bx;
#define R1_ISSUE(IT) do { const int n_ = (IT) & 63, h_ = ((IT) >> 6) & 3, b_ = (IT) >> 8; const size_t t0_ = (size_t)b_ * SEQ + n_ * 128; \
                tile_issue(rk, KB + t0_ * 512 + h_ * 128, 512, tid); tile_issue(rv, VB + t0_ * 512 + h_ * 128, 512, tid); } while (0)
            if (it < 1024) R1_ISSUE(it);
            for (; it < 1024; it += G) {
                const int h = (it >> 6) & 3;
                const float l2g = ret_log2_gamma(h);
                tile_commit(lds, rk, tid); tile_commit_zeta(lds + TILE_B, rv, tid, l2g);
                __syncthreads();
                if (it + G < 1024) R1_ISSUE(it + G);
                f32x4 acc[8];
#pragma unroll
                for (int nb = 0; nb < 8; ++nb) acc[nb] = (f32x4){0.f, 0.f, 0.f, 0.f};
                mma128<true, true>(acc, lds, lds_addr, TILE_B, 0, 16 * wave, lane);
                bf16_t* o = SST + (size_t)it * 16384 + (16 * wave + fr) * 128 + 4 * fq;
#pragma unroll
                for (int nb = 0; nb < 8; ++nb) { u32x2 w; w.x = cvt_pk_bf16(acc[nb][0], acc[nb][1]); w.y = cvt_pk_bf16(acc[nb][2], acc[nb][3]); *(u32x2*)(o + 16 * nb) = w; }
                __syncthreads();
            }
#undef R1_ISSUE
        }
    }
    SEAM(2);

    if (IN(3)) for (int rep = 0; rep < REPS(3); ++rep) {
        for (int idx = bx * 512 + tid; idx < 16 * 8192; idx += G * 512) {
            const int bh = idx >> 13, e2 = idx & 8191, h = bh & 3;
            const float gch = exp2f(128.0f * ret_log2_gamma(h));
            const unsigned* sp = (const unsigned*)(SST + (size_t)bh * 64 * 16384 + 2 * e2);
            unsigned* rp = (unsigned*)(RTB + (size_t)bh * 64 * 16384 + 2 * e2);
            float r0 = 0.f, r1 = 0.f;
            for (int n0 = 0; n0 < 64; n0 += 16) {
                unsigned s[16];
#pragma unroll
                for (int j = 0; j < 16; ++j) s[j] = ld_nt(sp + (size_t)(n0 + j) * 8192);
#pragma unroll
                for (int j = 0; j < 16; ++j) { rp[(size_t)(n0 + j) * 8192] = cvt_pk_bf16(r0, r1); r0 = gch * r0 + bf_lo(s[j]); r1 = gch * r1 + bf_hi(s[j]); }
            }
        }
        {
            LAS float* X = (LAS float*)lds;
            for (int it = bx; it < 128; it += G) {
                const int b = it >> 5, g = it & 31, p = tid & 63, seg = tid >> 6;
                const float lre = fminf(lam_re[g * 64 + p], -1e-4f), lim = lam_im[g * 64 + p], dt = expf(log_dt[g]);
                float ar, ai, Ar, Ai; s5_pow(lre, lim, dt, 32.0f, ar, ai); s5_pow(lre, lim, dt, 1024.0f, Ar, Ai);
                const float* hp = HINC + ((size_t)(g * 1024 + b * 256 + seg * 32)) * 128 + p;
                float xr = 0.f, xi = 0.f;
                for (int i = 0; i < 32; ++i) { const float hr = hp[(size_t)i * 128], hi_ = hp[(size_t)i * 128 + 64]; const float nr = ar * xr - ai * xi + hr, ni = ar * xi + ai * xr + hi_; xr = nr; xi = ni; }
                X[(seg * 64 + p) * 2] = xr; X[(seg * 64 + p) * 2 + 1] = xi;
                __syncthreads();
                float cr = 0.f, ci = 0.f;
                for (int s = 0; s < seg; ++s) { const float tr = X[(s * 64 + p) * 2], ti = X[(s * 64 + p) * 2 + 1]; const float nr = Ar * cr - Ai * ci + tr, ni = Ar * ci + Ai * cr + ti; cr = nr; ci = ni; }
                bf16_t* op = AU + ((size_t)(g * 1024 + b * 256 + seg * 32)) * 640 + 512 + p;
                xr = cr; xi = ci;
                for (int i = 0; i < 32; ++i) {
                    op[(size_t)i * 640] = f2bf(xr); op[(size_t)i * 640 + 64] = f2bf(xi);
                    const float hr = hp[(size_t)i * 128], hi_ = hp[(size_t)i * 128 + 64]; const float nr = ar * xr - ai * xi + hr, ni = ar * xi + ai * xr + hi_; xr = nr; xi = ni;
                }
                __syncthreads();
            }
        }
    }
    SEAM(3);

    if (IN(4)) for (int rep = 0; rep < REPS(4); ++rep) {
        const bool solo = (hi - lo == 1);
        if (!(solo && PROBE_P4_PART == 2)) for (int rep4 = 0; rep4 < (PROBE_P4_DUP == 1 ? 2 : 1); ++rep4) {
            pg8::Gemm g{AU, TW, 640, 640, 640, (size_t)1024 * 640, (size_t)512 * 640}; pg8::BatchOrder S{G, bx};
            pg8::EpiSsm E{AU, d_skip, YSSM};
            pg8::gemm_phase(lds, g, S, E);
        }
        const int fr = lane & 15, fq = lane >> 4;
        constexpr int OQ = 0, OK_ = TILE_B, OV = 2 * TILE_B, OR = 3 * TILE_B;
        for (int rep4 = 0; rep4 < (PROBE_P4_DUP == 2 ? 2 : 1); ++rep4) {
        u32x4 rq[4], rk[4], rv[4], rr[4];
        int it = bx;
#define R3_ISSUE_QK(IT) do { const int n_ = (IT) & 63, h_ = ((IT) >> 6) & 3, b_ = (IT) >> 8; const size_t t0_ = (size_t)b_ * SEQ + n_ * 128; \
            tile_issue_nt(rq, QB + t0_ * 512 + h_ * 128, 512, tid); tile_issue_nt(rk, KB + t0_ * 512 + h_ * 128, 512, tid); } while (0)
#define R3_ISSUE_VR(IT) do { const int n_ = (IT) & 63, h_ = ((IT) >> 6) & 3, b_ = (IT) >> 8; const size_t t0_ = (size_t)b_ * SEQ + n_ * 128; \
            tile_issue_nt(rv, VB + t0_ * 512 + h_ * 128, 512, tid); tile_issue_nt(rr, RTB + (size_t)(IT) * 16384, 128, tid); } while (0)
        if (solo && PROBE_P4_PART == 1) it = 1024;
        if (it < 1024) R3_ISSUE_QK(it);
        for (; it < 1024; it += G) {
            const int n = it & 63, h = (it >> 6) & 3, b = it >> 8;
            const float l2g = ret_log2_gamma(h);
            const size_t tok0 = (size_t)b * SEQ + n * 128;
            tile_commit(lds + OQ, rq, tid); tile_commit(lds + OK_, rk, tid);
            R3_ISSUE_VR(it);
            __syncthreads();
            const int i = 16 * wave + fr;
            f32x4 sc[8];
#pragma unroll
            for (int nb = 0; nb < 8; ++nb) sc[nb] = (f32x4){0.f, 0.f, 0.f, 0.f};
            mma128<false, false>(sc, lds, lds_addr, OQ, OK_, 16 * wave, lane);
            tile_commit(lds + OV, rv, tid); tile_commit(lds + OR, rr, tid);
            __syncthreads();
            if (it + G < 1024) R3_ISSUE_QK(it + G);
#pragma unroll
            for (int nb = 0; nb < 8; ++nb) {
                f32x4 pv;
#pragma unroll
                for (int e = 0; e < 4; ++e) { const int j = 16 * nb + 4 * fq + e; pv[e] = (i >= j) ? sc[nb][e] * exp2f((float)(i - j) * l2g) : 0.f; }
                u32x2 w; w.x = cvt_pk_bf16(pv[0], pv[1]); w.y = cvt_pk_bf16(pv[2], pv[3]);
                *(LAS u32x2*)(lds + OK_ + i * TS + (16 * nb + 4 * fq) * 2) = w;
            }
            LDS_WAIT();
            f32x4 a1[8], a2[8];
#pragma unroll
            for (int nb = 0; nb < 8; ++nb) { a1[nb] = (f32x4){0.f, 0.f, 0.f, 0.f}; a2[nb] = (f32x4){0.f, 0.f, 0.f, 0.f}; }
            mma128<false, true>(a1, lds, lds_addr, OK_, OV, 16 * wave, lane);
            mma128<false, false>(a2, lds, lds_addr, OQ, OR, 16 * wave, lane);
            const float xi = exp2f((float)(i + 1) * l2g);
            float s1 = 0.f, s2 = 0.f;
#pragma unroll
            for (int nb = 0; nb < 8; ++nb)
#pragma unroll
                for (int e = 0; e < 4; ++e) { const float o = a1[nb][e] + xi * a2[nb][e]; a1[nb][e] = o; s1 += o; s2 += o * o; }
            s1 += __shfl_xor(s1, 16); s1 += __shfl_xor(s1, 32); s2 += __shfl_xor(s2, 16); s2 += __shfl_xor(s2, 32);
            const float mu = s1 * (1.0f / 128.0f), var = fmaxf(s2 * (1.0f / 128.0f) - mu * mu, 0.f), rs = 1.0f / sqrtf(var + EPS);
            const size_t tok = tok0 + i;
            u32x2 gwv[8]; f32x4 ggv[8];
#pragma unroll
            for (int nb = 0; nb < 8; ++nb) { gwv[nb] = ld_nt((const u32x2*)(GB + tok * 512 + h * 128 + 16 * nb + 4 * fq)); ggv[nb] = *(const f32x4*)(gn_gain + h * 128 + 16 * nb + 4 * fq); }
#pragma unroll
            for (int nb = 0; nb < 8; ++nb) {
                const int d = 16 * nb + 4 * fq;
                const u32x2 gw = gwv[nb];
                const f32x4 gg = ggv[nb];
                const float g0 = bf_lo(gw.x), g1 = bf_hi(gw.x), g2 = bf_lo(gw.y), g3 = bf_hi(gw.y);
                const float y0 = (a1[nb][0] - mu) * rs * gg[0] * (g0 / (1.0f + __expf(-g0)));
                const float y1 = (a1[nb][1] - mu) * rs * gg[1] * (g1 / (1.0f + __expf(-g1)));
                const float y2 = (a1[nb][2] - mu) * rs * gg[2] * (g2 / (1.0f + __expf(-g2)));
                const float y3 = (a1[nb][3] - mu) * rs * gg[3] * (g3 / (1.0f + __expf(-g3)));
                u32x2 w; w.x = cvt_pk_bf16(y0, y1); w.y = cvt_pk_bf16(y2, y3);
                *(u32x2*)(YMIX + tok * 1024 + h * 128 + d) = w;
            }
            __syncthreads();
        }
        }
    }
#undef R3_ISSUE_QK
#undef R3_ISSUE_VR
    SEAM(4);

    if (IN(5)) for (int rep = 0; rep < REPS(5); ++rep) {
        pg8::Gemm g{YSSM, WGLU, 512, 512, 512, 0, 0}; pg8::StaticOrder S; S.init(T, 1024, G, bx);
        pg8::EpiGlu E{YMIX};
        pg8::gemm_phase(lds, g, S, E);
    }
    SEAM(5);

    if (IN(6)) for (int rep = 0; rep < REPS(6); ++rep) {
        pg8::Gemm g{YMIX, WOUT, DM, DM, DM, 0, 0}; pg8::StaticOrder S; S.init(T, DM, G, bx);
        pg8::EpiSS E{MIXB, SS};
        pg8::gemm_phase(lds, g, S, E);
    }
    SEAM(6);

    if (IN(7)) for (int rep = 0; rep < REPS(7); ++rep) {
        const int gw = bx * 8 + wave, NGW = G * 8;
        const f32x4* gr = (const f32x4*)g_mix_post + lane;
        f32x4 gv[4];
#pragma unroll
        for (int j = 0; j < 4; ++j) gv[j] = gr[64 * j];
        for (int m0 = gw; m0 < T; m0 += 2 * NGW) {
            f32x4 xv[2][4]; u32x2 mw[2][4]; float rs[2];
#pragma unroll
            for (int r = 0; r < 2; ++r) {
                const int m = (m0 + r * NGW < T) ? m0 + r * NGW : m0;
                const f32x4 pa = *((const f32x4*)(SS + (size_t)m * 16) + (lane & 3));
                float sa = (pa[0] + pa[1]) + (pa[2] + pa[3]); sa += __shfl_xor(sa, 1); sa += __shfl_xor(sa, 2);
                rs[r] = 1.0f / sqrtf(sa * (1.0f / DM) + EPS);
                const u32x2* xr = (const u32x2*)(XN + (size_t)m * DM) + lane; const u32x2* mr = (const u32x2*)(MIXB + (size_t)m * DM) + lane;
                const float xs = XSC[m];
#pragma unroll
                for (int j = 0; j < 4; ++j) { const u32x2 xw = ld_nt(xr + 64 * j); xv[r][j] = (f32x4){bf_lo(xw.x) * xs, bf_hi(xw.x) * xs, bf_lo(xw.y) * xs, bf_hi(xw.y) * xs}; mw[r][j] = ld_nt(mr + 64 * j); }
            }
#pragma unroll
            for (int r = 0; r < 2; ++r) {
                const int m = m0 + r * NGW;
                if (m < T) {
                    float sq = 0.f;
#pragma unroll
                    for (int j = 0; j < 4; ++j) {
                        f32x4& v = xv[r][j];
                        v[0] += bf_lo(mw[r][j].x) * rs[r] * gv[j][0]; v[1] += bf_hi(mw[r][j].x) * rs[r] * gv[j][1];
                        v[2] += bf_lo(mw[r][j].y) * rs[r] * gv[j][2]; v[3] += bf_hi(mw[r][j].y) * rs[r] * gv[j][3];
                        sq += (v[0] * v[0] + v[1] * v[1]) + (v[2] * v[2] + v[3] * v[3]);
                    }
                    const float rstd1 = 1.0f / sqrtf(wave_sum(sq) * (1.0f / DM) + EPS);
                    u32x2* o8 = (u32x2*)(XN + (size_t)m * DM) + lane;
#pragma unroll
                    for (int j = 0; j < 4; ++j) { const f32x4 v = xv[r][j]; u32x2 w; w.x = cvt_pk_bf16(v[0] * rstd1, v[1] * rstd1); w.y = cvt_pk_bf16(v[2] * rstd1, v[3] * rstd1); o8[64 * j] = w; }
                }
            }
        }
    }
    SEAM(7);

    if (IN(8)) for (int rep = 0; rep < REPS(8); ++rep) {
        pg8::Gemm g{XN, WFF1, DM, DM, DM, 0, 0}; pg8::StaticOrder S; S.init(T, DFF, G, bx);
        pg8::EpiRelu2 E{HID};
        pg8::gemm_phase(lds, g, S, E);
    }
    SEAM(8);

    if (IN(9)) for (int rep = 0; rep < REPS(9); ++rep) {
        pg8::Gemm g{HID, WFF2, DFF, DFF, DFF, 0, 0}; pg8::StaticOrder S; S.init(T, DM, G, bx);
        pg8::EpiSS E{MB, SS2};
        pg8::gemm_phase(lds, g, S, E);
    }
    SEAM(9);

    if (IN(10)) {
        const int gw = bx * 8 + wave, NGW = G * 8;
        const f32x4* g1r = (const f32x4*)g_mix_post + lane; const f32x4* g2r = (const f32x4*)g_mlp_post + lane;
        f32x4 ga[4], gb[4];
#pragma unroll
        for (int j = 0; j < 4; ++j) { ga[j] = g1r[64 * j]; gb[j] = g2r[64 * j]; }
        for (int m0 = gw; m0 < T; m0 += 2 * NGW) {
            f32x4 xv[2][4]; u32x2 aw[2][4], mw[2][4]; float r1[2], r2[2];
#pragma unroll
            for (int r = 0; r < 2; ++r) {
                const int m = (m0 + r * NGW < T) ? m0 + r * NGW : m0;
                const f32x4 pa = *((const f32x4*)(SS + (size_t)m * 16) + (lane & 3)), pb = *((const f32x4*)(SS2 + (size_t)m * 16) + (lane & 3));
                float sa = (pa[0] + pa[1]) + (pa[2] + pa[3]), sb = (pb[0] + pb[1]) + (pb[2] + pb[3]);
                sa += __shfl_xor(sa, 1); sa += __shfl_xor(sa, 2); sb += __shfl_xor(sb, 1); sb += __shfl_xor(sb, 2);
                r1[r] = 1.0f / sqrtf(sa * (1.0f / DM) + EPS); r2[r] = 1.0f / sqrtf(sb * (1.0f / DM) + EPS);
                const f32x4* xr = (const f32x4*)(x + (size_t)m * DM) + lane;
                const u32x2* ar = (const u32x2*)(MIXB + (size_t)m * DM) + lane; const u32x2* mr = (const u32x2*)(MB + (size_t)m * DM) + lane;
#pragma unroll
                for (int j = 0; j < 4; ++j) { xv[r][j] = ld_nt(xr + 64 * j); aw[r][j] = ld_nt(ar + 64 * j); mw[r][j] = ld_nt(mr + 64 * j); }
            }
#pragma unroll
            for (int r = 0; r < 2; ++r) {
                const int m = m0 + r * NGW;
                if (m < T) {
                    f32x4* orow = (f32x4*)(out + (size_t)m * DM) + lane;
#pragma unroll
                    for (int j = 0; j < 4; ++j) {
                        f32x4 v = xv[r][j];
                        v[0] = (v[0] + bf_lo(aw[r][j].x) * r1[r] * ga[j][0]) + bf_lo(mw[r][j].x) * r2[r] * gb[j][0]; v[1] = (v[1] + bf_hi(aw[r][j].x) * r1[r] * ga[j][1]) + bf_hi(mw[r][j].x) * r2[r] * gb[j][1];
                        v[2] = (v[2] + bf_lo(aw[r][j].y) * r1[r] * ga[j][2]) + bf_lo(mw[r][j].y) * r2[r] * gb[j][2]; v[3] = (v[3] + bf_hi(aw[r][j].y) * r1[r] * ga[j][3]) + bf_hi(mw[r][j].y) * r2[r] * gb[j][3];
                        st_nt(orow + 64 * j, v);
                    }
                }
            }
        }
    }
#undef IN
#undef SEAM
}

extern "C" void kernel_launch(void* const* d_in, const int* in_sizes, int n_in, void* d_out, int out_size, void* d_ws, size_t ws_size, hipStream_t stream) {
    static int grid = 0;
    if (grid == 0) {
        int dev = 0, cus = 0, per_cu = 0;
        hipGetDevice(&dev);
        hipDeviceGetAttribute(&cus, hipDeviceAttributeMultiprocessorCount, dev);
        hipFuncSetAttribute((const void*)fwd_kernel, hipFuncAttributeMaxDynamicSharedMemorySize, LDS_BYTES);
        if (hipOccupancyMaxActiveBlocksPerMultiprocessor(&per_cu, (const void*)fwd_kernel, 512, LDS_BYTES) != hipSuccess || per_cu < 1) per_cu = 1;
        (void)hipGetLastError();
        grid = cus * per_cu;
        if (grid <= 0) grid = 256;
    }
    Args a{};
    for (int i = 0; i < 19; ++i) a.in[i] = (const float*)d_in[i];
    a.out = (float*)d_out; a.ws = (unsigned char*)d_ws;
#if N_LAUNCH_PER_PHASE
    for (int ph = 0; ph < NPHASE; ++ph) {
        a.ph_lo = ph; a.ph_hi = ph + 1;
        void* args[] = {&a};
        hipError_t e = hipLaunchCooperativeKernel((const void*)fwd_kernel, dim3(grid), dim3(512), args, LDS_BYTES, stream);
        if (e != hipSuccess) { fprintf(stderr, "cooperative launch (phase %d) failed: %s (grid %d)\n", ph, hipGetErrorString(e), grid); break; }
    }
#else
    a.ph_lo = 0; a.ph_hi = NPHASE;
    (void)hipMemsetAsync(d_ws, 0, 16384, stream);
    void* args[] = {&a};
    hipError_t e = hipLaunchCooperativeKernel((const void*)fwd_kernel, dim3(grid), dim3(512), args, LDS_BYTES, stream);
    if (e != hipSuccess) fprintf(stderr, "cooperative launch failed: %s (grid %d)\n", hipGetErrorString(e), grid);
#ifdef PROBE_EXTRA_PHASE
    {
        Args b = a; b.ph_lo = PROBE_EXTRA_PHASE; b.ph_hi = PROBE_EXTRA_PHASE + 1;
        void* args2[] = {&b};
        (void)hipLaunchCooperativeKernel((const void*)fwd_kernel, dim3(grid), dim3(512), args2, LDS_BYTES, stream);
    }
#endif
#endif
}
```

```cpp
#include <hip/hip_runtime.h>
#include <hip/hip_cooperative_groups.h>
#include <cstdio>
namespace cg = cooperative_groups;

#ifndef N_LAUNCH_PER_PHASE
#define N_LAUNCH_PER_PHASE 0
#endif

#ifndef PROBE_P4_DUP
#define PROBE_P4_DUP 0
#endif
#ifndef PROBE_P4_PART
#define PROBE_P4_PART 0
#endif
#ifndef PROBE_DUP
#define PROBE_DUP 0
#endif
#define REPS(k) (1 + ((PROBE_DUP >> (k)) & 1))
#define LAS __attribute__((address_space(3)))
typedef unsigned short bf16_t;
typedef short bf16x8 __attribute__((ext_vector_type(8)));
typedef float f32x4 __attribute__((ext_vector_type(4)));
typedef float f32x2 __attribute__((ext_vector_type(2)));
typedef unsigned u32x4 __attribute__((ext_vector_type(4)));
typedef unsigned u32x2 __attribute__((ext_vector_type(2)));

constexpr int T = 32768, SEQ = 8192, DM = 1024, NIN = 2560, DFF = 4096;
constexpr float EPS = 1e-6f;
constexpr int NPHASE = 11;

constexpr size_t MiB = 1u << 20;
constexpr size_t WS_WIN = 1 * MiB, WS_WGLU = 6 * MiB, WS_WOUT = 7 * MiB, WS_WFF1 = 9 * MiB, WS_WFF2 = 17 * MiB;
constexpr size_t WS_ROPE = 25 * MiB, WS_TW = 29 * MiB, WS_W1S = 49 * MiB, WS_SS = 53 * MiB, WS_SS2 = 55 * MiB, WS_HINC = 57 * MiB;
constexpr size_t WS_XN = 80 * MiB;
constexpr size_t WS_QB = 144 * MiB, WS_KB = 176 * MiB, WS_VB = 208 * MiB, WS_GB = 240 * MiB, WS_AU = 272 * MiB;
constexpr size_t WS_SST = 440 * MiB, WS_RTB = 376 * MiB, WS_YSSM = 408 * MiB;
constexpr size_t WS_YMIX = 312 * MiB;
constexpr size_t WS_HID = 144 * MiB;
constexpr size_t WS_MIXB = 400 * MiB;
constexpr size_t WS_MB = 80 * MiB;

constexpr int LDS_BYTES = 147456;
constexpr int TS = 272;
constexpr int TILE_B = 128 * TS;

typedef __bf16 bf16x2_t __attribute__((ext_vector_type(2)));
__device__ __forceinline__ unsigned cvt_pk_bf16(float lo, float hi) { f32x2 v = {lo, hi}; return __builtin_bit_cast(unsigned, __builtin_convertvector(v, bf16x2_t)); }
__device__ __forceinline__ float bf_lo(unsigned w) { return __uint_as_float(w << 16); }
__device__ __forceinline__ float bf_hi(unsigned w) { return __uint_as_float(w & 0xffff0000u); }
__device__ __forceinline__ bf16_t f2bf(float f) { return (bf16_t)(cvt_pk_bf16(f, 0.f) & 0xffffu); }
__device__ __forceinline__ float wave_sum(float v) {
#pragma unroll
    for (int o = 1; o < 64; o <<= 1) v += __shfl_xor(v, o);
    return v;
}
#define LDS_WAIT() asm volatile("s_waitcnt lgkmcnt(0)" ::: "memory")
template <class Tv> __device__ __forceinline__ Tv ld_nt(const Tv* p) { return __builtin_nontemporal_load(p); }
__device__ __forceinline__ void st_nt(f32x4* p, f32x4 v) { __builtin_nontemporal_store(v, p); }

namespace pg8 {
constexpr int BM = 256, BK = 64, HALF = 128, HTB = HALF * BK * 2, STAGE_BYTES = 8 * HTB, NXCD = 8, WGM = 8;
__device__ __forceinline__ int lds_byte(int r, int c) { const int st = (r >> 4) * 2 + (c >> 5), rr = r & 15, cc = c & 31, ob = rr * 64 + cc * 2; return st * 1024 + (ob ^ (((ob >> 9) & 1) << 5)); }
__device__ __forceinline__ void stage_rc(int b, int& R, int& C) { const int st = b / 1024, sb = b % 1024, swz = sb ^ (((sb >> 9) & 1) << 5); R = (st >> 1) * 16 + swz / 64; C = (st & 1) * 32 + (swz % 64) / 2; }
__device__ __forceinline__ int perm32(int rho) { const int n = rho >> 4, i = rho & 15; return 8 * (i >> 2) + 4 * n + (i & 3); }

struct Unit { int pm, pn, pb; };
struct Gemm { const bf16_t* A; const bf16_t* Bt; int lda, ldb, K; size_t bsA, bsB; };

struct StaticOrder {
    int nM, nN, nwg, G, c;
    __device__ void init(int M, int N, int G_, int c_) { nM = M / BM; nN = N / BM; nwg = nM * nN; G = G_; c = c_; }
    __device__ bool next(int i, Unit& u) const {
        const long L = (long)i * G + c; if (L >= nwg) return false;
        int wgid = (int)L; { const int q = nwg / NXCD, r = nwg % NXCD, xcd = wgid % NXCD, off = wgid / NXCD; wgid = (xcd < r ? xcd * (q + 1) : r * (q + 1) + (xcd - r) * q) + off; }
        const int nig = WGM * nN, gid = wgid / nig, fm = gid * WGM, gsz = (nM - fm) < WGM ? (nM - fm) : WGM;
        u.pm = fm + ((wgid % nig) % gsz); u.pn = (wgid % nig) / gsz; u.pb = 0; return true;
    }
};
struct BatchOrder {
    int G, c;
    __device__ bool next(int i, Unit& u) const {
        const int L = i * G + c; if (L >= 256) return false;
        const int xcd = L & 7, slot = L >> 3;
        u.pb = xcd * 4 + (slot >> 3); const int r = slot & 7; u.pm = r & 3; u.pn = r >> 2; return true;
    }
};

template <class Epi, class Sched>
__device__ __forceinline__ void gemm_phase(LAS unsigned char* lds, const Gemm g, const Sched& S, const Epi& E) {
    const int tid = threadIdx.x, wid = __builtin_amdgcn_readfirstlane(tid >> 6), lane = tid & 63, wr = wid >> 2, wc = wid & 3, fr = lane & 15, fq = lane >> 4;
    const int K = g.K, nt = K / BK;
    unsigned voffA[2], voffB[2];
#pragma unroll
    for (int i = 0; i < 2; ++i) { int R, C; stage_rc(tid * 16 + i * 8192, R, C); const int Rb = Epi::PERM ? ((R & ~31) + perm32(R & 31)) : R;
        voffA[i] = (unsigned)(R * g.lda + C) * 2u; voffB[i] = (unsigned)(Rb * g.ldb + C) * 2u; }
    const size_t kstep = (size_t)(BK * 2);
    const size_t hstepA = (size_t)HALF * g.lda * 2, hstepB = (size_t)HALF * g.ldb * 2;
    const size_t tstepA = 2 * hstepA, tstepB = 2 * hstepB;
    const unsigned ldsw = (unsigned)wid * 1024u;
    const int aoff = lds_byte(wr * 64 + fr, fq * 8), boff = lds_byte(wc * 32 + fr, fq * 8);
#define PG8_SA(b, h) (((b) * 2 + (h)) * HTB)
#define PG8_SB(b, h) ((4 + (b) * 2 + (h)) * HTB)
#define PG8_STAGE(bufoff, gbase, voff) do { _Pragma("unroll") for (int _i = 0; _i < 2; ++_i) \
        __builtin_amdgcn_global_load_lds((const unsigned*)((const char*)(gbase) + (voff)[_i]), (LAS unsigned*)(lds + (bufoff) + ldsw + _i * 8192), 16, 0, 0); } while (0)
#define PG8_LDA(dst, b, h) do { _Pragma("unroll") for (int m = 0; m < 4; ++m) _Pragma("unroll") for (int k = 0; k < 2; ++k) dst[m][k] = *(const LAS bf16x8*)(lds + PG8_SA(b, h) + aoff + m * 2048 + k * 1024); } while (0)
#define PG8_LDB(dst, b, h) do { _Pragma("unroll") for (int n = 0; n < 2; ++n) _Pragma("unroll") for (int k = 0; k < 2; ++k) dst[n][k] = *(const LAS bf16x8*)(lds + PG8_SB(b, h) + boff + n * 2048 + k * 1024); } while (0)
#define PG8_MMA(ai, bj, At, Bt) do { __builtin_amdgcn_s_setprio(1); _Pragma("unroll") for (int m = 0; m < 4; ++m) _Pragma("unroll") for (int n = 0; n < 2; ++n) _Pragma("unroll") for (int k = 0; k < 2; ++k) \
        acc[ai][bj][m][n] = __builtin_amdgcn_mfma_f32_16x16x32_bf16(Bt[n][k], At[m][k], acc[ai][bj][m][n], 0, 0, 0); __builtin_amdgcn_s_setprio(0); } while (0)
#define PG8_WAIT_V(n) asm volatile("s_waitcnt vmcnt(" #n ")" ::: "memory")
#define PG8_WAIT_L(n) asm volatile("s_waitcnt lgkmcnt(" #n ")" ::: "memory")
#define PG8_BAR __builtin_amdgcn_s_barrier()
#define PG8_SCHED __builtin_amdgcn_sched_barrier(0)
    Unit cur, nxt; int ui = 0;
    if (!S.next(0, cur)) return;
    f32x4 acc[2][2][4][2];
#pragma unroll
    for (int a = 0; a < 2; ++a)
#pragma unroll
        for (int b = 0; b < 2; ++b)
#pragma unroll
            for (int m = 0; m < 4; ++m)
#pragma unroll
                for (int n = 0; n < 2; ++n) acc[a][b][m][n] = (f32x4){0.f, 0.f, 0.f, 0.f};
    bf16x8 At[4][2], B0[2][2], B1[2][2];
    const char* cA = (const char*)g.A + (size_t)cur.pb * g.bsA * 2 + (size_t)cur.pm * tstepA;
    const char* cB = (const char*)g.Bt + (size_t)cur.pb * g.bsB * 2 + (size_t)cur.pn * tstepB;
    PG8_STAGE(PG8_SB(0, 0), cB, voffB); PG8_STAGE(PG8_SA(0, 0), cA, voffA); PG8_STAGE(PG8_SB(0, 1), cB + hstepB, voffB); PG8_STAGE(PG8_SA(0, 1), cA + hstepA, voffA);
    if (wr == 1) PG8_BAR;
    PG8_WAIT_V(4); PG8_BAR;
    PG8_STAGE(PG8_SB(1, 0), cB + kstep, voffB); PG8_STAGE(PG8_SA(1, 0), cA + kstep, voffA); PG8_STAGE(PG8_SB(1, 1), cB + hstepB + kstep, voffB);
    PG8_WAIT_V(6); PG8_BAR;
    for (;;) {
        const bool has_next = S.next(ui + 1, nxt);
        const char* nA = has_next ? (const char*)g.A + (size_t)nxt.pb * g.bsA * 2 + (size_t)nxt.pm * tstepA : cA;
        const char* nB = has_next ? (const char*)g.Bt + (size_t)nxt.pb * g.bsB * 2 + (size_t)nxt.pn * tstepB : cB;
        for (int t = 0; t < nt; t += 2) {
            const bool last = (t == nt - 2);
            const char* a1 = cA + (size_t)(t + 1) * kstep;
            const char* a2 = last ? nA : cA + (size_t)(t + 2) * kstep; const char* b2 = last ? nB : cB + (size_t)(t + 2) * kstep;
            const char* a3 = a2 + kstep; const char* b3 = b2 + kstep;
            PG8_LDB(B0, 0, 0); PG8_SCHED; PG8_LDA(At, 0, 0); PG8_STAGE(PG8_SA(1, 1), a1 + hstepA, voffA);
            PG8_WAIT_L(8); PG8_BAR; PG8_WAIT_L(0); PG8_MMA(0, 0, At, B0); PG8_BAR; PG8_SCHED;
            PG8_LDB(B1, 0, 1); PG8_STAGE(PG8_SB(0, 0), b2, voffB);
            PG8_BAR; PG8_WAIT_L(0); PG8_MMA(0, 1, At, B1); PG8_BAR;
            PG8_LDA(At, 0, 1); PG8_STAGE(PG8_SA(0, 0), a2, voffA);
            PG8_BAR; PG8_WAIT_L(0); PG8_MMA(1, 0, At, B0); PG8_BAR; PG8_SCHED;
            PG8_STAGE(PG8_SB(0, 1), b2 + hstepB, voffB);
            PG8_WAIT_V(6); PG8_BAR; PG8_MMA(1, 1, At, B1); PG8_BAR;
            PG8_LDB(B0, 1, 0); PG8_SCHED; PG8_LDA(At, 1, 0); PG8_STAGE(PG8_SA(0, 1), a2 + hstepA, voffA);
            PG8_WAIT_L(8); PG8_BAR; PG8_WAIT_L(0); PG8_MMA(0, 0, At, B0); PG8_BAR; PG8_SCHED;
            PG8_LDB(B1, 1, 1); PG8_STAGE(PG8_SB(1, 0), b3, voffB);
            PG8_BAR; PG8_WAIT_L(0); PG8_MMA(0, 1, At, B1); PG8_BAR;
            PG8_LDA(At, 1, 1); PG8_STAGE(PG8_SA(1, 0), a3, voffA);
            PG8_BAR; PG8_WAIT_L(0); PG8_MMA(1, 0, At, B0); PG8_BAR; PG8_SCHED;
            PG8_STAGE(PG8_SB(1, 1), b3 + hstepB, voffB);
            PG8_WAIT_V(6); PG8_BAR; PG8_MMA(1, 1, At, B1); PG8_BAR;
        }
        E(acc, cur, wr, wc, fr, fq);
        if (!has_next) break;
#pragma unroll
        for (int a = 0; a < 2; ++a)
#pragma unroll
            for (int b = 0; b < 2; ++b)
#pragma unroll
                for (int m = 0; m < 4; ++m)
#pragma unroll
                    for (int n = 0; n < 2; ++n) acc[a][b][m][n] = (f32x4){0.f, 0.f, 0.f, 0.f};
        cur = nxt; cA = nA; cB = nB; ++ui;
    }
    PG8_WAIT_V(0);
    if (wr == 0) PG8_BAR;
    PG8_BAR;
#undef PG8_SA
#undef PG8_SB
#undef PG8_STAGE
#undef PG8_LDA
#undef PG8_LDB
#undef PG8_MMA
#undef PG8_WAIT_V
#undef PG8_WAIT_L
#undef PG8_BAR
#undef PG8_SCHED
}

__device__ __forceinline__ u32x4 pack8(const f32x4 v0, const f32x4 v1) {
    u32x4 w; w.x = cvt_pk_bf16(v0[0], v0[1]); w.y = cvt_pk_bf16(v0[2], v0[3]); w.z = cvt_pk_bf16(v1[0], v1[1]); w.w = cvt_pk_bf16(v1[2], v1[3]); return w;
}
__device__ __forceinline__ f32x4 rope4(const f32x4 v, const f32x4 cs) {
    f32x4 r; r[0] = v[0] * cs[0] - v[1] * cs[1]; r[1] = v[0] * cs[1] + v[1] * cs[0]; r[2] = v[2] * cs[2] - v[3] * cs[3]; r[3] = v[2] * cs[3] + v[3] * cs[2]; return r;
}
struct EpiInProj {
    static constexpr bool PERM = true;
    bf16_t *Q, *Kb, *V, *Gt, *AU; const float* rope;
    __device__ __forceinline__ void operator()(const f32x4 (&acc)[2][2][4][2], const Unit& u, int wr, int wc, int fr, int fq) const {
        const int sect = u.pn >> 1;
        const int row0 = u.pm * BM + wr * 64 + fr;
        const int colt = (u.pn & 1) * 256 + wc * 32 + 8 * fq;
        if (sect <= 1) {
            bf16_t* O = sect ? Kb : Q;
            f32x4 cs[2][4][2];
#pragma unroll
            for (int ai = 0; ai < 2; ++ai)
#pragma unroll
                for (int m = 0; m < 4; ++m) {
                    const int pos = (row0 + ai * HALF + m * 16) & (SEQ - 1);
                    const float* rp = rope + ((size_t)pos * 64 + 16 * wc + 4 * fq) * 2;
                    cs[ai][m][0] = *(const f32x4*)rp; cs[ai][m][1] = *(const f32x4*)(rp + 4);
                }
#pragma unroll
            for (int ai = 0; ai < 2; ++ai)
#pragma unroll
                for (int m = 0; m < 4; ++m) {
                    const int row = row0 + ai * HALF + m * 16;
#pragma unroll
                    for (int bj = 0; bj < 2; ++bj) {
                        const f32x4 v0 = rope4(acc[ai][bj][m][0], cs[ai][m][0]), v1 = rope4(acc[ai][bj][m][1], cs[ai][m][1]);
                        *(u32x4*)(O + (size_t)row * 512 + colt + bj * HALF) = pack8(v0, v1);
                    }
                }
        } else if (sect <= 3) {
            bf16_t* O = (sect == 2) ? V : Gt;
#pragma unroll
            for (int ai = 0; ai < 2; ++ai)
#pragma unroll
                for (int m = 0; m < 4; ++m) {
                    const int row = row0 + ai * HALF + m * 16;
#pragma unroll
                    for (int bj = 0; bj < 2; ++bj) *(u32x4*)(O + (size_t)row * 512 + colt + bj * HALF) = pack8(acc[ai][bj][m][0], acc[ai][bj][m][1]);
                }
        } else {
#pragma unroll
            for (int ai = 0; ai < 2; ++ai)
#pragma unroll
                for (int m = 0; m < 4; ++m) {
                    const int row = row0 + ai * HALF + m * 16, cr = row >> 5, s = row & 31;
#pragma unroll
                    for (int bj = 0; bj < 2; ++bj) {
                        const int cu = colt + bj * HALF, g = cu >> 4, c0 = cu & 15;
                        *(u32x4*)(AU + ((size_t)(g * 1024 + cr) * 640 + s * 16 + c0)) = pack8(acc[ai][bj][m][0], acc[ai][bj][m][1]);
                    }
                }
        }
    }
};
struct EpiGlu {
    static constexpr bool PERM = true;
    bf16_t* Y;
    __device__ __forceinline__ void operator()(const f32x4 (&acc)[2][2][4][2], const Unit& u, int wr, int wc, int fr, int fq) const {
        const int row0 = u.pm * BM + wr * 64 + fr, col = 512 + u.pn * 128 + wc * 32 + 8 * fq;
#pragma unroll
        for (int ai = 0; ai < 2; ++ai)
#pragma unroll
            for (int m = 0; m < 4; ++m) {
                const int row = row0 + ai * HALF + m * 16;
                f32x4 y0, y1;
#pragma unroll
                for (int j = 0; j < 4; ++j) {
                    y0[j] = acc[ai][0][m][0][j] / (1.0f + __expf(-acc[ai][1][m][0][j]));
                    y1[j] = acc[ai][0][m][1][j] / (1.0f + __expf(-acc[ai][1][m][1][j]));
                }
                *(u32x4*)(Y + (size_t)row * 1024 + col) = pack8(y0, y1);
            }
    }
};
struct EpiSS {
    static constexpr bool PERM = true;
    bf16_t* O; float* SS;
    __device__ __forceinline__ void operator()(const f32x4 (&acc)[2][2][4][2], const Unit& u, int wr, int wc, int fr, int fq) const {
        const int row0 = u.pm * BM + wr * 64 + fr, col = u.pn * BM + wc * 32 + 8 * fq;
#pragma unroll
        for (int ai = 0; ai < 2; ++ai)
#pragma unroll
            for (int m = 0; m < 4; ++m) {
                const int row = row0 + ai * HALF + m * 16; float q = 0.f;
#pragma unroll
                for (int bj = 0; bj < 2; ++bj) {
                    const f32x4 v0 = acc[ai][bj][m][0], v1 = acc[ai][bj][m][1];
                    q += (v0[0] * v0[0] + v0[1] * v0[1]) + (v0[2] * v0[2] + v0[3] * v0[3]) + (v1[0] * v1[0] + v1[1] * v1[1]) + (v1[2] * v1[2] + v1[3] * v1[3]);
                    *(u32x4*)(O + (size_t)row * 1024 + col + bj * HALF) = pack8(v0, v1);
                }
                q += __shfl_xor(q, 16); q += __shfl_xor(q, 32);
                if (fq == 0) SS[(size_t)row * 16 + u.pn * 4 + wc] = q;
            }
    }
};
struct EpiRelu2 {
    static constexpr bool PERM = true;
    bf16_t* O;
    __device__ __forceinline__ void operator()(const f32x4 (&acc)[2][2][4][2], const Unit& u, int wr, int wc, int fr, int fq) const {
        const int row0 = u.pm * BM + wr * 64 + fr, col = u.pn * BM + wc * 32 + 8 * fq;
#pragma unroll
        for (int ai = 0; ai < 2; ++ai)
#pragma unroll
            for (int m = 0; m < 4; ++m) {
                const int row = row0 + ai * HALF + m * 16;
#pragma unroll
                for (int bj = 0; bj < 2; ++bj) {
                    f32x4 v0 = acc[ai][bj][m][0], v1 = acc[ai][bj][m][1];
#pragma unroll
                    for (int j = 0; j < 4; ++j) { const float a = fmaxf(v0[j], 0.f), b = fmaxf(v1[j], 0.f); v0[j] = a * a; v1[j] = b * b; }
                    *(u32x4*)(O + (size_t)row * DFF + col + bj * HALF) = pack8(v0, v1);
                }
            }
    }
};
struct EpiSsm {
    static constexpr bool PERM = true;
    const bf16_t* AU; const float* dskip; bf16_t* Y;
    __device__ __forceinline__ void operator()(const f32x4 (&acc)[2][2][4][2], const Unit& u, int wr, int wc, int fr, int fq) const {
        const int g = u.pb;
        const int row0 = u.pm * BM + wr * 64 + fr, colt = u.pn * BM + wc * 32 + 8 * fq;
        const int c0 = 8 * (fq & 1);
        const f32x4 d0 = *(const f32x4*)(dskip + g * 16 + c0), d1 = *(const f32x4*)(dskip + g * 16 + c0 + 4);
        u32x4 uwv[2][4][2];
#pragma unroll
        for (int ai = 0; ai < 2; ++ai)
#pragma unroll
            for (int m = 0; m < 4; ++m)
#pragma unroll
                for (int bj = 0; bj < 2; ++bj) uwv[ai][m][bj] = *(const u32x4*)(AU + ((size_t)(g * 1024 + row0 + ai * HALF + m * 16) * 640 + colt + bj * HALF));
#pragma unroll
        for (int ai = 0; ai < 2; ++ai)
#pragma unroll
            for (int m = 0; m < 4; ++m) {
                const int cr = row0 + ai * HALF + m * 16;
#pragma unroll
                for (int bj = 0; bj < 2; ++bj) {
                    const int col = colt + bj * HALF, s = col >> 4;
                    const u32x4 uw = uwv[ai][m][bj];
                    f32x4 v0 = acc[ai][bj][m][0], v1 = acc[ai][bj][m][1];
                    v0[0] += d0[0] * bf_lo(uw.x); v0[1] += d0[1] * bf_hi(uw.x); v0[2] += d0[2] * bf_lo(uw.y); v0[3] += d0[3] * bf_hi(uw.y);
                    v1[0] += d1[0] * bf_lo(uw.z); v1[1] += d1[1] * bf_hi(uw.z); v1[2] += d1[2] * bf_lo(uw.w); v1[3] += d1[3] * bf_hi(uw.w);
#pragma unroll
                    for (int j = 0; j < 4; ++j) {
                        const float a = v0[j], za = 1.5957691216f * (a + 0.044715f * a * a * a); v0[j] = a / (1.0f + __expf(-za));
                        const float b = v1[j], zb = 1.5957691216f * (b + 0.044715f * b * b * b); v1[j] = b / (1.0f + __expf(-zb));
                    }
                    const size_t tok = (size_t)cr * 32 + s;
                    *(u32x4*)(Y + tok * 512 + g * 16 + c0) = pack8(v0, v1);
                }
            }
    }
};
}

__device__ __forceinline__ bf16x8 frag_nat(const LAS unsigned char* tile, int idx0, int k0, int fr, int fq) {
    return *(const LAS bf16x8*)(tile + (idx0 + fr) * TS + (k0 + 8 * fq) * 2);
}
__device__ __forceinline__ bf16x8 frag_tr(unsigned tile_addr, int k0, int idx0, int lane) {
    const int g = lane >> 4, q = (lane & 15) >> 2, p = lane & 3;
    const unsigned addr = tile_addr + (unsigned)((k0 + 8 * g + q) * TS + (idx0 + 4 * p) * 2);
    u32x2 lo, hi;
    asm volatile("ds_read_b64_tr_b16 %0, %2\n\tds_read_b64_tr_b16 %1, %2 offset:1088\n\ts_waitcnt lgkmcnt(0)" : "=&v"(lo), "=&v"(hi) : "v"(addr) : "memory");
    u32x4 r; r.x = lo.x; r.y = lo.y; r.z = hi.x; r.w = hi.y;
    return __builtin_bit_cast(bf16x8, r);
}
__device__ __forceinline__ void frags_tr8(bf16x8 (&b)[8], unsigned tile_addr, int k0, int lane) {
    const int g = lane >> 4, q = (lane & 15) >> 2, p = lane & 3;
    const unsigned addr = tile_addr + (unsigned)((k0 + 8 * g + q) * TS + (4 * p) * 2);
    u32x2 r0, r1, r2, r3, r4, r5, r6, r7, r8, r9, r10, r11, r12, r13, r14, r15;
    asm volatile(
        "ds_read_b64_tr_b16 %0, %16\n\t"
        "ds_read_b64_tr_b16 %1, %16 offset:1088\n\t"
        "ds_read_b64_tr_b16 %2, %16 offset:32\n\t"
        "ds_read_b64_tr_b16 %3, %16 offset:1120\n\t"
        "ds_read_b64_tr_b16 %4, %16 offset:64\n\t"
        "ds_read_b64_tr_b16 %5, %16 offset:1152\n\t"
        "ds_read_b64_tr_b16 %6, %16 offset:96\n\t"
        "ds_read_b64_tr_b16 %7, %16 offset:1184\n\t"
        "ds_read_b64_tr_b16 %8, %16 offset:128\n\t"
        "ds_read_b64_tr_b16 %9, %16 offset:1216\n\t"
        "ds_read_b64_tr_b16 %10, %16 offset:160\n\t"
        "ds_read_b64_tr_b16 %11, %16 offset:1248\n\t"
        "ds_read_b64_tr_b16 %12, %16 offset:192\n\t"
        "ds_read_b64_tr_b16 %13, %16 offset:1280\n\t"
        "ds_read_b64_tr_b16 %14, %16 offset:224\n\t"
        "ds_read_b64_tr_b16 %15, %16 offset:1312\n\t"
        "s_waitcnt lgkmcnt(0)"
        : "=&v"(r0), "=&v"(r1), "=&v"(r2), "=&v"(r3), "=&v"(r4), "=&v"(r5), "=&v"(r6), "=&v"(r7),
          "=&v"(r8), "=&v"(r9), "=&v"(r10), "=&v"(r11), "=&v"(r12), "=&v"(r13), "=&v"(r14), "=&v"(r15)
        : "v"(addr) : "memory");
    u32x4 w;
    w.x = r0.x; w.y = r0.y; w.z = r1.x; w.w = r1.y; b[0] = __builtin_bit_cast(bf16x8, w);
    w.x = r2.x; w.y = r2.y; w.z = r3.x; w.w = r3.y; b[1] = __builtin_bit_cast(bf16x8, w);
    w.x = r4.x; w.y = r4.y; w.z = r5.x; w.w = r5.y; b[2] = __builtin_bit_cast(bf16x8, w);
    w.x = r6.x; w.y = r6.y; w.z = r7.x; w.w = r7.y; b[3] = __builtin_bit_cast(bf16x8, w);
    w.x = r8.x; w.y = r8.y; w.z = r9.x; w.w = r9.y; b[4] = __builtin_bit_cast(bf16x8, w);
    w.x = r10.x; w.y = r10.y; w.z = r11.x; w.w = r11.y; b[5] = __builtin_bit_cast(bf16x8, w);
    w.x = r12.x; w.y = r12.y; w.z = r13.x; w.w = r13.y; b[6] = __builtin_bit_cast(bf16x8, w);
    w.x = r14.x; w.y = r14.y; w.z = r15.x; w.w = r15.y; b[7] = __builtin_bit_cast(bf16x8, w);
}
template <bool ATR, bool BTR>
__device__ __forceinline__ void mma128(f32x4 (&acc)[8], const LAS unsigned char* lds, unsigned lds_addr, int offA, int offB, int m0, int lane) {
    const int fr = lane & 15, fq = lane >> 4;
#pragma unroll
    for (int ks = 0; ks < 4; ++ks) {
        bf16x8 af, bfr[8];
        if (ATR) af = frag_tr(lds_addr + offA, 32 * ks, m0, lane); else af = frag_nat(lds + offA, m0, 32 * ks, fr, fq);
        if (BTR) frags_tr8(bfr, lds_addr + offB, 32 * ks, lane);
        else {
#pragma unroll
            for (int n = 0; n < 8; ++n) bfr[n] = frag_nat(lds + offB, 16 * n, 32 * ks, fr, fq);
        }
#pragma unroll
        for (int n = 0; n < 8; ++n) acc[n] = __builtin_amdgcn_mfma_f32_16x16x32_bf16(bfr[n], af, acc[n], 0, 0, 0);
    }
}
__device__ __forceinline__ void tile_load(LAS unsigned char* dst, const bf16_t* src, int ld, int tid) {
    u32x4 v[4];
#pragma unroll
    for (int i = 0; i < 4; ++i) { const int q = tid + 512 * i, row = q >> 4, pc = q & 15; v[i] = *(const u32x4*)(src + (size_t)row * ld + pc * 8); }
#pragma unroll
    for (int i = 0; i < 4; ++i) { const int q = tid + 512 * i, row = q >> 4, pc = q & 15; *(LAS u32x4*)(dst + row * TS + pc * 16) = v[i]; }
}
__device__ __forceinline__ void tile_load_zeta(LAS unsigned char* dst, const bf16_t* src, int ld, int tid, float l2g) {
    u32x4 v[4];
#pragma unroll
    for (int i = 0; i < 4; ++i) { const int q = tid + 512 * i, row = q >> 4, pc = q & 15; v[i] = *(const u32x4*)(src + (size_t)row * ld + pc * 8); }
#pragma unroll
    for (int i = 0; i < 4; ++i) {
        const int q = tid + 512 * i, row = q >> 4, pc = q & 15; const float z = exp2f((float)(127 - row) * l2g);
        u32x4 w;
        w.x = cvt_pk_bf16(bf_lo(v[i].x) * z, bf_hi(v[i].x) * z); w.y = cvt_pk_bf16(bf_lo(v[i].y) * z, bf_hi(v[i].y) * z);
        w.z = cvt_pk_bf16(bf_lo(v[i].z) * z, bf_hi(v[i].z) * z); w.w = cvt_pk_bf16(bf_lo(v[i].w) * z, bf_hi(v[i].w) * z);
        *(LAS u32x4*)(dst + row * TS + pc * 16) = w;
    }
}
__device__ __forceinline__ void tile_issue(u32x4 (&v)[4], const bf16_t* src, int ld, int tid) {
#pragma unroll
    for (int i = 0; i < 4; ++i) { const int q = tid + 512 * i, row = q >> 4, pc = q & 15; v[i] = *(const u32x4*)(src + (size_t)row * ld + pc * 8); }
}
__device__ __forceinline__ void tile_issue_nt(u32x4 (&v)[4], const bf16_t* src, int ld, int tid) {
#pragma unroll
    for (int i = 0; i < 4; ++i) { const int q = tid + 512 * i, row = q >> 4, pc = q & 15; v[i] = ld_nt((const u32x4*)(src + (size_t)row * ld + pc * 8)); }
}
__device__ __forceinline__ void tile_commit(LAS unsigned char* dst, const u32x4 (&v)[4], int tid) {
#pragma unroll
    for (int i = 0; i < 4; ++i) { const int q = tid + 512 * i, row = q >> 4, pc = q & 15; *(LAS u32x4*)(dst + row * TS + pc * 16) = v[i]; }
}
__device__ __forceinline__ void tile_commit_zeta(LAS unsigned char* dst, const u32x4 (&v)[4], int tid, float l2g) {
#pragma unroll
    for (int i = 0; i < 4; ++i) {
        const int q = tid + 512 * i, row = q >> 4, pc = q & 15; const float z = exp2f((float)(127 - row) * l2g);
        u32x4 w;
        w.x = cvt_pk_bf16(bf_lo(v[i].x) * z, bf_hi(v[i].x) * z); w.y = cvt_pk_bf16(bf_lo(v[i].y) * z, bf_hi(v[i].y) * z);
        w.z = cvt_pk_bf16(bf_lo(v[i].z) * z, bf_hi(v[i].z) * z); w.w = cvt_pk_bf16(bf_lo(v[i].w) * z, bf_hi(v[i].w) * z);
        *(LAS u32x4*)(dst + row * TS + pc * 16) = w;
    }
}
__device__ __forceinline__ float ret_log2_gamma(int h) { const float g = 1.0f - exp2f(-5.0f - (4.0f / 3.0f) * (float)h); return log2f(g); }

__device__ __forceinline__ int dest_row(int mode, int n) {
    if (mode == 1) { if (n < 1024) { const int sect = n >> 9, w = n & 511, h = w >> 7, j = w & 127; return (sect << 9) + (h << 7) + ((j & 63) << 1) + (j >> 6); } return n; }
    if (mode == 2) { const int bj = n >> 9, rem = n & 511, pn = rem >> 7, j = rem & 127; return (pn << 8) + (bj << 7) + j; }
    return n;
}
struct TrItem { const float* W; bf16_t* WT; const float* gain; int K, N, mode, item; };
__device__ __forceinline__ void p0_tr_load(const TrItem& t, f32x4 (&v)[8], int lane) {
    const int nblk = t.N / 32, kb = t.item / nblk, nb = t.item % nblk, k0 = 64 * kb, n0 = 32 * nb;
    const float cs = (t.mode == 1 && n0 >= 512 && n0 < 1024) ? 0.08838834764831845f : 1.0f;
#pragma unroll
    for (int i = 0; i < 8; ++i) { const int kk = (lane >> 3) + 8 * i; const float g = t.gain ? t.gain[k0 + kk] * cs : cs;
        v[i] = ld_nt((const f32x4*)(t.W + (size_t)(k0 + kk) * t.N + n0 + 4 * (lane & 7))) * g; }
}
__device__ __forceinline__ void p0_tr_finish(const TrItem& t, const f32x4 (&v)[8], LAS float* scr, int lane) {
    const int nblk = t.N / 32, kb = t.item / nblk, nb = t.item % nblk, k0 = 64 * kb, n0 = 32 * nb;
#pragma unroll
    for (int i = 0; i < 8; ++i) { const int kk = (lane >> 3) + 8 * i; LAS float* d = scr + kk * 33 + 4 * (lane & 7); d[0] = v[i][0]; d[1] = v[i][1]; d[2] = v[i][2]; d[3] = v[i][3]; }
    LDS_WAIT();
    const int c = lane & 7;
#pragma unroll
    for (int j = 0; j < 4; ++j) { const int n = (lane >> 3) + 8 * j; const LAS float* s = scr + (8 * c) * 33 + n;
        u32x4 o; o.x = cvt_pk_bf16(s[0 * 33], s[1 * 33]); o.y = cvt_pk_bf16(s[2 * 33], s[3 * 33]); o.z = cvt_pk_bf16(s[4 * 33], s[5 * 33]); o.w = cvt_pk_bf16(s[6 * 33], s[7 * 33]);
        *(u32x4*)(t.WT + (size_t)dest_row(t.mode, n0 + n) * t.K + k0 + 8 * c) = o; }
    LDS_WAIT();
}
__device__ __forceinline__ void s5_pow(float lre, float lim, float dt, float j, float& pr, float& pi) {
    const float mag = expf(j * (dt * lre)); float s, c; sincosf(j * (dt * lim), &s, &c); pr = mag * c; pi = mag * s;
}
__device__ __forceinline__ void s5_coef(float lre, float lim, float dt, float& cr, float& ci) {
    float br, bi; s5_pow(lre, lim, dt, 1.0f, br, bi); br -= 1.0f;
    const float den = lre * lre + lim * lim; cr = (br * lre + bi * lim) / den; ci = (bi * lre - br * lim) / den;
}

#define XB_TMO      128
#define XB_XCNT(j)  (256  + 64 * (j))
#define XB_XSUB(j)  (1280 + 64 * (j))
#define XB_XGEN(j)  (2304 + 64 * (j))
#define XB_TOP      3328
#define XB_TOPGEN   3392
#define XCD_BAR_WORDS 3456
#define XB_SPIN_CAP (1u << 18)
__device__ __forceinline__ unsigned xb_ld(unsigned* p)              { return __hip_atomic_load(p, __ATOMIC_RELAXED, __HIP_MEMORY_SCOPE_AGENT); }
__device__ __forceinline__ unsigned xb_add(unsigned* p, unsigned v) { return __hip_atomic_fetch_add(p, v, __ATOMIC_RELAXED, __HIP_MEMORY_SCOPE_AGENT); }
__device__ __forceinline__ unsigned xb_xcc_id() { return (unsigned)__builtin_amdgcn_s_getreg((3 << 11) | 20) & 0xFu; }
#define XB_SPIN(cond, bar) do { unsigned _sp = 0; while (cond) { __builtin_amdgcn_s_sleep(1); \
    if ((++_sp & 255u) == 0u) { if (xb_ld(&(bar)[XB_TMO])) break; if (_sp > XB_SPIN_CAP) { atomicAdd(&(bar)[XB_TMO], 1u); break; } } } } while (0)
struct XcdBarrier { unsigned* bar; unsigned x; volatile LAS unsigned* st; };
__device__ __forceinline__ XcdBarrier xcd_barrier_post(unsigned* bar, volatile LAS unsigned* st) {
    XcdBarrier b; b.bar = bar; b.x = xb_xcc_id(); b.st = st;
    if (threadIdx.x == 0) (void)xb_add(&bar[XB_XCNT(b.x)], 1u);
    return b;
}
__device__ __forceinline__ void xcd_barrier_complete(unsigned* bar, unsigned x, unsigned& nloc, unsigned& nx) {
    const unsigned G = gridDim.x * gridDim.y * gridDim.z;
    unsigned sum, cnt, mine, sp = 0u;
    for (;;) {
        sum = 0u; cnt = 0u; mine = 0u;
#pragma unroll
        for (unsigned j = 0; j < 16; ++j) { const unsigned c = xb_ld(&bar[XB_XCNT(j)]); sum += c; cnt += (c > 0u) ? 1u : 0u; mine = (j == x) ? c : mine; }
        if (sum == G) break;
        __builtin_amdgcn_s_sleep(1);
        if ((++sp & 255u) == 0u) { if (xb_ld(&bar[XB_TMO])) break; if (sp > XB_SPIN_CAP) { atomicAdd(&bar[XB_TMO], 1u); break; } }
    }
    nloc = mine > 0u ? mine : 1u; nx = cnt > 0u ? cnt : 1u;
}
__device__ __forceinline__ void xcd_barrier(const XcdBarrier& b) {
    asm volatile("s_waitcnt vmcnt(0)" ::: "memory");
    __syncthreads();
    if (threadIdx.x == 0) {
        unsigned* bar = b.bar;
        __builtin_amdgcn_s_waitcnt(0);
        unsigned nloc = b.st[0], nx = b.st[1];
        if (nloc == 0u) { xcd_barrier_complete(bar, b.x, nloc, nx); b.st[0] = nloc; b.st[1] = nx; }
        const unsigned old = xb_add(&bar[XB_XSUB(b.x)], 1u);
        const unsigned gen = old / nloc;
        if (old + 1u == (gen + 1u) * nloc) {
            __builtin_amdgcn_fence(__ATOMIC_RELEASE, "agent");
            asm volatile("s_waitcnt vmcnt(0)" ::: "memory");
            const unsigned og = xb_add(&bar[XB_TOP], 1u);
            const unsigned tg = og / nx;
            if (og + 1u == (tg + 1u) * nx) xb_add(&bar[XB_TOPGEN], 1u);
            else XB_SPIN(xb_ld(&bar[XB_TOPGEN]) == tg, bar);
            __builtin_amdgcn_fence(__ATOMIC_ACQUIRE, "agent");
            xb_add(&bar[XB_XGEN(b.x)], 1u);
            asm volatile("s_waitcnt vmcnt(0)" ::: "memory");
        } else {
            XB_SPIN(xb_ld(&bar[XB_XGEN(b.x)]) == gen, bar);
            __builtin_amdgcn_fence(__ATOMIC_ACQUIRE, "agent");
            asm volatile("s_waitcnt vmcnt(0)" ::: "memory");
        }
    }
    __syncthreads();
}

struct Args { const float* in[19]; float* out; unsigned char* ws; int ph_lo, ph_hi; };

__global__ void __launch_bounds__(512, 2) fwd_kernel(Args a) {
    extern __shared__ __attribute__((aligned(16))) unsigned char lds_raw[];
    LAS unsigned char* lds = (LAS unsigned char*)lds_raw;
    const unsigned lds_addr = (unsigned)(size_t)lds_raw;
    cg::grid_group grid = cg::this_grid();
    const int tid = threadIdx.x, lane = tid & 63, wave = __builtin_amdgcn_readfirstlane(tid >> 6);
    const int G = gridDim.x, bx = blockIdx.x;
    const int lo = a.ph_lo, hi = a.ph_hi;
    unsigned char* ws = a.ws;
#define IN(k) (lo <= (k) && (k) < hi)
#define SEAM(k) do { if (lo <= (k) && (k) + 1 < hi) xcd_barrier(xbar); } while (0)
    volatile LAS unsigned* misc = (volatile LAS unsigned*)(lds + (LDS_BYTES - 64));
    if (tid < 16) misc[tid] = 0u;
    __syncthreads();
    const XcdBarrier xbar = xcd_barrier_post((unsigned*)ws, misc);
    if (lo < 0) grid.sync();

    const float* x = a.in[0];
    const float* g_mix_pre = a.in[1]; const float* g_mix_post = a.in[2]; const float* w_in = a.in[3]; const float* gn_gain = a.in[4];
    const float* lam_re = a.in[5]; const float* lam_im = a.in[6]; const float* log_dt = a.in[7];
    const float* b_re = a.in[8]; const float* b_im = a.in[9]; const float* c_re = a.in[10]; const float* c_im = a.in[11]; const float* d_skip = a.in[12];
    const float* w_glu = a.in[13]; const float* w_out = a.in[14]; const float* g_mlp_pre = a.in[15]; const float* g_mlp_post = a.in[16];
    const float* w_ff1 = a.in[17]; const float* w_ff2 = a.in[18];
    float* out = a.out;

    bf16_t* WIN = (bf16_t*)(ws + WS_WIN); bf16_t* WGLU = (bf16_t*)(ws + WS_WGLU); bf16_t* WOUT = (bf16_t*)(ws + WS_WOUT);
    bf16_t* WFF1 = (bf16_t*)(ws + WS_WFF1); bf16_t* WFF2 = (bf16_t*)(ws + WS_WFF2);
    float* ROPE = (float*)(ws + WS_ROPE); bf16_t* TW = (bf16_t*)(ws + WS_TW); bf16_t* W1S = (bf16_t*)(ws + WS_W1S);
    float* XSC = (float*)(ws + 73 * MiB);
    float* SS = (float*)(ws + WS_SS); float* SS2 = (float*)(ws + WS_SS2); float* HINC = (float*)(ws + WS_HINC);
    bf16_t* XN = (bf16_t*)(ws + WS_XN);
    bf16_t* QB = (bf16_t*)(ws + WS_QB); bf16_t* KB = (bf16_t*)(ws + WS_KB); bf16_t* VB = (bf16_t*)(ws + WS_VB); bf16_t* GB = (bf16_t*)(ws + WS_GB);
    bf16_t* AU = (bf16_t*)(ws + WS_AU); bf16_t* SST = (bf16_t*)(ws + WS_SST); bf16_t* RTB = (bf16_t*)(ws + WS_RTB);
    bf16_t* YSSM = (bf16_t*)(ws + WS_YSSM); bf16_t* YMIX = (bf16_t*)(ws + WS_YMIX);
    bf16_t* MIXB = (bf16_t*)(ws + WS_MIXB); bf16_t* HID = (bf16_t*)(ws + WS_HID); bf16_t* MB = (bf16_t*)(ws + WS_MB);

    if (IN(0)) for (int rep = 0; rep < REPS(0); ++rep) {
        const int gw = bx * 8 + wave, NGW = G * 8;
        {
            LAS float* scr = (LAS float*)(lds + wave * 16384);
            constexpr int I_IN = (DM / 64) * (NIN / 32), I_GLU = (512 / 64) * (1024 / 32), I_OUT = (DM / 64) * (DM / 32), I_F1 = (DM / 64) * (DFF / 32), I_F2 = (DFF / 64) * (DM / 32);
            constexpr int NITEMS = I_IN + I_GLU + I_OUT + I_F1 + I_F2;
#define TR_DECODE(IT, t) do { int r_ = (IT); \
                if (r_ < I_IN) { t = TrItem{w_in, WIN, g_mix_pre, DM, NIN, 1, r_}; break; } r_ -= I_IN; \
                if (r_ < I_GLU) { t = TrItem{w_glu, WGLU, nullptr, 512, 1024, 2, r_}; break; } r_ -= I_GLU; \
                if (r_ < I_OUT) { t = TrItem{w_out, WOUT, nullptr, DM, DM, 0, r_}; break; } r_ -= I_OUT; \
                if (r_ < I_F1) { t = TrItem{w_ff1, WFF1, g_mlp_pre, DM, DFF, 0, r_}; break; } r_ -= I_F1; \
                t = TrItem{w_ff2, WFF2, nullptr, DFF, DM, 0, r_}; } while (0)
            for (int it = gw; it < NITEMS; it += 3 * NGW) {
                TrItem t0, t1, t2; f32x4 v0[8], v1[8], v2[8];
                const bool h1 = it + NGW < NITEMS, h2 = it + 2 * NGW < NITEMS;
                TR_DECODE(it, t0); p0_tr_load(t0, v0, lane);
                if (h1) { TR_DECODE(it + NGW, t1); p0_tr_load(t1, v1, lane); }
                if (h2) { TR_DECODE(it + 2 * NGW, t2); p0_tr_load(t2, v2, lane); }
                p0_tr_finish(t0, v0, scr, lane);
                if (h1) p0_tr_finish(t1, v1, scr, lane);
                if (h2) p0_tr_finish(t2, v2, scr, lane);
            }
#undef TR_DECODE
        }
        for (int m = gw; m < T; m += 2 * NGW) {
            const int m2 = m + NGW;
            const bool has2 = m2 < T;
            const f32x4* xr0 = (const f32x4*)(x + (size_t)m * DM) + lane;
            const f32x4* xr1 = (const f32x4*)(x + (size_t)(has2 ? m2 : m) * DM) + lane;
            f32x4 v0[4], v1[4]; float s0 = 0.f, s1 = 0.f;
#pragma unroll
            for (int j = 0; j < 4; ++j) { v0[j] = ld_nt(xr0 + 64 * j); v1[j] = ld_nt(xr1 + 64 * j); }
#pragma unroll
            for (int j = 0; j < 4; ++j) {
                s0 += (v0[j][0] * v0[j][0] + v0[j][1] * v0[j][1]) + (v0[j][2] * v0[j][2] + v0[j][3] * v0[j][3]);
                s1 += (v1[j][0] * v1[j][0] + v1[j][1] * v1[j][1]) + (v1[j][2] * v1[j][2] + v1[j][3] * v1[j][3]);
            }
            const float q0 = sqrtf(wave_sum(s0) * (1.0f / DM) + EPS), q1 = sqrtf(wave_sum(s1) * (1.0f / DM) + EPS);
            const float r0 = 1.0f / q0, r1 = 1.0f / q1;
            if (lane == 0) { XSC[m] = q0; if (has2) XSC[m2] = q1; }
            u32x2* o0 = (u32x2*)(XN + (size_t)m * DM) + lane; u32x2* o1 = (u32x2*)(XN + (size_t)m2 * DM) + lane;
#pragma unroll
            for (int j = 0; j < 4; ++j) { u32x2 w; w.x = cvt_pk_bf16(v0[j][0] * r0, v0[j][1] * r0); w.y = cvt_pk_bf16(v0[j][2] * r0, v0[j][3] * r0); o0[64 * j] = w; }
            if (has2) {
#pragma unroll
                for (int j = 0; j < 4; ++j) { u32x2 w; w.x = cvt_pk_bf16(v1[j][0] * r1, v1[j][1] * r1); w.y = cvt_pk_bf16(v1[j][2] * r1, v1[j][3] * r1); o1[64 * j] = w; }
            }
        }
        const float rope_inv = (float)pow(10000.0, -(double)(tid & 63) / 64.0);
        for (int i = bx * 512 + tid; i < SEQ * 64; i += G * 512) {
            const int pos = i >> 6;
            const float inv = rope_inv;
            const float ang = (float)pos * inv; float s, c; sincosf(ang, &s, &c);
            *(f32x2*)(ROPE + (size_t)i * 2) = (f32x2){c, s};
        }
        for (int i = bx * 512 + tid; i < 32 * 32 * 64; i += G * 512) {
            {
                const int q = i & 63, t = (i >> 6) & 31, g = i >> 11;
                const float lre = fminf(lam_re[g * 64 + q], -1e-4f), lim = lam_im[g * 64 + q], dt = expf(log_dt[g]);
                float pr, pi; s5_pow(lre, lim, dt, (float)(t + 1), pr, pi);
                float crv[16], civ[16];
#pragma unroll
                for (int c = 0; c < 16; ++c) { crv[c] = c_re[(g * 16 + c) * 64 + q]; civ[c] = c_im[(g * 16 + c) * 64 + q]; }
#pragma unroll
                for (int c = 0; c < 16; ++c) {
                    const float zr = crv[c] * pr - civ[c] * pi, zi = crv[c] * pi + civ[c] * pr;
                    bf16_t* row = TW + (size_t)(g * 512 + t * 16 + c) * 640 + 512;
                    row[q] = f2bf(zr); row[64 + q] = f2bf(-zi);
                }
            }
            {
                const int s = i & 31, p = (i >> 5) & 63, g = i >> 11;
                const float lre = fminf(lam_re[g * 64 + p], -1e-4f), lim = lam_im[g * 64 + p], dt = expf(log_dt[g]);
                float pr, pi, cr, ci; s5_pow(lre, lim, dt, (float)(31 - s), pr, pi); s5_coef(lre, lim, dt, cr, ci);
                const float wr_ = pr * cr - pi * ci, wi_ = pr * ci + pi * cr;
                float zr[16], zi[16];
#pragma unroll
                for (int c = 0; c < 16; ++c) { const float br = b_re[(g * 64 + p) * 16 + c], bi = b_im[(g * 64 + p) * 16 + c]; zr[c] = wr_ * br - wi_ * bi; zi[c] = wr_ * bi + wi_ * br; }
                u32x4* o0 = (u32x4*)(W1S + (size_t)(g * 128 + p) * 512 + s * 16);
                u32x4* o1 = (u32x4*)(W1S + (size_t)(g * 128 + 64 + p) * 512 + s * 16);
                u32x4 w;
                w.x = cvt_pk_bf16(zr[0], zr[1]); w.y = cvt_pk_bf16(zr[2], zr[3]); w.z = cvt_pk_bf16(zr[4], zr[5]); w.w = cvt_pk_bf16(zr[6], zr[7]); o0[0] = w;
                w.x = cvt_pk_bf16(zr[8], zr[9]); w.y = cvt_pk_bf16(zr[10], zr[11]); w.z = cvt_pk_bf16(zr[12], zr[13]); w.w = cvt_pk_bf16(zr[14], zr[15]); o0[1] = w;
                w.x = cvt_pk_bf16(zi[0], zi[1]); w.y = cvt_pk_bf16(zi[2], zi[3]); w.z = cvt_pk_bf16(zi[4], zi[5]); w.w = cvt_pk_bf16(zi[6], zi[7]); o1[0] = w;
                w.x = cvt_pk_bf16(zi[8], zi[9]); w.y = cvt_pk_bf16(zi[10], zi[11]); w.z = cvt_pk_bf16(zi[12], zi[13]); w.w = cvt_pk_bf16(zi[14], zi[15]); o1[1] = w;
            }
        }
        for (int i = bx * 512 + tid; i < 16384 * 64; i += G * 512) {
            const int piece = i & 63, row = i >> 6, t = (row >> 4) & 31;
            if (piece >= 2 * (t + 1)) *(u32x4*)(TW + (size_t)row * 640 + piece * 8) = (u32x4){0u, 0u, 0u, 0u};
        }
        __syncthreads();
        {
            LAS float* Bre = (LAS float*)lds; LAS float* Bim = Bre + 1024; LAS float* Cre = Bre + 2048; LAS float* Cim = Bre + 3072;
            LAS float* cpr = Bre + 4096; LAS float* cpi = cpr + 256;
            for (int it = bx; it < 256; it += G) {
                const int g = it >> 3, jq = it & 7;
                {
                    const int q0 = tid, q1 = tid + 512;
                    const float* s0 = (q0 < 256 ? b_re : b_im) + g * 1024 + (q0 & 255) * 4;
                    const float* s1 = (q1 < 768 ? c_re : c_im) + g * 1024 + (q1 & 255) * 4;
                    *(LAS f32x4*)(Bre + q0 * 4) = *(const f32x4*)s0;
                    *(LAS f32x4*)(Bre + q1 * 4) = *(const f32x4*)s1;
                }
                if (tid < 256) {
                    const int p = tid & 63, jl = tid >> 6;
                    const float lre = fminf(lam_re[g * 64 + p], -1e-4f), lim = lam_im[g * 64 + p], dt = expf(log_dt[g]);
                    float pr, pi, cr, ci; s5_pow(lre, lim, dt, (float)(4 * jq + jl), pr, pi); s5_coef(lre, lim, dt, cr, ci);
                    cpr[jl * 64 + p] = pr * cr - pi * ci; cpi[jl * 64 + p] = pr * ci + pi * cr;
                }
                __syncthreads();
                {
                    const int cc = tid & 255, c = cc >> 4, c2 = cc & 15, jh = tid >> 8;
                    float v0 = 0.f, v1 = 0.f;
#pragma unroll 8
                    for (int p = 0; p < 64; ++p) {
                        const float cr = Cre[c * 64 + p], ci = Cim[c * 64 + p], br = Bre[p * 16 + c2], bi = Bim[p * 16 + c2];
                        const float mr = cr * br - ci * bi, mi = cr * bi + ci * br;
                        v0 += mr * cpr[(2 * jh) * 64 + p] - mi * cpi[(2 * jh) * 64 + p];
                        v1 += mr * cpr[(2 * jh + 1) * 64 + p] - mi * cpi[(2 * jh + 1) * 64 + p];
                    }
                    const int jj0 = 4 * jq + 2 * jh;
                    const bf16_t w0 = f2bf(v0), w1 = f2bf(v1);
                    for (int t = jj0; t < 32; ++t) TW[(size_t)(g * 512 + t * 16 + c) * 640 + (t - jj0) * 16 + c2] = w0;
                    for (int t = jj0 + 1; t < 32; ++t) TW[(size_t)(g * 512 + t * 16 + c) * 640 + (t - jj0 - 1) * 16 + c2] = w1;
                }
                __syncthreads();
            }
        }
    }
    SEAM(0);

    if (IN(1)) for (int rep = 0; rep < REPS(1); ++rep) {
        pg8::Gemm g{XN, WIN, DM, DM, DM, 0, 0}; pg8::StaticOrder S; S.init(T, NIN, G, bx);
        pg8::EpiInProj E{QB, KB, VB, GB, AU, ROPE};
        pg8::gemm_phase(lds, g, S, E);
    }
    SEAM(1);

    if (IN(2)) for (int rep = 0; rep < REPS(2); ++rep) {
        const int fr = lane & 15, fq = lane >> 4;
        for (int it = bx; it < 256; it += G) {
            const int g = it >> 3, rt = it & 7;
            const bf16_t* pA = AU + (size_t)(g * 1024 + rt * 128) * 640; const bf16_t* pB = W1S + (size_t)(g * 128) * 512;
            f32x4 acc[8];
#pragma unroll
            for (int n = 0; n < 8; ++n) acc[n] = (f32x4){0.f, 0.f, 0.f, 0.f};
            u32x4 ra[4], rb[4];
            tile_issue(ra, pA, 640, tid); tile_issue(rb, pB, 512, tid);
            for (int kt = 0; kt < 4; ++kt) {
                tile_commit(lds, ra, tid); tile_commit(lds + TILE_B, rb, tid);
                __syncthreads();
                if (kt < 3) { tile_issue(ra, pA + (kt + 1) * 128, 640, tid); tile_issue(rb, pB + (kt + 1) * 128, 512, tid); }
                mma128<false, false>(acc, lds, lds_addr, 0, TILE_B, 16 * wave, lane);
                __syncthreads();
            }
            float* o = HINC + ((size_t)(g * 1024 + rt * 128 + 16 * wave + fr)) * 128 + 4 * fq;
#pragma unroll
            for (int n = 0; n < 8; ++n) *(f32x4*)(o + 16 * n) = acc[n];
        }
        {
            u32x4 rk[4], rv[4];
            int it = bx;
#define R1_ISSUE(IT) do { const int n_ = (IT) & 63, h_ = ((IT) >> 6) & 3, b_ = (IT) >> 8; const size_t t0_ = (size_t)b_ * SEQ + n_ * 128; \
                tile_issue(rk, KB + t0_ * 512 + h_ * 128, 512, tid); tile_issue(rv, VB + t0_ * 512 + h_ * 128, 512, tid); } while (0)
            if (it < 1024) R1_ISSUE(it);
            for (; it < 1024; it += G) {
                const int h = (it >> 6) & 3;
                const float l2g = ret_log2_gamma(h);
                tile_commit(lds, rk, tid); tile_commit_zeta(lds + TILE_B, rv, tid, l2g);
                __syncthreads();
                if (it + G < 1024) R1_ISSUE(it + G);
                f32x4 acc[8];
#pragma unroll
                for (int nb = 0; nb < 8; ++nb) acc[nb] = (f32x4){0.f, 0.f, 0.f, 0.f};
                mma128<true, true>(acc, lds, lds_addr, TILE_B, 0, 16 * wave, lane);
                bf16_t* o = SST + (size_t)it * 16384 + (16 * wave + fr) * 128 + 4 * fq;
#pragma unroll
                for (int nb = 0; nb < 8; ++nb) { u32x2 w; w.x = cvt_pk_bf16(acc[nb][0], acc[nb][1]); w.y = cvt_pk_bf16(acc[nb][2], acc[nb][3]); *(u32x2*)(o + 16 * nb) = w; }
                __syncthreads();
            }
#undef R1_ISSUE
        }
    }
    SEAM(2);

    if (IN(3)) for (int rep = 0; rep < REPS(3); ++rep) {
        for (int idx = bx * 512 + tid; idx < 16 * 8192; idx += G * 512) {
            const int bh = idx >> 13, e2 = idx & 8191, h = bh & 3;
            const float gch = exp2f(128.0f * ret_log2_gamma(h));
            const unsigned* sp = (const unsigned*)(SST + (size_t)bh * 64 * 16384 + 2 * e2);
            unsigned* rp = (unsigned*)(RTB + (size_t)bh * 64 * 16384 + 2 * e2);
            float r0 = 0.f, r1 = 0.f;
            for (int n0 = 0; n0 < 64; n0 += 16) {
                unsigned s[16];
#pragma unroll
                for (int j = 0; j < 16; ++j) s[j] = ld_nt(sp + (size_t)(n0 + j) * 8192);
#pragma unroll
                for (int j = 0; j < 16; ++j) { rp[(size_t)(n0 + j) * 8192] = cvt_pk_bf16(r0, r1); r0 = gch * r0 + bf_lo(s[j]); r1 = gch * r1 + bf_hi(s[j]); }
            }
        }
        {
            LAS float* X = (LAS float*)lds;
            for (int it = bx; it < 128; it += G) {
                const int b = it >> 5, g = it & 31, p = tid & 63, seg = tid >> 6;
                const float lre = fminf(lam_re[g * 64 + p], -1e-4f), lim = lam_im[g * 64 + p], dt = expf(log_dt[g]);
                float ar, ai, Ar, Ai; s5_pow(lre, lim, dt, 32.0f, ar, ai); s5_pow(lre, lim, dt, 1024.0f, Ar, Ai);
                const float* hp = HINC + ((size_t)(g * 1024 + b * 256 + seg * 32)) * 128 + p;
                float xr = 0.f, xi = 0.f;
                for (int i = 0; i < 32; ++i) { const float hr = hp[(size_t)i * 128], hi_ = hp[(size_t)i * 128 + 64]; const float nr = ar * xr - ai * xi + hr, ni = ar * xi + ai * xr + hi_; xr = nr; xi = ni; }
                X[(seg * 64 + p) * 2] = xr; X[(seg * 64 + p) * 2 + 1] = xi;
                __syncthreads();
                float cr = 0.f, ci = 0.f;
                for (int s = 0; s < seg; ++s) { const float tr = X[(s * 64 + p) * 2], ti = X[(s * 64 + p) * 2 + 1]; const float nr = Ar * cr - Ai * ci + tr, ni = Ar * ci + Ai * cr + ti; cr = nr; ci = ni; }
                bf16_t* op = AU + ((size_t)(g * 1024 + b * 256 + seg * 32)) * 640 + 512 + p;
                xr = cr; xi = ci;
                for (int i = 0; i < 32; ++i) {
                    op[(size_t)i * 640] = f2bf(xr); op[(size_t)i * 640 + 64] = f2bf(xi);
                    const float hr = hp[(size_t)i * 128], hi_ = hp[(size_t)i * 128 + 64]; const float nr = ar * xr - ai * xi + hr, ni = ar * xi + ai * xr + hi_; xr = nr; xi = ni;
                }
                __syncthreads();
            }
        }
    }
    SEAM(3);

    if (IN(4)) for (int rep = 0; rep < REPS(4); ++rep) {
        const bool solo = (hi - lo == 1);
        if (!(solo && PROBE_P4_PART == 2)) for (int rep4 = 0; rep4 < (PROBE_P4_DUP == 1 ? 2 : 1); ++rep4) {
            pg8::Gemm g{AU, TW, 640, 640, 640, (size_t)1024 * 640, (size_t)512 * 640}; pg8::BatchOrder S{G, bx};
            pg8::EpiSsm E{AU, d_skip, YSSM};
            pg8::gemm_phase(lds, g, S, E);
        }
        const int fr = lane & 15, fq = lane >> 4;
        constexpr int OQ = 0, OK_ = TILE_B, OV = 2 * TILE_B, OR = 3 * TILE_B;
        for (int rep4 = 0; rep4 < (PROBE_P4_DUP == 2 ? 2 : 1); ++rep4) {
        u32x4 rq[4], rk[4], rv[4], rr[4];
        int it = bx;
#define R3_ISSUE_QK(IT) do { const int n_ = (IT) & 63, h_ = ((IT) >> 6) & 3, b_ = (IT) >> 8; const size_t t0_ = (size_t)b_ * SEQ + n_ * 128; \
            tile_issue_nt(rq, QB + t0_ * 512 + h_ * 128, 512, tid); tile_issue_nt(rk, KB + t0_ * 512 + h_ * 128, 512, tid); } while (0)
#define R3_ISSUE_VR(IT) do { const int n_ = (IT) & 63, h_ = ((IT) >> 6) & 3, b_ = (IT) >> 8; const size_t t0_ = (size_t)b_ * SEQ + n_ * 128; \
            tile_issue_nt(rv, VB + t0_ * 512 + h_ * 128, 512, tid); tile_issue_nt(rr, RTB + (size_t)(IT) * 16384, 128, tid); } while (0)
        if (solo && PROBE_P4_PART == 1) it = 1024;
        if (it < 1024) R3_ISSUE_QK(it);
        for (; it < 1024; it += G) {
            const int n = it & 63, h = (it >> 6) & 3, b = it >> 8;
            const float l2g = ret_log2_gamma(h);
            const size_t tok0 = (size_t)b * SEQ + n * 128;
            tile_commit(lds + OQ, rq, tid); tile_commit(lds + OK_, rk, tid);
            R3_ISSUE_VR(it);
            __syncthreads();
            const int i = 16 * wave + fr;
            f32x4 sc[8];
#pragma unroll
            for (int nb = 0; nb < 8; ++nb) sc[nb] = (f32x4){0.f, 0.f, 0.f, 0.f};
            mma128<false, false>(sc, lds, lds_addr, OQ, OK_, 16 * wave, lane);
            tile_commit(lds + OV, rv, tid); tile_commit(lds + OR, rr, tid);
            __syncthreads();
            if (it + G < 1024) R3_ISSUE_QK(it + G);
#pragma unroll
            for (int nb = 0; nb < 8; ++nb) {
                f32x4 pv;
#pragma unroll
                for (int e = 0; e < 4; ++e) { const int j = 16 * nb + 4 * fq + e; pv[e] = (i >= j) ? sc[nb][e] * exp2f((float)(i - j) * l2g) : 0.f; }
                u32x2 w; w.x = cvt_pk_bf16(pv[0], pv[1]); w.y = cvt_pk_bf16(pv[2], pv[3]);
                *(LAS u32x2*)(lds + OK_ + i * TS + (16 * nb + 4 * fq) * 2) = w;
            }
            LDS_WAIT();
            f32x4 a1[8], a2[8];
#pragma unroll
            for (int nb = 0; nb < 8; ++nb) { a1[nb] = (f32x4){0.f, 0.f, 0.f, 0.f}; a2[nb] = (f32x4){0.f, 0.f, 0.f, 0.f}; }
            mma128<false, true>(a1, lds, lds_addr, OK_, OV, 16 * wave, lane);
            mma128<false, false>(a2, lds, lds_addr, OQ, OR, 16 * wave, lane);
            const float xi = exp2f((float)(i + 1) * l2g);
            float s1 = 0.f, s2 = 0.f;
#pragma unroll
            for (int nb = 0; nb < 8; ++nb)
#pragma unroll
                for (int e = 0; e < 4; ++e) { const float o = a1[nb][e] + xi * a2[nb][e]; a1[nb][e] = o; s1 += o; s2 += o * o; }
            s1 += __shfl_xor(s1, 16); s1 += __shfl_xor(s1, 32); s2 += __shfl_xor(s2, 16); s2 += __shfl_xor(s2, 32);
            const float mu = s1 * (1.0f / 128.0f), var = fmaxf(s2 * (1.0f / 128.0f) - mu * mu, 0.f), rs = 1.0f / sqrtf(var + EPS);
            const size_t tok = tok0 + i;
            u32x2 gwv[8]; f32x4 ggv[8];
#pragma unroll
            for (int nb = 0; nb < 8; ++nb) { gwv[nb] = ld_nt((const u32x2*)(GB + tok * 512 + h * 128 + 16 * nb + 4 * fq)); ggv[nb] = *(const f32x4*)(gn_gain + h * 128 + 16 * nb + 4 * fq); }
#pragma unroll
            for (int nb = 0; nb < 8; ++nb) {
                const int d = 16 * nb + 4 * fq;
                const u32x2 gw = gwv[nb];
                const f32x4 gg = ggv[nb];
                const float g0 = bf_lo(gw.x), g1 = bf_hi(gw.x), g2 = bf_lo(gw.y), g3 = bf_hi(gw.y);
                const float y0 = (a1[nb][0] - mu) * rs * gg[0] * (g0 / (1.0f + __expf(-g0)));
                const float y1 = (a1[nb][1] - mu) * rs * gg[1] * (g1 / (1.0f + __expf(-g1)));
                const float y2 = (a1[nb][2] - mu) * rs * gg[2] * (g2 / (1.0f + __expf(-g2)));
                const float y3 = (a1[nb][3] - mu) * rs * gg[3] * (g3 / (1.0f + __expf(-g3)));
                u32x2 w; w.x = cvt_pk_bf16(y0, y1); w.y = cvt_pk_bf16(y2, y3);
                *(u32x2*)(YMIX + tok * 1024 + h * 128 + d) = w;
            }
            __syncthreads();
        }
        }
    }
#undef R3_ISSUE_QK
#undef R3_ISSUE_VR
    SEAM(4);

    if (IN(5)) for (int rep = 0; rep < REPS(5); ++rep) {
        pg8::Gemm g{YSSM, WGLU, 512, 512, 512, 0, 0}; pg8::StaticOrder S; S.init(T, 1024, G, bx);
        pg8::EpiGlu E{YMIX};
        pg8::gemm_phase(lds, g, S, E);
    }
    SEAM(5);

    if (IN(6)) for (int rep = 0; rep < REPS(6); ++rep) {
        pg8::Gemm g{YMIX, WOUT, DM, DM, DM, 0, 0}; pg8::StaticOrder S; S.init(T, DM, G, bx);
        pg8::EpiSS E{MIXB, SS};
        pg8::gemm_phase(lds, g, S, E);
    }
    SEAM(6);

    if (IN(7)) for (int rep = 0; rep < REPS(7); ++rep) {
        const int gw = bx * 8 + wave, NGW = G * 8;
        const f32x4* gr = (const f32x4*)g_mix_post + lane;
        f32x4 gv[4];
#pragma unroll
        for (int j = 0; j < 4; ++j) gv[j] = gr[64 * j];
        for (int m0 = gw; m0 < T; m0 += 2 * NGW) {
            f32x4 xv[2][4]; u32x2 mw[2][4]; float rs[2];
#pragma unroll
            for (int r = 0; r < 2; ++r) {
                const int m = (m0 + r * NGW < T) ? m0 + r * NGW : m0;
                const f32x4 pa = *((const f32x4*)(SS + (size_t)m * 16) + (lane & 3));
                float sa = (pa[0] + pa[1]) + (pa[2] + pa[3]); sa += __shfl_xor(sa, 1); sa += __shfl_xor(sa, 2);
                rs[r] = 1.0f / sqrtf(sa * (1.0f / DM) + EPS);
                const u32x2* xr = (const u32x2*)(XN + (size_t)m * DM) + lane; const u32x2* mr = (const u32x2*)(MIXB + (size_t)m * DM) + lane;
                const float xs = XSC[m];
#pragma unroll
                for (int j = 0; j < 4; ++j) { const u32x2 xw = ld_nt(xr + 64 * j); xv[r][j] = (f32x4){bf_lo(xw.x) * xs, bf_hi(xw.x) * xs, bf_lo(xw.y) * xs, bf_hi(xw.y) * xs}; mw[r][j] = ld_nt(mr + 64 * j); }
            }
#pragma unroll
            for (int r = 0; r < 2; ++r) {
                const int m = m0 + r * NGW;
                if (m < T) {
                    float sq = 0.f;
#pragma unroll
                    for (int j = 0; j < 4; ++j) {
                        f32x4& v = xv[r][j];
                        v[0] += bf_lo(mw[r][j].x) * rs[r] * gv[j][0]; v[1] += bf_hi(mw[r][j].x) * rs[r] * gv[j][1];
                        v[2] += bf_lo(mw[r][j].y) * rs[r] * gv[j][2]; v[3] += bf_hi(mw[r][j].y) * rs[r] * gv[j][3];
                        sq += (v[0] * v[0] + v[1] * v[1]) + (v[2] * v[2] + v[3] * v[3]);
                    }
                    const float rstd1 = 1.0f / sqrtf(wave_sum(sq) * (1.0f / DM) + EPS);
                    u32x2* o8 = (u32x2*)(XN + (size_t)m * DM) + lane;
#pragma unroll
                    for (int j = 0; j < 4; ++j) { const f32x4 v = xv[r][j]; u32x2 w; w.x = cvt_pk_bf16(v[0] * rstd1, v[1] * rstd1); w.y = cvt_pk_bf16(v[2] * rstd1, v[3] * rstd1); o8[64 * j] = w; }
                }
            }
        }
    }
    SEAM(7);

    if (IN(8)) for (int rep = 0; rep < REPS(8); ++rep) {
        pg8::Gemm g{XN, WFF1, DM, DM, DM, 0, 0}; pg8::StaticOrder S; S.init(T, DFF, G, bx);
        pg8::EpiRelu2 E{HID};
        pg8::gemm_phase(lds, g, S, E);
    }
    SEAM(8);

    if (IN(9)) for (int rep = 0; rep < REPS(9); ++rep) {
        pg8::Gemm g{HID, WFF2, DFF, DFF, DFF, 0, 0}; pg8::StaticOrder S; S.init(T, DM, G, bx);
        pg8::EpiSS E{MB, SS2};
        pg8::gemm_phase(lds, g, S, E);
    }
    SEAM(9);

    if (IN(10)) {
        const int gw = bx * 8 + wave, NGW = G * 8;
        const f32x4* g1r = (const f32x4*)g_mix_post + lane; const f32x4* g2r = (const f32x4*)g_mlp_post + lane;
        f32x4 ga[4], gb[4];
#pragma unroll
        for (int j = 0; j < 4; ++j) { ga[j] = g1r[64 * j]; gb[j] = g2r[64 * j]; }
        for (int m0 = gw; m0 < T; m0 += 2 * NGW) {
            f32x4 xv[2][4]; u32x2 aw[2][4], mw[2][4]; float r1[2], r2[2];
#pragma unroll
            for (int r = 0; r < 2; ++r) {
                const int m = (m0 + r * NGW < T) ? m0 + r * NGW : m0;
                const f32x4 pa = *((const f32x4*)(SS + (size_t)m * 16) + (lane & 3)), pb = *((const f32x4*)(SS2 + (size_t)m * 16) + (lane & 3));
                float sa = (pa[0] + pa[1]) + (pa[2] + pa[3]), sb = (pb[0] + pb[1]) + (pb[2] + pb[3]);
                sa += __shfl_xor(sa, 1); sa += __shfl_xor(sa, 2); sb += __shfl_xor(sb, 1); sb += __shfl_xor(sb, 2);
                r1[r] = 1.0f / sqrtf(sa * (1.0f / DM) + EPS); r2[r] = 1.0f / sqrtf(sb * (1.0f / DM) + EPS);
                const f32x4* xr = (const f32x4*)(x + (size_t)m * DM) + lane;
                const u32x2* ar = (const u32x2*)(MIXB + (size_t)m * DM) + lane; const u32x2* mr = (const u32x2*)(MB + (size_t)m * DM) + lane;
#pragma unroll
                for (int j = 0; j < 4; ++j) { xv[r][j] = ld_nt(xr + 64 * j); aw[r][j] = ld_nt(ar + 64 * j); mw[r][j] = ld_nt(mr + 64 * j); }
            }
#pragma unroll
            for (int r = 0; r < 2; ++r) {
                const int m = m0 + r * NGW;
                if (m < T) {
                    f32x4* orow = (f32x4*)(out + (size_t)m * DM) + lane;
#pragma unroll
                    for (int j = 0; j < 4; ++j) {
                        f32x4 v = xv[r][j];
                        v[0] = (v[0] + bf_lo(aw[r][j].x) * r1[r] * ga[j][0]) + bf_lo(mw[r][j].x) * r2[r] * gb[j][0]; v[1] = (v[1] + bf_hi(aw[r][j].x) * r1[r] * ga[j][1]) + bf_hi(mw[r][j].x) * r2[r] * gb[j][1];
                        v[2] = (v[2] + bf_lo(aw[r][j].y) * r1[r] * ga[j][2]) + bf_lo(mw[r][j].y) * r2[r] * gb[j][2]; v[3] = (v[3] + bf_hi(aw[r][j].y) * r1[r] * ga[j][3]) + bf_hi(mw[r][j].y) * r2[r] * gb[j][3];
                        st_nt(orow + 64 * j, v);
                    }
                }
            }
        }
    }
#undef IN
#undef SEAM
}

extern "C" void kernel_launch(void* const* d_in, const int* in_sizes, int n_in, void* d_out, int out_size, void* d_ws, size_t ws_size, hipStream_t stream) {
    static int grid = 0;
    if (grid == 0) {
        int dev = 0, cus = 0, per_cu = 0;
        hipGetDevice(&dev);
        hipDeviceGetAttribute(&cus, hipDeviceAttributeMultiprocessorCount, dev);
        hipFuncSetAttribute((const void*)fwd_kernel, hipFuncAttributeMaxDynamicSharedMemorySize, LDS_BYTES);
        if (hipOccupancyMaxActiveBlocksPerMultiprocessor(&per_cu, (const void*)fwd_kernel, 512, LDS_BYTES) != hipSuccess || per_cu < 1) per_cu = 1;
        (void)hipGetLastError();
        grid = cus * per_cu;
        if (grid <= 0) grid = 256;
    }
    Args a{};
    for (int i = 0; i < 19; ++i) a.in[i] = (const float*)d_in[i];
    a.out = (float*)d_out; a.ws = (unsigned char*)d_ws;
#if N_LAUNCH_PER_PHASE
    for (int ph = 0; ph < NPHASE; ++ph) {
        a.ph_lo = ph; a.ph_hi = ph + 1;
        void* args[] = {&a};
        hipError_t e = hipLaunchCooperativeKernel((const void*)fwd_kernel, dim3(grid), dim3(512), args, LDS_BYTES, stream);
        if (e != hipSuccess) { fprintf(stderr, "cooperative launch (phase %d) failed: %s (grid %d)\n", ph, hipGetErrorString(e), grid); break; }
    }
#else
    a.ph_lo = 0; a.ph_hi = NPHASE;
    (void)hipMemsetAsync(d_ws, 0, 16384, stream);
    void* args[] = {&a};
    hipError_t e = hipLaunchCooperativeKernel((const void*)fwd_kernel, dim3(grid), dim3(512), args, LDS_BYTES, stream);
    if (e != hipSuccess) fprintf(stderr, "cooperative launch failed: %s (grid %d)\n", hipGetErrorString(e), grid);
#ifdef PROBE_EXTRA_PHASE
    {
        Args b = a; b.ph_lo = PROBE_EXTRA_PHASE; b.ph_hi = PROBE_EXTRA_PHASE + 1;
        void* args2[] = {&b};
        (void)hipLaunchCooperativeKernel((const void*)fwd_kernel, dim3(grid), dim3(512), args2, LDS_BYTES, stream);
    }
#endif
#endif
}
```

```cpp
#include <hip/hip_runtime.h>
#include <hip/hip_cooperative_groups.h>
#include <cstdio>
namespace cg = cooperative_groups;

#ifndef N_LAUNCH_PER_PHASE
#define N_LAUNCH_PER_PHASE 0
#endif

#ifndef PROBE_P4_DUP
#define PROBE_P4_DUP 0
#endif
#ifndef PROBE_P4_PART
#define PROBE_P4_PART 0
#endif
#ifndef PROBE_DUP
#define PROBE_DUP 0
#endif
#define REPS(k) (1 + ((PROBE_DUP >> (k)) & 1))
#define LAS __attribute__((address_space(3)))
typedef unsigned short bf16_t;
typedef short bf16x8 __attribute__((ext_vector_type(8)));
typedef float f32x4 __attribute__((ext_vector_type(4)));
typedef float f32x2 __attribute__((ext_vector_type(2)));
typedef unsigned u32x4 __attribute__((ext_vector_type(4)));
typedef unsigned u32x2 __attribute__((ext_vector_type(2)));

constexpr int T = 32768, SEQ = 8192, DM = 1024, NIN = 2560, DFF = 4096;
constexpr float EPS = 1e-6f;
constexpr int NPHASE = 11;

constexpr size_t MiB = 1u << 20;
constexpr size_t WS_WIN = 1 * MiB, WS_WGLU = 6 * MiB, WS_WOUT = 7 * MiB, WS_WFF1 = 9 * MiB, WS_WFF2 = 17 * MiB;
constexpr size_t WS_ROPE = 25 * MiB, WS_TW = 29 * MiB, WS_W1S = 49 * MiB, WS_SS = 53 * MiB, WS_SS2 = 55 * MiB, WS_HINC = 57 * MiB;
constexpr size_t WS_XN = 80 * MiB;
constexpr size_t WS_QB = 144 * MiB, WS_KB = 176 * MiB, WS_VB = 208 * MiB, WS_GB = 240 * MiB, WS_AU = 272 * MiB;
constexpr size_t WS_SST = 440 * MiB, WS_RTB = 376 * MiB, WS_YSSM = 408 * MiB;
constexpr size_t WS_YMIX = 312 * MiB;
constexpr size_t WS_HID = 144 * MiB;
constexpr size_t WS_MIXB = 400 * MiB;
constexpr size_t WS_MB = 80 * MiB;

constexpr int LDS_BYTES = 147456;
constexpr int TS = 272;
constexpr int TILE_B = 128 * TS;

typedef __bf16 bf16x2_t __attribute__((ext_vector_type(2)));
__device__ __forceinline__ unsigned cvt_pk_bf16(float lo, float hi) { f32x2 v = {lo, hi}; return __builtin_bit_cast(unsigned, __builtin_convertvector(v, bf16x2_t)); }
__device__ __forceinline__ float bf_lo(unsigned w) { return __uint_as_float(w << 16); }
__device__ __forceinline__ float bf_hi(unsigned w) { return __uint_as_float(w & 0xffff0000u); }
__device__ __forceinline__ bf16_t f2bf(float f) { return (bf16_t)(cvt_pk_bf16(f, 0.f) & 0xffffu); }
__device__ __forceinline__ float wave_sum(float v) {
#pragma unroll
    for (int o = 1; o < 64; o <<= 1) v += __shfl_xor(v, o);
    return v;
}
#define LDS_WAIT() asm volatile("s_waitcnt lgkmcnt(0)" ::: "memory")
template <class Tv> __device__ __forceinline__ Tv ld_nt(const Tv* p) { return __builtin_nontemporal_load(p); }
__device__ __forceinline__ void st_nt(f32x4* p, f32x4 v) { __builtin_nontemporal_store(v, p); }

namespace pg8 {
constexpr int BM = 256, BK = 64, HALF = 128, HTB = HALF * BK * 2, STAGE_BYTES = 8 * HTB, NXCD = 8, WGM = 8;
__device__ __forceinline__ int lds_byte(int r, int c) { const int st = (r >> 4) * 2 + (c >> 5), rr = r & 15, cc = c & 31, ob = rr * 64 + cc * 2; return st * 1024 + (ob ^ (((ob >> 9) & 1) << 5)); }
__device__ __forceinline__ void stage_rc(int b, int& R, int& C) { const int st = b / 1024, sb = b % 1024, swz = sb ^ (((sb >> 9) & 1) << 5); R = (st >> 1) * 16 + swz / 64; C = (st & 1) * 32 + (swz % 64) / 2; }
__device__ __forceinline__ int perm32(int rho) { const int n = rho >> 4, i = rho & 15; return 8 * (i >> 2) + 4 * n + (i & 3); }

struct Unit { int pm, pn, pb; };
struct Gemm { const bf16_t* A; const bf16_t* Bt; int lda, ldb, K; size_t bsA, bsB; };

struct StaticOrder {
    int nM, nN, nwg, G, c;
    __device__ void init(int M, int N, int G_, int c_) { nM = M / BM; nN = N / BM; nwg = nM * nN; G = G_; c = c_; }
    __device__ bool next(int i, Unit& u) const {
        const long L = (long)i * G + c; if (L >= nwg) return false;
        int wgid = (int)L; { const int q = nwg / NXCD, r = nwg % NXCD, xcd = wgid % NXCD, off = wgid / NXCD; wgid = (xcd < r ? xcd * (q + 1) : r * (q + 1) + (xcd - r) * q) + off; }
        const int nig = WGM * nN, gid = wgid / nig, fm = gid * WGM, gsz = (nM - fm) < WGM ? (nM - fm) : WGM;
        u.pm = fm + ((wgid % nig) % gsz); u.pn = (wgid % nig) / gsz; u.pb = 0; return true;
    }
};
struct BatchOrder {
    int G, c;
    __device__ bool next(int i, Unit& u) const {
        const int L = i * G + c; if (L >= 256) return false;
        const int xcd = L & 7, slot = L >> 3;
        u.pb = xcd * 4 + (slot >> 3); const int r = slot & 7; u.pm = r & 3; u.pn = r >> 2; return true;
    }
};

template <class Epi, class Sched>
__device__ __forceinline__ void gemm_phase(LAS unsigned char* lds, const Gemm g, const Sched& S, const Epi& E) {
    const int tid = threadIdx.x, wid = __builtin_amdgcn_readfirstlane(tid >> 6), lane = tid & 63, wr = wid >> 2, wc = wid & 3, fr = lane & 15, fq = lane >> 4;
    const int K = g.K, nt = K / BK;
    unsigned voffA[2], voffB[2];
#pragma unroll
    for (int i = 0; i < 2; ++i) { int R, C; stage_rc(tid * 16 + i * 8192, R, C); const int Rb = Epi::PERM ? ((R & ~31) + perm32(R & 31)) : R;
        voffA[i] = (unsigned)(R * g.lda + C) * 2u; voffB[i] = (unsigned)(Rb * g.ldb + C) * 2u; }
    const size_t kstep = (size_t)(BK * 2);
    const size_t hstepA = (size_t)HALF * g.lda * 2, hstepB = (size_t)HALF * g.ldb * 2;
    const size_t tstepA = 2 * hstepA, tstepB = 2 * hstepB;
    const unsigned ldsw = (unsigned)wid * 1024u;
    const int aoff = lds_byte(wr * 64 + fr, fq * 8), boff = lds_byte(wc * 32 + fr, fq * 8);
#define PG8_SA(b, h) (((b) * 2 + (h)) * HTB)
#define PG8_SB(b, h) ((4 + (b) * 2 + (h)) * HTB)
#define PG8_STAGE(bufoff, gbase, voff) do { _Pragma("unroll") for (int _i = 0; _i < 2; ++_i) \
        __builtin_amdgcn_global_load_lds((const unsigned*)((const char*)(gbase) + (voff)[_i]), (LAS unsigned*)(lds + (bufoff) + ldsw + _i * 8192), 16, 0, 0); } while (0)
#define PG8_LDA(dst, b, h) do { _Pragma("unroll") for (int m = 0; m < 4; ++m) _Pragma("unroll") for (int k = 0; k < 2; ++k) dst[m][k] = *(const LAS bf16x8*)(lds + PG8_SA(b, h) + aoff + m * 2048 + k * 1024); } while (0)
#define PG8_LDB(dst, b, h) do { _Pragma("unroll") for (int n = 0; n < 2; ++n) _Pragma("unroll") for (int k = 0; k < 2; ++k) dst[n][k] = *(const LAS bf16x8*)(lds + PG8_SB(b, h) + boff + n * 2048 + k * 1024); } while (0)
#define PG8_MMA(ai, bj, At, Bt) do { __builtin_amdgcn_s_setprio(1); _Pragma("unroll") for (int m = 0; m < 4; ++m) _Pragma("unroll") for (int n = 0; n < 2; ++n) _Pragma("unroll") for (int k = 0; k < 2; ++k) \
        acc[ai][bj][m][n] = __builtin_amdgcn_mfma_f32_16x16x32_bf16(Bt[n][k], At[m][k], acc[ai][bj][m][n], 0, 0, 0); __builtin_amdgcn_s_setprio(0); } while (0)
#define PG8_WAIT_V(n) asm volatile("s_waitcnt vmcnt(" #n ")" ::: "memory")
#define PG8_WAIT_L(n) asm volatile("s_waitcnt lgkmcnt(" #n ")" ::: "memory")
#define PG8_BAR __builtin_amdgcn_s_barrier()
#define PG8_SCHED __builtin_amdgcn_sched_barrier(0)
    Unit cur, nxt; int ui = 0;
    if (!S.next(0, cur)) return;
    f32x4 acc[2][2][4][2];
#pragma unroll
    for (int a = 0; a < 2; ++a)
#pragma unroll
        for (int b = 0; b < 2; ++b)
#pragma unroll
            for (int m = 0; m < 4; ++m)
#pragma unroll
                for (int n = 0; n < 2; ++n) acc[a][b][m][n] = (f32x4){0.f, 0.f, 0.f, 0.f};
    bf16x8 At[4][2], B0[2][2], B1[2][2];
    const char* cA = (const char*)g.A + (size_t)cur.pb * g.bsA * 2 + (size_t)cur.pm * tstepA;
    const char* cB = (const char*)g.Bt + (size_t)cur.pb * g.bsB * 2 + (size_t)cur.pn * tstepB;
    PG8_STAGE(PG8_SB(0, 0), cB, voffB); PG8_STAGE(PG8_SA(0, 0), cA, voffA); PG8_STAGE(PG8_SB(0, 1), cB + hstepB, voffB); PG8_STAGE(PG8_SA(0, 1), cA + hstepA, voffA);
    if (wr == 1) PG8_BAR;
    PG8_WAIT_V(4); PG8_BAR;
    PG8_STAGE(PG8_SB(1, 0), cB + kstep, voffB); PG8_STAGE(PG8_SA(1, 0), cA + kstep, voffA); PG8_STAGE(PG8_SB(1, 1), cB + hstepB + kstep, voffB);
    PG8_WAIT_V(6); PG8_BAR;
    for (;;) {
        const bool has_next = S.next(ui + 1, nxt);
        const char* nA = has_next ? (const char*)g.A + (size_t)nxt.pb * g.bsA * 2 + (size_t)nxt.pm * tstepA : cA;
        const char* nB = has_next ? (const char*)g.Bt + (size_t)nxt.pb * g.bsB * 2 + (size_t)nxt.pn * tstepB : cB;
        for (int t = 0; t < nt; t += 2) {
            const bool last = (t == nt - 2);
            const char* a1 = cA + (size_t)(t + 1) * kstep;
            const char* a2 = last ? nA : cA + (size_t)(t + 2) * kstep; const char* b2 = last ? nB : cB + (size_t)(t + 2) * kstep;
            const char* a3 = a2 + kstep; const char* b3 = b2 + kstep;
            PG8_LDB(B0, 0, 0); PG8_SCHED; PG8_LDA(At, 0, 0); PG8_STAGE(PG8_SA(1, 1), a1 + hstepA, voffA);
            PG8_WAIT_L(8); PG8_BAR; PG8_WAIT_L(0); PG8_MMA(0, 0, At, B0); PG8_BAR; PG8_SCHED;
            PG8_LDB(B1, 0, 1); PG8_STAGE(PG8_SB(0, 0), b2, voffB);
            PG8_BAR; PG8_WAIT_L(0); PG8_MMA(0, 1, At, B1); PG8_BAR;
            PG8_LDA(At, 0, 1); PG8_STAGE(PG8_SA(0, 0), a2, voffA);
            PG8_BAR; PG8_WAIT_L(0); PG8_MMA(1, 0, At, B0); PG8_BAR; PG8_SCHED;
            PG8_STAGE(PG8_SB(0, 1), b2 + hstepB, voffB);
            PG8_WAIT_V(6); PG8_BAR; PG8_MMA(1, 1, At, B1); PG8_BAR;
            PG8_LDB(B0, 1, 0); PG8_SCHED; PG8_LDA(At, 1, 0); PG8_STAGE(PG8_SA(0, 1), a2 + hstepA, voffA);
            PG8_WAIT_L(8); PG8_BAR; PG8_WAIT_L(0); PG8_MMA(0, 0, At, B0); PG8_BAR; PG8_SCHED;
            PG8_LDB(B1, 1, 1); PG8_STAGE(PG8_SB(1, 0), b3, voffB);
            PG8_BAR; PG8_WAIT_L(0); PG8_MMA(0, 1, At, B1); PG8_BAR;
            PG8_LDA(At, 1, 1); PG8_STAGE(PG8_SA(1, 0), a3, voffA);
            PG8_BAR; PG8_WAIT_L(0); PG8_MMA(1, 0, At, B0); PG8_BAR; PG8_SCHED;
            PG8_STAGE(PG8_SB(1, 1), b3 + hstepB, voffB);
            PG8_WAIT_V(6); PG8_BAR; PG8_MMA(1, 1, At, B1); PG8_BAR;
        }
        E(acc, cur, wr, wc, fr, fq);
        if (!has_next) break;
#pragma unroll
        for (int a = 0; a < 2; ++a)
#pragma unroll
            for (int b = 0; b < 2; ++b)
#pragma unroll
                for (int m = 0; m < 4; ++m)
#pragma unroll
                    for (int n = 0; n < 2; ++n) acc[a][b][m][n] = (f32x4){0.f, 0.f, 0.f, 0.f};
        cur = nxt; cA = nA; cB = nB; ++ui;
    }
    PG8_WAIT_V(0);
    if (wr == 0) PG8_BAR;
    PG8_BAR;
#undef PG8_SA
#undef PG8_SB
#undef PG8_STAGE
#undef PG8_LDA
#undef PG8_LDB
#undef PG8_MMA
#undef PG8_WAIT_V
#undef PG8_WAIT_L
#undef PG8_BAR
#undef PG8_SCHED
}

__device__ __forceinline__ u32x4 pack8(const f32x4 v0, const f32x4 v1) {
    u32x4 w; w.x = cvt_pk_bf16(v0[0], v0[1]); w.y = cvt_pk_bf16(v0[2], v0[3]); w.z = cvt_pk_bf16(v1[0], v1[1]); w.w = cvt_pk_bf16(v1[2], v1[3]); return w;
}
__device__ __forceinline__ f32x4 rope4(const f32x4 v, const f32x4 cs) {
    f32x4 r; r[0] = v[0] * cs[0] - v[1] * cs[1]; r[1] = v[0] * cs[1] + v[1] * cs[0]; r[2] = v[2] * cs[2] - v[3] * cs[3]; r[3] = v[2] * cs[3] + v[3] * cs[2]; return r;
}
struct EpiInProj {
    static constexpr bool PERM = true;
    bf16_t *Q, *Kb, *V, *Gt, *AU; const float* rope;
    __device__ __forceinline__ void operator()(const f32x4 (&acc)[2][2][4][2], const Unit& u, int wr, int wc, int fr, int fq) const {
        const int sect = u.pn >> 1;
        const int row0 = u.pm * BM + wr * 64 + fr;
        const int colt = (u.pn & 1) * 256 + wc * 32 + 8 * fq;
        if (sect <= 1) {
            bf16_t* O = sect ? Kb : Q;
            f32x4 cs[2][4][2];
#pragma unroll
            for (int ai = 0; ai < 2; ++ai)
#pragma unroll
                for (int m = 0; m < 4; ++m) {
                    const int pos = (row0 + ai * HALF + m * 16) & (SEQ - 1);
                    const float* rp = rope + ((size_t)pos * 64 + 16 * wc + 4 * fq) * 2;
                    cs[ai][m][0] = *(const f32x4*)rp; cs[ai][m][1] = *(const f32x4*)(rp + 4);
                }
#pragma unroll
            for (int ai = 0; ai < 2; ++ai)
#pragma unroll
                for (int m = 0; m < 4; ++m) {
                    const int row = row0 + ai * HALF + m * 16;
#pragma unroll
                    for (int bj = 0; bj < 2; ++bj) {
                        const f32x4 v0 = rope4(acc[ai][bj][m][0], cs[ai][m][0]), v1 = rope4(acc[ai][bj][m][1], cs[ai][m][1]);
                        *(u32x4*)(O + (size_t)row * 512 + colt + bj * HALF) = pack8(v0, v1);
                    }
                }
        } else if (sect <= 3) {
            bf16_t* O = (sect == 2) ? V : Gt;
#pragma unroll
            for (int ai = 0; ai < 2; ++ai)
#pragma unroll
                for (int m = 0; m < 4; ++m) {
                    const int row = row0 + ai * HALF + m * 16;
#pragma unroll
                    for (int bj = 0; bj < 2; ++bj) *(u32x4*)(O + (size_t)row * 512 + colt + bj * HALF) = pack8(acc[ai][bj][m][0], acc[ai][bj][m][1]);
                }
        } else {
#pragma unroll
            for (int ai = 0; ai < 2; ++ai)
#pragma unroll
                for (int m = 0; m < 4; ++m) {
                    const int row = row0 + ai * HALF + m * 16, cr = row >> 5, s = row & 31;
#pragma unroll
                    for (int bj = 0; bj < 2; ++bj) {
                        const int cu = colt + bj * HALF, g = cu >> 4, c0 = cu & 15;
                        *(u32x4*)(AU + ((size_t)(g * 1024 + cr) * 640 + s * 16 + c0)) = pack8(acc[ai][bj][m][0], acc[ai][bj][m][1]);
                    }
                }
        }
    }
};
struct EpiGlu {
    static constexpr bool PERM = true;
    bf16_t* Y;
    __device__ __forceinline__ void operator()(const f32x4 (&acc)[2][2][4][2], const Unit& u, int wr, int wc, int fr, int fq) const {
        const int row0 = u.pm * BM + wr * 64 + fr, col = 512 + u.pn * 128 + wc * 32 + 8 * fq;
#pragma unroll
        for (int ai = 0; ai < 2; ++ai)
#pragma unroll
            for (int m = 0; m < 4; ++m) {
                const int row = row0 + ai * HALF + m * 16;
                f32x4 y0, y1;
#pragma unroll
                for (int j = 0; j < 4; ++j) {
                    y0[j] = acc[ai][0][m][0][j] / (1.0f + __expf(-acc[ai][1][m][0][j]));
                    y1[j] = acc[ai][0][m][1][j] / (1.0f + __expf(-acc[ai][1][m][1][j]));
                }
                *(u32x4*)(Y + (size_t)row * 1024 + col) = pack8(y0, y1);
            }
    }
};
struct EpiSS {
    static constexpr bool PERM = true;
    bf16_t* O; float* SS;
    __device__ __forceinline__ void operator()(const f32x4 (&acc)[2][2][4][2], const Unit& u, int wr, int wc, int fr, int fq) const {
        const int row0 = u.pm * BM + wr * 64 + fr, col = u.pn * BM + wc * 32 + 8 * fq;
#pragma unroll
        for (int ai = 0; ai < 2; ++ai)
#pragma unroll
            for (int m = 0; m < 4; ++m) {
                const int row = row0 + ai * HALF + m * 16; float q = 0.f;
#pragma unroll
                for (int bj = 0; bj < 2; ++bj) {
                    const f32x4 v0 = acc[ai][bj][m][0], v1 = acc[ai][bj][m][1];
                    q += (v0[0] * v0[0] + v0[1] * v0[1]) + (v0[2] * v0[2] + v0[3] * v0[3]) + (v1[0] * v1[0] + v1[1] * v1[1]) + (v1[2] * v1[2] + v1[3] * v1[3]);
                    *(u32x4*)(O + (size_t)row * 1024 + col + bj * HALF) = pack8(v0, v1);
                }
                q += __shfl_xor(q, 16); q += __shfl_xor(q, 32);
                if (fq == 0) SS[(size_t)row * 16 + u.pn * 4 + wc] = q;
            }
    }
};
struct EpiRelu2 {
    static constexpr bool PERM = true;
    bf16_t* O;
    __device__ __forceinline__ void operator()(const f32x4 (&acc)[2][2][4][2], const Unit& u, int wr, int wc, int fr, int fq) const {
        const int row0 = u.pm * BM + wr * 64 + fr, col = u.pn * BM + wc * 32 + 8 * fq;
#pragma unroll
        for (int ai = 0; ai < 2; ++ai)
#pragma unroll
            for (int m = 0; m < 4; ++m) {
                const int row = row0 + ai * HALF + m * 16;
#pragma unroll
                for (int bj = 0; bj < 2; ++bj) {
                    f32x4 v0 = acc[ai][bj][m][0], v1 = acc[ai][bj][m][1];
#pragma unroll
                    for (int j = 0; j < 4; ++j) { const float a = fmaxf(v0[j], 0.f), b = fmaxf(v1[j], 0.f); v0[j] = a * a; v1[j] = b * b; }
                    *(u32x4*)(O + (size_t)row * DFF + col + bj * HALF) = pack8(v0, v1);
                }
            }
    }
};
struct EpiSsm {
    static constexpr bool PERM = true;
    const bf16_t* AU; const float* dskip; bf16_t* Y;
    __device__ __forceinline__ void operator()(const f32x4 (&acc)[2][2][4][2], const Unit& u, int wr, int wc, int fr, int fq) const {
        const int g = u.pb;
        const int row0 = u.pm * BM + wr * 64 + fr, colt = u.pn * BM + wc * 32 + 8 * fq;
        const int c0 = 8 * (fq & 1);
        const f32x4 d0 = *(const f32x4*)(dskip + g * 16 + c0), d1 = *(const f32x4*)(dskip + g * 16 + c0 + 4);
        u32x4 uwv[2][4][2];
#pragma unroll
        for (int ai = 0; ai < 2; ++ai)
#pragma unroll
            for (int m = 0; m < 4; ++m)
#pragma unroll
                for (int bj = 0; bj < 2; ++bj) uwv[ai][m][bj] = *(const u32x4*)(AU + ((size_t)(g * 1024 + row0 + ai * HALF + m * 16) * 640 + colt + bj * HALF));
#pragma unroll
        for (int ai = 0; ai < 2; ++ai)
#pragma unroll
            for (int m = 0; m < 4; ++m) {
                const int cr = row0 + ai * HALF + m * 16;
#pragma unroll
                for (int bj = 0; bj < 2; ++bj) {
                    const int col = colt + bj * HALF, s = col >> 4;
                    const u32x4 uw = uwv[ai][m][bj];
                    f32x4 v0 = acc[ai][bj][m][0], v1 = acc[ai][bj][m][1];
                    v0[0] += d0[0] * bf_lo(uw.x); v0[1] += d0[1] * bf_hi(uw.x); v0[2] += d0[2] * bf_lo(uw.y); v0[3] += d0[3] * bf_hi(uw.y);
                    v1[0] += d1[0] * bf_lo(uw.z); v1[1] += d1[1] * bf_hi(uw.z); v1[2] += d1[2] * bf_lo(uw.w); v1[3] += d1[3] * bf_hi(uw.w);
#pragma unroll
                    for (int j = 0; j < 4; ++j) {
                        const float a = v0[j], za = 1.5957691216f * (a + 0.044715f * a * a * a); v0[j] = a / (1.0f + __expf(-za));
                        const float b = v1[j], zb = 1.5957691216f * (b + 0.044715f * b * b * b); v1[j] = b / (1.0f + __expf(-zb));
                    }
                    const size_t tok = (size_t)cr * 32 + s;
                    *(u32x4*)(Y + tok * 512 + g * 16 + c0) = pack8(v0, v1);
                }
            }
    }
};
}

__device__ __forceinline__ bf16x8 frag_nat(const LAS unsigned char* tile, int idx0, int k0, int fr, int fq) {
    return *(const LAS bf16x8*)(tile + (idx0 + fr) * TS + (k0 + 8 * fq) * 2);
}
__device__ __forceinline__ bf16x8 frag_tr(unsigned tile_addr, int k0, int idx0, int lane) {
    const int g = lane >> 4, q = (lane & 15) >> 2, p = lane & 3;
    const unsigned addr = tile_addr + (unsigned)((k0 + 8 * g + q) * TS + (idx0 + 4 * p) * 2);
    u32x2 lo, hi;
    asm volatile("ds_read_b64_tr_b16 %0, %2\n\tds_read_b64_tr_b16 %1, %2 offset:1088\n\ts_waitcnt lgkmcnt(0)" : "=&v"(lo), "=&v"(hi) : "v"(addr) : "memory");
    u32x4 r; r.x = lo.x; r.y = lo.y; r.z = hi.x; r.w = hi.y;
    return __builtin_bit_cast(bf16x8, r);
}
__device__ __forceinline__ void frags_tr8(bf16x8 (&b)[8], unsigned tile_addr, int k0, int lane) {
    const int g = lane >> 4, q = (lane & 15) >> 2, p = lane & 3;
    const unsigned addr = tile_addr + (unsigned)((k0 + 8 * g + q) * TS + (4 * p) * 2);
    u32x2 r0, r1, r2, r3, r4, r5, r6, r7, r8, r9, r10, r11, r12, r13, r14, r15;
    asm volatile(
        "ds_read_b64_tr_b16 %0, %16\n\t"
        "ds_read_b64_tr_b16 %1, %16 offset:1088\n\t"
        "ds_read_b64_tr_b16 %2, %16 offset:32\n\t"
        "ds_read_b64_tr_b16 %3, %16 offset:1120\n\t"
        "ds_read_b64_tr_b16 %4, %16 offset:64\n\t"
        "ds_read_b64_tr_b16 %5, %16 offset:1152\n\t"
        "ds_read_b64_tr_b16 %6, %16 offset:96\n\t"
        "ds_read_b64_tr_b16 %7, %16 offset:1184\n\t"
        "ds_read_b64_tr_b16 %8, %16 offset:128\n\t"
        "ds_read_b64_tr_b16 %9, %16 offset:1216\n\t"
        "ds_read_b64_tr_b16 %10, %16 offset:160\n\t"
        "ds_read_b64_tr_b16 %11, %16 offset:1248\n\t"
        "ds_read_b64_tr_b16 %12, %16 offset:192\n\t"
        "ds_read_b64_tr_b16 %13, %16 offset:1280\n\t"
        "ds_read_b64_tr_b16 %14, %16 offset:224\n\t"
        "ds_read_b64_tr_b16 %15, %16 offset:1312\n\t"
        "s_waitcnt lgkmcnt(0)"
        : "=&v"(r0), "=&v"(r1), "=&v"(r2), "=&v"(r3), "=&v"(r4), "=&v"(r5), "=&v"(r6), "=&v"(r7),
          "=&v"(r8), "=&v"(r9), "=&v"(r10), "=&v"(r11), "=&v"(r12), "=&v"(r13), "=&v"(r14), "=&v"(r15)
        : "v"(addr) : "memory");
    u32x4 w;
    w.x = r0.x; w.y = r0.y; w.z = r1.x; w.w = r1.y; b[0] = __builtin_bit_cast(bf16x8, w);
    w.x = r2.x; w.y = r2.y; w.z = r3.x; w.w = r3.y; b[1] = __builtin_bit_cast(bf16x8, w);
    w.x = r4.x; w.y = r4.y; w.z = r5.x; w.w = r5.y; b[2] = __builtin_bit_cast(bf16x8, w);
    w.x = r6.x; w.y = r6.y; w.z = r7.x; w.w = r7.y; b[3] = __builtin_bit_cast(bf16x8, w);
    w.x = r8.x; w.y = r8.y; w.z = r9.x; w.w = r9.y; b[4] = __builtin_bit_cast(bf16x8, w);
    w.x = r10.x; w.y = r10.y; w.z = r11.x; w.w = r11.y; b[5] = __builtin_bit_cast(bf16x8, w);
    w.x = r12.x; w.y = r12.y; w.z = r13.x; w.w = r13.y; b[6] = __builtin_bit_cast(bf16x8, w);
    w.x = r14.x; w.y = r14.y; w.z = r15.x; w.w = r15.y; b[7] = __builtin_bit_cast(bf16x8, w);
}
template <bool ATR, bool BTR>
__device__ __forceinline__ void mma128(f32x4 (&acc)[8], const LAS unsigned char* lds, unsigned lds_addr, int offA, int offB, int m0, int lane) {
    const int fr = lane & 15, fq = lane >> 4;
#pragma unroll
    for (int ks = 0; ks < 4; ++ks) {
        bf16x8 af, bfr[8];
        if (ATR) af = frag_tr(lds_addr + offA, 32 * ks, m0, lane); else af = frag_nat(lds + offA, m0, 32 * ks, fr, fq);
        if (BTR) frags_tr8(bfr, lds_addr + offB, 32 * ks, lane);
        else {
#pragma unroll
            for (int n = 0; n < 8; ++n) bfr[n] = frag_nat(lds + offB, 16 * n, 32 * ks, fr, fq);
        }
#pragma unroll
        for (int n = 0; n < 8; ++n) acc[n] = __builtin_amdgcn_mfma_f32_16x16x32_bf16(bfr[n], af, acc[n], 0, 0, 0);
    }
}
__device__ __forceinline__ void tile_load(LAS unsigned char* dst, const bf16_t* src, int ld, int tid) {
    u32x4 v[4];
#pragma unroll
    for (int i = 0; i < 4; ++i) { const int q = tid + 512 * i, row = q >> 4, pc = q & 15; v[i] = *(const u32x4*)(src + (size_t)row * ld + pc * 8); }
#pragma unroll
    for (int i = 0; i < 4; ++i) { const int q = tid + 512 * i, row = q >> 4, pc = q & 15; *(LAS u32x4*)(dst + row * TS + pc * 16) = v[i]; }
}
__device__ __forceinline__ void tile_load_zeta(LAS unsigned char* dst, const bf16_t* src, int ld, int tid, float l2g) {
    u32x4 v[4];
#pragma unroll
    for (int i = 0; i < 4; ++i) { const int q = tid + 512 * i, row = q >> 4, pc = q & 15; v[i] = *(const u32x4*)(src + (size_t)row * ld + pc * 8); }
#pragma unroll
    for (int i = 0; i < 4; ++i) {
        const int q = tid + 512 * i, row = q >> 4, pc = q & 15; const float z = exp2f((float)(127 - row) * l2g);
        u32x4 w;
        w.x = cvt_pk_bf16(bf_lo(v[i].x) * z, bf_hi(v[i].x) * z); w.y = cvt_pk_bf16(bf_lo(v[i].y) * z, bf_hi(v[i].y) * z);
        w.z = cvt_pk_bf16(bf_lo(v[i].z) * z, bf_hi(v[i].z) * z); w.w = cvt_pk_bf16(bf_lo(v[i].w) * z, bf_hi(v[i].w) * z);
        *(LAS u32x4*)(dst + row * TS + pc * 16) = w;
    }
}
__device__ __forceinline__ void tile_issue(u32x4 (&v)[4], const bf16_t* src, int ld, int tid) {
#pragma unroll
    for (int i = 0; i < 4; ++i) { const int q = tid + 512 * i, row = q >> 4, pc = q & 15; v[i] = *(const u32x4*)(src + (size_t)row * ld + pc * 8); }
}
__device__ __forceinline__ void tile_issue_nt(u32x4 (&v)[4], const bf16_t* src, int ld, int tid) {
#pragma unroll
    for (int i = 0; i < 4; ++i) { const int q = tid + 512 * i, row = q >> 4, pc = q & 15; v[i] = ld_nt((const u32x4*)(src + (size_t)row * ld + pc * 8)); }
}
__device__ __forceinline__ void tile_commit(LAS unsigned char* dst, const u32x4 (&v)[4], int tid) {
#pragma unroll
    for (int i = 0; i < 4; ++i) { const int q = tid + 512 * i, row = q >> 4, pc = q & 15; *(LAS u32x4*)(dst + row * TS + pc * 16) = v[i]; }
}
__device__ __forceinline__ void tile_commit_zeta(LAS unsigned char* dst, const u32x4 (&v)[4], int tid, float l2g) {
#pragma unroll
    for (int i = 0; i < 4; ++i) {
        const int q = tid + 512 * i, row = q >> 4, pc = q & 15; const float z = exp2f((float)(127 - row) * l2g);
        u32x4 w;
        w.x = cvt_pk_bf16(bf_lo(v[i].x) * z, bf_hi(v[i].x) * z); w.y = cvt_pk_bf16(bf_lo(v[i].y) * z, bf_hi(v[i].y) * z);
        w.z = cvt_pk_bf16(bf_lo(v[i].z) * z, bf_hi(v[i].z) * z); w.w = cvt_pk_bf16(bf_lo(v[i].w) * z, bf_hi(v[i].w) * z);
        *(LAS u32x4*)(dst + row * TS + pc * 16) = w;
    }
}
__device__ __forceinline__ float ret_log2_gamma(int h) { const float g = 1.0f - exp2f(-5.0f - (4.0f / 3.0f) * (float)h); return log2f(g); }

__device__ __forceinline__ int dest_row(int mode, int n) {
    if (mode == 1) { if (n < 1024) { const int sect = n >> 9, w = n & 511, h = w >> 7, j = w & 127; return (sect << 9) + (h << 7) + ((j & 63) << 1) + (j >> 6); } return n; }
    if (mode == 2) { const int bj = n >> 9, rem = n & 511, pn = rem >> 7, j = rem & 127; return (pn << 8) + (bj << 7) + j; }
    return n;
}
struct TrItem { const float* W; bf16_t* WT; const float* gain; int K, N, mode, item; };
__device__ __forceinline__ void p0_tr_load(const TrItem& t, f32x4 (&v)[8], int lane) {
    const int nblk = t.N / 32, kb = t.item / nblk, nb = t.item % nblk, k0 = 64 * kb, n0 = 32 * nb;
    const float cs = (t.mode == 1 && n0 >= 512 && n0 < 1024) ? 0.08838834764831845f : 1.0f;
#pragma unroll
    for (int i = 0; i < 8; ++i) { const int kk = (lane >> 3) + 8 * i; const float g = t.gain ? t.gain[k0 + kk] * cs : cs;
        v[i] = ld_nt((const f32x4*)(t.W + (size_t)(k0 + kk) * t.N + n0 + 4 * (lane & 7))) * g; }
}
__device__ __forceinline__ void p0_tr_finish(const TrItem& t, const f32x4 (&v)[8], LAS float* scr, int lane) {
    const int nblk = t.N / 32, kb = t.item / nblk, nb = t.item % nblk, k0 = 64 * kb, n0 = 32 * nb;
#pragma unroll
    for (int i = 0; i < 8; ++i) { const int kk = (lane >> 3) + 8 * i; LAS float* d = scr + kk * 33 + 4 * (lane & 7); d[0] = v[i][0]; d[1] = v[i][1]; d[2] = v[i][2]; d[3] = v[i][3]; }
    LDS_WAIT();
    const int c = lane & 7;
#pragma unroll
    for (int j = 0; j < 4; ++j) { const int n = (lane >> 3) + 8 * j; const LAS float* s = scr + (8 * c) * 33 + n;
        u32x4 o; o.x = cvt_pk_bf16(s[0 * 33], s[1 * 33]); o.y = cvt_pk_bf16(s[2 * 33], s[3 * 33]); o.z = cvt_pk_bf16(s[4 * 33], s[5 * 33]); o.w = cvt_pk_bf16(s[6 * 33], s[7 * 33]);
        *(u32x4*)(t.WT + (size_t)dest_row(t.mode, n0 + n) * t.K + k0 + 8 * c) = o; }
    LDS_WAIT();
}
__device__ __forceinline__ void s5_pow(float lre, float lim, float dt, float j, float& pr, float& pi) {
    const float mag = expf(j * (dt * lre)); float s, c; sincosf(j * (dt * lim), &s, &c); pr = mag * c; pi = mag * s;
}
__device__ __forceinline__ void s5_coef(float lre, float lim, float dt, float& cr, float& ci) {
    float br, bi; s5_pow(lre, lim, dt, 1.0f, br, bi); br -= 1.0f;
    const float den = lre * lre + lim * lim; cr = (br * lre + bi * lim) / den; ci = (bi * lre - br * lim) / den;
}

#define XB_TMO      128
#define XB_XCNT(j)  (256  + 64 * (j))
#define XB_XSUB(j)  (1280 + 64 * (j))
#define XB_XGEN(j)  (2304 + 64 * (j))
#define XB_TOP      3328
#define XB_TOPGEN   3392
#define XCD_BAR_WORDS 3456
#define XB_SPIN_CAP (1u << 18)
__device__ __forceinline__ unsigned xb_ld(unsigned* p)              { return __hip_atomic_load(p, __ATOMIC_RELAXED, __HIP_MEMORY_SCOPE_AGENT); }
__device__ __forceinline__ unsigned xb_add(unsigned* p, unsigned v) { return __hip_atomic_fetch_add(p, v, __ATOMIC_RELAXED, __HIP_MEMORY_SCOPE_AGENT); }
__device__ __forceinline__ unsigned xb_xcc_id() { return (unsigned)__builtin_amdgcn_s_getreg((3 << 11) | 20) & 0xFu; }
#define XB_SPIN(cond, bar) do { unsigned _sp = 0; while (cond) { __builtin_amdgcn_s_sleep(1); \
    if ((++_sp & 255u) == 0u) { if (xb_ld(&(bar)[XB_TMO])) break; if (_sp > XB_SPIN_CAP) { atomicAdd(&(bar)[XB_TMO], 1u); break; } } } } while (0)
struct XcdBarrier { unsigned* bar; unsigned x; volatile LAS unsigned* st; };
__device__ __forceinline__ XcdBarrier xcd_barrier_post(unsigned* bar, volatile LAS unsigned* st) {
    XcdBarrier b; b.bar = bar; b.x = xb_xcc_id(); b.st = st;
    if (threadIdx.x == 0) (void)xb_add(&bar[XB_XCNT(b.x)], 1u);
    return b;
}
__device__ __forceinline__ void xcd_barrier_complete(unsigned* bar, unsigned x, unsigned& nloc, unsigned& nx) {
    const unsigned G = gridDim.x * gridDim.y * gridDim.z;
    unsigned sum, cnt, mine, sp = 0u;
    for (;;) {
        sum = 0u; cnt = 0u; mine = 0u;
#pragma unroll
        for (unsigned j = 0; j < 16; ++j) { const unsigned c = xb_ld(&bar[XB_XCNT(j)]); sum += c; cnt += (c > 0u) ? 1u : 0u; mine = (j == x) ? c : mine; }
        if (sum == G) break;
        __builtin_amdgcn_s_sleep(1);
        if ((++sp & 255u) == 0u) { if (xb_ld(&bar[XB_TMO])) break; if (sp > XB_SPIN_CAP) { atomicAdd(&bar[XB_TMO], 1u); break; } }
    }
    nloc = mine > 0u ? mine : 1u; nx = cnt > 0u ? cnt : 1u;
}
__device__ __forceinline__ void xcd_barrier(const XcdBarrier& b) {
    asm volatile("s_waitcnt vmcnt(0)" ::: "memory");
    __syncthreads();
    if (threadIdx.x == 0) {
        unsigned* bar = b.bar;
        __builtin_amdgcn_s_waitcnt(0);
        unsigned nloc = b.st[0], nx = b.st[1];
        if (nloc == 0u) { xcd_barrier_complete(bar, b.x, nloc, nx); b.st[0] = nloc; b.st[1] = nx; }
        const unsigned old = xb_add(&bar[XB_XSUB(b.x)], 1u);
        const unsigned gen = old / nloc;
        if (old + 1u == (gen + 1u) * nloc) {
            __builtin_amdgcn_fence(__ATOMIC_RELEASE, "agent");
            asm volatile("s_waitcnt vmcnt(0)" ::: "memory");
            const unsigned og = xb_add(&bar[XB_TOP], 1u);
            const unsigned tg = og / nx;
            if (og + 1u == (tg + 1u) * nx) xb_add(&bar[XB_TOPGEN], 1u);
            else XB_SPIN(xb_ld(&bar[XB_TOPGEN]) == tg, bar);
            __builtin_amdgcn_fence(__ATOMIC_ACQUIRE, "agent");
            xb_add(&bar[XB_XGEN(b.x)], 1u);
            asm volatile("s_waitcnt vmcnt(0)" ::: "memory");
        } else {
            XB_SPIN(xb_ld(&bar[XB_XGEN(b.x)]) == gen, bar);
            __builtin_amdgcn_fence(__ATOMIC_ACQUIRE, "agent");
            asm volatile("s_waitcnt vmcnt(0)" ::: "memory");
        }
    }
    __syncthreads();
}

struct Args { const float* in[19]; float* out; unsigned char* ws; int ph_lo, ph_hi; };

__global__ void __launch_bounds__(512, 2) fwd_kernel(Args a) {
    extern __shared__ __attribute__((aligned(16))) unsigned char lds_raw[];
    LAS unsigned char* lds = (LAS unsigned char*)lds_raw;
    const unsigned lds_addr = (unsigned)(size_t)lds_raw;
    cg::grid_group grid = cg::this_grid();
    const int tid = threadIdx.x, lane = tid & 63, wave = __builtin_amdgcn_readfirstlane(tid >> 6);
    const int G = gridDim.x, bx = blockIdx.x;
    const int lo = a.ph_lo, hi = a.ph_hi;
    unsigned char* ws = a.ws;
#define IN(k) (lo <= (k) && (k) < hi)
#define SEAM(k) do { if (lo <= (k) && (k) + 1 < hi) xcd_barrier(xbar); } while (0)
    volatile LAS unsigned* misc = (volatile LAS unsigned*)(lds + (LDS_BYTES - 64));
    if (tid < 16) misc[tid] = 0u;
    __syncthreads();
    const XcdBarrier xbar = xcd_barrier_post((unsigned*)ws, misc);
    if (lo < 0) grid.sync();

    const float* x = a.in[0];
    const float* g_mix_pre = a.in[1]; const float* g_mix_post = a.in[2]; const float* w_in = a.in[3]; const float* gn_gain = a.in[4];
    const float* lam_re = a.in[5]; const float* lam_im = a.in[6]; const float* log_dt = a.in[7];
    const float* b_re = a.in[8]; const float* b_im = a.in[9]; const float* c_re = a.in[10]; const float* c_im = a.in[11]; const float* d_skip = a.in[12];
    const float* w_glu = a.in[13]; const float* w_out = a.in[14]; const float* g_mlp_pre = a.in[15]; const float* g_mlp_post = a.in[16];
    const float* w_ff1 = a.in[17]; const float* w_ff2 = a.in[18];
    float* out = a.out;

    bf16_t* WIN = (bf16_t*)(ws + WS_WIN); bf16_t* WGLU = (bf16_t*)(ws + WS_WGLU); bf16_t* WOUT = (bf16_t*)(ws + WS_WOUT);
    bf16_t* WFF1 = (bf16_t*)(ws + WS_WFF1); bf16_t* WFF2 = (bf16_t*)(ws + WS_WFF2);
    float* ROPE = (float*)(ws + WS_ROPE); bf16_t* TW = (bf16_t*)(ws + WS_TW); bf16_t* W1S = (bf16_t*)(ws + WS_W1S);
    float* XSC = (float*)(ws + 73 * MiB);
    float* SS = (float*)(ws + WS_SS); float* SS2 = (float*)(ws + WS_SS2); float* HINC = (float*)(ws + WS_HINC);
    bf16_t* XN = (bf16_t*)(ws + WS_XN);
    bf16_t* QB = (bf16_t*)(ws + WS_QB); bf16_t* KB = (bf16_t*)(ws + WS_KB); bf16_t* VB = (bf16_t*)(ws + WS_VB); bf16_t* GB = (bf16_t*)(ws + WS_GB);
    bf16_t* AU = (bf16_t*)(ws + WS_AU); bf16_t* SST = (bf16_t*)(ws + WS_SST); bf16_t* RTB = (bf16_t*)(ws + WS_RTB);
    bf16_t* YSSM = (bf16_t*)(ws + WS_YSSM); bf16_t* YMIX = (bf16_t*)(ws + WS_YMIX);
    bf16_t* MIXB = (bf16_t*)(ws + WS_MIXB); bf16_t* HID = (bf16_t*)(ws + WS_HID); bf16_t* MB = (bf16_t*)(ws + WS_MB);

    if (IN(0)) for (int rep = 0; rep < REPS(0); ++rep) {
        const int gw = bx * 8 + wave, NGW = G * 8;
        {
            LAS float* scr = (LAS float*)(lds + wave * 16384);
            constexpr int I_IN = (DM / 64) * (NIN / 32), I_GLU = (512 / 64) * (1024 / 32), I_OUT = (DM / 64) * (DM / 32), I_F1 = (DM / 64) * (DFF / 32), I_F2 = (DFF / 64) * (DM / 32);
            constexpr int NITEMS = I_IN + I_GLU + I_OUT + I_F1 + I_F2;
#define TR_DECODE(IT, t) do { int r_ = (IT); \
                if (r_ < I_IN) { t = TrItem{w_in, WIN, g_mix_pre, DM, NIN, 1, r_}; break; } r_ -= I_IN; \
                if (r_ < I_GLU) { t = TrItem{w_glu, WGLU, nullptr, 512, 1024, 2, r_}; break; } r_ -= I_GLU; \
                if (r_ < I_OUT) { t = TrItem{w_out, WOUT, nullptr, DM, DM, 0, r_}; break; } r_ -= I_OUT; \
                if (r_ < I_F1) { t = TrItem{w_ff1, WFF1, g_mlp_pre, DM, DFF, 0, r_}; break; } r_ -= I_F1; \
                t = TrItem{w_ff2, WFF2, nullptr, DFF, DM, 0, r_}; } while (0)
            for (int it = gw; it < NITEMS; it += 3 * NGW) {
                TrItem t0, t1, t2; f32x4 v0[8], v1[8], v2[8];
                const bool h1 = it + NGW < NITEMS, h2 = it + 2 * NGW < NITEMS;
                TR_DECODE(it, t0); p0_tr_load(t0, v0, lane);
                if (h1) { TR_DECODE(it + NGW, t1); p0_tr_load(t1, v1, lane); }
                if (h2) { TR_DECODE(it + 2 * NGW, t2); p0_tr_load(t2, v2, lane); }
                p0_tr_finish(t0, v0, scr, lane);
                if (h1) p0_tr_finish(t1, v1, scr, lane);
                if (h2) p0_tr_finish(t2, v2, scr, lane);
            }
#undef TR_DECODE
        }
        for (int m = gw; m < T; m += 2 * NGW) {
            const int m2 = m + NGW;
            const bool has2 = m2 < T;
            const f32x4* xr0 = (const f32x4*)(x + (size_t)m * DM) + lane;
            const f32x4* xr1 = (const f32x4*)(x + (size_t)(has2 ? m2 : m) * DM) + lane;
            f32x4 v0[4], v1[4]; float s0 = 0.f, s1 = 0.f;
#pragma unroll
            for (int j = 0; j < 4; ++j) { v0[j] = ld_nt(xr0 + 64 * j); v1[j] = ld_nt(xr1 + 64 * j); }
#pragma unroll
            for (int j = 0; j < 4; ++j) {
                s0 += (v0[j][0] * v0[j][0] + v0[j][1] * v0[j][1]) + (v0[j][2] * v0[j][2] + v0[j][3] * v0[j][3]);
                s1 += (v1[j][0] * v1[j][0] + v1[j][1] * v1[j][1]) + (v1[j][2] * v1[j][2] + v1[j][3] * v1[j][3]);
            }
            const float q0 = sqrtf(wave_sum(s0) * (1.0f / DM) + EPS), q1 = sqrtf(wave_sum(s1) * (1.0f / DM) + EPS);
            const float r0 = 1.0f / q0, r1 = 1.0f / q1;
            if (lane == 0) { XSC[m] = q0; if (has2) XSC[m2] = q1; }
            u32x2* o0 = (u32x2*)(XN + (size_t)m * DM) + lane; u32x2* o1 = (u32x2*)(XN + (size_t)m2 * DM) + lane;
#pragma unroll
            for (int j = 0; j < 4; ++j) { u32x2 w; w.x = cvt_pk_bf16(v0[j][0] * r0, v0[j][1] * r0); w.y = cvt_pk_bf16(v0[j][2] * r0, v0[j][3] * r0); o0[64 * j] = w; }
            if (has2) {
#pragma unroll
                for (int j = 0; j < 4; ++j) { u32x2 w; w.x = cvt_pk_bf16(v1[j][0] * r1, v1[j][1] * r1); w.y = cvt_pk_bf16(v1[j][2] * r1, v1[j][3] * r1); o1[64 * j] = w; }
            }
        }
        const float rope_inv = (float)pow(10000.0, -(double)(tid & 63) / 64.0);
        for (int i = bx * 512 + tid; i < SEQ * 64; i += G * 512) {
            const int pos = i >> 6;
            const float inv = rope_inv;
            const float ang = (float)pos * inv; float s, c; sincosf(ang, &s, &c);
            *(f32x2*)(ROPE + (size_t)i * 2) = (f32x2){c, s};
        }
        for (int i = bx * 512 + tid; i < 32 * 32 * 64; i += G * 512) {
            {
                const int q = i & 63, t = (i >> 6) & 31, g = i >> 11;
                const float lre = fminf(lam_re[g * 64 + q], -1e-4f), lim = lam_im[g * 64 + q], dt = expf(log_dt[g]);
                float pr, pi; s5_pow(lre, lim, dt, (float)(t + 1), pr, pi);
                float crv[16], civ[16];
#pragma unroll
                for (int c = 0; c < 16; ++c) { crv[c] = c_re[(g * 16 + c) * 64 + q]; civ[c] = c_im[(g * 16 + c) * 64 + q]; }
#pragma unroll
                for (int c = 0; c < 16; ++c) {
                    const float zr = crv[c] * pr - civ[c] * pi, zi = crv[c] * pi + civ[c] * pr;
                    bf16_t* row = TW + (size_t)(g * 512 + t * 16 + c) * 640 + 512;
                    row[q] = f2bf(zr); row[64 + q] = f2bf(-zi);
                }
            }
            {
                const int s = i & 31, p = (i >> 5) & 63, g = i >> 11;
                const float lre = fminf(lam_re[g * 64 + p], -1e-4f), lim = lam_im[g * 64 + p], dt = expf(log_dt[g]);
                float pr, pi, cr, ci; s5_pow(lre, lim, dt, (float)(31 - s), pr, pi); s5_coef(lre, lim, dt, cr, ci);
                const float wr_ = pr * cr - pi * ci, wi_ = pr * ci + pi * cr;
                float zr[16], zi[16];
#pragma unroll
                for (int c = 0; c < 16; ++c) { const float br = b_re[(g * 64 + p) * 16 + c], bi = b_im[(g * 64 + p) * 16 + c]; zr[c] = wr_ * br - wi_ * bi; zi[c] = wr_ * bi + wi_ * br; }
                u32x4* o0 = (u32x4*)(W1S + (size_t)(g * 128 + p) * 512 + s * 16);
                u32x4* o1 = (u32x4*)(W1S + (size_t)(g * 128 + 64 + p) * 512 + s * 16);
                u32x4 w;
                w.x = cvt_pk_bf16(zr[0], zr[1]); w.y = cvt_pk_bf16(zr[2], zr[3]); w.z = cvt_pk_bf16(zr[4], zr[5]); w.w = cvt_pk_bf16(zr[6], zr[7]); o0[0] = w;
                w.x = cvt_pk_bf16(zr[8], zr[9]); w.y = cvt_pk_bf16(zr[10], zr[11]); w.z = cvt_pk_bf16(zr[12], zr[13]); w.w = cvt_pk_bf16(zr[14], zr[15]); o0[1] = w;
                w.x = cvt_pk_bf16(zi[0], zi[1]); w.y = cvt_pk_bf16(zi[2], zi[3]); w.z = cvt_pk_bf16(zi[4], zi[5]); w.w = cvt_pk_bf16(zi[6], zi[7]); o1[0] = w;
                w.x = cvt_pk_bf16(zi[8], zi[9]); w.y = cvt_pk_bf16(zi[10], zi[11]); w.z = cvt_pk_bf16(zi[12], zi[13]); w.w = cvt_pk_bf16(zi[14], zi[15]); o1[1] = w;
            }
        }
        for (int i = bx * 512 + tid; i < 16384 * 64; i += G * 512) {
            const int piece = i & 63, row = i >> 6, t = (row >> 4) & 31;
            if (piece >= 2 * (t + 1)) *(u32x4*)(TW + (size_t)row * 640 + piece * 8) = (u32x4){0u, 0u, 0u, 0u};
        }
        __syncthreads();
        {
            LAS float* Bre = (LAS float*)lds; LAS float* Bim = Bre + 1024; LAS float* Cre = Bre + 2048; LAS float* Cim = Bre + 3072;
            LAS float* cpr = Bre + 4096; LAS float* cpi = cpr + 256;
            for (int it = bx; it < 256; it += G) {
                const int g = it >> 3, jq = it & 7;
                {
                    const int q0 = tid, q1 = tid + 512;
                    const float* s0 = (q0 < 256 ? b_re : b_im) + g * 1024 + (q0 & 255) * 4;
                    const float* s1 = (q1 < 768 ? c_re : c_im) + g * 1024 + (q1 & 255) * 4;
                    *(LAS f32x4*)(Bre + q0 * 4) = *(const f32x4*)s0;
                    *(LAS f32x4*)(Bre + q1 * 4) = *(const f32x4*)s1;
                }
                if (tid < 256) {
                    const int p = tid & 63, jl = tid >> 6;
                    const float lre = fminf(lam_re[g * 64 + p], -1e-4f), lim = lam_im[g * 64 + p], dt = expf(log_dt[g]);
                    float pr, pi, cr, ci; s5_pow(lre, lim, dt, (float)(4 * jq + jl), pr, pi); s5_coef(lre, lim, dt, cr, ci);
                    cpr[jl * 64 + p] = pr * cr - pi * ci; cpi[jl * 64 + p] = pr * ci + pi * cr;
                }
                __syncthreads();
                {
                    const int cc = tid & 255, c = cc >> 4, c2 = cc & 15, jh = tid >> 8;
                    float v0 = 0.f, v1 = 0.f;
#pragma unroll 8
                    for (int p = 0; p < 64; ++p) {
                        const float cr = Cre[c * 64 + p], ci = Cim[c * 64 + p], br = Bre[p * 16 + c2], bi = Bim[p * 16 + c2];
                        const float mr = cr * br - ci * bi, mi = cr * bi + ci * br;
                        v0 += mr * cpr[(2 * jh) * 64 + p] - mi * cpi[(2 * jh) * 64 + p];
                        v1 += mr * cpr[(2 * jh + 1) * 64 + p] - mi * cpi[(2 * jh + 1) * 64 + p];
                    }
                    const int jj0 = 4 * jq + 2 * jh;
                    const bf16_t w0 = f2bf(v0), w1 = f2bf(v1);
                    for (int t = jj0; t < 32; ++t) TW[(size_t)(g * 512 + t * 16 + c) * 640 + (t - jj0) * 16 + c2] = w0;
                    for (int t = jj0 + 1; t < 32; ++t) TW[(size_t)(g * 512 + t * 16 + c) * 640 + (t - jj0 - 1) * 16 + c2] = w1;
                }
                __syncthreads();
            }
        }
    }
    SEAM(0);

    if (IN(1)) for (int rep = 0; rep < REPS(1); ++rep) {
        pg8::Gemm g{XN, WIN, DM, DM, DM, 0, 0}; pg8::StaticOrder S; S.init(T, NIN, G, bx);
        pg8::EpiInProj E{QB, KB, VB, GB, AU, ROPE};
        pg8::gemm_phase(lds, g, S, E);
    }
    SEAM(1);

    if (IN(2)) for (int rep = 0; rep < REPS(2); ++rep) {
        const int fr = lane & 15, fq = lane >> 4;
        for (int it = bx; it < 256; it += G) {
            const int g = it >> 3, rt = it & 7;
            const bf16_t* pA = AU + (size_t)(g * 1024 + rt * 128) * 640; const bf16_t* pB = W1S + (size_t)(g * 128) * 512;
            f32x4 acc[8];
#pragma unroll
            for (int n = 0; n < 8; ++n) acc[n] = (f32x4){0.f, 0.f, 0.f, 0.f};
            u32x4 ra[4], rb[4];
            tile_issue(ra, pA, 640, tid); tile_issue(rb, pB, 512, tid);
            for (int kt = 0; kt < 4; ++kt) {
                tile_commit(lds, ra, tid); tile_commit(lds + TILE_B, rb, tid);
                __syncthreads();
                if (kt < 3) { tile_issue(ra, pA + (kt + 1) * 128, 640, tid); tile_issue(rb, pB + (kt + 1) * 128, 512, tid); }
                mma128<false, false>(acc, lds, lds_addr, 0, TILE_B, 16 * wave, lane);
                __syncthreads();
            }
            float* o = HINC + ((size_t)(g * 1024 + rt * 128 + 16 * wave + fr)) * 128 + 4 * fq;
#pragma unroll
            for (int n = 0; n < 8; ++n) *(f32x4*)(o + 16 * n) = acc[n];
        }
        {
            u32x4 rk[4], rv[4];
            int it = bx;
#define R1_ISSUE(IT) do { const int n_ = (IT) & 63, h_ = ((IT) >> 6) & 3, b_ = (IT) >> 8; const size_t t0_ = (size_t)b_ * SEQ + n_ * 128; \
                tile_issue(rk, KB + t0_ * 512 + h_ * 128, 512, tid); tile_issue(rv, VB + t0_ * 512 + h_ * 128, 512, tid); } while (0)
            if (it < 1024) R1_ISSUE(it);
            for (; it < 1024; it += G) {
                const int h = (it >> 6) & 3;
                const float l2g = ret_log2_gamma(h);
                tile_commit(lds, rk, tid); tile_commit_zeta(lds + TILE_B, rv, tid, l2g);
                __syncthreads();
                if (it + G < 1024) R1_ISSUE(it + G);
                f32x4 acc[8];
#pragma unroll
                for (int nb = 0; nb < 8; ++nb) acc[nb] = (f32x4){0.f, 0.f, 0.f, 0.f};
                mma128<true, true>(acc, lds, lds_addr, TILE_B, 0, 16 * wave, lane);
                bf16_t* o = SST + (size_t)it * 16384 + (16 * wave + fr) * 128 + 4 * fq;
#pragma unroll
                for (int nb = 0; nb < 8; ++nb) { u32x2 w; w.x = cvt_pk_bf16(acc[nb][0], acc[nb][1]); w.y = cvt_pk_bf16(acc[nb][2], acc[nb][3]); *(u32x2*)(o + 16 * nb) = w; }
                __syncthreads();
            }
#undef R1_ISSUE
        }
    }
    SEAM(2);

    if (IN(3)) for (int rep = 0; rep < REPS(3); ++rep) {
        for (int idx = bx * 512 + tid; idx < 16 * 8192; idx += G * 512) {
            const int bh = idx >> 13, e2 = idx & 8191, h = bh & 3;
            const float gch = exp2f(128.0f * ret_log2_gamma(h));
            const unsigned* sp = (const unsigned*)(SST + (size_t)bh * 64 * 16384 + 2 * e2);
            unsigned* rp = (unsigned*)(RTB + (size_t)bh * 64 * 16384 + 2 * e2);
            float r0 = 0.f, r1 = 0.f;
            for (int n0 = 0; n0 < 64; n0 += 16) {
                unsigned s[16];
#pragma unroll
                for (int j = 0; j < 16; ++j) s[j] = ld_nt(sp + (size_t)(n0 + j) * 8192);
#pragma unroll
                for (int j = 0; j < 16; ++j) { rp[(size_t)(n0 + j) * 8192] = cvt_pk_bf16(r0, r1); r0 = gch * r0 + bf_lo(s[j]); r1 = gch * r1 + bf_hi(s[j]); }
            }
        }
        {
            LAS float* X = (LAS float*)lds;
            for (int it = bx; it < 256; it += G) {
                const int ph = it & 1, g = (it >> 1) & 31, b = it >> 6, pl = tid & 31, p = 32 * ph + pl, seg = tid >> 5;
                const float lre = fminf(lam_re[g * 64 + p], -1e-4f), lim = lam_im[g * 64 + p], dt = expf(log_dt[g]);
                float ar, ai, Ar, Ai; s5_pow(lre, lim, dt, 32.0f, ar, ai); s5_pow(lre, lim, dt, 512.0f, Ar, Ai);
                const float* hp = HINC + ((size_t)(g * 1024 + b * 256 + seg * 16)) * 128 + p;
                float hr[16], hi_[16];
#pragma unroll
                for (int i = 0; i < 16; ++i) { hr[i] = hp[(size_t)i * 128]; hi_[i] = hp[(size_t)i * 128 + 64]; }
                float xr = 0.f, xi = 0.f;
#pragma unroll
                for (int i = 0; i < 16; ++i) { const float nr = ar * xr - ai * xi + hr[i], ni = ar * xi + ai * xr + hi_[i]; xr = nr; xi = ni; }
                X[(seg * 32 + pl) * 2] = xr; X[(seg * 32 + pl) * 2 + 1] = xi;
                __syncthreads();
                float cr = 0.f, ci = 0.f;
                for (int s2 = 0; s2 < seg; ++s2) { const float tr = X[(s2 * 32 + pl) * 2], ti = X[(s2 * 32 + pl) * 2 + 1]; const float nr = Ar * cr - Ai * ci + tr, ni = Ar * ci + Ai * cr + ti; cr = nr; ci = ni; }
                bf16_t* op = AU + ((size_t)(g * 1024 + b * 256 + seg * 16)) * 640 + 512 + p;
                xr = cr; xi = ci;
#pragma unroll
                for (int i = 0; i < 16; ++i) {
                    op[(size_t)i * 640] = f2bf(xr); op[(size_t)i * 640 + 64] = f2bf(xi);
                    const float nr = ar * xr - ai * xi + hr[i], ni = ar * xi + ai * xr + hi_[i]; xr = nr; xi = ni;
                }
                __syncthreads();
            }
        }
    }
    SEAM(3);

    if (IN(4)) for (int rep = 0; rep < REPS(4); ++rep) {
        const bool solo = (hi - lo == 1);
        if (!(solo && PROBE_P4_PART == 2)) for (int rep4 = 0; rep4 < (PROBE_P4_DUP == 1 ? 2 : 1); ++rep4) {
            pg8::Gemm g{AU, TW, 640, 640, 640, (size_t)1024 * 640, (size_t)512 * 640}; pg8::BatchOrder S{G, bx};
            pg8::EpiSsm E{AU, d_skip, YSSM};
            pg8::gemm_phase(lds, g, S, E);
        }
        const int fr = lane & 15, fq = lane >> 4;
        constexpr int OQ = 0, OK_ = TILE_B, OV = 2 * TILE_B, OR = 3 * TILE_B;
        for (int rep4 = 0; rep4 < (PROBE_P4_DUP == 2 ? 2 : 1); ++rep4) {
        u32x4 rq[4], rk[4], rv[4], rr[4];
        int it = bx;
#define R3_ISSUE_QK(IT) do { const int n_ = (IT) & 63, h_ = ((IT) >> 6) & 3, b_ = (IT) >> 8; const size_t t0_ = (size_t)b_ * SEQ + n_ * 128; \
            tile_issue_nt(rq, QB + t0_ * 512 + h_ * 128, 512, tid); tile_issue_nt(rk, KB + t0_ * 512 + h_ * 128, 512, tid); } while (0)
#define R3_ISSUE_VR(IT) do { const int n_ = (IT) & 63, h_ = ((IT) >> 6) & 3, b_ = (IT) >> 8; const size_t t0_ = (size_t)b_ * SEQ + n_ * 128; \
            tile_issue_nt(rv, VB + t0_ * 512 + h_ * 128, 512, tid); tile_issue_nt(rr, RTB + (size_t)(IT) * 16384, 128, tid); } while (0)
        if (solo && PROBE_P4_PART == 1) it = 1024;
        if (it < 1024) R3_ISSUE_QK(it);
        for (; it < 1024; it += G) {
            const int n = it & 63, h = (it >> 6) & 3, b = it >> 8;
            const float l2g = ret_log2_gamma(h);
            const size_t tok0 = (size_t)b * SEQ + n * 128;
            tile_commit(lds + OQ, rq, tid); tile_commit(lds + OK_, rk, tid);
            R3_ISSUE_VR(it);
            __syncthreads();
            const int i = 16 * wave + fr;
            f32x4 sc[8];
#pragma unroll
            for (int nb = 0; nb < 8; ++nb) sc[nb] = (f32x4){0.f, 0.f, 0.f, 0.f};
            mma128<false, false>(sc, lds, lds_addr, OQ, OK_, 16 * wave, lane);
            tile_commit(lds + OV, rv, tid); tile_commit(lds + OR, rr, tid);
            __syncthreads();
            if (it + G < 1024) R3_ISSUE_QK(it + G);
#pragma unroll
            for (int nb = 0; nb < 8; ++nb) {
                f32x4 pv;
#pragma unroll
                for (int e = 0; e < 4; ++e) { const int j = 16 * nb + 4 * fq + e; pv[e] = (i >= j) ? sc[nb][e] * exp2f((float)(i - j) * l2g) : 0.f; }
                u32x2 w; w.x = cvt_pk_bf16(pv[0], pv[1]); w.y = cvt_pk_bf16(pv[2], pv[3]);
                *(LAS u32x2*)(lds + OK_ + i * TS + (16 * nb + 4 * fq) * 2) = w;
            }
            LDS_WAIT();
            f32x4 a1[8], a2[8];
#pragma unroll
            for (int nb = 0; nb < 8; ++nb) { a1[nb] = (f32x4){0.f, 0.f, 0.f, 0.f}; a2[nb] = (f32x4){0.f, 0.f, 0.f, 0.f}; }
            mma128<false, true>(a1, lds, lds_addr, OK_, OV, 16 * wave, lane);
            mma128<false, false>(a2, lds, lds_addr, OQ, OR, 16 * wave, lane);
            const float xi = exp2f((float)(i + 1) * l2g);
            float s1 = 0.f, s2 = 0.f;
#pragma unroll
            for (int nb = 0; nb < 8; ++nb)
#pragma unroll
                for (int e = 0; e < 4; ++e) { const float o = a1[nb][e] + xi * a2[nb][e]; a1[nb][e] = o; s1 += o; s2 += o * o; }
            s1 += __shfl_xor(s1, 16); s1 += __shfl_xor(s1, 32); s2 += __shfl_xor(s2, 16); s2 += __shfl_xor(s2, 32);
            const float mu = s1 * (1.0f / 128.0f), var = fmaxf(s2 * (1.0f / 128.0f) - mu * mu, 0.f), rs = 1.0f / sqrtf(var + EPS);
            const size_t tok = tok0 + i;
            u32x2 gwv[8]; f32x4 ggv[8];
#pragma unroll
            for (int nb = 0; nb < 8; ++nb) { gwv[nb] = ld_nt((const u32x2*)(GB + tok * 512 + h * 128 + 16 * nb + 4 * fq)); ggv[nb] = *(const f32x4*)(gn_gain + h * 128 + 16 * nb + 4 * fq); }
#pragma unroll
            for (int nb = 0; nb < 8; ++nb) {
                const int d = 16 * nb + 4 * fq;
                const u32x2 gw = gwv[nb];
                const f32x4 gg = ggv[nb];
                const float g0 = bf_lo(gw.x), g1 = bf_hi(gw.x), g2 = bf_lo(gw.y), g3 = bf_hi(gw.y);
                const float y0 = (a1[nb][0] - mu) * rs * gg[0] * (g0 / (1.0f + __expf(-g0)));
                const float y1 = (a1[nb][1] - mu) * rs * gg[1] * (g1 / (1.0f + __expf(-g1)));
                const float y2 = (a1[nb][2] - mu) * rs * gg[2] * (g2 / (1.0f + __expf(-g2)));
                const float y3 = (a1[nb][3] - mu) * rs * gg[3] * (g3 / (1.0f + __expf(-g3)));
                u32x2 w; w.x = cvt_pk_bf16(y0, y1); w.y = cvt_pk_bf16(y2, y3);
                *(u32x2*)(YMIX + tok * 1024 + h * 128 + d) = w;
            }
            __syncthreads();
        }
        }
    }
#undef R3_ISSUE_QK
#undef R3_ISSUE_VR
    SEAM(4);

    if (IN(5)) for (int rep = 0; rep < REPS(5); ++rep) {
        pg8::Gemm g{YSSM, WGLU, 512, 512, 512, 0, 0}; pg8::StaticOrder S; S.init(T, 1024, G, bx);
        pg8::EpiGlu E{YMIX};
        pg8::gemm_phase(lds, g, S, E);
    }
    SEAM(5);

    if (IN(6)) for (int rep = 0; rep < REPS(6); ++rep) {
        pg8::Gemm g{YMIX, WOUT, DM, DM, DM, 0, 0}; pg8::StaticOrder S; S.init(T, DM, G, bx);
        pg8::EpiSS E{MIXB, SS};
        pg8::gemm_phase(lds, g, S, E);
    }
    SEAM(6);

    if (IN(7)) for (int rep = 0; rep < REPS(7); ++rep) {
        const int gw = bx * 8 + wave, NGW = G * 8;
        const f32x4* gr = (const f32x4*)g_mix_post + lane;
        f32x4 gv[4];
#pragma unroll
        for (int j = 0; j < 4; ++j) gv[j] = gr[64 * j];
        for (int m0 = gw; m0 < T; m0 += 2 * NGW) {
            f32x4 xv[2][4]; u32x2 mw[2][4]; float rs[2];
#pragma unroll
            for (int r = 0; r < 2; ++r) {
                const int m = (m0 + r * NGW < T) ? m0 + r * NGW : m0;
                const f32x4 pa = *((const f32x4*)(SS + (size_t)m * 16) + (lane & 3));
                float sa = (pa[0] + pa[1]) + (pa[2] + pa[3]); sa += __shfl_xor(sa, 1); sa += __shfl_xor(sa, 2);
                rs[r] = 1.0f / sqrtf(sa * (1.0f / DM) + EPS);
                const u32x2* xr = (const u32x2*)(XN + (size_t)m * DM) + lane; const u32x2* mr = (const u32x2*)(MIXB + (size_t)m * DM) + lane;
                const float xs = XSC[m];
#pragma unroll
                for (int j = 0; j < 4; ++j) { const u32x2 xw = ld_nt(xr + 64 * j); xv[r][j] = (f32x4){bf_lo(xw.x) * xs, bf_hi(xw.x) * xs, bf_lo(xw.y) * xs, bf_hi(xw.y) * xs}; mw[r][j] = ld_nt(mr + 64 * j); }
            }
#pragma unroll
            for (int r = 0; r < 2; ++r) {
                const int m = m0 + r * NGW;
                if (m < T) {
                    float sq = 0.f;
#pragma unroll
                    for (int j = 0; j < 4; ++j) {
                        f32x4& v = xv[r][j];
                        v[0] += bf_lo(mw[r][j].x) * rs[r] * gv[j][0]; v[1] += bf_hi(mw[r][j].x) * rs[r] * gv[j][1];
                        v[2] += bf_lo(mw[r][j].y) * rs[r] * gv[j][2]; v[3] += bf_hi(mw[r][j].y) * rs[r] * gv[j][3];
                        sq += (v[0] * v[0] + v[1] * v[1]) + (v[2] * v[2] + v[3] * v[3]);
                    }
                    const float rstd1 = 1.0f / sqrtf(wave_sum(sq) * (1.0f / DM) + EPS);
                    u32x2* o8 = (u32x2*)(XN + (size_t)m * DM) + lane;
#pragma unroll
                    for (int j = 0; j < 4; ++j) { const f32x4 v = xv[r][j]; u32x2 w; w.x = cvt_pk_bf16(v[0] * rstd1, v[1] * rstd1); w.y = cvt_pk_bf16(v[2] * rstd1, v[3] * rstd1); o8[64 * j] = w; }
                }
            }
        }
    }
    SEAM(7);

    if (IN(8)) for (int rep = 0; rep < REPS(8); ++rep) {
        pg8::Gemm g{XN, WFF1, DM, DM, DM, 0, 0}; pg8::StaticOrder S; S.init(T, DFF, G, bx);
        pg8::EpiRelu2 E{HID};
        pg8::gemm_phase(lds, g, S, E);
    }
    SEAM(8);

    if (IN(9)) for (int rep = 0; rep < REPS(9); ++rep) {
        pg8::Gemm g{HID, WFF2, DFF, DFF, DFF, 0, 0}; pg8::StaticOrder S; S.init(T, DM, G, bx);
        pg8::EpiSS E{MB, SS2};
        pg8::gemm_phase(lds, g, S, E);
    }
    SEAM(9);

    if (IN(10)) {
        const int gw = bx * 8 + wave, NGW = G * 8;
        const f32x4* g1r = (const f32x4*)g_mix_post + lane; const f32x4* g2r = (const f32x4*)g_mlp_post + lane;
        f32x4 ga[4], gb[4];
#pragma unroll
        for (int j = 0; j < 4; ++j) { ga[j] = g1r[64 * j]; gb[j] = g2r[64 * j]; }
        for (int m0 = gw; m0 < T; m0 += 2 * NGW) {
            f32x4 xv[2][4]; u32x2 aw[2][4], mw[2][4]; float r1[2], r2[2];
#pragma unroll
            for (int r = 0; r < 2; ++r) {
                const int m = (m0 + r * NGW < T) ? m0 + r * NGW : m0;
                const f32x4 pa = *((const f32x4*)(SS + (size_t)m * 16) + (lane & 3)), pb = *((const f32x4*)(SS2 + (size_t)m * 16) + (lane & 3));
                float sa = (pa[0] + pa[1]) + (pa[2] + pa[3]), sb = (pb[0] + pb[1]) + (pb[2] + pb[3]);
                sa += __shfl_xor(sa, 1); sa += __shfl_xor(sa, 2); sb += __shfl_xor(sb, 1); sb += __shfl_xor(sb, 2);
                r1[r] = 1.0f / sqrtf(sa * (1.0f / DM) + EPS); r2[r] = 1.0f / sqrtf(sb * (1.0f / DM) + EPS);
                const f32x4* xr = (const f32x4*)(x + (size_t)m * DM) + lane;
                const u32x2* ar = (const u32x2*)(MIXB + (size_t)m * DM) + lane; const u32x2* mr = (const u32x2*)(MB + (size_t)m * DM) + lane;
#pragma unroll
                for (int j = 0; j < 4; ++j) { xv[r][j] = ld_nt(xr + 64 * j); aw[r][j] = ld_nt(ar + 64 * j); mw[r][j] = ld_nt(mr + 64 * j); }
            }
#pragma unroll
            for (int r = 0; r < 2; ++r) {
                const int m = m0 + r * NGW;
                if (m < T) {
                    f32x4* orow = (f32x4*)(out + (size_t)m * DM) + lane;
#pragma unroll
                    for (int j = 0; j < 4; ++j) {
                        f32x4 v = xv[r][j];
                        v[0] = (v[0] + bf_lo(aw[r][j].x) * r1[r] * ga[j][0]) + bf_lo(mw[r][j].x) * r2[r] * gb[j][0]; v[1] = (v[1] + bf_hi(aw[r][j].x) * r1[r] * ga[j][1]) + bf_hi(mw[r][j].x) * r2[r] * gb[j][1];
                        v[2] = (v[2] + bf_lo(aw[r][j].y) * r1[r] * ga[j][2]) + bf_lo(mw[r][j].y) * r2[r] * gb[j][2]; v[3] = (v[3] + bf_hi(aw[r][j].y) * r1[r] * ga[j][3]) + bf_hi(mw[r][j].y) * r2[r] * gb[j][3];
                        st_nt(orow + 64 * j, v);
                    }
                }
            }
        }
    }
#undef IN
#undef SEAM
}

extern "C" void kernel_launch(void* const* d_in, const int* in_sizes, int n_in, void* d_out, int out_size, void* d_ws, size_t ws_size, hipStream_t stream) {
    static int grid = 0;
    if (grid == 0) {
        int dev = 0, cus = 0, per_cu = 0;
        hipGetDevice(&dev);
        hipDeviceGetAttribute(&cus, hipDeviceAttributeMultiprocessorCount, dev);
        hipFuncSetAttribute((const void*)fwd_kernel, hipFuncAttributeMaxDynamicSharedMemorySize, LDS_BYTES);
        if (hipOccupancyMaxActiveBlocksPerMultiprocessor(&per_cu, (const void*)fwd_kernel, 512, LDS_BYTES) != hipSuccess || per_cu < 1) per_cu = 1;
        (void)hipGetLastError();
        grid = cus * per_cu;
        if (grid <= 0) grid = 256;
    }
    Args a{};
    for (int i = 0; i < 19; ++i) a.in[i] = (const float*)d_in[i];
    a.out = (float*)d_out; a.ws = (unsigned char*)d_ws;
#if N_LAUNCH_PER_PHASE
    for (int ph = 0; ph < NPHASE; ++ph) {
        a.ph_lo = ph; a.ph_hi = ph + 1;
        void* args[] = {&a};
        hipError_t e = hipLaunchCooperativeKernel((const void*)fwd_kernel, dim3(grid), dim3(512), args, LDS_BYTES, stream);
        if (e != hipSuccess) { fprintf(stderr, "cooperative launch (phase %d) failed: %s (grid %d)\n", ph, hipGetErrorString(e), grid); break; }
    }
#else
    a.ph_lo = 0; a.ph_hi = NPHASE;
    (void)hipMemsetAsync(d_ws, 0, 16384, stream);
    void* args[] = {&a};
    hipError_t e = hipLaunchCooperativeKernel((const void*)fwd_kernel, dim3(grid), dim3(512), args, LDS_BYTES, stream);
    if (e != hipSuccess) fprintf(stderr, "cooperative launch failed: %s (grid %d)\n", hipGetErrorString(e), grid);
#ifdef PROBE_EXTRA_PHASE
    {
        Args b = a; b.ph_lo = PROBE_EXTRA_PHASE; b.ph_hi = PROBE_EXTRA_PHASE + 1;
        void* args2[] = {&b};
        (void)hipLaunchCooperativeKernel((const void*)fwd_kernel, dim3(grid), dim3(512), args2, LDS_BYTES, stream);
    }
#endif
#endif
}
```

```cpp
#include <hip/hip_runtime.h>
#include <hip/hip_cooperative_groups.h>
#include <cstdio>
namespace cg = cooperative_groups;

#ifndef N_LAUNCH_PER_PHASE
#define N_LAUNCH_PER_PHASE 0
#endif

#ifndef PROBE_P4_DUP
#define PROBE_P4_DUP 0
#endif
#ifndef PROBE_P4_PART
#define PROBE_P4_PART 0
#endif
#ifndef PROBE_DUP
#define PROBE_DUP 0
#endif
#define REPS(k) (1 + ((PROBE_DUP >> (k)) & 1))
#define LAS __attribute__((address_space(3)))
typedef unsigned short bf16_t;
typedef short bf16x8 __attribute__((ext_vector_type(8)));
typedef float f32x4 __attribute__((ext_vector_type(4)));
typedef float f32x2 __attribute__((ext_vector_type(2)));
typedef unsigned u32x4 __attribute__((ext_vector_type(4)));
typedef unsigned u32x2 __attribute__((ext_vector_type(2)));

constexpr int T = 32768, SEQ = 8192, DM = 1024, NIN = 2560, DFF = 4096;
constexpr float EPS = 1e-6f;
constexpr int NPHASE = 11;

constexpr size_t MiB = 1u << 20;
constexpr size_t WS_WIN = 1 * MiB, WS_WGLU = 6 * MiB, WS_WOUT = 7 * MiB, WS_WFF1 = 9 * MiB, WS_WFF2 = 17 * MiB;
constexpr size_t WS_ROPE = 25 * MiB, WS_TW = 29 * MiB, WS_W1S = 49 * MiB, WS_SS = 53 * MiB, WS_SS2 = 55 * MiB, WS_HINC = 57 * MiB;
constexpr size_t WS_XN = 80 * MiB;
constexpr size_t WS_QB = 144 * MiB, WS_KB = 176 * MiB, WS_VB = 208 * MiB, WS_GB = 240 * MiB, WS_AU = 272 * MiB;
constexpr size_t WS_SST = 440 * MiB, WS_RTB = 376 * MiB, WS_YSSM = 408 * MiB;
constexpr size_t WS_YMIX = 312 * MiB;
constexpr size_t WS_HID = 144 * MiB;
constexpr size_t WS_MIXB = 400 * MiB;
constexpr size_t WS_MB = 80 * MiB;

constexpr int LDS_BYTES = 147456;
constexpr int TS = 272;
constexpr int TILE_B = 128 * TS;

typedef __bf16 bf16x2_t __attribute__((ext_vector_type(2)));
__device__ __forceinline__ unsigned cvt_pk_bf16(float lo, float hi) { f32x2 v = {lo, hi}; return __builtin_bit_cast(unsigned, __builtin_convertvector(v, bf16x2_t)); }
__device__ __forceinline__ float bf_lo(unsigned w) { return __uint_as_float(w << 16); }
__device__ __forceinline__ float bf_hi(unsigned w) { return __uint_as_float(w & 0xffff0000u); }
__device__ __forceinline__ bf16_t f2bf(float f) { return (bf16_t)(cvt_pk_bf16(f, 0.f) & 0xffffu); }
__device__ __forceinline__ float wave_sum(float v) {
#pragma unroll
    for (int o = 1; o < 64; o <<= 1) v += __shfl_xor(v, o);
    return v;
}
#define LDS_WAIT() asm volatile("s_waitcnt lgkmcnt(0)" ::: "memory")
template <class Tv> __device__ __forceinline__ Tv ld_nt(const Tv* p) { return __builtin_nontemporal_load(p); }
__device__ __forceinline__ void st_nt(f32x4* p, f32x4 v) { __builtin_nontemporal_store(v, p); }

namespace pg8 {
constexpr int BM = 256, BK = 64, HALF = 128, HTB = HALF * BK * 2, STAGE_BYTES = 8 * HTB, NXCD = 8, WGM = 8;
__device__ __forceinline__ int lds_byte(int r, int c) { const int st = (r >> 4) * 2 + (c >> 5), rr = r & 15, cc = c & 31, ob = rr * 64 + cc * 2; return st * 1024 + (ob ^ (((ob >> 9) & 1) << 5)); }
__device__ __forceinline__ void stage_rc(int b, int& R, int& C) { const int st = b / 1024, sb = b % 1024, swz = sb ^ (((sb >> 9) & 1) << 5); R = (st >> 1) * 16 + swz / 64; C = (st & 1) * 32 + (swz % 64) / 2; }
__device__ __forceinline__ int perm32(int rho) { const int n = rho >> 4, i = rho & 15; return 8 * (i >> 2) + 4 * n + (i & 3); }

struct Unit { int pm, pn, pb; };
struct Gemm { const bf16_t* A; const bf16_t* Bt; int lda, ldb, K; size_t bsA, bsB; };

struct StaticOrder {
    int nM, nN, nwg, G, c;
    __device__ void init(int M, int N, int G_, int c_) { nM = M / BM; nN = N / BM; nwg = nM * nN; G = G_; c = c_; }
    __device__ bool next(int i, Unit& u) const {
        const long L = (long)i * G + c; if (L >= nwg) return false;
        int wgid = (int)L; { const int q = nwg / NXCD, r = nwg % NXCD, xcd = wgid % NXCD, off = wgid / NXCD; wgid = (xcd < r ? xcd * (q + 1) : r * (q + 1) + (xcd - r) * q) + off; }
        const int nig = WGM * nN, gid = wgid / nig, fm = gid * WGM, gsz = (nM - fm) < WGM ? (nM - fm) : WGM;
        u.pm = fm + ((wgid % nig) % gsz); u.pn = (wgid % nig) / gsz; u.pb = 0; return true;
    }
};
struct BatchOrder {
    int G, c;
    __device__ bool next(int i, Unit& u) const {
        const int L = i * G + c; if (L >= 256) return false;
        const int xcd = L & 7, slot = L >> 3;
        u.pb = xcd * 4 + (slot >> 3); const int r = slot & 7; u.pm = r & 3; u.pn = r >> 2; return true;
    }
};

template <class Epi, class Sched, bool ALIGN_EPI = true, bool SP2 = true>
__device__ __forceinline__ void gemm_phase(LAS unsigned char* lds, const Gemm g, const Sched& S, const Epi& E) {
    const int tid = threadIdx.x, wid = __builtin_amdgcn_readfirstlane(tid >> 6), lane = tid & 63, wr = wid >> 2, wc = wid & 3, fr = lane & 15, fq = lane >> 4;
    const int K = g.K, nt = K / BK;
    unsigned voffA[2], voffB[2];
#pragma unroll
    for (int i = 0; i < 2; ++i) { int R, C; stage_rc(tid * 16 + i * 8192, R, C); const int Rb = Epi::PERM ? ((R & ~31) + perm32(R & 31)) : R;
        voffA[i] = (unsigned)(R * g.lda + C) * 2u; voffB[i] = (unsigned)(Rb * g.ldb + C) * 2u; }
    const size_t kstep = (size_t)(BK * 2);
    const size_t hstepA = (size_t)HALF * g.lda * 2, hstepB = (size_t)HALF * g.ldb * 2;
    const size_t tstepA = 2 * hstepA, tstepB = 2 * hstepB;
    const unsigned ldsw = (unsigned)wid * 1024u;
    const int aoff = lds_byte(wr * 64 + fr, fq * 8), boff = lds_byte(wc * 32 + fr, fq * 8);
#define PG8_SA(b, h) (((b) * 2 + (h)) * HTB)
#define PG8_SB(b, h) ((4 + (b) * 2 + (h)) * HTB)
#define PG8_STAGE(bufoff, gbase, voff) do { _Pragma("unroll") for (int _i = 0; _i < 2; ++_i) \
        __builtin_amdgcn_global_load_lds((const unsigned*)((const char*)(gbase) + (voff)[_i]), (LAS unsigned*)(lds + (bufoff) + ldsw + _i * 8192), 16, 0, 0); } while (0)
#define PG8_LDA(dst, b, h) do { _Pragma("unroll") for (int m = 0; m < 4; ++m) _Pragma("unroll") for (int k = 0; k < 2; ++k) dst[m][k] = *(const LAS bf16x8*)(lds + PG8_SA(b, h) + aoff + m * 2048 + k * 1024); } while (0)
#define PG8_LDB(dst, b, h) do { _Pragma("unroll") for (int n = 0; n < 2; ++n) _Pragma("unroll") for (int k = 0; k < 2; ++k) dst[n][k] = *(const LAS bf16x8*)(lds + PG8_SB(b, h) + boff + n * 2048 + k * 1024); } while (0)
#define PG8_MMA(ai, bj, At, Bt) do { __builtin_amdgcn_s_setprio(1); _Pragma("unroll") for (int m = 0; m < 4; ++m) _Pragma("unroll") for (int n = 0; n < 2; ++n) _Pragma("unroll") for (int k = 0; k < 2; ++k) \
        acc[ai][bj][m][n] = __builtin_amdgcn_mfma_f32_16x16x32_bf16(Bt[n][k], At[m][k], acc[ai][bj][m][n], 0, 0, 0); __builtin_amdgcn_s_setprio(0); } while (0)
#define PG8_WAIT_V(n) asm volatile("s_waitcnt vmcnt(" #n ")" ::: "memory")
#define PG8_WAIT_L(n) asm volatile("s_waitcnt lgkmcnt(" #n ")" ::: "memory")
#define PG8_BAR __builtin_amdgcn_s_barrier()
#define PG8_SCHED __builtin_amdgcn_sched_barrier(0)
    Unit cur, nxt; int ui = 0;
    if (!S.next(0, cur)) return;
    f32x4 acc[2][2][4][2];
#pragma unroll
    for (int a = 0; a < 2; ++a)
#pragma unroll
        for (int b = 0; b < 2; ++b)
#pragma unroll
            for (int m = 0; m < 4; ++m)
#pragma unroll
                for (int n = 0; n < 2; ++n) acc[a][b][m][n] = (f32x4){0.f, 0.f, 0.f, 0.f};
    bf16x8 At[4][2], B0[2][2], B1[2][2];
    const char* cA = (const char*)g.A + (size_t)cur.pb * g.bsA * 2 + (size_t)cur.pm * tstepA;
    const char* cB = (const char*)g.Bt + (size_t)cur.pb * g.bsB * 2 + (size_t)cur.pn * tstepB;
    if constexpr (SP2) {
        PG8_STAGE(PG8_SB(0, 0), cB, voffB); PG8_STAGE(PG8_SB(0, 1), cB + hstepB, voffB); PG8_STAGE(PG8_SA(0, 0), cA, voffA); PG8_STAGE(PG8_SA(0, 1), cA + hstepA, voffA);
        if (wr == 1) PG8_BAR;
        PG8_WAIT_V(2); PG8_BAR;
        PG8_STAGE(PG8_SB(1, 0), cB + kstep, voffB); PG8_STAGE(PG8_SA(1, 0), cA + kstep, voffA); PG8_STAGE(PG8_SB(1, 1), cB + hstepB + kstep, voffB);
        PG8_WAIT_V(6); PG8_BAR;
    } else {
        PG8_STAGE(PG8_SB(0, 0), cB, voffB); PG8_STAGE(PG8_SA(0, 0), cA, voffA); PG8_STAGE(PG8_SB(0, 1), cB + hstepB, voffB); PG8_STAGE(PG8_SA(0, 1), cA + hstepA, voffA);
        if (wr == 1) PG8_BAR;
        PG8_WAIT_V(4); PG8_BAR;
        PG8_STAGE(PG8_SB(1, 0), cB + kstep, voffB); PG8_STAGE(PG8_SA(1, 0), cA + kstep, voffA); PG8_STAGE(PG8_SB(1, 1), cB + hstepB + kstep, voffB);
        PG8_WAIT_V(6); PG8_BAR;
    }
    for (;;) {
        const bool has_next = S.next(ui + 1, nxt);
        const char* nA = has_next ? (const char*)g.A + (size_t)nxt.pb * g.bsA * 2 + (size_t)nxt.pm * tstepA : cA;
        const char* nB = has_next ? (const char*)g.Bt + (size_t)nxt.pb * g.bsB * 2 + (size_t)nxt.pn * tstepB : cB;
        for (int t = 0; t < nt; t += 2) {
            const bool last = (t == nt - 2);
            const char* a1 = cA + (size_t)(t + 1) * kstep;
            const char* a2 = last ? nA : cA + (size_t)(t + 2) * kstep; const char* b2 = last ? nB : cB + (size_t)(t + 2) * kstep;
            const char* a3 = a2 + kstep; const char* b3 = b2 + kstep;
            if constexpr (SP2) {
            PG8_LDB(B0, 0, 0); PG8_LDB(B1, 0, 1); PG8_SCHED; PG8_LDA(At, 0, 0); PG8_STAGE(PG8_SA(1, 1), a1 + hstepA, voffA);
            PG8_WAIT_V(8); PG8_WAIT_L(0); PG8_BAR; PG8_MMA(0, 0, At, B0); PG8_MMA(0, 1, At, B1); PG8_BAR; PG8_SCHED;
            PG8_LDA(At, 0, 1); PG8_STAGE(PG8_SB(0, 0), b2, voffB); PG8_STAGE(PG8_SB(0, 1), b2 + hstepB, voffB); PG8_STAGE(PG8_SA(0, 0), a2, voffA);
            PG8_WAIT_V(8); PG8_WAIT_L(0); PG8_BAR; PG8_MMA(1, 0, At, B0); PG8_MMA(1, 1, At, B1); PG8_BAR; PG8_SCHED;
            PG8_LDB(B0, 1, 0); PG8_LDB(B1, 1, 1); PG8_SCHED; PG8_LDA(At, 1, 0); PG8_STAGE(PG8_SA(0, 1), a2 + hstepA, voffA);
            PG8_WAIT_V(8); PG8_WAIT_L(0); PG8_BAR; PG8_MMA(0, 0, At, B0); PG8_MMA(0, 1, At, B1); PG8_BAR; PG8_SCHED;
            PG8_LDA(At, 1, 1); PG8_STAGE(PG8_SB(1, 0), b3, voffB); PG8_STAGE(PG8_SB(1, 1), b3 + hstepB, voffB); PG8_STAGE(PG8_SA(1, 0), a3, voffA);
            PG8_WAIT_V(8); PG8_WAIT_L(0); PG8_BAR; PG8_MMA(1, 0, At, B0); PG8_MMA(1, 1, At, B1); PG8_BAR; PG8_SCHED;
            } else {
            PG8_LDB(B0, 0, 0); PG8_SCHED; PG8_LDA(At, 0, 0); PG8_STAGE(PG8_SA(1, 1), a1 + hstepA, voffA);
            PG8_WAIT_L(8); PG8_BAR; PG8_WAIT_L(0); PG8_MMA(0, 0, At, B0); PG8_BAR; PG8_SCHED;
            PG8_LDB(B1, 0, 1); PG8_STAGE(PG8_SB(0, 0), b2, voffB);
            PG8_BAR; PG8_WAIT_L(0); PG8_MMA(0, 1, At, B1); PG8_BAR;
            PG8_LDA(At, 0, 1); PG8_STAGE(PG8_SA(0, 0), a2, voffA);
            PG8_BAR; PG8_WAIT_L(0); PG8_MMA(1, 0, At, B0); PG8_BAR; PG8_SCHED;
            PG8_STAGE(PG8_SB(0, 1), b2 + hstepB, voffB);
            PG8_WAIT_V(6); PG8_BAR; PG8_MMA(1, 1, At, B1); PG8_BAR;
            PG8_LDB(B0, 1, 0); PG8_SCHED; PG8_LDA(At, 1, 0); PG8_STAGE(PG8_SA(0, 1), a2 + hstepA, voffA);
            PG8_WAIT_L(8); PG8_BAR; PG8_WAIT_L(0); PG8_MMA(0, 0, At, B0); PG8_BAR; PG8_SCHED;
            PG8_LDB(B1, 1, 1); PG8_STAGE(PG8_SB(1, 0), b3, voffB);
            PG8_BAR; PG8_WAIT_L(0); PG8_MMA(0, 1, At, B1); PG8_BAR;
            PG8_LDA(At, 1, 1); PG8_STAGE(PG8_SA(1, 0), a3, voffA);
            PG8_BAR; PG8_WAIT_L(0); PG8_MMA(1, 0, At, B0); PG8_BAR; PG8_SCHED;
            PG8_STAGE(PG8_SB(1, 1), b3 + hstepB, voffB);
            PG8_WAIT_V(6); PG8_BAR; PG8_MMA(1, 1, At, B1); PG8_BAR;
            }
        }
        if constexpr (ALIGN_EPI) { if (wr == 0) PG8_BAR; }
        E(acc, cur, wr, wc, fr, fq);
        if (!has_next) break;
#pragma unroll
        for (int a = 0; a < 2; ++a)
#pragma unroll
            for (int b = 0; b < 2; ++b)
#pragma unroll
                for (int m = 0; m < 4; ++m)
#pragma unroll
                    for (int n = 0; n < 2; ++n) acc[a][b][m][n] = (f32x4){0.f, 0.f, 0.f, 0.f};
        cur = nxt; cA = nA; cB = nB; ++ui;
        if constexpr (ALIGN_EPI) { if (wr == 1) PG8_BAR; }
    }
    PG8_WAIT_V(0);
    if constexpr (!ALIGN_EPI) { if (wr == 0) PG8_BAR; }
    PG8_BAR;
#undef PG8_SA
#undef PG8_SB
#undef PG8_STAGE
#undef PG8_LDA
#undef PG8_LDB
#undef PG8_MMA
#undef PG8_WAIT_V
#undef PG8_WAIT_L
#undef PG8_BAR
#undef PG8_SCHED
}

__device__ __forceinline__ u32x4 pack8(const f32x4 v0, const f32x4 v1) {
    u32x4 w; w.x = cvt_pk_bf16(v0[0], v0[1]); w.y = cvt_pk_bf16(v0[2], v0[3]); w.z = cvt_pk_bf16(v1[0], v1[1]); w.w = cvt_pk_bf16(v1[2], v1[3]); return w;
}
__device__ __forceinline__ f32x4 rope4(const f32x4 v, const f32x4 cs) {
    f32x4 r; r[0] = v[0] * cs[0] - v[1] * cs[1]; r[1] = v[0] * cs[1] + v[1] * cs[0]; r[2] = v[2] * cs[2] - v[3] * cs[3]; r[3] = v[2] * cs[3] + v[3] * cs[2]; return r;
}
struct EpiInProj {
    static constexpr bool PERM = true;
    bf16_t *Q, *Kb, *V, *Gt, *AU; const float* rope;
    __device__ __forceinline__ void operator()(const f32x4 (&acc)[2][2][4][2], const Unit& u, int wr, int wc, int fr, int fq) const {
        const int sect = u.pn >> 1;
        const int row0 = u.pm * BM + wr * 64 + fr;
        const int colt = (u.pn & 1) * 256 + wc * 32 + 8 * fq;
        if (sect <= 1) {
            bf16_t* O = sect ? Kb : Q;
            f32x4 cs[2][4][2];
#pragma unroll
            for (int ai = 0; ai < 2; ++ai)
#pragma unroll
                for (int m = 0; m < 4; ++m) {
                    const int pos = (row0 + ai * HALF + m * 16) & (SEQ - 1);
                    const float* rp = rope + ((size_t)pos * 64 + 16 * wc + 4 * fq) * 2;
                    cs[ai][m][0] = *(const f32x4*)rp; cs[ai][m][1] = *(const f32x4*)(rp + 4);
                }
#pragma unroll
            for (int ai = 0; ai < 2; ++ai)
#pragma unroll
                for (int m = 0; m < 4; ++m) {
                    const int row = row0 + ai * HALF + m * 16;
#pragma unroll
                    for (int bj = 0; bj < 2; ++bj) {
                        const f32x4 v0 = rope4(acc[ai][bj][m][0], cs[ai][m][0]), v1 = rope4(acc[ai][bj][m][1], cs[ai][m][1]);
                        *(u32x4*)(O + (size_t)row * 512 + colt + bj * HALF) = pack8(v0, v1);
                    }
                }
        } else if (sect <= 3) {
            bf16_t* O = (sect == 2) ? V : Gt;
#pragma unroll
            for (int ai = 0; ai < 2; ++ai)
#pragma unroll
                for (int m = 0; m < 4; ++m) {
                    const int row = row0 + ai * HALF + m * 16;
#pragma unroll
                    for (int bj = 0; bj < 2; ++bj) *(u32x4*)(O + (size_t)row * 512 + colt + bj * HALF) = pack8(acc[ai][bj][m][0], acc[ai][bj][m][1]);
                }
        } else {
#pragma unroll
            for (int ai = 0; ai < 2; ++ai)
#pragma unroll
                for (int m = 0; m < 4; ++m) {
                    const int row = row0 + ai * HALF + m * 16, cr = row >> 5, s = row & 31;
#pragma unroll
                    for (int bj = 0; bj < 2; ++bj) {
                        const int cu = colt + bj * HALF, g = cu >> 4, c0 = cu & 15;
                        *(u32x4*)(AU + ((size_t)(g * 1024 + cr) * 640 + s * 16 + c0)) = pack8(acc[ai][bj][m][0], acc[ai][bj][m][1]);
                    }
                }
        }
    }
};
struct EpiGlu {
    static constexpr bool PERM = true;
    bf16_t* Y;
    __device__ __forceinline__ void operator()(const f32x4 (&acc)[2][2][4][2], const Unit& u, int wr, int wc, int fr, int fq) const {
        const int row0 = u.pm * BM + wr * 64 + fr, col = 512 + u.pn * 128 + wc * 32 + 8 * fq;
#pragma unroll
        for (int ai = 0; ai < 2; ++ai)
#pragma unroll
            for (int m = 0; m < 4; ++m) {
                const int row = row0 + ai * HALF + m * 16;
                f32x4 y0, y1;
#pragma unroll
                for (int j = 0; j < 4; ++j) {
                    y0[j] = acc[ai][0][m][0][j] / (1.0f + __expf(-acc[ai][1][m][0][j]));
                    y1[j] = acc[ai][0][m][1][j] / (1.0f + __expf(-acc[ai][1][m][1][j]));
                }
                *(u32x4*)(Y + (size_t)row * 1024 + col) = pack8(y0, y1);
            }
    }
};
struct EpiSS {
    static constexpr bool PERM = true;
    bf16_t* O; float* SS;
    __device__ __forceinline__ void operator()(const f32x4 (&acc)[2][2][4][2], const Unit& u, int wr, int wc, int fr, int fq) const {
        const int row0 = u.pm * BM + wr * 64 + fr, col = u.pn * BM + wc * 32 + 8 * fq;
#pragma unroll
        for (int ai = 0; ai < 2; ++ai)
#pragma unroll
            for (int m = 0; m < 4; ++m) {
                const int row = row0 + ai * HALF + m * 16; float q = 0.f;
#pragma unroll
                for (int bj = 0; bj < 2; ++bj) {
                    const f32x4 v0 = acc[ai][bj][m][0], v1 = acc[ai][bj][m][1];
                    q += (v0[0] * v0[0] + v0[1] * v0[1]) + (v0[2] * v0[2] + v0[3] * v0[3]) + (v1[0] * v1[0] + v1[1] * v1[1]) + (v1[2] * v1[2] + v1[3] * v1[3]);
                    *(u32x4*)(O + (size_t)row * 1024 + col + bj * HALF) = pack8(v0, v1);
                }
                q += __shfl_xor(q, 16); q += __shfl_xor(q, 32);
                if (fq == 0) SS[(size_t)row * 16 + u.pn * 4 + wc] = q;
            }
    }
};
struct EpiRelu2 {
    static constexpr bool PERM = true;
    bf16_t* O;
    __device__ __forceinline__ void operator()(const f32x4 (&acc)[2][2][4][2], const Unit& u, int wr, int wc, int fr, int fq) const {
        const int row0 = u.pm * BM + wr * 64 + fr, col = u.pn * BM + wc * 32 + 8 * fq;
#pragma unroll
        for (int ai = 0; ai < 2; ++ai)
#pragma unroll
            for (int m = 0; m < 4; ++m) {
                const int row = row0 + ai * HALF + m * 16;
#pragma unroll
                for (int bj = 0; bj < 2; ++bj) {
                    f32x4 v0 = acc[ai][bj][m][0], v1 = acc[ai][bj][m][1];
#pragma unroll
                    for (int j = 0; j < 4; ++j) { const float a = fmaxf(v0[j], 0.f), b = fmaxf(v1[j], 0.f); v0[j] = a * a; v1[j] = b * b; }
                    *(u32x4*)(O + (size_t)row * DFF + col + bj * HALF) = pack8(v0, v1);
                }
            }
    }
};
struct EpiSsm {
    static constexpr bool PERM = true;
    const bf16_t* AU; const float* dskip; bf16_t* Y;
    __device__ __forceinline__ void operator()(const f32x4 (&acc)[2][2][4][2], const Unit& u, int wr, int wc, int fr, int fq) const {
        const int g = u.pb;
        const int row0 = u.pm * BM + wr * 64 + fr, colt = u.pn * BM + wc * 32 + 8 * fq;
        const int c0 = 8 * (fq & 1);
        const f32x4 d0 = *(const f32x4*)(dskip + g * 16 + c0), d1 = *(const f32x4*)(dskip + g * 16 + c0 + 4);
        u32x4 uwv[2][4][2];
#pragma unroll
        for (int ai = 0; ai < 2; ++ai)
#pragma unroll
            for (int m = 0; m < 4; ++m)
#pragma unroll
                for (int bj = 0; bj < 2; ++bj) uwv[ai][m][bj] = *(const u32x4*)(AU + ((size_t)(g * 1024 + row0 + ai * HALF + m * 16) * 640 + colt + bj * HALF));
#pragma unroll
        for (int ai = 0; ai < 2; ++ai)
#pragma unroll
            for (int m = 0; m < 4; ++m) {
                const int cr = row0 + ai * HALF + m * 16;
#pragma unroll
                for (int bj = 0; bj < 2; ++bj) {
                    const int col = colt + bj * HALF, s = col >> 4;
                    const u32x4 uw = uwv[ai][m][bj];
                    f32x4 v0 = acc[ai][bj][m][0], v1 = acc[ai][bj][m][1];
                    v0[0] += d0[0] * bf_lo(uw.x); v0[1] += d0[1] * bf_hi(uw.x); v0[2] += d0[2] * bf_lo(uw.y); v0[3] += d0[3] * bf_hi(uw.y);
                    v1[0] += d1[0] * bf_lo(uw.z); v1[1] += d1[1] * bf_hi(uw.z); v1[2] += d1[2] * bf_lo(uw.w); v1[3] += d1[3] * bf_hi(uw.w);
#pragma unroll
                    for (int j = 0; j < 4; ++j) {
                        const float a = v0[j], za = 1.5957691216f * (a + 0.044715f * a * a * a); v0[j] = a / (1.0f + __expf(-za));
                        const float b = v1[j], zb = 1.5957691216f * (b + 0.044715f * b * b * b); v1[j] = b / (1.0f + __expf(-zb));
                    }
                    const size_t tok = (size_t)cr * 32 + s;
                    *(u32x4*)(Y + tok * 512 + g * 16 + c0) = pack8(v0, v1);
                }
            }
    }
};
}

__device__ __forceinline__ bf16x8 frag_nat(const LAS unsigned char* tile, int idx0, int k0, int fr, int fq) {
    return *(const LAS bf16x8*)(tile + (idx0 + fr) * TS + (k0 + 8 * fq) * 2);
}
__device__ __forceinline__ bf16x8 frag_tr(unsigned tile_addr, int k0, int idx0, int lane) {
    const int g = lane >> 4, q = (lane & 15) >> 2, p = lane & 3;
    const unsigned addr = tile_addr + (unsigned)((k0 + 8 * g + q) * TS + (idx0 + 4 * p) * 2);
    u32x2 lo, hi;
    asm volatile("ds_read_b64_tr_b16 %0, %2\n\tds_read_b64_tr_b16 %1, %2 offset:1088\n\ts_waitcnt lgkmcnt(0)" : "=&v"(lo), "=&v"(hi) : "v"(addr) : "memory");
    u32x4 r; r.x = lo.x; r.y = lo.y; r.z = hi.x; r.w = hi.y;
    return __builtin_bit_cast(bf16x8, r);
}
__device__ __forceinline__ void frags_tr8(bf16x8 (&b)[8], unsigned tile_addr, int k0, int lane) {
    const int g = lane >> 4, q = (lane & 15) >> 2, p = lane & 3;
    const unsigned addr = tile_addr + (unsigned)((k0 + 8 * g + q) * TS + (4 * p) * 2);
    u32x2 r0, r1, r2, r3, r4, r5, r6, r7, r8, r9, r10, r11, r12, r13, r14, r15;
    asm volatile(
        "ds_read_b64_tr_b16 %0, %16\n\t"
        "ds_read_b64_tr_b16 %1, %16 offset:1088\n\t"
        "ds_read_b64_tr_b16 %2, %16 offset:32\n\t"
        "ds_read_b64_tr_b16 %3, %16 offset:1120\n\t"
        "ds_read_b64_tr_b16 %4, %16 offset:64\n\t"
        "ds_read_b64_tr_b16 %5, %16 offset:1152\n\t"
        "ds_read_b64_tr_b16 %6, %16 offset:96\n\t"
        "ds_read_b64_tr_b16 %7, %16 offset:1184\n\t"
        "ds_read_b64_tr_b16 %8, %16 offset:128\n\t"
        "ds_read_b64_tr_b16 %9, %16 offset:1216\n\t"
        "ds_read_b64_tr_b16 %10, %16 offset:160\n\t"
        "ds_read_b64_tr_b16 %11, %16 offset:1248\n\t"
        "ds_read_b64_tr_b16 %12, %16 offset:192\n\t"
        "ds_read_b64_tr_b16 %13, %16 offset:1280\n\t"
        "ds_read_b64_tr_b16 %14, %16 offset:224\n\t"
        "ds_read_b64_tr_b16 %15, %16 offset:1312\n\t"
        "s_waitcnt lgkmcnt(0)"
        : "=&v"(r0), "=&v"(r1), "=&v"(r2), "=&v"(r3), "=&v"(r4), "=&v"(r5), "=&v"(r6), "=&v"(r7),
          "=&v"(r8), "=&v"(r9), "=&v"(r10), "=&v"(r11), "=&v"(r12), "=&v"(r13), "=&v"(r14), "=&v"(r15)
        : "v"(addr) : "memory");
    u32x4 w;
    w.x = r0.x; w.y = r0.y; w.z = r1.x; w.w = r1.y; b[0] = __builtin_bit_cast(bf16x8, w);
    w.x = r2.x; w.y = r2.y; w.z = r3.x; w.w = r3.y; b[1] = __builtin_bit_cast(bf16x8, w);
    w.x = r4.x; w.y = r4.y; w.z = r5.x; w.w = r5.y; b[2] = __builtin_bit_cast(bf16x8, w);
    w.x = r6.x; w.y = r6.y; w.z = r7.x; w.w = r7.y; b[3] = __builtin_bit_cast(bf16x8, w);
    w.x = r8.x; w.y = r8.y; w.z = r9.x; w.w = r9.y; b[4] = __builtin_bit_cast(bf16x8, w);
    w.x = r10.x; w.y = r10.y; w.z = r11.x; w.w = r11.y; b[5] = __builtin_bit_cast(bf16x8, w);
    w.x = r12.x; w.y = r12.y; w.z = r13.x; w.w = r13.y; b[6] = __builtin_bit_cast(bf16x8, w);
    w.x = r14.x; w.y = r14.y; w.z = r15.x; w.w = r15.y; b[7] = __builtin_bit_cast(bf16x8, w);
}
template <bool ATR, bool BTR>
__device__ __forceinline__ void mma128(f32x4 (&acc)[8], const LAS unsigned char* lds, unsigned lds_addr, int offA, int offB, int m0, int lane) {
    const int fr = lane & 15, fq = lane >> 4;
#pragma unroll
    for (int ks = 0; ks < 4; ++ks) {
        bf16x8 af, bfr[8];
        if (ATR) af = frag_tr(lds_addr + offA, 32 * ks, m0, lane); else af = frag_nat(lds + offA, m0, 32 * ks, fr, fq);
        if (BTR) frags_tr8(bfr, lds_addr + offB, 32 * ks, lane);
        else {
#pragma unroll
            for (int n = 0; n < 8; ++n) bfr[n] = frag_nat(lds + offB, 16 * n, 32 * ks, fr, fq);
        }
#pragma unroll
        for (int n = 0; n < 8; ++n) acc[n] = __builtin_amdgcn_mfma_f32_16x16x32_bf16(bfr[n], af, acc[n], 0, 0, 0);
    }
}
__device__ __forceinline__ void tile_load(LAS unsigned char* dst, const bf16_t* src, int ld, int tid) {
    u32x4 v[4];
#pragma unroll
    for (int i = 0; i < 4; ++i) { const int q = tid + 512 * i, row = q >> 4, pc = q & 15; v[i] = *(const u32x4*)(src + (size_t)row * ld + pc * 8); }
#pragma unroll
    for (int i = 0; i < 4; ++i) { const int q = tid + 512 * i, row = q >> 4, pc = q & 15; *(LAS u32x4*)(dst + row * TS + pc * 16) = v[i]; }
}
__device__ __forceinline__ void tile_load_zeta(LAS unsigned char* dst, const bf16_t* src, int ld, int tid, float l2g) {
    u32x4 v[4];
#pragma unroll
    for (int i = 0; i < 4; ++i) { const int q = tid + 512 * i, row = q >> 4, pc = q & 15; v[i] = *(const u32x4*)(src + (size_t)row * ld + pc * 8); }
#pragma unroll
    for (int i = 0; i < 4; ++i) {
        const int q = tid + 512 * i, row = q >> 4, pc = q & 15; const float z = exp2f((float)(127 - row) * l2g);
        u32x4 w;
        w.x = cvt_pk_bf16(bf_lo(v[i].x) * z, bf_hi(v[i].x) * z); w.y = cvt_pk_bf16(bf_lo(v[i].y) * z, bf_hi(v[i].y) * z);
        w.z = cvt_pk_bf16(bf_lo(v[i].z) * z, bf_hi(v[i].z) * z); w.w = cvt_pk_bf16(bf_lo(v[i].w) * z, bf_hi(v[i].w) * z);
        *(LAS u32x4*)(dst + row * TS + pc * 16) = w;
    }
}
__device__ __forceinline__ void tile_issue(u32x4 (&v)[4], const bf16_t* src, int ld, int tid) {
#pragma unroll
    for (int i = 0; i < 4; ++i) { const int q = tid + 512 * i, row = q >> 4, pc = q & 15; v[i] = *(const u32x4*)(src + (size_t)row * ld + pc * 8); }
}
__device__ __forceinline__ void tile_issue_nt(u32x4 (&v)[4], const bf16_t* src, int ld, int tid) {
#pragma unroll
    for (int i = 0; i < 4; ++i) { const int q = tid + 512 * i, row = q >> 4, pc = q & 15; v[i] = ld_nt((const u32x4*)(src + (size_t)row * ld + pc * 8)); }
}
__device__ __forceinline__ void tile_commit(LAS unsigned char* dst, const u32x4 (&v)[4], int tid) {
#pragma unroll
    for (int i = 0; i < 4; ++i) { const int q = tid + 512 * i, row = q >> 4, pc = q & 15; *(LAS u32x4*)(dst + row * TS + pc * 16) = v[i]; }
}
__device__ __forceinline__ void tile_commit_zeta(LAS unsigned char* dst, const u32x4 (&v)[4], int tid, float l2g) {
#pragma unroll
    for (int i = 0; i < 4; ++i) {
        const int q = tid + 512 * i, row = q >> 4, pc = q & 15; const float z = exp2f((float)(127 - row) * l2g);
        u32x4 w;
        w.x = cvt_pk_bf16(bf_lo(v[i].x) * z, bf_hi(v[i].x) * z); w.y = cvt_pk_bf16(bf_lo(v[i].y) * z, bf_hi(v[i].y) * z);
        w.z = cvt_pk_bf16(bf_lo(v[i].z) * z, bf_hi(v[i].z) * z); w.w = cvt_pk_bf16(bf_lo(v[i].w) * z, bf_hi(v[i].w) * z);
        *(LAS u32x4*)(dst + row * TS + pc * 16) = w;
    }
}
__device__ __forceinline__ float ret_log2_gamma(int h) { const float g = 1.0f - exp2f(-5.0f - (4.0f / 3.0f) * (float)h); return log2f(g); }

__device__ __forceinline__ int dest_row(int mode, int n) {
    if (mode == 1) { if (n < 1024) { const int sect = n >> 9, w = n & 511, h = w >> 7, j = w & 127; return (sect << 9) + (h << 7) + ((j & 63) << 1) + (j >> 6); } return n; }
    if (mode == 2) { const int bj = n >> 9, rem = n & 511, pn = rem >> 7, j = rem & 127; return (pn << 8) + (bj << 7) + j; }
    return n;
}
struct TrItem { const float* W; bf16_t* WT; const float* gain; int K, N, mode, item; };
__device__ __forceinline__ void p0_tr_load(const TrItem& t, f32x4 (&v)[8], int lane) {
    const int nblk = t.N / 32, kb = t.item / nblk, nb = t.item % nblk, k0 = 64 * kb, n0 = 32 * nb;
    const float cs = (t.mode == 1 && n0 >= 512 && n0 < 1024) ? 0.08838834764831845f : 1.0f;
#pragma unroll
    for (int i = 0; i < 8; ++i) { const int kk = (lane >> 3) + 8 * i; const float g = t.gain ? t.gain[k0 + kk] * cs : cs;
        v[i] = ld_nt((const f32x4*)(t.W + (size_t)(k0 + kk) * t.N + n0 + 4 * (lane & 7))) * g; }
}
__device__ __forceinline__ void p0_tr_finish(const TrItem& t, const f32x4 (&v)[8], LAS float* scr, int lane) {
    const int nblk = t.N / 32, kb = t.item / nblk, nb = t.item % nblk, k0 = 64 * kb, n0 = 32 * nb;
#pragma unroll
    for (int i = 0; i < 8; ++i) { const int kk = (lane >> 3) + 8 * i; LAS float* d = scr + kk * 33 + 4 * (lane & 7); d[0] = v[i][0]; d[1] = v[i][1]; d[2] = v[i][2]; d[3] = v[i][3]; }
    LDS_WAIT();
    const int c = lane & 7;
#pragma unroll
    for (int j = 0; j < 4; ++j) { const int n = (lane >> 3) + 8 * j; const LAS float* s = scr + (8 * c) * 33 + n;
        u32x4 o; o.x = cvt_pk_bf16(s[0 * 33], s[1 * 33]); o.y = cvt_pk_bf16(s[2 * 33], s[3 * 33]); o.z = cvt_pk_bf16(s[4 * 33], s[5 * 33]); o.w = cvt_pk_bf16(s[6 * 33], s[7 * 33]);
        *(u32x4*)(t.WT + (size_t)dest_row(t.mode, n0 + n) * t.K + k0 + 8 * c) = o; }
    LDS_WAIT();
}
__device__ __forceinline__ void s5_pow(float lre, float lim, float dt, float j, float& pr, float& pi) {
    const float mag = expf(j * (dt * lre)); float s, c; sincosf(j * (dt * lim), &s, &c); pr = mag * c; pi = mag * s;
}
__device__ __forceinline__ void s5_coef(float lre, float lim, float dt, float& cr, float& ci) {
    float br, bi; s5_pow(lre, lim, dt, 1.0f, br, bi); br -= 1.0f;
    const float den = lre * lre + lim * lim; cr = (br * lre + bi * lim) / den; ci = (bi * lre - br * lim) / den;
}

#define XB_TMO      128
#define XB_XCNT(j)  (256  + 64 * (j))
#define XB_XSUB(j)  (1280 + 64 * (j))
#define XB_XGEN(j)  (2304 + 64 * (j))
#define XB_TOP      3328
#define XB_TOPGEN   3392
#define XCD_BAR_WORDS 3456
#define XB_SPIN_CAP (1u << 18)
__device__ __forceinline__ unsigned xb_ld(unsigned* p)              { return __hip_atomic_load(p, __ATOMIC_RELAXED, __HIP_MEMORY_SCOPE_AGENT); }
__device__ __forceinline__ unsigned xb_add(unsigned* p, unsigned v) { return __hip_atomic_fetch_add(p, v, __ATOMIC_RELAXED, __HIP_MEMORY_SCOPE_AGENT); }
__device__ __forceinline__ unsigned xb_xcc_id() { return (unsigned)__builtin_amdgcn_s_getreg((3 << 11) | 20) & 0xFu; }
#define XB_SPIN(cond, bar) do { unsigned _sp = 0; while (cond) { __builtin_amdgcn_s_sleep(1); \
    if ((++_sp & 255u) == 0u) { if (xb_ld(&(bar)[XB_TMO])) break; if (_sp > XB_SPIN_CAP) { atomicAdd(&(bar)[XB_TMO], 1u); break; } } } } while (0)
struct XcdBarrier { unsigned* bar; unsigned x; volatile LAS unsigned* st; };
__device__ __forceinline__ XcdBarrier xcd_barrier_post(unsigned* bar, volatile LAS unsigned* st) {
    XcdBarrier b; b.bar = bar; b.x = xb_xcc_id(); b.st = st;
    if (threadIdx.x == 0) (void)xb_add(&bar[XB_XCNT(b.x)], 1u);
    return b;
}
__device__ __forceinline__ void xcd_barrier_complete(unsigned* bar, unsigned x, unsigned& nloc, unsigned& nx) {
    const unsigned G = gridDim.x * gridDim.y * gridDim.z;
    unsigned sum, cnt, mine, sp = 0u;
    for (;;) {
        sum = 0u; cnt = 0u; mine = 0u;
#pragma unroll
        for (unsigned j = 0; j < 16; ++j) { const unsigned c = xb_ld(&bar[XB_XCNT(j)]); sum += c; cnt += (c > 0u) ? 1u : 0u; mine = (j == x) ? c : mine; }
        if (sum == G) break;
        __builtin_amdgcn_s_sleep(1);
        if ((++sp & 255u) == 0u) { if (xb_ld(&bar[XB_TMO])) break; if (sp > XB_SPIN_CAP) { atomicAdd(&bar[XB_TMO], 1u); break; } }
    }
    nloc = mine > 0u ? mine : 1u; nx = cnt > 0u ? cnt : 1u;
}
__device__ __forceinline__ void xcd_barrier(const XcdBarrier& b) {
    asm volatile("s_waitcnt vmcnt(0)" ::: "memory");
    __syncthreads();
    if (threadIdx.x == 0) {
        unsigned* bar = b.bar;
        __builtin_amdgcn_s_waitcnt(0);
        unsigned nloc = b.st[0], nx = b.st[1];
        if (nloc == 0u) { xcd_barrier_complete(bar, b.x, nloc, nx); b.st[0] = nloc; b.st[1] = nx; }
        const unsigned old = xb_add(&bar[XB_XSUB(b.x)], 1u);
        const unsigned gen = old / nloc;
        if (old + 1u == (gen + 1u) * nloc) {
            __builtin_amdgcn_fence(__ATOMIC_RELEASE, "agent");
            asm volatile("s_waitcnt vmcnt(0)" ::: "memory");
            const unsigned og = xb_add(&bar[XB_TOP], 1u);
            const unsigned tg = og / nx;
            if (og + 1u == (tg + 1u) * nx) xb_add(&bar[XB_TOPGEN], 1u);
            else XB_SPIN(xb_ld(&bar[XB_TOPGEN]) == tg, bar);
            __builtin_amdgcn_fence(__ATOMIC_ACQUIRE, "agent");
            xb_add(&bar[XB_XGEN(b.x)], 1u);
            asm volatile("s_waitcnt vmcnt(0)" ::: "memory");
        } else {
            XB_SPIN(xb_ld(&bar[XB_XGEN(b.x)]) == gen, bar);
            __builtin_amdgcn_fence(__ATOMIC_ACQUIRE, "agent");
            asm volatile("s_waitcnt vmcnt(0)" ::: "memory");
        }
    }
    __syncthreads();
}

struct Args { const float* in[19]; float* out; unsigned char* ws; int ph_lo, ph_hi; };

__global__ void __launch_bounds__(512, 2) fwd_kernel(Args a) {
    extern __shared__ __attribute__((aligned(16))) unsigned char lds_raw[];
    LAS unsigned char* lds = (LAS unsigned char*)lds_raw;
    const unsigned lds_addr = (unsigned)(size_t)lds_raw;
    cg::grid_group grid = cg::this_grid();
    const int tid = threadIdx.x, lane = tid & 63, wave = __builtin_amdgcn_readfirstlane(tid >> 6);
    const int G = gridDim.x, bx = blockIdx.x;
    const int lo = a.ph_lo, hi = a.ph_hi;
    unsigned char* ws = a.ws;
#define IN(k) (lo <= (k) && (k) < hi)
#define SEAM(k) do { if (lo <= (k) && (k) + 1 < hi) xcd_barrier(xbar); } while (0)
    volatile LAS unsigned* misc = (volatile LAS unsigned*)(lds + (LDS_BYTES - 64));
    if (tid < 16) misc[tid] = 0u;
    __syncthreads();
    const XcdBarrier xbar = xcd_barrier_post((unsigned*)ws, misc);
    if (lo < 0) grid.sync();

    const float* x = a.in[0];
    const float* g_mix_pre = a.in[1]; const float* g_mix_post = a.in[2]; const float* w_in = a.in[3]; const float* gn_gain = a.in[4];
    const float* lam_re = a.in[5]; const float* lam_im = a.in[6]; const float* log_dt = a.in[7];
    const float* b_re = a.in[8]; const float* b_im = a.in[9]; const float* c_re = a.in[10]; const float* c_im = a.in[11]; const float* d_skip = a.in[12];
    const float* w_glu = a.in[13]; const float* w_out = a.in[14]; const float* g_mlp_pre = a.in[15]; const float* g_mlp_post = a.in[16];
    const float* w_ff1 = a.in[17]; const float* w_ff2 = a.in[18];
    float* out = a.out;

    bf16_t* WIN = (bf16_t*)(ws + WS_WIN); bf16_t* WGLU = (bf16_t*)(ws + WS_WGLU); bf16_t* WOUT = (bf16_t*)(ws + WS_WOUT);
    bf16_t* WFF1 = (bf16_t*)(ws + WS_WFF1); bf16_t* WFF2 = (bf16_t*)(ws + WS_WFF2);
    float* ROPE = (float*)(ws + WS_ROPE); bf16_t* TW = (bf16_t*)(ws + WS_TW); bf16_t* W1S = (bf16_t*)(ws + WS_W1S);
    float* XSC = (float*)(ws + 73 * MiB);
    float* SS = (float*)(ws + WS_SS); float* SS2 = (float*)(ws + WS_SS2); float* HINC = (float*)(ws + WS_HINC);
    bf16_t* XN = (bf16_t*)(ws + WS_XN);
    bf16_t* QB = (bf16_t*)(ws + WS_QB); bf16_t* KB = (bf16_t*)(ws + WS_KB); bf16_t* VB = (bf16_t*)(ws + WS_VB); bf16_t* GB = (bf16_t*)(ws + WS_GB);
    bf16_t* AU = (bf16_t*)(ws + WS_AU); bf16_t* SST = (bf16_t*)(ws + WS_SST); bf16_t* RTB = (bf16_t*)(ws + WS_RTB);
    bf16_t* YSSM = (bf16_t*)(ws + WS_YSSM); bf16_t* YMIX = (bf16_t*)(ws + WS_YMIX);
    bf16_t* MIXB = (bf16_t*)(ws + WS_MIXB); bf16_t* HID = (bf16_t*)(ws + WS_HID); bf16_t* MB = (bf16_t*)(ws + WS_MB);

    if (IN(0)) for (int rep = 0; rep < REPS(0); ++rep) {
        const int gw = bx * 8 + wave, NGW = G * 8;
        {
            LAS float* scr = (LAS float*)(lds + wave * 16384);
            constexpr int I_IN = (DM / 64) * (NIN / 32), I_GLU = (512 / 64) * (1024 / 32), I_OUT = (DM / 64) * (DM / 32), I_F1 = (DM / 64) * (DFF / 32), I_F2 = (DFF / 64) * (DM / 32);
            constexpr int NITEMS = I_IN + I_GLU + I_OUT + I_F1 + I_F2;
#define TR_DECODE(IT, t) do { int r_ = (IT); \
                if (r_ < I_IN) { t = TrItem{w_in, WIN, g_mix_pre, DM, NIN, 1, r_}; break; } r_ -= I_IN; \
                if (r_ < I_GLU) { t = TrItem{w_glu, WGLU, nullptr, 512, 1024, 2, r_}; break; } r_ -= I_GLU; \
                if (r_ < I_OUT) { t = TrItem{w_out, WOUT, nullptr, DM, DM, 0, r_}; break; } r_ -= I_OUT; \
                if (r_ < I_F1) { t = TrItem{w_ff1, WFF1, g_mlp_pre, DM, DFF, 0, r_}; break; } r_ -= I_F1; \
                t = TrItem{w_ff2, WFF2, nullptr, DFF, DM, 0, r_}; } while (0)
            for (int it = gw; it < NITEMS; it += 3 * NGW) {
                TrItem t0, t1, t2; f32x4 v0[8], v1[8], v2[8];
                const bool h1 = it + NGW < NITEMS, h2 = it + 2 * NGW < NITEMS;
                TR_DECODE(it, t0); p0_tr_load(t0, v0, lane);
                if (h1) { TR_DECODE(it + NGW, t1); p0_tr_load(t1, v1, lane); }
                if (h2) { TR_DECODE(it + 2 * NGW, t2); p0_tr_load(t2, v2, lane); }
                p0_tr_finish(t0, v0, scr, lane);
                if (h1) p0_tr_finish(t1, v1, scr, lane);
                if (h2) p0_tr_finish(t2, v2, scr, lane);
            }
#undef TR_DECODE
        }
        for (int m = gw; m < T; m += 2 * NGW) {
            const int m2 = m + NGW;
            const bool has2 = m2 < T;
            const f32x4* xr0 = (const f32x4*)(x + (size_t)m * DM) + lane;
            const f32x4* xr1 = (const f32x4*)(x + (size_t)(has2 ? m2 : m) * DM) + lane;
            f32x4 v0[4], v1[4]; float s0 = 0.f, s1 = 0.f;
#pragma unroll
            for (int j = 0; j < 4; ++j) { v0[j] = ld_nt(xr0 + 64 * j); v1[j] = ld_nt(xr1 + 64 * j); }
#pragma unroll
            for (int j = 0; j < 4; ++j) {
                s0 += (v0[j][0] * v0[j][0] + v0[j][1] * v0[j][1]) + (v0[j][2] * v0[j][2] + v0[j][3] * v0[j][3]);
                s1 += (v1[j][0] * v1[j][0] + v1[j][1] * v1[j][1]) + (v1[j][2] * v1[j][2] + v1[j][3] * v1[j][3]);
            }
            const float q0 = sqrtf(wave_sum(s0) * (1.0f / DM) + EPS), q1 = sqrtf(wave_sum(s1) * (1.0f / DM) + EPS);
            const float r0 = 1.0f / q0, r1 = 1.0f / q1;
            if (lane == 0) { XSC[m] = q0; if (has2) XSC[m2] = q1; }
            u32x2* o0 = (u32x2*)(XN + (size_t)m * DM) + lane; u32x2* o1 = (u32x2*)(XN + (size_t)m2 * DM) + lane;
#pragma unroll
            for (int j = 0; j < 4; ++j) { u32x2 w; w.x = cvt_pk_bf16(v0[j][0] * r0, v0[j][1] * r0); w.y = cvt_pk_bf16(v0[j][2] * r0, v0[j][3] * r0); o0[64 * j] = w; }
            if (has2) {
#pragma unroll
                for (int j = 0; j < 4; ++j) { u32x2 w; w.x = cvt_pk_bf16(v1[j][0] * r1, v1[j][1] * r1); w.y = cvt_pk_bf16(v1[j][2] * r1, v1[j][3] * r1); o1[64 * j] = w; }
            }
        }
        const float rope_inv = (float)pow(10000.0, -(double)(tid & 63) / 64.0);
        for (int i = bx * 512 + tid; i < SEQ * 64; i += G * 512) {
            const int pos = i >> 6;
            const float inv = rope_inv;
            const float ang = (float)pos * inv; float s, c; sincosf(ang, &s, &c);
            *(f32x2*)(ROPE + (size_t)i * 2) = (f32x2){c, s};
        }
        for (int i = bx * 512 + tid; i < 32 * 32 * 64; i += G * 512) {
            {
                const int q = i & 63, t = (i >> 6) & 31, g = i >> 11;
                const float lre = fminf(lam_re[g * 64 + q], -1e-4f), lim = lam_im[g * 64 + q], dt = expf(log_dt[g]);
                float pr, pi; s5_pow(lre, lim, dt, (float)(t + 1), pr, pi);
                float crv[16], civ[16];
#pragma unroll
                for (int c = 0; c < 16; ++c) { crv[c] = c_re[(g * 16 + c) * 64 + q]; civ[c] = c_im[(g * 16 + c) * 64 + q]; }
#pragma unroll
                for (int c = 0; c < 16; ++c) {
                    const float zr = crv[c] * pr - civ[c] * pi, zi = crv[c] * pi + civ[c] * pr;
                    bf16_t* row = TW + (size_t)(g * 512 + t * 16 + c) * 640 + 512;
                    row[q] = f2bf(zr); row[64 + q] = f2bf(-zi);
                }
            }
            {
                const int s = i & 31, p = (i >> 5) & 63, g = i >> 11;
                const float lre = fminf(lam_re[g * 64 + p], -1e-4f), lim = lam_im[g * 64 + p], dt = expf(log_dt[g]);
                float pr, pi, cr, ci; s5_pow(lre, lim, dt, (float)(31 - s), pr, pi); s5_coef(lre, lim, dt, cr, ci);
                const float wr_ = pr * cr - pi * ci, wi_ = pr * ci + pi * cr;
                float zr[16], zi[16];
#pragma unroll
                for (int c = 0; c < 16; ++c) { const float br = b_re[(g * 64 + p) * 16 + c], bi = b_im[(g * 64 + p) * 16 + c]; zr[c] = wr_ * br - wi_ * bi; zi[c] = wr_ * bi + wi_ * br; }
                u32x4* o0 = (u32x4*)(W1S + (size_t)(g * 128 + p) * 512 + s * 16);
                u32x4* o1 = (u32x4*)(W1S + (size_t)(g * 128 + 64 + p) * 512 + s * 16);
                u32x4 w;
                w.x = cvt_pk_bf16(zr[0], zr[1]); w.y = cvt_pk_bf16(zr[2], zr[3]); w.z = cvt_pk_bf16(zr[4], zr[5]); w.w = cvt_pk_bf16(zr[6], zr[7]); o0[0] = w;
                w.x = cvt_pk_bf16(zr[8], zr[9]); w.y = cvt_pk_bf16(zr[10], zr[11]); w.z = cvt_pk_bf16(zr[12], zr[13]); w.w = cvt_pk_bf16(zr[14], zr[15]); o0[1] = w;
                w.x = cvt_pk_bf16(zi[0], zi[1]); w.y = cvt_pk_bf16(zi[2], zi[3]); w.z = cvt_pk_bf16(zi[4], zi[5]); w.w = cvt_pk_bf16(zi[6], zi[7]); o1[0] = w;
                w.x = cvt_pk_bf16(zi[8], zi[9]); w.y = cvt_pk_bf16(zi[10], zi[11]); w.z = cvt_pk_bf16(zi[12], zi[13]); w.w = cvt_pk_bf16(zi[14], zi[15]); o1[1] = w;
            }
        }
        for (int i = bx * 512 + tid; i < 16384 * 64; i += G * 512) {
            const int piece = i & 63, row = i >> 6, t = (row >> 4) & 31;
            if (piece >= 2 * (t + 1)) *(u32x4*)(TW + (size_t)row * 640 + piece * 8) = (u32x4){0u, 0u, 0u, 0u};
        }
        __syncthreads();
        {
            LAS float* Bre = (LAS float*)lds; LAS float* Bim = Bre + 1024; LAS float* Cre = Bre + 2048; LAS float* Cim = Bre + 3072;
            LAS float* cpr = Bre + 4096; LAS float* cpi = cpr + 256;
            for (int it = bx; it < 256; it += G) {
                const int g = it >> 3, jq = it & 7;
                {
                    const int q0 = tid, q1 = tid + 512;
                    const float* s0 = (q0 < 256 ? b_re : b_im) + g * 1024 + (q0 & 255) * 4;
                    const float* s1 = (q1 < 768 ? c_re : c_im) + g * 1024 + (q1 & 255) * 4;
                    *(LAS f32x4*)(Bre + q0 * 4) = *(const f32x4*)s0;
                    *(LAS f32x4*)(Bre + q1 * 4) = *(const f32x4*)s1;
                }
                if (tid < 256) {
                    const int p = tid & 63, jl = tid >> 6;
                    const float lre = fminf(lam_re[g * 64 + p], -1e-4f), lim = lam_im[g * 64 + p], dt = expf(log_dt[g]);
                    float pr, pi, cr, ci; s5_pow(lre, lim, dt, (float)(4 * jq + jl), pr, pi); s5_coef(lre, lim, dt, cr, ci);
                    cpr[jl * 64 + p] = pr * cr - pi * ci; cpi[jl * 64 + p] = pr * ci + pi * cr;
                }
                __syncthreads();
                {
                    const int cc = tid & 255, c = cc >> 4, c2 = cc & 15, jh = tid >> 8;
                    float v0 = 0.f, v1 = 0.f;
#pragma unroll 8
                    for (int p = 0; p < 64; ++p) {
                        const float cr = Cre[c * 64 + p], ci = Cim[c * 64 + p], br = Bre[p * 16 + c2], bi = Bim[p * 16 + c2];
                        const float mr = cr * br - ci * bi, mi = cr * bi + ci * br;
                        v0 += mr * cpr[(2 * jh) * 64 + p] - mi * cpi[(2 * jh) * 64 + p];
                        v1 += mr * cpr[(2 * jh + 1) * 64 + p] - mi * cpi[(2 * jh + 1) * 64 + p];
                    }
                    const int jj0 = 4 * jq + 2 * jh;
                    const bf16_t w0 = f2bf(v0), w1 = f2bf(v1);
                    for (int t = jj0; t < 32; ++t) TW[(size_t)(g * 512 + t * 16 + c) * 640 + (t - jj0) * 16 + c2] = w0;
                    for (int t = jj0 + 1; t < 32; ++t) TW[(size_t)(g * 512 + t * 16 + c) * 640 + (t - jj0 - 1) * 16 + c2] = w1;
                }
                __syncthreads();
            }
        }
    }
    SEAM(0);

    if (IN(1)) for (int rep = 0; rep < REPS(1); ++rep) {
        pg8::Gemm g{XN, WIN, DM, DM, DM, 0, 0}; pg8::StaticOrder S; S.init(T, NIN, G, bx);
        pg8::EpiInProj E{QB, KB, VB, GB, AU, ROPE};
        pg8::gemm_phase(lds, g, S, E);
    }
    SEAM(1);

    if (IN(2)) for (int rep = 0; rep < REPS(2); ++rep) {
        const int fr = lane & 15, fq = lane >> 4;
        for (int it = bx; it < 256; it += G) {
            const int g = it >> 3, rt = it & 7;
            const bf16_t* pA = AU + (size_t)(g * 1024 + rt * 128) * 640; const bf16_t* pB = W1S + (size_t)(g * 128) * 512;
            f32x4 acc[8];
#pragma unroll
            for (int n = 0; n < 8; ++n) acc[n] = (f32x4){0.f, 0.f, 0.f, 0.f};
            u32x4 ra[4], rb[4];
            tile_issue(ra, pA, 640, tid); tile_issue(rb, pB, 512, tid);
            for (int kt = 0; kt < 4; ++kt) {
                tile_commit(lds, ra, tid); tile_commit(lds + TILE_B, rb, tid);
                __syncthreads();
                if (kt < 3) { tile_issue(ra, pA + (kt + 1) * 128, 640, tid); tile_issue(rb, pB + (kt + 1) * 128, 512, tid); }
                mma128<false, false>(acc, lds, lds_addr, 0, TILE_B, 16 * wave, lane);
                __syncthreads();
            }
            float* o = HINC + ((size_t)(g * 1024 + rt * 128 + 16 * wave + fr)) * 128 + 4 * fq;
#pragma unroll
            for (int n = 0; n < 8; ++n) *(f32x4*)(o + 16 * n) = acc[n];
        }
        {
            u32x4 rk[4], rv[4];
            int it = bx;
#define R1_ISSUE(IT) do { const int n_ = (IT) & 63, h_ = ((IT) >> 6) & 3, b_ = (IT) >> 8; const size_t t0_ = (size_t)b_ * SEQ + n_ * 128; \
                tile_issue(rk, KB + t0_ * 512 + h_ * 128, 512, tid); tile_issue(rv, VB + t0_ * 512 + h_ * 128, 512, tid); } while (0)
            if (it < 1024) R1_ISSUE(it);
            for (; it < 1024; it += G) {
                const int h = (it >> 6) & 3;
                const float l2g = ret_log2_gamma(h);
                tile_commit(lds, rk, tid); tile_commit_zeta(lds + TILE_B, rv, tid, l2g);
                __syncthreads();
                if (it + G < 1024) R1_ISSUE(it + G);
                f32x4 acc[8];
#pragma unroll
                for (int nb = 0; nb < 8; ++nb) acc[nb] = (f32x4){0.f, 0.f, 0.f, 0.f};
                mma128<true, true>(acc, lds, lds_addr, TILE_B, 0, 16 * wave, lane);
                bf16_t* o = SST + (size_t)it * 16384 + (16 * wave + fr) * 128 + 4 * fq;
#pragma unroll
                for (int nb = 0; nb < 8; ++nb) { u32x2 w; w.x = cvt_pk_bf16(acc[nb][0], acc[nb][1]); w.y = cvt_pk_bf16(acc[nb][2], acc[nb][3]); *(u32x2*)(o + 16 * nb) = w; }
                __syncthreads();
            }
#undef R1_ISSUE
        }
    }
    SEAM(2);

    if (IN(3)) for (int rep = 0; rep < REPS(3); ++rep) {
        for (int idx = bx * 512 + tid; idx < 16 * 8192; idx += G * 512) {
            const int bh = idx >> 13, e2 = idx & 8191, h = bh & 3;
            const float gch = exp2f(128.0f * ret_log2_gamma(h));
            const unsigned* sp = (const unsigned*)(SST + (size_t)bh * 64 * 16384 + 2 * e2);
            unsigned* rp = (unsigned*)(RTB + (size_t)bh * 64 * 16384 + 2 * e2);
            float r0 = 0.f, r1 = 0.f;
            for (int n0 = 0; n0 < 64; n0 += 16) {
                unsigned s[16];
#pragma unroll
                for (int j = 0; j < 16; ++j) s[j] = ld_nt(sp + (size_t)(n0 + j) * 8192);
#pragma unroll
                for (int j = 0; j < 16; ++j) { rp[(size_t)(n0 + j) * 8192] = cvt_pk_bf16(r0, r1); r0 = gch * r0 + bf_lo(s[j]); r1 = gch * r1 + bf_hi(s[j]); }
            }
        }
        {
            LAS float* X = (LAS float*)lds;
            for (int it = bx; it < 256; it += G) {
                const int ph = it & 1, g = (it >> 1) & 31, b = it >> 6, pl = tid & 31, p = 32 * ph + pl, seg = tid >> 5;
                const float lre = fminf(lam_re[g * 64 + p], -1e-4f), lim = lam_im[g * 64 + p], dt = expf(log_dt[g]);
                float ar, ai, Ar, Ai; s5_pow(lre, lim, dt, 32.0f, ar, ai); s5_pow(lre, lim, dt, 512.0f, Ar, Ai);
                const float* hp = HINC + ((size_t)(g * 1024 + b * 256 + seg * 16)) * 128 + p;
                float hr[16], hi_[16];
#pragma unroll
                for (int i = 0; i < 16; ++i) { hr[i] = hp[(size_t)i * 128]; hi_[i] = hp[(size_t)i * 128 + 64]; }
                float xr = 0.f, xi = 0.f;
#pragma unroll
                for (int i = 0; i < 16; ++i) { const float nr = ar * xr - ai * xi + hr[i], ni = ar * xi + ai * xr + hi_[i]; xr = nr; xi = ni; }
                X[(seg * 32 + pl) * 2] = xr; X[(seg * 32 + pl) * 2 + 1] = xi;
                __syncthreads();
                float cr = 0.f, ci = 0.f;
                for (int s2 = 0; s2 < seg; ++s2) { const float tr = X[(s2 * 32 + pl) * 2], ti = X[(s2 * 32 + pl) * 2 + 1]; const float nr = Ar * cr - Ai * ci + tr, ni = Ar * ci + Ai * cr + ti; cr = nr; ci = ni; }
                bf16_t* op = AU + ((size_t)(g * 1024 + b * 256 + seg * 16)) * 640 + 512 + p;
                xr = cr; xi = ci;
#pragma unroll
                for (int i = 0; i < 16; ++i) {
                    op[(size_t)i * 640] = f2bf(xr); op[(size_t)i * 640 + 64] = f2bf(xi);
                    const float nr = ar * xr - ai * xi + hr[i], ni = ar * xi + ai * xr + hi_[i]; xr = nr; xi = ni;
                }
                __syncthreads();
            }
        }
    }
    SEAM(3);

    if (IN(4)) for (int rep = 0; rep < REPS(4); ++rep) {
        const bool solo = (hi - lo == 1);
        if (!(solo && PROBE_P4_PART == 2)) for (int rep4 = 0; rep4 < (PROBE_P4_DUP == 1 ? 2 : 1); ++rep4) {
            pg8::Gemm g{AU, TW, 640, 640, 640, (size_t)1024 * 640, (size_t)512 * 640}; pg8::BatchOrder S{G, bx};
            pg8::EpiSsm E{AU, d_skip, YSSM};
            pg8::gemm_phase(lds, g, S, E);
        }
        const int fr = lane & 15, fq = lane >> 4;
        constexpr int OQ = 0, OK_ = TILE_B, OV = 2 * TILE_B, OR = 3 * TILE_B;
        for (int rep4 = 0; rep4 < (PROBE_P4_DUP == 2 ? 2 : 1); ++rep4) {
        u32x4 rq[4], rk[4], rv[4], rr[4];
        int it = bx;
#define R3_ISSUE_QK(IT) do { const int n_ = (IT) & 63, h_ = ((IT) >> 6) & 3, b_ = (IT) >> 8; const size_t t0_ = (size_t)b_ * SEQ + n_ * 128; \
            tile_issue_nt(rq, QB + t0_ * 512 + h_ * 128, 512, tid); tile_issue_nt(rk, KB + t0_ * 512 + h_ * 128, 512, tid); } while (0)
#define R3_ISSUE_VR(IT) do { const int n_ = (IT) & 63, h_ = ((IT) >> 6) & 3, b_ = (IT) >> 8; const size_t t0_ = (size_t)b_ * SEQ + n_ * 128; \
            tile_issue_nt(rv, VB + t0_ * 512 + h_ * 128, 512, tid); tile_issue_nt(rr, RTB + (size_t)(IT) * 16384, 128, tid); } while (0)
        if (solo && PROBE_P4_PART == 1) it = 1024;
        if (it < 1024) R3_ISSUE_QK(it);
        for (; it < 1024; it += G) {
            const int n = it & 63, h = (it >> 6) & 3, b = it >> 8;
            const float l2g = ret_log2_gamma(h);
            const size_t tok0 = (size_t)b * SEQ + n * 128;
            tile_commit(lds + OQ, rq, tid); tile_commit(lds + OK_, rk, tid);
            R3_ISSUE_VR(it);
            __syncthreads();
            const int i = 16 * wave + fr;
            f32x4 sc[8];
#pragma unroll
            for (int nb = 0; nb < 8; ++nb) sc[nb] = (f32x4){0.f, 0.f, 0.f, 0.f};
            mma128<false, false>(sc, lds, lds_addr, OQ, OK_, 16 * wave, lane);
            tile_commit(lds + OV, rv, tid); tile_commit(lds + OR, rr, tid);
            __syncthreads();
            if (it + G < 1024) R3_ISSUE_QK(it + G);
#pragma unroll
            for (int nb = 0; nb < 8; ++nb) {
                f32x4 pv;
#pragma unroll
                for (int e = 0; e < 4; ++e) { const int j = 16 * nb + 4 * fq + e; pv[e] = (i >= j) ? sc[nb][e] * exp2f((float)(i - j) * l2g) : 0.f; }
                u32x2 w; w.x = cvt_pk_bf16(pv[0], pv[1]); w.y = cvt_pk_bf16(pv[2], pv[3]);
                *(LAS u32x2*)(lds + OK_ + i * TS + (16 * nb + 4 * fq) * 2) = w;
            }
            LDS_WAIT();
            f32x4 a1[8], a2[8];
#pragma unroll
            for (int nb = 0; nb < 8; ++nb) { a1[nb] = (f32x4){0.f, 0.f, 0.f, 0.f}; a2[nb] = (f32x4){0.f, 0.f, 0.f, 0.f}; }
            mma128<false, true>(a1, lds, lds_addr, OK_, OV, 16 * wave, lane);
            mma128<false, false>(a2, lds, lds_addr, OQ, OR, 16 * wave, lane);
            const float xi = exp2f((float)(i + 1) * l2g);
            float s1 = 0.f, s2 = 0.f;
#pragma unroll
            for (int nb = 0; nb < 8; ++nb)
#pragma unroll
                for (int e = 0; e < 4; ++e) { const float o = a1[nb][e] + xi * a2[nb][e]; a1[nb][e] = o; s1 += o; s2 += o * o; }
            s1 += __shfl_xor(s1, 16); s1 += __shfl_xor(s1, 32); s2 += __shfl_xor(s2, 16); s2 += __shfl_xor(s2, 32);
            const float mu = s1 * (1.0f / 128.0f), var = fmaxf(s2 * (1.0f / 128.0f) - mu * mu, 0.f), rs = 1.0f / sqrtf(var + EPS);
            const size_t tok = tok0 + i;
            u32x2 gwv[8]; f32x4 ggv[8];
#pragma unroll
            for (int nb = 0; nb < 8; ++nb) { gwv[nb] = ld_nt((const u32x2*)(GB + tok * 512 + h * 128 + 16 * nb + 4 * fq)); ggv[nb] = *(const f32x4*)(gn_gain + h * 128 + 16 * nb + 4 * fq); }
#pragma unroll
            for (int nb = 0; nb < 8; ++nb) {
                const int d = 16 * nb + 4 * fq;
                const u32x2 gw = gwv[nb];
                const f32x4 gg = ggv[nb];
                const float g0 = bf_lo(gw.x), g1 = bf_hi(gw.x), g2 = bf_lo(gw.y), g3 = bf_hi(gw.y);
                const float y0 = (a1[nb][0] - mu) * rs * gg[0] * (g0 / (1.0f + __expf(-g0)));
                const float y1 = (a1[nb][1] - mu) * rs * gg[1] * (g1 / (1.0f + __expf(-g1)));
                const float y2 = (a1[nb][2] - mu) * rs * gg[2] * (g2 / (1.0f + __expf(-g2)));
                const float y3 = (a1[nb][3] - mu) * rs * gg[3] * (g3 / (1.0f + __expf(-g3)));
                u32x2 w; w.x = cvt_pk_bf16(y0, y1); w.y = cvt_pk_bf16(y2, y3);
                *(u32x2*)(YMIX + tok * 1024 + h * 128 + d) = w;
            }
            __syncthreads();
        }
        }
    }
#undef R3_ISSUE_QK
#undef R3_ISSUE_VR
    SEAM(4);

    if (IN(5)) for (int rep = 0; rep < REPS(5); ++rep) {
        pg8::Gemm g{YSSM, WGLU, 512, 512, 512, 0, 0}; pg8::StaticOrder S; S.init(T, 1024, G, bx);
        pg8::EpiGlu E{YMIX};
        pg8::gemm_phase(lds, g, S, E);
    }
    SEAM(5);

    if (IN(6)) for (int rep = 0; rep < REPS(6); ++rep) {
        pg8::Gemm g{YMIX, WOUT, DM, DM, DM, 0, 0}; pg8::StaticOrder S; S.init(T, DM, G, bx);
        pg8::EpiSS E{MIXB, SS};
        pg8::gemm_phase(lds, g, S, E);
    }
    SEAM(6);

    if (IN(7)) for (int rep = 0; rep < REPS(7); ++rep) {
        const int gw = bx * 8 + wave, NGW = G * 8;
        const f32x4* gr = (const f32x4*)g_mix_post + lane;
        f32x4 gv[4];
#pragma unroll
        for (int j = 0; j < 4; ++j) gv[j] = gr[64 * j];
        for (int m0 = gw; m0 < T; m0 += 2 * NGW) {
            f32x4 xv[2][4]; u32x2 mw[2][4]; float rs[2];
#pragma unroll
            for (int r = 0; r < 2; ++r) {
                const int m = (m0 + r * NGW < T) ? m0 + r * NGW : m0;
                const f32x4 pa = *((const f32x4*)(SS + (size_t)m * 16) + (lane & 3));
                float sa = (pa[0] + pa[1]) + (pa[2] + pa[3]); sa += __shfl_xor(sa, 1); sa += __shfl_xor(sa, 2);
                rs[r] = 1.0f / sqrtf(sa * (1.0f / DM) + EPS);
                const u32x2* xr = (const u32x2*)(XN + (size_t)m * DM) + lane; const u32x2* mr = (const u32x2*)(MIXB + (size_t)m * DM) + lane;
                const float xs = XSC[m];
#pragma unroll
                for (int j = 0; j < 4; ++j) { const u32x2 xw = ld_nt(xr + 64 * j); xv[r][j] = (f32x4){bf_lo(xw.x) * xs, bf_hi(xw.x) * xs, bf_lo(xw.y) * xs, bf_hi(xw.y) * xs}; mw[r][j] = ld_nt(mr + 64 * j); }
            }
#pragma unroll
            for (int r = 0; r < 2; ++r) {
                const int m = m0 + r * NGW;
                if (m < T) {
                    float sq = 0.f;
#pragma unroll
                    for (int j = 0; j < 4; ++j) {
                        f32x4& v = xv[r][j];
                        v[0] += bf_lo(mw[r][j].x) * rs[r] * gv[j][0]; v[1] += bf_hi(mw[r][j].x) * rs[r] * gv[j][1];
                        v[2] += bf_lo(mw[r][j].y) * rs[r] * gv[j][2]; v[3] += bf_hi(mw[r][j].y) * rs[r] * gv[j][3];
                        sq += (v[0] * v[0] + v[1] * v[1]) + (v[2] * v[2] + v[3] * v[3]);
                    }
                    const float rstd1 = 1.0f / sqrtf(wave_sum(sq) * (1.0f / DM) + EPS);
                    u32x2* o8 = (u32x2*)(XN + (size_t)m * DM) + lane;
#pragma unroll
                    for (int j = 0; j < 4; ++j) { const f32x4 v = xv[r][j]; u32x2 w; w.x = cvt_pk_bf16(v[0] * rstd1, v[1] * rstd1); w.y = cvt_pk_bf16(v[2] * rstd1, v[3] * rstd1); o8[64 * j] = w; }
                }
            }
        }
    }
    SEAM(7);

    if (IN(8)) for (int rep = 0; rep < REPS(8); ++rep) {
        pg8::Gemm g{XN, WFF1, DM, DM, DM, 0, 0}; pg8::StaticOrder S; S.init(T, DFF, G, bx);
        pg8::EpiRelu2 E{HID};
        pg8::gemm_phase(lds, g, S, E);
    }
    SEAM(8);

    if (IN(9)) for (int rep = 0; rep < REPS(9); ++rep) {
        pg8::Gemm g{HID, WFF2, DFF, DFF, DFF, 0, 0}; pg8::StaticOrder S; S.init(T, DM, G, bx);
        pg8::EpiSS E{MB, SS2};
        pg8::gemm_phase(lds, g, S, E);
    }
    SEAM(9);

    if (IN(10)) {
        const int gw = bx * 8 + wave, NGW = G * 8;
        const f32x4* g1r = (const f32x4*)g_mix_post + lane; const f32x4* g2r = (const f32x4*)g_mlp_post + lane;
        f32x4 ga[4], gb[4];
#pragma unroll
        for (int j = 0; j < 4; ++j) { ga[j] = g1r[64 * j]; gb[j] = g2r[64 * j]; }
        for (int m0 = gw; m0 < T; m0 += 2 * NGW) {
            f32x4 xv[2][4]; u32x2 aw[2][4], mw[2][4]; float r1[2], r2[2];
#pragma unroll
            for (int r = 0; r < 2; ++r) {
                const int m = (m0 + r * NGW < T) ? m0 + r * NGW : m0;
                const f32x4 pa = *((const f32x4*)(SS + (size_t)m * 16) + (lane & 3)), pb = *((const f32x4*)(SS2 + (size_t)m * 16) + (lane & 3));
                float sa = (pa[0] + pa[1]) + (pa[2] + pa[3]), sb = (pb[0] + pb[1]) + (pb[2] + pb[3]);
                sa += __shfl_xor(sa, 1); sa += __shfl_xor(sa, 2); sb += __shfl_xor(sb, 1); sb += __shfl_xor(sb, 2);
                r1[r] = 1.0f / sqrtf(sa * (1.0f / DM) + EPS); r2[r] = 1.0f / sqrtf(sb * (1.0f / DM) + EPS);
                const f32x4* xr = (const f32x4*)(x + (size_t)m * DM) + lane;
                const u32x2* ar = (const u32x2*)(MIXB + (size_t)m * DM) + lane; const u32x2* mr = (const u32x2*)(MB + (size_t)m * DM) + lane;
#pragma unroll
                for (int j = 0; j < 4; ++j) { xv[r][j] = ld_nt(xr + 64 * j); aw[r][j] = ld_nt(ar + 64 * j); mw[r][j] = ld_nt(mr + 64 * j); }
            }
#pragma unroll
            for (int r = 0; r < 2; ++r) {
                const int m = m0 + r * NGW;
                if (m < T) {
                    f32x4* orow = (f32x4*)(out + (size_t)m * DM) + lane;
#pragma unroll
                    for (int j = 0; j < 4; ++j) {
                        f32x4 v = xv[r][j];
                        v[0] = (v[0] + bf_lo(aw[r][j].x) * r1[r] * ga[j][0]) + bf_lo(mw[r][j].x) * r2[r] * gb[j][0]; v[1] = (v[1] + bf_hi(aw[r][j].x) * r1[r] * ga[j][1]) + bf_hi(mw[r][j].x) * r2[r] * gb[j][1];
                        v[2] = (v[2] + bf_lo(aw[r][j].y) * r1[r] * ga[j][2]) + bf_lo(mw[r][j].y) * r2[r] * gb[j][2]; v[3] = (v[3] + bf_hi(aw[r][j].y) * r1[r] * ga[j][3]) + bf_hi(mw[r][j].y) * r2[r] * gb[j][3];
                        st_nt(orow + 64 * j, v);
                    }
                }
            }
        }
    }
#undef IN
#undef SEAM
}

extern "C" void kernel_launch(void* const* d_in, const int* in_sizes, int n_in, void* d_out, int out_size, void* d_ws, size_t ws_size, hipStream_t stream) {
    static int grid = 0;
    if (grid == 0) {
        int dev = 0, cus = 0, per_cu = 0;
        hipGetDevice(&dev);
        hipDeviceGetAttribute(&cus, hipDeviceAttributeMultiprocessorCount, dev);
        hipFuncSetAttribute((const void*)fwd_kernel, hipFuncAttributeMaxDynamicSharedMemorySize, LDS_BYTES);
        if (hipOccupancyMaxActiveBlocksPerMultiprocessor(&per_cu, (const void*)fwd_kernel, 512, LDS_BYTES) != hipSuccess || per_cu < 1) per_cu = 1;
        (void)hipGetLastError();
        grid = cus * per_cu;
        if (grid <= 0) grid = 256;
    }
    Args a{};
    for (int i = 0; i < 19; ++i) a.in[i] = (const float*)d_in[i];
    a.out = (float*)d_out; a.ws = (unsigned char*)d_ws;
#if N_LAUNCH_PER_PHASE
    for (int ph = 0; ph < NPHASE; ++ph) {
        a.ph_lo = ph; a.ph_hi = ph + 1;
        void* args[] = {&a};
        hipError_t e = hipLaunchCooperativeKernel((const void*)fwd_kernel, dim3(grid), dim3(512), args, LDS_BYTES, stream);
        if (e != hipSuccess) { fprintf(stderr, "cooperative launch (phase %d) failed: %s (grid %d)\n", ph, hipGetErrorString(e), grid); break; }
    }
#else
    a.ph_lo = 0; a.ph_hi = NPHASE;
    (void)hipMemsetAsync(d_ws, 0, 16384, stream);
    void* args[] = {&a};
    hipError_t e = hipLaunchCooperativeKernel((const void*)fwd_kernel, dim3(grid), dim3(512), args, LDS_BYTES, stream);
    if (e != hipSuccess) fprintf(stderr, "cooperative launch failed: %s (grid %d)\n", hipGetErrorString(e), grid);
#ifdef PROBE_EXTRA_PHASE
    {
        Args b = a; b.ph_lo = PROBE_EXTRA_PHASE; b.ph_hi = PROBE_EXTRA_PHASE + 1;
        void* args2[] = {&b};
        (void)hipLaunchCooperativeKernel((const void*)fwd_kernel, dim3(grid), dim3(512), args2, LDS_BYTES, stream);
    }
#endif
#endif
}
```

```cpp
#include <hip/hip_runtime.h>
#include <hip/hip_cooperative_groups.h>
#include <cstdio>
namespace cg = cooperative_groups;

#ifndef N_LAUNCH_PER_PHASE
#define N_LAUNCH_PER_PHASE 0
#endif

#ifndef PROBE_P4_DUP
#define PROBE_P4_DUP 0
#endif
#ifndef PROBE_P4_PART
#define PROBE_P4_PART 0
#endif
#ifndef PROBE_DUP
#define PROBE_DUP 0
#endif
#define REPS(k) (1 + ((PROBE_DUP >> (k)) & 1))
#define LAS __attribute__((address_space(3)))
typedef unsigned short bf16_t;
typedef short bf16x8 __attribute__((ext_vector_type(8)));
typedef float f32x4 __attribute__((ext_vector_type(4)));
typedef float f32x2 __attribute__((ext_vector_type(2)));
typedef unsigned u32x4 __attribute__((ext_vector_type(4)));
typedef unsigned u32x2 __attribute__((ext_vector_type(2)));

constexpr int T = 32768, SEQ = 8192, DM = 1024, NIN = 2560, DFF = 4096;
constexpr float EPS = 1e-6f;
constexpr int NPHASE = 11;

constexpr size_t MiB = 1u << 20;
constexpr size_t WS_WIN = 1 * MiB, WS_WGLU = 6 * MiB, WS_WOUT = 7 * MiB, WS_WFF1 = 9 * MiB, WS_WFF2 = 17 * MiB;
constexpr size_t WS_ROPE = 25 * MiB, WS_TW = 29 * MiB, WS_W1S = 49 * MiB, WS_SS = 53 * MiB, WS_SS2 = 55 * MiB, WS_HINC = 57 * MiB;
constexpr size_t WS_XN = 80 * MiB;
constexpr size_t WS_QB = 144 * MiB, WS_KB = 176 * MiB, WS_VB = 208 * MiB, WS_GB = 240 * MiB, WS_AU = 272 * MiB;
constexpr size_t WS_SST = 440 * MiB, WS_RTB = 376 * MiB, WS_YSSM = 408 * MiB;
constexpr size_t WS_YMIX = 312 * MiB;
constexpr size_t WS_HID = 144 * MiB;
constexpr size_t WS_MIXB = 400 * MiB;
constexpr size_t WS_MB = 80 * MiB;

constexpr int LDS_BYTES = 147456;
constexpr int TS = 272;
constexpr int TILE_B = 128 * TS;

typedef __bf16 bf16x2_t __attribute__((ext_vector_type(2)));
__device__ __forceinline__ unsigned cvt_pk_bf16(float lo, float hi) { f32x2 v = {lo, hi}; return __builtin_bit_cast(unsigned, __builtin_convertvector(v, bf16x2_t)); }
__device__ __forceinline__ float bf_lo(unsigned w) { return __uint_as_float(w << 16); }
__device__ __forceinline__ float bf_hi(unsigned w) { return __uint_as_float(w & 0xffff0000u); }
__device__ __forceinline__ bf16_t f2bf(float f) { return (bf16_t)(cvt_pk_bf16(f, 0.f) & 0xffffu); }
__device__ __forceinline__ float wave_sum(float v) {
#pragma unroll
    for (int o = 1; o < 64; o <<= 1) v += __shfl_xor(v, o);
    return v;
}
#define LDS_WAIT() asm volatile("s_waitcnt lgkmcnt(0)" ::: "memory")
__device__ __forceinline__ float frcp(float x) { return __builtin_amdgcn_rcpf(x); }
__device__ __forceinline__ float fex2(float x) { return __builtin_amdgcn_exp2f(x); }
__device__ __forceinline__ float fsigm(float x) { return frcp(1.0f + fex2(-1.4426950408889634f * x)); }
template <class Tv> __device__ __forceinline__ Tv ld_nt(const Tv* p) { return __builtin_nontemporal_load(p); }
__device__ __forceinline__ void st_nt(f32x4* p, f32x4 v) { __builtin_nontemporal_store(v, p); }

namespace pg8 {
constexpr int BM = 256, BK = 64, HALF = 128, HTB = HALF * BK * 2, STAGE_BYTES = 8 * HTB, NXCD = 8, WGM = 8;
__device__ __forceinline__ int lds_byte(int r, int c) { const int st = (r >> 4) * 2 + (c >> 5), rr = r & 15, cc = c & 31, ob = rr * 64 + cc * 2; return st * 1024 + (ob ^ (((ob >> 9) & 1) << 5)); }
__device__ __forceinline__ void stage_rc(int b, int& R, int& C) { const int st = b / 1024, sb = b % 1024, swz = sb ^ (((sb >> 9) & 1) << 5); R = (st >> 1) * 16 + swz / 64; C = (st & 1) * 32 + (swz % 64) / 2; }
__device__ __forceinline__ int perm32(int rho) { const int n = rho >> 4, i = rho & 15; return 8 * (i >> 2) + 4 * n + (i & 3); }

struct Unit { int pm, pn, pb; };
struct Gemm { const bf16_t* A; const bf16_t* Bt; int lda, ldb, K; size_t bsA, bsB; };

struct StaticOrder {
    int nM, nN, nwg, G, c;
    __device__ void init(int M, int N, int G_, int c_) { nM = M / BM; nN = N / BM; nwg = nM * nN; G = G_; c = c_; }
    __device__ bool next(int i, Unit& u) const {
        const long L = (long)i * G + c; if (L >= nwg) return false;
        int wgid = (int)L; { const int q = nwg / NXCD, r = nwg % NXCD, xcd = wgid % NXCD, off = wgid / NXCD; wgid = (xcd < r ? xcd * (q + 1) : r * (q + 1) + (xcd - r) * q) + off; }
        const int nig = WGM * nN, gid = wgid / nig, fm = gid * WGM, gsz = (nM - fm) < WGM ? (nM - fm) : WGM;
        u.pm = fm + ((wgid % nig) % gsz); u.pn = (wgid % nig) / gsz; u.pb = 0; return true;
    }
};
struct BatchOrder {
    int G, c;
    __device__ bool next(int i, Unit& u) const {
        const int L = i * G + c; if (L >= 256) return false;
        const int xcd = L & 7, slot = L >> 3;
        u.pb = xcd * 4 + (slot >> 3); const int r = slot & 7; u.pm = r & 3; u.pn = r >> 2; return true;
    }
};

template <class Epi, class Sched, bool ALIGN_EPI = true, bool SP2 = true>
__device__ __forceinline__ void gemm_phase(LAS unsigned char* lds, const Gemm g, const Sched& S, const Epi& E) {
    const int tid = threadIdx.x, wid = __builtin_amdgcn_readfirstlane(tid >> 6), lane = tid & 63, wr = wid >> 2, wc = wid & 3, fr = lane & 15, fq = lane >> 4;
    const int K = g.K, nt = K / BK;
    unsigned voffA[2], voffB[2];
#pragma unroll
    for (int i = 0; i < 2; ++i) { int R, C; stage_rc(tid * 16 + i * 8192, R, C); const int Rb = Epi::PERM ? ((R & ~31) + perm32(R & 31)) : R;
        voffA[i] = (unsigned)(R * g.lda + C) * 2u; voffB[i] = (unsigned)(Rb * g.ldb + C) * 2u; }
    const size_t kstep = (size_t)(BK * 2);
    const size_t hstepA = (size_t)HALF * g.lda * 2, hstepB = (size_t)HALF * g.ldb * 2;
    const size_t tstepA = 2 * hstepA, tstepB = 2 * hstepB;
    const unsigned ldsw = (unsigned)wid * 1024u;
    const int aoff = lds_byte(wr * 64 + fr, fq * 8), boff = lds_byte(wc * 32 + fr, fq * 8);
#define PG8_SA(b, h) (((b) * 2 + (h)) * HTB)
#define PG8_SB(b, h) ((4 + (b) * 2 + (h)) * HTB)
#define PG8_STAGE(bufoff, gbase, voff) do { _Pragma("unroll") for (int _i = 0; _i < 2; ++_i) \
        __builtin_amdgcn_global_load_lds((const unsigned*)((const char*)(gbase) + (voff)[_i]), (LAS unsigned*)(lds + (bufoff) + ldsw + _i * 8192), 16, 0, 0); } while (0)
#define PG8_LDA(dst, b, h) do { _Pragma("unroll") for (int m = 0; m < 4; ++m) _Pragma("unroll") for (int k = 0; k < 2; ++k) dst[m][k] = *(const LAS bf16x8*)(lds + PG8_SA(b, h) + aoff + m * 2048 + k * 1024); } while (0)
#define PG8_LDB(dst, b, h) do { _Pragma("unroll") for (int n = 0; n < 2; ++n) _Pragma("unroll") for (int k = 0; k < 2; ++k) dst[n][k] = *(const LAS bf16x8*)(lds + PG8_SB(b, h) + boff + n * 2048 + k * 1024); } while (0)
#define PG8_MMA(ai, bj, At, Bt) do { __builtin_amdgcn_s_setprio(1); _Pragma("unroll") for (int m = 0; m < 4; ++m) _Pragma("unroll") for (int n = 0; n < 2; ++n) _Pragma("unroll") for (int k = 0; k < 2; ++k) \
        acc[ai][bj][m][n] = __builtin_amdgcn_mfma_f32_16x16x32_bf16(Bt[n][k], At[m][k], acc[ai][bj][m][n], 0, 0, 0); __builtin_amdgcn_s_setprio(0); } while (0)
#define PG8_WAIT_V(n) asm volatile("s_waitcnt vmcnt(" #n ")" ::: "memory")
#define PG8_WAIT_L(n) asm volatile("s_waitcnt lgkmcnt(" #n ")" ::: "memory")
#define PG8_BAR __builtin_amdgcn_s_barrier()
#define PG8_SCHED __builtin_amdgcn_sched_barrier(0)
    Unit cur, nxt; int ui = 0;
    if (!S.next(0, cur)) return;
    f32x4 acc[2][2][4][2];
#pragma unroll
    for (int a = 0; a < 2; ++a)
#pragma unroll
        for (int b = 0; b < 2; ++b)
#pragma unroll
            for (int m = 0; m < 4; ++m)
#pragma unroll
                for (int n = 0; n < 2; ++n) acc[a][b][m][n] = (f32x4){0.f, 0.f, 0.f, 0.f};
    bf16x8 At[4][2], B0[2][2], B1[2][2];
    const char* cA = (const char*)g.A + (size_t)cur.pb * g.bsA * 2 + (size_t)cur.pm * tstepA;
    const char* cB = (const char*)g.Bt + (size_t)cur.pb * g.bsB * 2 + (size_t)cur.pn * tstepB;
    if constexpr (SP2) {
        PG8_STAGE(PG8_SB(0, 0), cB, voffB); PG8_STAGE(PG8_SB(0, 1), cB + hstepB, voffB); PG8_STAGE(PG8_SA(0, 0), cA, voffA); PG8_STAGE(PG8_SA(0, 1), cA + hstepA, voffA);
        if (wr == 1) PG8_BAR;
        PG8_WAIT_V(2); PG8_BAR;
        PG8_STAGE(PG8_SB(1, 0), cB + kstep, voffB); PG8_STAGE(PG8_SA(1, 0), cA + kstep, voffA); PG8_STAGE(PG8_SB(1, 1), cB + hstepB + kstep, voffB);
        PG8_WAIT_V(6); PG8_BAR;
    } else {
        PG8_STAGE(PG8_SB(0, 0), cB, voffB); PG8_STAGE(PG8_SA(0, 0), cA, voffA); PG8_STAGE(PG8_SB(0, 1), cB + hstepB, voffB); PG8_STAGE(PG8_SA(0, 1), cA + hstepA, voffA);
        if (wr == 1) PG8_BAR;
        PG8_WAIT_V(4); PG8_BAR;
        PG8_STAGE(PG8_SB(1, 0), cB + kstep, voffB); PG8_STAGE(PG8_SA(1, 0), cA + kstep, voffA); PG8_STAGE(PG8_SB(1, 1), cB + hstepB + kstep, voffB);
        PG8_WAIT_V(6); PG8_BAR;
    }
    for (;;) {
        const bool has_next = S.next(ui + 1, nxt);
        const char* nA = has_next ? (const char*)g.A + (size_t)nxt.pb * g.bsA * 2 + (size_t)nxt.pm * tstepA : cA;
        const char* nB = has_next ? (const char*)g.Bt + (size_t)nxt.pb * g.bsB * 2 + (size_t)nxt.pn * tstepB : cB;
        for (int t = 0; t < nt; t += 2) {
            const bool last = (t == nt - 2);
            const char* a1 = cA + (size_t)(t + 1) * kstep;
            const char* a2 = last ? nA : cA + (size_t)(t + 2) * kstep; const char* b2 = last ? nB : cB + (size_t)(t + 2) * kstep;
            const char* a3 = a2 + kstep; const char* b3 = b2 + kstep;
            if constexpr (SP2) {
            PG8_LDB(B0, 0, 0); PG8_LDB(B1, 0, 1); PG8_SCHED; PG8_LDA(At, 0, 0); PG8_STAGE(PG8_SA(1, 1), a1 + hstepA, voffA);
            PG8_WAIT_V(8); PG8_WAIT_L(0); PG8_BAR; PG8_MMA(0, 0, At, B0); PG8_MMA(0, 1, At, B1); PG8_BAR; PG8_SCHED;
            PG8_LDA(At, 0, 1); PG8_STAGE(PG8_SB(0, 0), b2, voffB); PG8_STAGE(PG8_SB(0, 1), b2 + hstepB, voffB); PG8_STAGE(PG8_SA(0, 0), a2, voffA);
            PG8_WAIT_V(8); PG8_WAIT_L(0); PG8_BAR; PG8_MMA(1, 0, At, B0); PG8_MMA(1, 1, At, B1); PG8_BAR; PG8_SCHED;
            PG8_LDB(B0, 1, 0); PG8_LDB(B1, 1, 1); PG8_SCHED; PG8_LDA(At, 1, 0); PG8_STAGE(PG8_SA(0, 1), a2 + hstepA, voffA);
            PG8_WAIT_V(8); PG8_WAIT_L(0); PG8_BAR; PG8_MMA(0, 0, At, B0); PG8_MMA(0, 1, At, B1); PG8_BAR; PG8_SCHED;
            PG8_LDA(At, 1, 1); PG8_STAGE(PG8_SB(1, 0), b3, voffB); PG8_STAGE(PG8_SB(1, 1), b3 + hstepB, voffB); PG8_STAGE(PG8_SA(1, 0), a3, voffA);
            PG8_WAIT_V(8); PG8_WAIT_L(0); PG8_BAR; PG8_MMA(1, 0, At, B0); PG8_MMA(1, 1, At, B1); PG8_BAR; PG8_SCHED;
            } else {
            PG8_LDB(B0, 0, 0); PG8_SCHED; PG8_LDA(At, 0, 0); PG8_STAGE(PG8_SA(1, 1), a1 + hstepA, voffA);
            PG8_WAIT_L(8); PG8_BAR; PG8_WAIT_L(0); PG8_MMA(0, 0, At, B0); PG8_BAR; PG8_SCHED;
            PG8_LDB(B1, 0, 1); PG8_STAGE(PG8_SB(0, 0), b2, voffB);
            PG8_BAR; PG8_WAIT_L(0); PG8_MMA(0, 1, At, B1); PG8_BAR;
            PG8_LDA(At, 0, 1); PG8_STAGE(PG8_SA(0, 0), a2, voffA);
            PG8_BAR; PG8_WAIT_L(0); PG8_MMA(1, 0, At, B0); PG8_BAR; PG8_SCHED;
            PG8_STAGE(PG8_SB(0, 1), b2 + hstepB, voffB);
            PG8_WAIT_V(6); PG8_BAR; PG8_MMA(1, 1, At, B1); PG8_BAR;
            PG8_LDB(B0, 1, 0); PG8_SCHED; PG8_LDA(At, 1, 0); PG8_STAGE(PG8_SA(0, 1), a2 + hstepA, voffA);
            PG8_WAIT_L(8); PG8_BAR; PG8_WAIT_L(0); PG8_MMA(0, 0, At, B0); PG8_BAR; PG8_SCHED;
            PG8_LDB(B1, 1, 1); PG8_STAGE(PG8_SB(1, 0), b3, voffB);
            PG8_BAR; PG8_WAIT_L(0); PG8_MMA(0, 1, At, B1); PG8_BAR;
            PG8_LDA(At, 1, 1); PG8_STAGE(PG8_SA(1, 0), a3, voffA);
            PG8_BAR; PG8_WAIT_L(0); PG8_MMA(1, 0, At, B0); PG8_BAR; PG8_SCHED;
            PG8_STAGE(PG8_SB(1, 1), b3 + hstepB, voffB);
            PG8_WAIT_V(6); PG8_BAR; PG8_MMA(1, 1, At, B1); PG8_BAR;
            }
        }
        if constexpr (ALIGN_EPI) { if (wr == 0) PG8_BAR; }
        E(acc, cur, wr, wc, fr, fq);
        if (!has_next) break;
#pragma unroll
        for (int a = 0; a < 2; ++a)
#pragma unroll
            for (int b = 0; b < 2; ++b)
#pragma unroll
                for (int m = 0; m < 4; ++m)
#pragma unroll
                    for (int n = 0; n < 2; ++n) acc[a][b][m][n] = (f32x4){0.f, 0.f, 0.f, 0.f};
        cur = nxt; cA = nA; cB = nB; ++ui;
        if constexpr (ALIGN_EPI) { if (wr == 1) PG8_BAR; }
    }
    PG8_WAIT_V(0);
    if constexpr (!ALIGN_EPI) { if (wr == 0) PG8_BAR; }
    PG8_BAR;
#undef PG8_SA
#undef PG8_SB
#undef PG8_STAGE
#undef PG8_LDA
#undef PG8_LDB
#undef PG8_MMA
#undef PG8_WAIT_V
#undef PG8_WAIT_L
#undef PG8_BAR
#undef PG8_SCHED
}

__device__ __forceinline__ u32x4 pack8(const f32x4 v0, const f32x4 v1) {
    u32x4 w; w.x = cvt_pk_bf16(v0[0], v0[1]); w.y = cvt_pk_bf16(v0[2], v0[3]); w.z = cvt_pk_bf16(v1[0], v1[1]); w.w = cvt_pk_bf16(v1[2], v1[3]); return w;
}
__device__ __forceinline__ f32x4 rope4(const f32x4 v, const f32x4 cs) {
    f32x4 r; r[0] = v[0] * cs[0] - v[1] * cs[1]; r[1] = v[0] * cs[1] + v[1] * cs[0]; r[2] = v[2] * cs[2] - v[3] * cs[3]; r[3] = v[2] * cs[3] + v[3] * cs[2]; return r;
}
struct EpiInProj {
    static constexpr bool PERM = true;
    bf16_t *Q, *Kb, *V, *Gt, *AU; const float* rope;
    __device__ __forceinline__ void operator()(const f32x4 (&acc)[2][2][4][2], const Unit& u, int wr, int wc, int fr, int fq) const {
        const int sect = u.pn >> 1;
        const int row0 = u.pm * BM + wr * 64 + fr;
        const int colt = (u.pn & 1) * 256 + wc * 32 + 8 * fq;
        if (sect <= 1) {
            bf16_t* O = sect ? Kb : Q;
            f32x4 cs[2][4][2];
#pragma unroll
            for (int ai = 0; ai < 2; ++ai)
#pragma unroll
                for (int m = 0; m < 4; ++m) {
                    const int pos = (row0 + ai * HALF + m * 16) & (SEQ - 1);
                    const float* rp = rope + ((size_t)pos * 64 + 16 * wc + 4 * fq) * 2;
                    cs[ai][m][0] = *(const f32x4*)rp; cs[ai][m][1] = *(const f32x4*)(rp + 4);
                }
#pragma unroll
            for (int ai = 0; ai < 2; ++ai)
#pragma unroll
                for (int m = 0; m < 4; ++m) {
                    const int row = row0 + ai * HALF + m * 16;
#pragma unroll
                    for (int bj = 0; bj < 2; ++bj) {
                        const f32x4 v0 = rope4(acc[ai][bj][m][0], cs[ai][m][0]), v1 = rope4(acc[ai][bj][m][1], cs[ai][m][1]);
                        *(u32x4*)(O + (size_t)row * 512 + colt + bj * HALF) = pack8(v0, v1);
                    }
                }
        } else if (sect <= 3) {
            bf16_t* O = (sect == 2) ? V : Gt;
#pragma unroll
            for (int ai = 0; ai < 2; ++ai)
#pragma unroll
                for (int m = 0; m < 4; ++m) {
                    const int row = row0 + ai * HALF + m * 16;
#pragma unroll
                    for (int bj = 0; bj < 2; ++bj) *(u32x4*)(O + (size_t)row * 512 + colt + bj * HALF) = pack8(acc[ai][bj][m][0], acc[ai][bj][m][1]);
                }
        } else {
#pragma unroll
            for (int ai = 0; ai < 2; ++ai)
#pragma unroll
                for (int m = 0; m < 4; ++m) {
                    const int row = row0 + ai * HALF + m * 16, cr = row >> 5, s = row & 31;
#pragma unroll
                    for (int bj = 0; bj < 2; ++bj) {
                        const int cu = colt + bj * HALF, g = cu >> 4, c0 = cu & 15;
                        *(u32x4*)(AU + ((size_t)(g * 1024 + cr) * 640 + s * 16 + c0)) = pack8(acc[ai][bj][m][0], acc[ai][bj][m][1]);
                    }
                }
        }
    }
};
struct EpiGlu {
    static constexpr bool PERM = true;
    bf16_t* Y;
    __device__ __forceinline__ void operator()(const f32x4 (&acc)[2][2][4][2], const Unit& u, int wr, int wc, int fr, int fq) const {
        const int row0 = u.pm * BM + wr * 64 + fr, col = 512 + u.pn * 128 + wc * 32 + 8 * fq;
#pragma unroll
        for (int ai = 0; ai < 2; ++ai)
#pragma unroll
            for (int m = 0; m < 4; ++m) {
                const int row = row0 + ai * HALF + m * 16;
                f32x4 y0, y1;
#pragma unroll
                for (int j = 0; j < 4; ++j) {
                    y0[j] = acc[ai][0][m][0][j] * fsigm(acc[ai][1][m][0][j]);
                    y1[j] = acc[ai][0][m][1][j] * fsigm(acc[ai][1][m][1][j]);
                }
                *(u32x4*)(Y + (size_t)row * 1024 + col) = pack8(y0, y1);
            }
    }
};
struct EpiSS {
    static constexpr bool PERM = true;
    bf16_t* O; float* SS;
    __device__ __forceinline__ void operator()(const f32x4 (&acc)[2][2][4][2], const Unit& u, int wr, int wc, int fr, int fq) const {
        const int row0 = u.pm * BM + wr * 64 + fr, col = u.pn * BM + wc * 32 + 8 * fq;
#pragma unroll
        for (int ai = 0; ai < 2; ++ai)
#pragma unroll
            for (int m = 0; m < 4; ++m) {
                const int row = row0 + ai * HALF + m * 16; float q = 0.f;
#pragma unroll
                for (int bj = 0; bj < 2; ++bj) {
                    const f32x4 v0 = acc[ai][bj][m][0], v1 = acc[ai][bj][m][1];
                    q += (v0[0] * v0[0] + v0[1] * v0[1]) + (v0[2] * v0[2] + v0[3] * v0[3]) + (v1[0] * v1[0] + v1[1] * v1[1]) + (v1[2] * v1[2] + v1[3] * v1[3]);
                    *(u32x4*)(O + (size_t)row * 1024 + col + bj * HALF) = pack8(v0, v1);
                }
                q += __shfl_xor(q, 16); q += __shfl_xor(q, 32);
                if (fq == 0) SS[(size_t)row * 16 + u.pn * 4 + wc] = q;
            }
    }
};
struct EpiRelu2 {
    static constexpr bool PERM = true;
    bf16_t* O;
    __device__ __forceinline__ void operator()(const f32x4 (&acc)[2][2][4][2], const Unit& u, int wr, int wc, int fr, int fq) const {
        const int row0 = u.pm * BM + wr * 64 + fr, col = u.pn * BM + wc * 32 + 8 * fq;
#pragma unroll
        for (int ai = 0; ai < 2; ++ai)
#pragma unroll
            for (int m = 0; m < 4; ++m) {
                const int row = row0 + ai * HALF + m * 16;
#pragma unroll
                for (int bj = 0; bj < 2; ++bj) {
                    f32x4 v0 = acc[ai][bj][m][0], v1 = acc[ai][bj][m][1];
#pragma unroll
                    for (int j = 0; j < 4; ++j) { const float a = fmaxf(v0[j], 0.f), b = fmaxf(v1[j], 0.f); v0[j] = a * a; v1[j] = b * b; }
                    *(u32x4*)(O + (size_t)row * DFF + col + bj * HALF) = pack8(v0, v1);
                }
            }
    }
};
struct EpiSsm {
    static constexpr bool PERM = true;
    const bf16_t* AU; const float* dskip; bf16_t* Y;
    __device__ __forceinline__ void operator()(const f32x4 (&acc)[2][2][4][2], const Unit& u, int wr, int wc, int fr, int fq) const {
        const int g = u.pb;
        const int row0 = u.pm * BM + wr * 64 + fr, colt = u.pn * BM + wc * 32 + 8 * fq;
        const int c0 = 8 * (fq & 1);
        const f32x4 d0 = *(const f32x4*)(dskip + g * 16 + c0), d1 = *(const f32x4*)(dskip + g * 16 + c0 + 4);
        u32x4 uwv[2][4][2];
#pragma unroll
        for (int ai = 0; ai < 2; ++ai)
#pragma unroll
            for (int m = 0; m < 4; ++m)
#pragma unroll
                for (int bj = 0; bj < 2; ++bj) uwv[ai][m][bj] = *(const u32x4*)(AU + ((size_t)(g * 1024 + row0 + ai * HALF + m * 16) * 640 + colt + bj * HALF));
#pragma unroll
        for (int ai = 0; ai < 2; ++ai)
#pragma unroll
            for (int m = 0; m < 4; ++m) {
                const int cr = row0 + ai * HALF + m * 16;
#pragma unroll
                for (int bj = 0; bj < 2; ++bj) {
                    const int col = colt + bj * HALF, s = col >> 4;
                    const u32x4 uw = uwv[ai][m][bj];
                    f32x4 v0 = acc[ai][bj][m][0], v1 = acc[ai][bj][m][1];
                    v0[0] += d0[0] * bf_lo(uw.x); v0[1] += d0[1] * bf_hi(uw.x); v0[2] += d0[2] * bf_lo(uw.y); v0[3] += d0[3] * bf_hi(uw.y);
                    v1[0] += d1[0] * bf_lo(uw.z); v1[1] += d1[1] * bf_hi(uw.z); v1[2] += d1[2] * bf_lo(uw.w); v1[3] += d1[3] * bf_hi(uw.w);
#pragma unroll
                    for (int j = 0; j < 4; ++j) {
                        const float a = v0[j], za = 1.5957691216f * (a + 0.044715f * a * a * a); v0[j] = a * fsigm(za);
                        const float b = v1[j], zb = 1.5957691216f * (b + 0.044715f * b * b * b); v1[j] = b * fsigm(zb);
                    }
                    const size_t tok = (size_t)cr * 32 + s;
                    *(u32x4*)(Y + tok * 512 + g * 16 + c0) = pack8(v0, v1);
                }
            }
    }
};
}

__device__ __forceinline__ bf16x8 frag_nat(const LAS unsigned char* tile, int idx0, int k0, int fr, int fq) {
    return *(const LAS bf16x8*)(tile + (idx0 + fr) * TS + (k0 + 8 * fq) * 2);
}
__device__ __forceinline__ bf16x8 frag_tr(unsigned tile_addr, int k0, int idx0, int lane) {
    const int g = lane >> 4, q = (lane & 15) >> 2, p = lane & 3;
    const unsigned addr = tile_addr + (unsigned)((k0 + 8 * g + q) * TS + (idx0 + 4 * p) * 2);
    u32x2 lo, hi;
    asm volatile("ds_read_b64_tr_b16 %0, %2\n\tds_read_b64_tr_b16 %1, %2 offset:1088\n\ts_waitcnt lgkmcnt(0)" : "=&v"(lo), "=&v"(hi) : "v"(addr) : "memory");
    u32x4 r; r.x = lo.x; r.y = lo.y; r.z = hi.x; r.w = hi.y;
    return __builtin_bit_cast(bf16x8, r);
}
__device__ __forceinline__ void frags_tr8(bf16x8 (&b)[8], unsigned tile_addr, int k0, int lane) {
    const int g = lane >> 4, q = (lane & 15) >> 2, p = lane & 3;
    const unsigned addr = tile_addr + (unsigned)((k0 + 8 * g + q) * TS + (4 * p) * 2);
    u32x2 r0, r1, r2, r3, r4, r5, r6, r7, r8, r9, r10, r11, r12, r13, r14, r15;
    asm volatile(
        "ds_read_b64_tr_b16 %0, %16\n\t"
        "ds_read_b64_tr_b16 %1, %16 offset:1088\n\t"
        "ds_read_b64_tr_b16 %2, %16 offset:32\n\t"
        "ds_read_b64_tr_b16 %3, %16 offset:1120\n\t"
        "ds_read_b64_tr_b16 %4, %16 offset:64\n\t"
        "ds_read_b64_tr_b16 %5, %16 offset:1152\n\t"
        "ds_read_b64_tr_b16 %6, %16 offset:96\n\t"
        "ds_read_b64_tr_b16 %7, %16 offset:1184\n\t"
        "ds_read_b64_tr_b16 %8, %16 offset:128\n\t"
        "ds_read_b64_tr_b16 %9, %16 offset:1216\n\t"
        "ds_read_b64_tr_b16 %10, %16 offset:160\n\t"
        "ds_read_b64_tr_b16 %11, %16 offset:1248\n\t"
        "ds_read_b64_tr_b16 %12, %16 offset:192\n\t"
        "ds_read_b64_tr_b16 %13, %16 offset:1280\n\t"
        "ds_read_b64_tr_b16 %14, %16 offset:224\n\t"
        "ds_read_b64_tr_b16 %15, %16 offset:1312\n\t"
        "s_waitcnt lgkmcnt(0)"
        : "=&v"(r0), "=&v"(r1), "=&v"(r2), "=&v"(r3), "=&v"(r4), "=&v"(r5), "=&v"(r6), "=&v"(r7),
          "=&v"(r8), "=&v"(r9), "=&v"(r10), "=&v"(r11), "=&v"(r12), "=&v"(r13), "=&v"(r14), "=&v"(r15)
        : "v"(addr) : "memory");
    u32x4 w;
    w.x = r0.x; w.y = r0.y; w.z = r1.x; w.w = r1.y; b[0] = __builtin_bit_cast(bf16x8, w);
    w.x = r2.x; w.y = r2.y; w.z = r3.x; w.w = r3.y; b[1] = __builtin_bit_cast(bf16x8, w);
    w.x = r4.x; w.y = r4.y; w.z = r5.x; w.w = r5.y; b[2] = __builtin_bit_cast(bf16x8, w);
    w.x = r6.x; w.y = r6.y; w.z = r7.x; w.w = r7.y; b[3] = __builtin_bit_cast(bf16x8, w);
    w.x = r8.x; w.y = r8.y; w.z = r9.x; w.w = r9.y; b[4] = __builtin_bit_cast(bf16x8, w);
    w.x = r10.x; w.y = r10.y; w.z = r11.x; w.w = r11.y; b[5] = __builtin_bit_cast(bf16x8, w);
    w.x = r12.x; w.y = r12.y; w.z = r13.x; w.w = r13.y; b[6] = __builtin_bit_cast(bf16x8, w);
    w.x = r14.x; w.y = r14.y; w.z = r15.x; w.w = r15.y; b[7] = __builtin_bit_cast(bf16x8, w);
}
template <bool ATR, bool BTR>
__device__ __forceinline__ void mma128(f32x4 (&acc)[8], const LAS unsigned char* lds, unsigned lds_addr, int offA, int offB, int m0, int lane) {
    const int fr = lane & 15, fq = lane >> 4;
#pragma unroll
    for (int ks = 0; ks < 4; ++ks) {
        bf16x8 af, bfr[8];
        if (ATR) af = frag_tr(lds_addr + offA, 32 * ks, m0, lane); else af = frag_nat(lds + offA, m0, 32 * ks, fr, fq);
        if (BTR) frags_tr8(bfr, lds_addr + offB, 32 * ks, lane);
        else {
#pragma unroll
            for (int n = 0; n < 8; ++n) bfr[n] = frag_nat(lds + offB, 16 * n, 32 * ks, fr, fq);
        }
#pragma unroll
        for (int n = 0; n < 8; ++n) acc[n] = __builtin_amdgcn_mfma_f32_16x16x32_bf16(bfr[n], af, acc[n], 0, 0, 0);
    }
}
__device__ __forceinline__ void tile_load(LAS unsigned char* dst, const bf16_t* src, int ld, int tid) {
    u32x4 v[4];
#pragma unroll
    for (int i = 0; i < 4; ++i) { const int q = tid + 512 * i, row = q >> 4, pc = q & 15; v[i] = *(const u32x4*)(src + (size_t)row * ld + pc * 8); }
#pragma unroll
    for (int i = 0; i < 4; ++i) { const int q = tid + 512 * i, row = q >> 4, pc = q & 15; *(LAS u32x4*)(dst + row * TS + pc * 16) = v[i]; }
}
__device__ __forceinline__ void tile_load_zeta(LAS unsigned char* dst, const bf16_t* src, int ld, int tid, float l2g) {
    u32x4 v[4];
#pragma unroll
    for (int i = 0; i < 4; ++i) { const int q = tid + 512 * i, row = q >> 4, pc = q & 15; v[i] = *(const u32x4*)(src + (size_t)row * ld + pc * 8); }
#pragma unroll
    for (int i = 0; i < 4; ++i) {
        const int q = tid + 512 * i, row = q >> 4, pc = q & 15; const float z = exp2f((float)(127 - row) * l2g);
        u32x4 w;
        w.x = cvt_pk_bf16(bf_lo(v[i].x) * z, bf_hi(v[i].x) * z); w.y = cvt_pk_bf16(bf_lo(v[i].y) * z, bf_hi(v[i].y) * z);
        w.z = cvt_pk_bf16(bf_lo(v[i].z) * z, bf_hi(v[i].z) * z); w.w = cvt_pk_bf16(bf_lo(v[i].w) * z, bf_hi(v[i].w) * z);
        *(LAS u32x4*)(dst + row * TS + pc * 16) = w;
    }
}
__device__ __forceinline__ void tile_issue(u32x4 (&v)[4], const bf16_t* src, int ld, int tid) {
#pragma unroll
    for (int i = 0; i < 4; ++i) { const int q = tid + 512 * i, row = q >> 4, pc = q & 15; v[i] = *(const u32x4*)(src + (size_t)row * ld + pc * 8); }
}
__device__ __forceinline__ void tile_issue_nt(u32x4 (&v)[4], const bf16_t* src, int ld, int tid) {
#pragma unroll
    for (int i = 0; i < 4; ++i) { const int q = tid + 512 * i, row = q >> 4, pc = q & 15; v[i] = ld_nt((const u32x4*)(src + (size_t)row * ld + pc * 8)); }
}
__device__ __forceinline__ void tile_commit(LAS unsigned char* dst, const u32x4 (&v)[4], int tid) {
#pragma unroll
    for (int i = 0; i < 4; ++i) { const int q = tid + 512 * i, row = q >> 4, pc = q & 15; *(LAS u32x4*)(dst + row * TS + pc * 16) = v[i]; }
}
__device__ __forceinline__ void tile_commit_zeta(LAS unsigned char* dst, const u32x4 (&v)[4], int tid, float l2g) {
#pragma unroll
    for (int i = 0; i < 4; ++i) {
        const int q = tid + 512 * i, row = q >> 4, pc = q & 15; const float z = exp2f((float)(127 - row) * l2g);
        u32x4 w;
        w.x = cvt_pk_bf16(bf_lo(v[i].x) * z, bf_hi(v[i].x) * z); w.y = cvt_pk_bf16(bf_lo(v[i].y) * z, bf_hi(v[i].y) * z);
        w.z = cvt_pk_bf16(bf_lo(v[i].z) * z, bf_hi(v[i].z) * z); w.w = cvt_pk_bf16(bf_lo(v[i].w) * z, bf_hi(v[i].w) * z);
        *(LAS u32x4*)(dst + row * TS + pc * 16) = w;
    }
}
__device__ __forceinline__ float ret_log2_gamma(int h) { const float g = 1.0f - exp2f(-5.0f - (4.0f / 3.0f) * (float)h); return log2f(g); }

__device__ __forceinline__ int dest_row(int mode, int n) {
    if (mode == 1) { if (n < 1024) { const int sect = n >> 9, w = n & 511, h = w >> 7, j = w & 127; return (sect << 9) + (h << 7) + ((j & 63) << 1) + (j >> 6); } return n; }
    if (mode == 2) { const int bj = n >> 9, rem = n & 511, pn = rem >> 7, j = rem & 127; return (pn << 8) + (bj << 7) + j; }
    return n;
}
struct TrItem { const float* W; bf16_t* WT; const float* gain; int K, N, mode, item; };
__device__ __forceinline__ void p0_tr_load(const TrItem& t, f32x4 (&v)[8], int lane) {
    const int nblk = t.N / 32, kb = t.item / nblk, nb = t.item % nblk, k0 = 64 * kb, n0 = 32 * nb;
    const float cs = (t.mode == 1 && n0 >= 512 && n0 < 1024) ? 0.08838834764831845f : 1.0f;
#pragma unroll
    for (int i = 0; i < 8; ++i) { const int kk = (lane >> 3) + 8 * i; const float g = t.gain ? t.gain[k0 + kk] * cs : cs;
        v[i] = ld_nt((const f32x4*)(t.W + (size_t)(k0 + kk) * t.N + n0 + 4 * (lane & 7))) * g; }
}
__device__ __forceinline__ void p0_tr_finish(const TrItem& t, const f32x4 (&v)[8], LAS float* scr, int lane) {
    const int nblk = t.N / 32, kb = t.item / nblk, nb = t.item % nblk, k0 = 64 * kb, n0 = 32 * nb;
#pragma unroll
    for (int i = 0; i < 8; ++i) { const int kk = (lane >> 3) + 8 * i; LAS float* d = scr + kk * 33 + 4 * (lane & 7); d[0] = v[i][0]; d[1] = v[i][1]; d[2] = v[i][2]; d[3] = v[i][3]; }
    LDS_WAIT();
    const int c = lane & 7;
#pragma unroll
    for (int j = 0; j < 4; ++j) { const int n = (lane >> 3) + 8 * j; const LAS float* s = scr + (8 * c) * 33 + n;
        u32x4 o; o.x = cvt_pk_bf16(s[0 * 33], s[1 * 33]); o.y = cvt_pk_bf16(s[2 * 33], s[3 * 33]); o.z = cvt_pk_bf16(s[4 * 33], s[5 * 33]); o.w = cvt_pk_bf16(s[6 * 33], s[7 * 33]);
        *(u32x4*)(t.WT + (size_t)dest_row(t.mode, n0 + n) * t.K + k0 + 8 * c) = o; }
    LDS_WAIT();
}
__device__ __forceinline__ void s5_pow(float lre, float lim, float dt, float j, float& pr, float& pi) {
    const float mag = expf(j * (dt * lre)); float s, c; sincosf(j * (dt * lim), &s, &c); pr = mag * c; pi = mag * s;
}
__device__ __forceinline__ void s5_coef(float lre, float lim, float dt, float& cr, float& ci) {
    float br, bi; s5_pow(lre, lim, dt, 1.0f, br, bi); br -= 1.0f;
    const float den = lre * lre + lim * lim; cr = (br * lre + bi * lim) / den; ci = (bi * lre - br * lim) / den;
}

#define XB_TMO      128
#define XB_XCNT(j)  (256  + 64 * (j))
#define XB_XSUB(j)  (1280 + 64 * (j))
#define XB_XGEN(j)  (2304 + 64 * (j))
#define XB_TOP      3328
#define XB_TOPGEN   3392
#define XCD_BAR_WORDS 3456
#define XB_SPIN_CAP (1u << 18)
__device__ __forceinline__ unsigned xb_ld(unsigned* p)              { return __hip_atomic_load(p, __ATOMIC_RELAXED, __HIP_MEMORY_SCOPE_AGENT); }
__device__ __forceinline__ unsigned xb_add(unsigned* p, unsigned v) { return __hip_atomic_fetch_add(p, v, __ATOMIC_RELAXED, __HIP_MEMORY_SCOPE_AGENT); }
__device__ __forceinline__ unsigned xb_xcc_id() { return (unsigned)__builtin_amdgcn_s_getreg((3 << 11) | 20) & 0xFu; }
#define XB_SPIN(cond, bar) do { unsigned _sp = 0; while (cond) { __builtin_amdgcn_s_sleep(1); \
    if ((++_sp & 255u) == 0u) { if (xb_ld(&(bar)[XB_TMO])) break; if (_sp > XB_SPIN_CAP) { atomicAdd(&(bar)[XB_TMO], 1u); break; } } } } while (0)
struct XcdBarrier { unsigned* bar; unsigned x; volatile LAS unsigned* st; };
__device__ __forceinline__ XcdBarrier xcd_barrier_post(unsigned* bar, volatile LAS unsigned* st) {
    XcdBarrier b; b.bar = bar; b.x = xb_xcc_id(); b.st = st;
    if (threadIdx.x == 0) (void)xb_add(&bar[XB_XCNT(b.x)], 1u);
    return b;
}
__device__ __forceinline__ void xcd_barrier_complete(unsigned* bar, unsigned x, unsigned& nloc, unsigned& nx) {
    const unsigned G = gridDim.x * gridDim.y * gridDim.z;
    unsigned sum, cnt, mine, sp = 0u;
    for (;;) {
        sum = 0u; cnt = 0u; mine = 0u;
#pragma unroll
        for (unsigned j = 0; j < 16; ++j) { const unsigned c = xb_ld(&bar[XB_XCNT(j)]); sum += c; cnt += (c > 0u) ? 1u : 0u; mine = (j == x) ? c : mine; }
        if (sum == G) break;
        __builtin_amdgcn_s_sleep(1);
        if ((++sp & 255u) == 0u) { if (xb_ld(&bar[XB_TMO])) break; if (sp > XB_SPIN_CAP) { atomicAdd(&bar[XB_TMO], 1u); break; } }
    }
    nloc = mine > 0u ? mine : 1u; nx = cnt > 0u ? cnt : 1u;
}
__device__ __forceinline__ void xcd_barrier(const XcdBarrier& b) {
    asm volatile("s_waitcnt vmcnt(0)" ::: "memory");
    __syncthreads();
    if (threadIdx.x == 0) {
        unsigned* bar = b.bar;
        __builtin_amdgcn_s_waitcnt(0);
        unsigned nloc = b.st[0], nx = b.st[1];
        if (nloc == 0u) { xcd_barrier_complete(bar, b.x, nloc, nx); b.st[0] = nloc; b.st[1] = nx; }
        const unsigned old = xb_add(&bar[XB_XSUB(b.x)], 1u);
        const unsigned gen = old / nloc;
        if (old + 1u == (gen + 1u) * nloc) {
            __builtin_amdgcn_fence(__ATOMIC_RELEASE, "agent");
            asm volatile("s_waitcnt vmcnt(0)" ::: "memory");
            const unsigned og = xb_add(&bar[XB_TOP], 1u);
            const unsigned tg = og / nx;
            if (og + 1u == (tg + 1u) * nx) xb_add(&bar[XB_TOPGEN], 1u);
            else XB_SPIN(xb_ld(&bar[XB_TOPGEN]) == tg, bar);
            __builtin_amdgcn_fence(__ATOMIC_ACQUIRE, "agent");
            xb_add(&bar[XB_XGEN(b.x)], 1u);
            asm volatile("s_waitcnt vmcnt(0)" ::: "memory");
        } else {
            XB_SPIN(xb_ld(&bar[XB_XGEN(b.x)]) == gen, bar);
            __builtin_amdgcn_fence(__ATOMIC_ACQUIRE, "agent");
            asm volatile("s_waitcnt vmcnt(0)" ::: "memory");
        }
    }
    __syncthreads();
}

struct Args { const float* in[19]; float* out; unsigned char* ws; int ph_lo, ph_hi; };

__global__ void __launch_bounds__(512, 2) fwd_kernel(Args a) {
    extern __shared__ __attribute__((aligned(16))) unsigned char lds_raw[];
    LAS unsigned char* lds = (LAS unsigned char*)lds_raw;
    const unsigned lds_addr = (unsigned)(size_t)lds_raw;
    cg::grid_group grid = cg::this_grid();
    const int tid = threadIdx.x, lane = tid & 63, wave = __builtin_amdgcn_readfirstlane(tid >> 6);
    const int G = gridDim.x, bx = blockIdx.x;
    const int lo = a.ph_lo, hi = a.ph_hi;
    unsigned char* ws = a.ws;
#define IN(k) (lo <= (k) && (k) < hi)
#define SEAM(k) do { if (lo <= (k) && (k) + 1 < hi) xcd_barrier(xbar); } while (0)
    volatile LAS unsigned* misc = (volatile LAS unsigned*)(lds + (LDS_BYTES - 64));
    if (tid < 16) misc[tid] = 0u;
    __syncthreads();
    const XcdBarrier xbar = xcd_barrier_post((unsigned*)ws, misc);
    if (lo < 0) grid.sync();

    const float* x = a.in[0];
    const float* g_mix_pre = a.in[1]; const float* g_mix_post = a.in[2]; const float* w_in = a.in[3]; const float* gn_gain = a.in[4];
    const float* lam_re = a.in[5]; const float* lam_im = a.in[6]; const float* log_dt = a.in[7];
    const float* b_re = a.in[8]; const float* b_im = a.in[9]; const float* c_re = a.in[10]; const float* c_im = a.in[11]; const float* d_skip = a.in[12];
    const float* w_glu = a.in[13]; const float* w_out = a.in[14]; const float* g_mlp_pre = a.in[15]; const float* g_mlp_post = a.in[16];
    const float* w_ff1 = a.in[17]; const float* w_ff2 = a.in[18];
    float* out = a.out;

    bf16_t* WIN = (bf16_t*)(ws + WS_WIN); bf16_t* WGLU = (bf16_t*)(ws + WS_WGLU); bf16_t* WOUT = (bf16_t*)(ws + WS_WOUT);
    bf16_t* WFF1 = (bf16_t*)(ws + WS_WFF1); bf16_t* WFF2 = (bf16_t*)(ws + WS_WFF2);
    float* ROPE = (float*)(ws + WS_ROPE); bf16_t* TW = (bf16_t*)(ws + WS_TW); bf16_t* W1S = (bf16_t*)(ws + WS_W1S);
    float* XSC = (float*)(ws + 73 * MiB);
    float* SS = (float*)(ws + WS_SS); float* SS2 = (float*)(ws + WS_SS2); float* HINC = (float*)(ws + WS_HINC);
    bf16_t* XN = (bf16_t*)(ws + WS_XN);
    bf16_t* QB = (bf16_t*)(ws + WS_QB); bf16_t* KB = (bf16_t*)(ws + WS_KB); bf16_t* VB = (bf16_t*)(ws + WS_VB); bf16_t* GB = (bf16_t*)(ws + WS_GB);
    bf16_t* AU = (bf16_t*)(ws + WS_AU); bf16_t* SST = (bf16_t*)(ws + WS_SST); bf16_t* RTB = (bf16_t*)(ws + WS_RTB);
    bf16_t* YSSM = (bf16_t*)(ws + WS_YSSM); bf16_t* YMIX = (bf16_t*)(ws + WS_YMIX);
    bf16_t* MIXB = (bf16_t*)(ws + WS_MIXB); bf16_t* HID = (bf16_t*)(ws + WS_HID); bf16_t* MB = (bf16_t*)(ws + WS_MB);

    if (IN(0)) for (int rep = 0; rep < REPS(0); ++rep) {
        const int gw = bx * 8 + wave, NGW = G * 8;
        {
            LAS float* scr = (LAS float*)(lds + wave * 16384);
            constexpr int I_IN = (DM / 64) * (NIN / 32), I_GLU = (512 / 64) * (1024 / 32), I_OUT = (DM / 64) * (DM / 32), I_F1 = (DM / 64) * (DFF / 32), I_F2 = (DFF / 64) * (DM / 32);
            constexpr int NITEMS = I_IN + I_GLU + I_OUT + I_F1 + I_F2;
#define TR_DECODE(IT, t) do { int r_ = (IT); \
                if (r_ < I_IN) { t = TrItem{w_in, WIN, g_mix_pre, DM, NIN, 1, r_}; break; } r_ -= I_IN; \
                if (r_ < I_GLU) { t = TrItem{w_glu, WGLU, nullptr, 512, 1024, 2, r_}; break; } r_ -= I_GLU; \
                if (r_ < I_OUT) { t = TrItem{w_out, WOUT, nullptr, DM, DM, 0, r_}; break; } r_ -= I_OUT; \
                if (r_ < I_F1) { t = TrItem{w_ff1, WFF1, g_mlp_pre, DM, DFF, 0, r_}; break; } r_ -= I_F1; \
                t = TrItem{w_ff2, WFF2, nullptr, DFF, DM, 0, r_}; } while (0)
            for (int it = gw; it < NITEMS; it += 3 * NGW) {
                TrItem t0, t1, t2; f32x4 v0[8], v1[8], v2[8];
                const bool h1 = it + NGW < NITEMS, h2 = it + 2 * NGW < NITEMS;
                TR_DECODE(it, t0); p0_tr_load(t0, v0, lane);
                if (h1) { TR_DECODE(it + NGW, t1); p0_tr_load(t1, v1, lane); }
                if (h2) { TR_DECODE(it + 2 * NGW, t2); p0_tr_load(t2, v2, lane); }
                p0_tr_finish(t0, v0, scr, lane);
                if (h1) p0_tr_finish(t1, v1, scr, lane);
                if (h2) p0_tr_finish(t2, v2, scr, lane);
            }
#undef TR_DECODE
        }
        for (int m = gw; m < T; m += 2 * NGW) {
            const int m2 = m + NGW;
            const bool has2 = m2 < T;
            const f32x4* xr0 = (const f32x4*)(x + (size_t)m * DM) + lane;
            const f32x4* xr1 = (const f32x4*)(x + (size_t)(has2 ? m2 : m) * DM) + lane;
            f32x4 v0[4], v1[4]; float s0 = 0.f, s1 = 0.f;
#pragma unroll
            for (int j = 0; j < 4; ++j) { v0[j] = ld_nt(xr0 + 64 * j); v1[j] = ld_nt(xr1 + 64 * j); }
#pragma unroll
            for (int j = 0; j < 4; ++j) {
                s0 += (v0[j][0] * v0[j][0] + v0[j][1] * v0[j][1]) + (v0[j][2] * v0[j][2] + v0[j][3] * v0[j][3]);
                s1 += (v1[j][0] * v1[j][0] + v1[j][1] * v1[j][1]) + (v1[j][2] * v1[j][2] + v1[j][3] * v1[j][3]);
            }
            const float q0 = sqrtf(wave_sum(s0) * (1.0f / DM) + EPS), q1 = sqrtf(wave_sum(s1) * (1.0f / DM) + EPS);
            const float r0 = 1.0f / q0, r1 = 1.0f / q1;
            if (lane == 0) { XSC[m] = q0; if (has2) XSC[m2] = q1; }
            u32x2* o0 = (u32x2*)(XN + (size_t)m * DM) + lane; u32x2* o1 = (u32x2*)(XN + (size_t)m2 * DM) + lane;
#pragma unroll
            for (int j = 0; j < 4; ++j) { u32x2 w; w.x = cvt_pk_bf16(v0[j][0] * r0, v0[j][1] * r0); w.y = cvt_pk_bf16(v0[j][2] * r0, v0[j][3] * r0); o0[64 * j] = w; }
            if (has2) {
#pragma unroll
                for (int j = 0; j < 4; ++j) { u32x2 w; w.x = cvt_pk_bf16(v1[j][0] * r1, v1[j][1] * r1); w.y = cvt_pk_bf16(v1[j][2] * r1, v1[j][3] * r1); o1[64 * j] = w; }
            }
        }
        const float rope_inv = (float)pow(10000.0, -(double)(tid & 63) / 64.0);
        for (int i = bx * 512 + tid; i < SEQ * 64; i += G * 512) {
            const int pos = i >> 6;
            const float inv = rope_inv;
            const float ang = (float)pos * inv; float s, c; sincosf(ang, &s, &c);
            *(f32x2*)(ROPE + (size_t)i * 2) = (f32x2){c, s};
        }
        for (int i = bx * 512 + tid; i < 32 * 32 * 64; i += G * 512) {
            {
                const int q = i & 63, t = (i >> 6) & 31, g = i >> 11;
                const float lre = fminf(lam_re[g * 64 + q], -1e-4f), lim = lam_im[g * 64 + q], dt = expf(log_dt[g]);
                float pr, pi; s5_pow(lre, lim, dt, (float)(t + 1), pr, pi);
                float crv[16], civ[16];
#pragma unroll
                for (int c = 0; c < 16; ++c) { crv[c] = c_re[(g * 16 + c) * 64 + q]; civ[c] = c_im[(g * 16 + c) * 64 + q]; }
#pragma unroll
                for (int c = 0; c < 16; ++c) {
                    const float zr = crv[c] * pr - civ[c] * pi, zi = crv[c] * pi + civ[c] * pr;
                    bf16_t* row = TW + (size_t)(g * 512 + t * 16 + c) * 640 + 512;
                    row[q] = f2bf(zr); row[64 + q] = f2bf(-zi);
                }
            }
            {
                const int s = i & 31, p = (i >> 5) & 63, g = i >> 11;
                const float lre = fminf(lam_re[g * 64 + p], -1e-4f), lim = lam_im[g * 64 + p], dt = expf(log_dt[g]);
                float pr, pi, cr, ci; s5_pow(lre, lim, dt, (float)(31 - s), pr, pi); s5_coef(lre, lim, dt, cr, ci);
                const float wr_ = pr * cr - pi * ci, wi_ = pr * ci + pi * cr;
                float zr[16], zi[16];
#pragma unroll
                for (int c = 0; c < 16; ++c) { const float br = b_re[(g * 64 + p) * 16 + c], bi = b_im[(g * 64 + p) * 16 + c]; zr[c] = wr_ * br - wi_ * bi; zi[c] = wr_ * bi + wi_ * br; }
                u32x4* o0 = (u32x4*)(W1S + (size_t)(g * 128 + p) * 512 + s * 16);
                u32x4* o1 = (u32x4*)(W1S + (size_t)(g * 128 + 64 + p) * 512 + s * 16);
                u32x4 w;
                w.x = cvt_pk_bf16(zr[0], zr[1]); w.y = cvt_pk_bf16(zr[2], zr[3]); w.z = cvt_pk_bf16(zr[4], zr[5]); w.w = cvt_pk_bf16(zr[6], zr[7]); o0[0] = w;
                w.x = cvt_pk_bf16(zr[8], zr[9]); w.y = cvt_pk_bf16(zr[10], zr[11]); w.z = cvt_pk_bf16(zr[12], zr[13]); w.w = cvt_pk_bf16(zr[14], zr[15]); o0[1] = w;
                w.x = cvt_pk_bf16(zi[0], zi[1]); w.y = cvt_pk_bf16(zi[2], zi[3]); w.z = cvt_pk_bf16(zi[4], zi[5]); w.w = cvt_pk_bf16(zi[6], zi[7]); o1[0] = w;
                w.x = cvt_pk_bf16(zi[8], zi[9]); w.y = cvt_pk_bf16(zi[10], zi[11]); w.z = cvt_pk_bf16(zi[12], zi[13]); w.w = cvt_pk_bf16(zi[14], zi[15]); o1[1] = w;
            }
        }
        for (int i = bx * 512 + tid; i < 16384 * 64; i += G * 512) {
            const int piece = i & 63, row = i >> 6, t = (row >> 4) & 31;
            if (piece >= 2 * (t + 1)) *(u32x4*)(TW + (size_t)row * 640 + piece * 8) = (u32x4){0u, 0u, 0u, 0u};
        }
        __syncthreads();
        {
            LAS float* Bre = (LAS float*)lds; LAS float* Bim = Bre + 1024; LAS float* Cre = Bre + 2048; LAS float* Cim = Bre + 3072;
            LAS float* cpr = Bre + 4096; LAS float* cpi = cpr + 256;
            for (int it = bx; it < 256; it += G) {
                const int g = it >> 3, jq = it & 7;
                {
                    const int q0 = tid, q1 = tid + 512;
                    const float* s0 = (q0 < 256 ? b_re : b_im) + g * 1024 + (q0 & 255) * 4;
                    const float* s1 = (q1 < 768 ? c_re : c_im) + g * 1024 + (q1 & 255) * 4;
                    *(LAS f32x4*)(Bre + q0 * 4) = *(const f32x4*)s0;
                    *(LAS f32x4*)(Bre + q1 * 4) = *(const f32x4*)s1;
                }
                if (tid < 256) {
                    const int p = tid & 63, jl = tid >> 6;
                    const float lre = fminf(lam_re[g * 64 + p], -1e-4f), lim = lam_im[g * 64 + p], dt = expf(log_dt[g]);
                    float pr, pi, cr, ci; s5_pow(lre, lim, dt, (float)(4 * jq + jl), pr, pi); s5_coef(lre, lim, dt, cr, ci);
                    cpr[jl * 64 + p] = pr * cr - pi * ci; cpi[jl * 64 + p] = pr * ci + pi * cr;
                }
                __syncthreads();
                {
                    const int cc = tid & 255, c = cc >> 4, c2 = cc & 15, jh = tid >> 8;
                    float v0 = 0.f, v1 = 0.f;
#pragma unroll 8
                    for (int p = 0; p < 64; ++p) {
                        const float cr = Cre[c * 64 + p], ci = Cim[c * 64 + p], br = Bre[p * 16 + c2], bi = Bim[p * 16 + c2];
                        const float mr = cr * br - ci * bi, mi = cr * bi + ci * br;
                        v0 += mr * cpr[(2 * jh) * 64 + p] - mi * cpi[(2 * jh) * 64 + p];
                        v1 += mr * cpr[(2 * jh + 1) * 64 + p] - mi * cpi[(2 * jh + 1) * 64 + p];
                    }
                    const int jj0 = 4 * jq + 2 * jh;
                    const bf16_t w0 = f2bf(v0), w1 = f2bf(v1);
                    for (int t = jj0; t < 32; ++t) TW[(size_t)(g * 512 + t * 16 + c) * 640 + (t - jj0) * 16 + c2] = w0;
                    for (int t = jj0 + 1; t < 32; ++t) TW[(size_t)(g * 512 + t * 16 + c) * 640 + (t - jj0 - 1) * 16 + c2] = w1;
                }
                __syncthreads();
            }
        }
    }
    SEAM(0);

    if (IN(1)) for (int rep = 0; rep < REPS(1); ++rep) {
        pg8::Gemm g{XN, WIN, DM, DM, DM, 0, 0}; pg8::StaticOrder S; S.init(T, NIN, G, bx);
        pg8::EpiInProj E{QB, KB, VB, GB, AU, ROPE};
        pg8::gemm_phase(lds, g, S, E);
    }
    SEAM(1);

    if (IN(2)) for (int rep = 0; rep < REPS(2); ++rep) {
        const int fr = lane & 15, fq = lane >> 4;
        for (int it = bx; it < 256; it += G) {
            const int g = it >> 3, rt = it & 7;
            const bf16_t* pA = AU + (size_t)(g * 1024 + rt * 128) * 640; const bf16_t* pB = W1S + (size_t)(g * 128) * 512;
            f32x4 acc[8];
#pragma unroll
            for (int n = 0; n < 8; ++n) acc[n] = (f32x4){0.f, 0.f, 0.f, 0.f};
            u32x4 ra[4], rb[4];
            tile_issue(ra, pA, 640, tid); tile_issue(rb, pB, 512, tid);
            for (int kt = 0; kt < 4; ++kt) {
                tile_commit(lds, ra, tid); tile_commit(lds + TILE_B, rb, tid);
                __syncthreads();
                if (kt < 3) { tile_issue(ra, pA + (kt + 1) * 128, 640, tid); tile_issue(rb, pB + (kt + 1) * 128, 512, tid); }
                mma128<false, false>(acc, lds, lds_addr, 0, TILE_B, 16 * wave, lane);
                __syncthreads();
            }
            float* o = HINC + ((size_t)(g * 1024 + rt * 128 + 16 * wave + fr)) * 128 + 4 * fq;
#pragma unroll
            for (int n = 0; n < 8; ++n) *(f32x4*)(o + 16 * n) = acc[n];
        }
        {
            u32x4 rk[4], rv[4];
            int it = bx;
#define R1_ISSUE(IT) do { const int n_ = (IT) & 63, h_ = ((IT) >> 6) & 3, b_ = (IT) >> 8; const size_t t0_ = (size_t)b_ * SEQ + n_ * 128; \
                tile_issue(rk, KB + t0_ * 512 + h_ * 128, 512, tid); tile_issue(rv, VB + t0_ * 512 + h_ * 128, 512, tid); } while (0)
            if (it < 1024) R1_ISSUE(it);
            for (; it < 1024; it += G) {
                const int h = (it >> 6) & 3;
                const float l2g = ret_log2_gamma(h);
                tile_commit(lds, rk, tid); tile_commit_zeta(lds + TILE_B, rv, tid, l2g);
                __syncthreads();
                if (it + G < 1024) R1_ISSUE(it + G);
                f32x4 acc[8];
#pragma unroll
                for (int nb = 0; nb < 8; ++nb) acc[nb] = (f32x4){0.f, 0.f, 0.f, 0.f};
                mma128<true, true>(acc, lds, lds_addr, TILE_B, 0, 16 * wave, lane);
                bf16_t* o = SST + (size_t)it * 16384 + (16 * wave + fr) * 128 + 4 * fq;
#pragma unroll
                for (int nb = 0; nb < 8; ++nb) { u32x2 w; w.x = cvt_pk_bf16(acc[nb][0], acc[nb][1]); w.y = cvt_pk_bf16(acc[nb][2], acc[nb][3]); *(u32x2*)(o + 16 * nb) = w; }
                __syncthreads();
            }
#undef R1_ISSUE
        }
    }
    SEAM(2);

    if (IN(3)) for (int rep = 0; rep < REPS(3); ++rep) {
        for (int idx = bx * 512 + tid; idx < 16 * 8192; idx += G * 512) {
            const int bh = idx >> 13, e2 = idx & 8191, h = bh & 3;
            const float gch = exp2f(128.0f * ret_log2_gamma(h));
            const unsigned* sp = (const unsigned*)(SST + (size_t)bh * 64 * 16384 + 2 * e2);
            unsigned* rp = (unsigned*)(RTB + (size_t)bh * 64 * 16384 + 2 * e2);
            float r0 = 0.f, r1 = 0.f;
            for (int n0 = 0; n0 < 64; n0 += 16) {
                unsigned s[16];
#pragma unroll
                for (int j = 0; j < 16; ++j) s[j] = ld_nt(sp + (size_t)(n0 + j) * 8192);
#pragma unroll
                for (int j = 0; j < 16; ++j) { rp[(size_t)(n0 + j) * 8192] = cvt_pk_bf16(r0, r1); r0 = gch * r0 + bf_lo(s[j]); r1 = gch * r1 + bf_hi(s[j]); }
            }
        }
        {
            LAS float* X = (LAS float*)lds;
            for (int it = bx; it < 256; it += G) {
                const int ph = it & 1, g = (it >> 1) & 31, b = it >> 6, pl = tid & 31, p = 32 * ph + pl, seg = tid >> 5;
                const float lre = fminf(lam_re[g * 64 + p], -1e-4f), lim = lam_im[g * 64 + p], dt = expf(log_dt[g]);
                float ar, ai, Ar, Ai; s5_pow(lre, lim, dt, 32.0f, ar, ai); s5_pow(lre, lim, dt, 512.0f, Ar, Ai);
                const float* hp = HINC + ((size_t)(g * 1024 + b * 256 + seg * 16)) * 128 + p;
                float hr[16], hi_[16];
#pragma unroll
                for (int i = 0; i < 16; ++i) { hr[i] = hp[(size_t)i * 128]; hi_[i] = hp[(size_t)i * 128 + 64]; }
                float xr = 0.f, xi = 0.f;
#pragma unroll
                for (int i = 0; i < 16; ++i) { const float nr = ar * xr - ai * xi + hr[i], ni = ar * xi + ai * xr + hi_[i]; xr = nr; xi = ni; }
                X[(seg * 32 + pl) * 2] = xr; X[(seg * 32 + pl) * 2 + 1] = xi;
                __syncthreads();
                float cr = 0.f, ci = 0.f;
                for (int s2 = 0; s2 < seg; ++s2) { const float tr = X[(s2 * 32 + pl) * 2], ti = X[(s2 * 32 + pl) * 2 + 1]; const float nr = Ar * cr - Ai * ci + tr, ni = Ar * ci + Ai * cr + ti; cr = nr; ci = ni; }
                bf16_t* op = AU + ((size_t)(g * 1024 + b * 256 + seg * 16)) * 640 + 512 + p;
                xr = cr; xi = ci;
#pragma unroll
                for (int i = 0; i < 16; ++i) {
                    op[(size_t)i * 640] = f2bf(xr); op[(size_t)i * 640 + 64] = f2bf(xi);
                    const float nr = ar * xr - ai * xi + hr[i], ni = ar * xi + ai * xr + hi_[i]; xr = nr; xi = ni;
                }
                __syncthreads();
            }
        }
    }
    SEAM(3);

    if (IN(4)) for (int rep = 0; rep < REPS(4); ++rep) {
        const bool solo = (hi - lo == 1);
        if (!(solo && PROBE_P4_PART == 2)) for (int rep4 = 0; rep4 < (PROBE_P4_DUP == 1 ? 2 : 1); ++rep4) {
            pg8::Gemm g{AU, TW, 640, 640, 640, (size_t)1024 * 640, (size_t)512 * 640}; pg8::BatchOrder S{G, bx};
            pg8::EpiSsm E{AU, d_skip, YSSM};
            pg8::gemm_phase(lds, g, S, E);
        }
        const int fr = lane & 15, fq = lane >> 4;
        constexpr int OQ = 0, OK_ = TILE_B, OV = 2 * TILE_B, OR = 3 * TILE_B;
        for (int rep4 = 0; rep4 < (PROBE_P4_DUP == 2 ? 2 : 1); ++rep4) {
        u32x4 rq[4], rk[4], rv[4], rr[4];
        int it = bx;
#define R3_ISSUE_QK(IT) do { const int n_ = (IT) & 63, h_ = ((IT) >> 6) & 3, b_ = (IT) >> 8; const size_t t0_ = (size_t)b_ * SEQ + n_ * 128; \
            tile_issue_nt(rq, QB + t0_ * 512 + h_ * 128, 512, tid); tile_issue_nt(rk, KB + t0_ * 512 + h_ * 128, 512, tid); } while (0)
#define R3_ISSUE_VR(IT) do { const int n_ = (IT) & 63, h_ = ((IT) >> 6) & 3, b_ = (IT) >> 8; const size_t t0_ = (size_t)b_ * SEQ + n_ * 128; \
            tile_issue_nt(rv, VB + t0_ * 512 + h_ * 128, 512, tid); tile_issue_nt(rr, RTB + (size_t)(IT) * 16384, 128, tid); } while (0)
        if (solo && PROBE_P4_PART == 1) it = 1024;
        if (it < 1024) R3_ISSUE_QK(it);
        for (; it < 1024; it += G) {
            const int n = it & 63, h = (it >> 6) & 3, b = it >> 8;
            const float l2g = ret_log2_gamma(h);
            const size_t tok0 = (size_t)b * SEQ + n * 128;
            tile_commit(lds + OQ, rq, tid); tile_commit(lds + OK_, rk, tid);
            R3_ISSUE_VR(it);
            __syncthreads();
            const int i = 16 * wave + fr;
            f32x4 sc[8];
#pragma unroll
            for (int nb = 0; nb < 8; ++nb) sc[nb] = (f32x4){0.f, 0.f, 0.f, 0.f};
            mma128<false, false>(sc, lds, lds_addr, OQ, OK_, 16 * wave, lane);
            tile_commit(lds + OV, rv, tid); tile_commit(lds + OR, rr, tid);
            __syncthreads();
            if (it + G < 1024) R3_ISSUE_QK(it + G);
#pragma unroll
            for (int nb = 0; nb < 8; ++nb) {
                f32x4 pv;
#pragma unroll
                for (int e = 0; e < 4; ++e) { const int j = 16 * nb + 4 * fq + e; pv[e] = (i >= j) ? sc[nb][e] * fex2((float)(i - j) * l2g) : 0.f; }
                u32x2 w; w.x = cvt_pk_bf16(pv[0], pv[1]); w.y = cvt_pk_bf16(pv[2], pv[3]);
                *(LAS u32x2*)(lds + OK_ + i * TS + (16 * nb + 4 * fq) * 2) = w;
            }
            LDS_WAIT();
            f32x4 a1[8], a2[8];
#pragma unroll
            for (int nb = 0; nb < 8; ++nb) { a1[nb] = (f32x4){0.f, 0.f, 0.f, 0.f}; a2[nb] = (f32x4){0.f, 0.f, 0.f, 0.f}; }
            mma128<false, true>(a1, lds, lds_addr, OK_, OV, 16 * wave, lane);
            mma128<false, false>(a2, lds, lds_addr, OQ, OR, 16 * wave, lane);
            const float xi = exp2f((float)(i + 1) * l2g);
            float s1 = 0.f, s2 = 0.f;
#pragma unroll
            for (int nb = 0; nb < 8; ++nb)
#pragma unroll
                for (int e = 0; e < 4; ++e) { const float o = a1[nb][e] + xi * a2[nb][e]; a1[nb][e] = o; s1 += o; s2 += o * o; }
            s1 += __shfl_xor(s1, 16); s1 += __shfl_xor(s1, 32); s2 += __shfl_xor(s2, 16); s2 += __shfl_xor(s2, 32);
            const float mu = s1 * (1.0f / 128.0f), var = fmaxf(s2 * (1.0f / 128.0f) - mu * mu, 0.f), rs = 1.0f / sqrtf(var + EPS);
            const size_t tok = tok0 + i;
            u32x2 gwv[8]; f32x4 ggv[8];
#pragma unroll
            for (int nb = 0; nb < 8; ++nb) { gwv[nb] = ld_nt((const u32x2*)(GB + tok * 512 + h * 128 + 16 * nb + 4 * fq)); ggv[nb] = *(const f32x4*)(gn_gain + h * 128 + 16 * nb + 4 * fq); }
#pragma unroll
            for (int nb = 0; nb < 8; ++nb) {
                const int d = 16 * nb + 4 * fq;
                const u32x2 gw = gwv[nb];
                const f32x4 gg = ggv[nb];
                const float g0 = bf_lo(gw.x), g1 = bf_hi(gw.x), g2 = bf_lo(gw.y), g3 = bf_hi(gw.y);
                const float y0 = (a1[nb][0] - mu) * rs * gg[0] * (g0 * fsigm(g0));
                const float y1 = (a1[nb][1] - mu) * rs * gg[1] * (g1 * fsigm(g1));
                const float y2 = (a1[nb][2] - mu) * rs * gg[2] * (g2 * fsigm(g2));
                const float y3 = (a1[nb][3] - mu) * rs * gg[3] * (g3 * fsigm(g3));
                u32x2 w; w.x = cvt_pk_bf16(y0, y1); w.y = cvt_pk_bf16(y2, y3);
                *(u32x2*)(YMIX + tok * 1024 + h * 128 + d) = w;
            }
            __syncthreads();
        }
        }
    }
#undef R3_ISSUE_QK
#undef R3_ISSUE_VR
    SEAM(4);

    if (IN(5)) for (int rep = 0; rep < REPS(5); ++rep) {
        pg8::Gemm g{YSSM, WGLU, 512, 512, 512, 0, 0}; pg8::StaticOrder S; S.init(T, 1024, G, bx);
        pg8::EpiGlu E{YMIX};
        pg8::gemm_phase(lds, g, S, E);
    }
    SEAM(5);

    if (IN(6)) for (int rep = 0; rep < REPS(6); ++rep) {
        pg8::Gemm g{YMIX, WOUT, DM, DM, DM, 0, 0}; pg8::StaticOrder S; S.init(T, DM, G, bx);
        pg8::EpiSS E{MIXB, SS};
        pg8::gemm_phase(lds, g, S, E);
    }
    SEAM(6);

    if (IN(7)) for (int rep = 0; rep < REPS(7); ++rep) {
        const int gw = bx * 8 + wave, NGW = G * 8;
        const f32x4* gr = (const f32x4*)g_mix_post + lane;
        f32x4 gv[4];
#pragma unroll
        for (int j = 0; j < 4; ++j) gv[j] = gr[64 * j];
        for (int m0 = gw; m0 < T; m0 += 2 * NGW) {
            f32x4 xv[2][4]; u32x2 mw[2][4]; float rs[2];
#pragma unroll
            for (int r = 0; r < 2; ++r) {
                const int m = (m0 + r * NGW < T) ? m0 + r * NGW : m0;
                const f32x4 pa = *((const f32x4*)(SS + (size_t)m * 16) + (lane & 3));
                float sa = (pa[0] + pa[1]) + (pa[2] + pa[3]); sa += __shfl_xor(sa, 1); sa += __shfl_xor(sa, 2);
                rs[r] = 1.0f / sqrtf(sa * (1.0f / DM) + EPS);
                const u32x2* xr = (const u32x2*)(XN + (size_t)m * DM) + lane; const u32x2* mr = (const u32x2*)(MIXB + (size_t)m * DM) + lane;
                const float xs = XSC[m];
#pragma unroll
                for (int j = 0; j < 4; ++j) { const u32x2 xw = ld_nt(xr + 64 * j); xv[r][j] = (f32x4){bf_lo(xw.x) * xs, bf_hi(xw.x) * xs, bf_lo(xw.y) * xs, bf_hi(xw.y) * xs}; mw[r][j] = ld_nt(mr + 64 * j); }
            }
#pragma unroll
            for (int r = 0; r < 2; ++r) {
                const int m = m0 + r * NGW;
                if (m < T) {
                    float sq = 0.f;
#pragma unroll
                    for (int j = 0; j < 4; ++j) {
                        f32x4& v = xv[r][j];
                        v[0] += bf_lo(mw[r][j].x) * rs[r] * gv[j][0]; v[1] += bf_hi(mw[r][j].x) * rs[r] * gv[j][1];
                        v[2] += bf_lo(mw[r][j].y) * rs[r] * gv[j][2]; v[3] += bf_hi(mw[r][j].y) * rs[r] * gv[j][3];
                        sq += (v[0] * v[0] + v[1] * v[1]) + (v[2] * v[2] + v[3] * v[3]);
                    }
                    const float rstd1 = 1.0f / sqrtf(wave_sum(sq) * (1.0f / DM) + EPS);
                    u32x2* o8 = (u32x2*)(XN + (size_t)m * DM) + lane;
#pragma unroll
                    for (int j = 0; j < 4; ++j) { const f32x4 v = xv[r][j]; u32x2 w; w.x = cvt_pk_bf16(v[0] * rstd1, v[1] * rstd1); w.y = cvt_pk_bf16(v[2] * rstd1, v[3] * rstd1); o8[64 * j] = w; }
                }
            }
        }
    }
    SEAM(7);

    if (IN(8)) for (int rep = 0; rep < REPS(8); ++rep) {
        pg8::Gemm g{XN, WFF1, DM, DM, DM, 0, 0}; pg8::StaticOrder S; S.init(T, DFF, G, bx);
        pg8::EpiRelu2 E{HID};
        pg8::gemm_phase(lds, g, S, E);
    }
    SEAM(8);

    if (IN(9)) for (int rep = 0; rep < REPS(9); ++rep) {
        pg8::Gemm g{HID, WFF2, DFF, DFF, DFF, 0, 0}; pg8::StaticOrder S; S.init(T, DM, G, bx);
        pg8::EpiSS E{MB, SS2};
        pg8::gemm_phase(lds, g, S, E);
    }
    SEAM(9);

    if (IN(10)) {
        const int gw = bx * 8 + wave, NGW = G * 8;
        const f32x4* g1r = (const f32x4*)g_mix_post + lane; const f32x4* g2r = (const f32x4*)g_mlp_post + lane;
        f32x4 ga[4], gb[4];
#pragma unroll
        for (int j = 0; j < 4; ++j) { ga[j] = g1r[64 * j]; gb[j] = g2r[64 * j]; }
        for (int m0 = gw; m0 < T; m0 += 2 * NGW) {
            f32x4 xv[2][4]; u32x2 aw[2][4], mw[2][4]; float r1[2], r2[2];
#pragma unroll
            for (int r = 0; r < 2; ++r) {
                const int m = (m0 + r * NGW < T) ? m0 + r * NGW : m0;
                const f32x4 pa = *((const f32x4*)(SS + (size_t)m * 16) + (lane & 3)), pb = *((const f32x4*)(SS2 + (size_t)m * 16) + (lane & 3));
                float sa = (pa[0] + pa[1]) + (pa[2] + pa[3]), sb = (pb[0] + pb[1]) + (pb[2] + pb[3]);
                sa += __shfl_xor(sa, 1); sa += __shfl_xor(sa, 2); sb += __shfl_xor(sb, 1); sb += __shfl_xor(sb, 2);
                r1[r] = 1.0f / sqrtf(sa * (1.0f / DM) + EPS); r2[r] = 1.0f / sqrtf(sb * (1.0f / DM) + EPS);
                const f32x4* xr = (const f32x4*)(x + (size_t)m * DM) + lane;
                const u32x2* ar = (const u32x2*)(MIXB + (size_t)m * DM) + lane; const u32x2* mr = (const u32x2*)(MB + (size_t)m * DM) + lane;
#pragma unroll
                for (int j = 0; j < 4; ++j) { xv[r][j] = ld_nt(xr + 64 * j); aw[r][j] = ld_nt(ar + 64 * j); mw[r][j] = ld_nt(mr + 64 * j); }
            }
#pragma unroll
            for (int r = 0; r < 2; ++r) {
                const int m = m0 + r * NGW;
                if (m < T) {
                    f32x4* orow = (f32x4*)(out + (size_t)m * DM) + lane;
#pragma unroll
                    for (int j = 0; j < 4; ++j) {
                        f32x4 v = xv[r][j];
                        v[0] = (v[0] + bf_lo(aw[r][j].x) * r1[r] * ga[j][0]) + bf_lo(mw[r][j].x) * r2[r] * gb[j][0]; v[1] = (v[1] + bf_hi(aw[r][j].x) * r1[r] * ga[j][1]) + bf_hi(mw[r][j].x) * r2[r] * gb[j][1];
                        v[2] = (v[2] + bf_lo(aw[r][j].y) * r1[r] * ga[j][2]) + bf_lo(mw[r][j].y) * r2[r] * gb[j][2]; v[3] = (v[3] + bf_hi(aw[r][j].y) * r1[r] * ga[j][3]) + bf_hi(mw[r][j].y) * r2[r] * gb[j][3];
                        st_nt(orow + 64 * j, v);
                    }
                }
            }
        }
    }
#undef IN
#undef SEAM
}

extern "C" void kernel_launch(void* const* d_in, const int* in_sizes, int n_in, void* d_out, int out_size, void* d_ws, size_t ws_size, hipStream_t stream) {
    static int grid = 0;
    if (grid == 0) {
        int dev = 0, cus = 0, per_cu = 0;
        hipGetDevice(&dev);
        hipDeviceGetAttribute(&cus, hipDeviceAttributeMultiprocessorCount, dev);
        hipFuncSetAttribute((const void*)fwd_kernel, hipFuncAttributeMaxDynamicSharedMemorySize, LDS_BYTES);
        if (hipOccupancyMaxActiveBlocksPerMultiprocessor(&per_cu, (const void*)fwd_kernel, 512, LDS_BYTES) != hipSuccess || per_cu < 1) per_cu = 1;
        (void)hipGetLastError();
        grid = cus * per_cu;
        if (grid <= 0) grid = 256;
    }
    Args a{};
    for (int i = 0; i < 19; ++i) a.in[i] = (const float*)d_in[i];
    a.out = (float*)d_out; a.ws = (unsigned char*)d_ws;
#if N_LAUNCH_PER_PHASE
    for (int ph = 0; ph < NPHASE; ++ph) {
        a.ph_lo = ph; a.ph_hi = ph + 1;
        void* args[] = {&a};
        hipError_t e = hipLaunchCooperativeKernel((const void*)fwd_kernel, dim3(grid), dim3(512), args, LDS_BYTES, stream);
        if (e != hipSuccess) { fprintf(stderr, "cooperative launch (phase %d) failed: %s (grid %d)\n", ph, hipGetErrorString(e), grid); break; }
    }
#else
    a.ph_lo = 0; a.ph_hi = NPHASE;
    (void)hipMemsetAsync(d_ws, 0, 16384, stream);
    void* args[] = {&a};
    hipError_t e = hipLaunchCooperativeKernel((const void*)fwd_kernel, dim3(grid), dim3(512), args, LDS_BYTES, stream);
    if (e != hipSuccess) fprintf(stderr, "cooperative launch failed: %s (grid %d)\n", hipGetErrorString(e), grid);
#ifdef PROBE_EXTRA_PHASE
    {
        Args b = a; b.ph_lo = PROBE_EXTRA_PHASE; b.ph_hi = PROBE_EXTRA_PHASE + 1;
        void* args2[] = {&b};
        (void)hipLaunchCooperativeKernel((const void*)fwd_kernel, dim3(grid), dim3(512), args2, LDS_BYTES, stream);
    }
#endif
#endif
}
```
